# Optimizing an MI355X kernel written in HIP

```python
import jax, jax.numpy as jnp
from jax import lax
import numpy as np

D_MODEL = 1024
BATCH = 8
SEQ = 4096
DEPTH = 1

ATTN_HEADS = 8
ATTN_HEAD_DIM = 64
RET_HEADS = 8
RET_KEY_DIM = 64
RET_VALUE_DIM = 64
ATTN_WIDTH = ATTN_HEADS * ATTN_HEAD_DIM
RET_KEY_WIDTH = RET_HEADS * RET_KEY_DIM
RET_WIDTH = RET_HEADS * RET_VALUE_DIM
MIX_WIDTH = ATTN_WIDTH + RET_WIDTH
IN_PROJ_WIDTH = 3 * ATTN_WIDTH + 2 * RET_KEY_WIDTH + 2 * RET_WIDTH

DILATED_BRANCHES = ((128, 1), (512, 4), (2048, 16))
ROPE_THETA = 500000.0
ROPE_DIM = ATTN_HEAD_DIM // 4

RET_THETA = 10000.0
RET_CHUNK = 128
RET_DECAY_BASE = 5.0

MOE_GROUPS = 4
EXPERTS_PER_GROUP = 8
N_EXPERTS = MOE_GROUPS * EXPERTS_PER_GROUP
EXPERT_FF = D_MODEL // 2
MOE_TOP_K = 2
MOE_BLOCK = 256

NORM_EPS = 1e-6
NEG_INF = -1e30

kernel_name = "hymba_dilated_retention_hiermoe_encoder"


def rms_norm(x, gain):
    xf = x.astype(jnp.float32)
    y = xf * lax.rsqrt(jnp.mean(xf * xf, axis=-1, keepdims=True) + NORM_EPS)
    return (y * gain.astype(jnp.float32)).astype(x.dtype)


def apply_rotary(t, pos, freqs):
    half = freqs.shape[0]
    ang = pos[:, None] * freqs[None, :]
    cos, sin = jnp.cos(ang), jnp.sin(ang)
    t1, t2, rest = t[..., :half], t[..., half:2 * half], t[..., 2 * half:]
    return jnp.concatenate([t1 * cos - t2 * sin, t2 * cos + t1 * sin, rest], axis=-1)


def dilated_window_branch(q, k, v, window, dilation):
    b, h, s, dh = q.shape
    reach = (window // 2) // dilation
    blk = reach
    length = s // dilation
    nb = -(-length // blk)
    lp = nb * blk

    def by_stride(t):
        t = t.reshape(b, h, length, dilation, dh).transpose(0, 1, 3, 2, 4)
        return jnp.pad(t, ((0, 0), (0, 0), (0, 0), (0, lp - length), (0, 0)))

    def neighbours(t):
        t = jnp.pad(t, ((0, 0), (0, 0), (0, 0), (blk, blk), (0, 0)))
        t = t.reshape(b, h, dilation, nb + 2, blk, dh)
        return jnp.concatenate([t[:, :, :, :-2], t[:, :, :, 1:-1], t[:, :, :, 2:]], axis=-2)

    qb = by_stride(q).reshape(b, h, dilation, nb, blk, dh)
    kn = neighbours(by_stride(k))
    vn = neighbours(by_stride(v))

    t_idx = jnp.arange(blk)[:, None]
    u_idx = jnp.arange(3 * blk)[None, :]
    key_pos = (jnp.arange(nb)[:, None, None] - 1) * blk + u_idx
    offset = u_idx - blk - t_idx
    valid = (jnp.abs(offset) <= reach)[None] & (key_pos >= 0) & (key_pos < length)

    scores = jnp.einsum('bhrjtd,bhrjud->bhrjtu', qb, kn)
    scores = jnp.where(valid, scores, NEG_INF)
    m = jnp.max(scores, axis=-1, keepdims=True)
    p = jnp.exp(scores - m)
    denom = jnp.sum(p, axis=-1, keepdims=True)
    o = jnp.einsum('bhrjtu,bhrjud->bhrjtd', p, vn) / denom
    lse = (m + jnp.log(denom))[..., 0]

    o = o.reshape(b, h, dilation, lp, dh)[:, :, :, :length]
    o = o.transpose(0, 1, 3, 2, 4).reshape(b, h, s, dh)
    lse = lse.reshape(b, h, dilation, lp)[:, :, :, :length]
    lse = lse.transpose(0, 1, 3, 2).reshape(b, h, s)
    return o, lse


def dilated_attention(q, k, v):
    outs, lses = [], []
    for window, dilation in DILATED_BRANCHES:
        o, lse = dilated_window_branch(q, k, v, window, dilation)
        outs.append(o)
        lses.append(lse)
    weights = jax.nn.softmax(jnp.stack(lses), axis=0)
    return jnp.einsum('nbhs,nbhsd->bhsd', weights, jnp.stack(outs))


def retention_chunkwise(q, k, v, log_gamma, include_diag):
    b, h, s, dk = q.shape
    dv = v.shape[-1]
    c = RET_CHUNK
    n = s // c
    qc = q.reshape(b, h, n, c, dk)
    kc = k.reshape(b, h, n, c, dk)
    vc = v.reshape(b, h, n, c, dv)
    idx = jnp.arange(c, dtype=jnp.float32)
    diff = idx[:, None] - idx[None, :]
    mask = (diff >= 0) if include_diag else (diff > 0)
    decay = jnp.where(mask, jnp.exp(jnp.maximum(diff, 0.0) * log_gamma[:, None, None]), 0.0)
    inner = jnp.einsum('bhnid,bhnjd->bhnij', qc, kc) * decay[:, None]
    o_inner = jnp.einsum('bhnij,bhnje->bhnie', inner, vc)

    k_decay = jnp.exp((c - 1 - idx)[None, :] * log_gamma[:, None])
    q_decay = jnp.exp((idx + 1)[None, :] * log_gamma[:, None])
    chunk_kv = jnp.einsum('bhnjd,bhnje->nbhde', kc * k_decay[:, None, :, None], vc)
    chunk_decay = jnp.exp(c * log_gamma)[:, None, None]

    def step(state, kv):
        return state * chunk_decay + kv, state

    _, prev_states = lax.scan(step, jnp.zeros((b, h, dk, dv), jnp.float32), chunk_kv)
    o_cross = jnp.einsum('bhnid,nbhde->bhnie', qc * q_decay[:, None, :, None], prev_states)
    return (o_inner + o_cross).reshape(b, h, s, dv)


def hybrid_mixer(xn, w_in, attn_out_gain, ret_decay_fwd, ret_decay_bwd, ret_out_gain, w_out):
    b, s, _ = xn.shape
    proj = (xn @ w_in).astype(jnp.float32)
    cuts = np.cumsum([ATTN_WIDTH, ATTN_WIDTH, ATTN_WIDTH, RET_KEY_WIDTH, RET_KEY_WIDTH, RET_WIDTH]).tolist()
    qa, ka, va, qr, kr, vr, gr = jnp.split(proj, cuts, axis=-1)

    def heads(t, n_heads):
        return t.reshape(b, s, n_heads, -1).transpose(0, 2, 1, 3)

    pos = jnp.arange(s, dtype=jnp.float32)

    rope_freqs = ROPE_THETA ** (-jnp.arange(0, ROPE_DIM, 2, dtype=jnp.float32) / ROPE_DIM)
    qa = apply_rotary(heads(qa, ATTN_HEADS), pos, rope_freqs) * (ATTN_HEAD_DIM ** -0.5)
    ka = apply_rotary(heads(ka, ATTN_HEADS), pos, rope_freqs)
    oa = dilated_attention(qa, ka, heads(va, ATTN_HEADS))
    oa = rms_norm(oa.transpose(0, 2, 1, 3).reshape(b, s, ATTN_WIDTH), attn_out_gain)

    ret_freqs = RET_THETA ** (-jnp.linspace(0.0, 1.0, RET_KEY_DIM // 2, dtype=jnp.float32))
    qr = apply_rotary(heads(qr, RET_HEADS), pos, ret_freqs)
    kr = apply_rotary(heads(kr, RET_HEADS), pos, ret_freqs) * (RET_KEY_DIM ** -0.5)
    vr = heads(vr, RET_HEADS)
    lg_f = jnp.log1p(-jnp.exp2(ret_decay_fwd.astype(jnp.float32)))
    lg_b = jnp.log1p(-jnp.exp2(ret_decay_bwd.astype(jnp.float32)))
    o_f = retention_chunkwise(qr, kr, vr, lg_f, True)
    o_b = jnp.flip(retention_chunkwise(jnp.flip(qr, 2), jnp.flip(kr, 2), jnp.flip(vr, 2), lg_b, False), 2)
    orr = o_f + o_b
    mu = jnp.mean(orr, axis=-1, keepdims=True)
    var = jnp.mean(jnp.square(orr - mu), axis=-1, keepdims=True)
    orr = (orr - mu) * lax.rsqrt(var + NORM_EPS)
    orr = orr.transpose(0, 2, 1, 3).reshape(b, s, RET_WIDTH)
    orr = orr * ret_out_gain.astype(jnp.float32) * jax.nn.silu(gr)

    mixed = jnp.concatenate([oa.astype(jnp.float32), orr], axis=-1).astype(xn.dtype)
    return mixed @ w_out


def hierarchical_moe(xn, w_route_group, b_route_group, w_route_expert, b_route_expert,
                     w_expert_gate, w_expert_up, w_expert_down):
    b, s, d = xn.shape
    t = b * s
    xt = xn.reshape(t, d)
    xf = xt.astype(jnp.float32)
    group_prob = jax.nn.softmax(xf @ w_route_group.astype(jnp.float32)
                                + b_route_group.astype(jnp.float32), axis=-1)
    group_idx = jnp.argmax(group_prob, axis=-1).astype(jnp.int32)
    group_gate = jnp.take_along_axis(group_prob, group_idx[:, None], axis=-1)
    expert_logits = (xf @ w_route_expert.astype(jnp.float32)
                     + b_route_expert.astype(jnp.float32)).reshape(t, MOE_GROUPS, EXPERTS_PER_GROUP)
    in_group = jnp.take_along_axis(expert_logits, group_idx[:, None, None], axis=1)[:, 0]
    top_logits, top_idx = lax.top_k(in_group, MOE_TOP_K)
    gates = group_gate * jax.nn.softmax(top_logits, axis=-1)

    expert_ids = (group_idx[:, None] * EXPERTS_PER_GROUP + top_idx).reshape(-1).astype(jnp.int32)
    token_ids = jnp.repeat(jnp.arange(t, dtype=jnp.int32), MOE_TOP_K)
    gate_flat = gates.reshape(-1)
    n_assign = t * MOE_TOP_K
    n_blocks = -(-n_assign // MOE_BLOCK) + N_EXPERTS
    n_slots = n_blocks * MOE_BLOCK

    counts = jax.ops.segment_sum(jnp.ones((n_assign,), jnp.int32), expert_ids, num_segments=N_EXPERTS)
    padded = ((counts + MOE_BLOCK - 1) // MOE_BLOCK) * MOE_BLOCK
    pad_end = jnp.cumsum(padded)
    pad_start = pad_end - padded
    start = jnp.cumsum(counts) - counts
    order = jnp.argsort(expert_ids)
    sorted_e = expert_ids[order]
    dest = pad_start[sorted_e] + (jnp.arange(n_assign, dtype=jnp.int32) - start[sorted_e])
    slot_tok = jnp.full((n_slots,), t, jnp.int32).at[dest].set(token_ids[order])
    slot_gate = jnp.zeros((n_slots,), jnp.float32).at[dest].set(gate_flat[order])
    block_start = jnp.arange(n_blocks, dtype=jnp.int32) * MOE_BLOCK
    block_expert = jnp.clip(jnp.searchsorted(pad_end, block_start, side='right'), 0, N_EXPERTS - 1)

    x_pad = jnp.concatenate([xt, jnp.zeros((1, d), xt.dtype)], axis=0)
    xs = x_pad[slot_tok].reshape(n_blocks, MOE_BLOCK, d)

    def expert_block(args):
        xb, e = args
        hid = jax.nn.silu(xb @ w_expert_gate[e]) * (xb @ w_expert_up[e])
        return hid @ w_expert_down[e]

    ys = lax.map(expert_block, (xs, block_expert)).reshape(n_slots, d)
    out = jax.ops.segment_sum(ys * slot_gate[:, None].astype(ys.dtype), slot_tok, num_segments=t + 1)[:t]
    return out.reshape(b, s, d)


def setup_inputs(seed: int = 0) -> dict:
    key = jax.random.key(seed)
    ks = jax.random.split(key, 20)
    f32 = jnp.float32
    nrm = lambda k, shape, scale: jax.random.normal(k, shape, f32) * scale
    decay_base = -(RET_DECAY_BASE + jnp.arange(RET_HEADS, dtype=f32))
    return {
        "x": nrm(ks[0], (BATCH, SEQ, D_MODEL), 1.0),
        "mix_norm_gain": 1.0 + nrm(ks[1], (DEPTH, D_MODEL), 0.02),
        "w_in": nrm(ks[2], (DEPTH, D_MODEL, IN_PROJ_WIDTH), D_MODEL ** -0.5),
        "attn_out_gain": 1.0 + nrm(ks[3], (DEPTH, ATTN_WIDTH), 0.02),
        "ret_decay_fwd": decay_base + nrm(ks[4], (DEPTH, RET_HEADS), 0.1),
        "ret_decay_bwd": decay_base + nrm(ks[5], (DEPTH, RET_HEADS), 0.1),
        "ret_out_gain": 1.0 + nrm(ks[6], (DEPTH, RET_WIDTH), 0.02),
        "w_out": nrm(ks[7], (DEPTH, MIX_WIDTH, D_MODEL), MIX_WIDTH ** -0.5),
        "ffn_norm_gain": 1.0 + nrm(ks[8], (DEPTH, D_MODEL), 0.02),
        "w_route_group": nrm(ks[9], (DEPTH, D_MODEL, MOE_GROUPS), D_MODEL ** -0.5),
        "b_route_group": nrm(ks[10], (DEPTH, MOE_GROUPS), 0.01),
        "w_route_expert": nrm(ks[11], (DEPTH, D_MODEL, N_EXPERTS), D_MODEL ** -0.5),
        "b_route_expert": nrm(ks[12], (DEPTH, N_EXPERTS), 0.01),
        "w_expert_gate": nrm(ks[13], (DEPTH, N_EXPERTS, D_MODEL, EXPERT_FF), D_MODEL ** -0.5),
        "w_expert_up": nrm(ks[14], (DEPTH, N_EXPERTS, D_MODEL, EXPERT_FF), D_MODEL ** -0.5),
        "w_expert_down": nrm(ks[15], (DEPTH, N_EXPERTS, EXPERT_FF, D_MODEL), EXPERT_FF ** -0.5),
        "final_norm_gain": 1.0 + nrm(ks[16], (D_MODEL,), 0.02),
    }


def reference(x, mix_norm_gain, w_in, attn_out_gain, ret_decay_fwd, ret_decay_bwd, ret_out_gain,
              w_out, ffn_norm_gain, w_route_group, b_route_group, w_route_expert, b_route_expert,
              w_expert_gate, w_expert_up, w_expert_down, final_norm_gain):
    h = x
    for l in range(DEPTH):
        hn = rms_norm(h, mix_norm_gain[l])
        h = h + hybrid_mixer(hn, w_in[l], attn_out_gain[l], ret_decay_fwd[l], ret_decay_bwd[l],
                             ret_out_gain[l], w_out[l]).astype(h.dtype)
        hn = rms_norm(h, ffn_norm_gain[l])
        h = h + hierarchical_moe(hn, w_route_group[l], b_route_group[l], w_route_expert[l],
                                 b_route_expert[l], w_expert_gate[l], w_expert_up[l],
                                 w_expert_down[l]).astype(h.dtype)
    return rms_norm(h, final_norm_gain)
```

```cpp
#include <hip/hip_runtime.h>
#include <cstdio>
#include <cstdint>
#include <cmath>

#ifndef MK_N_LAUNCHES
#define MK_N_LAUNCHES 1
#endif
#ifndef MK_CHECK
#define MK_CHECK 0
#endif

#define LAS __attribute__((address_space(3)))
#define GAS __attribute__((address_space(1)))
typedef unsigned short bf16;
typedef short bf16x8 __attribute__((ext_vector_type(8)));
typedef short s16x4 __attribute__((ext_vector_type(4)));
typedef float f32x2 __attribute__((ext_vector_type(2)));
typedef float f32x4 __attribute__((ext_vector_type(4)));
typedef float f32x16 __attribute__((ext_vector_type(16)));
typedef unsigned u32x2 __attribute__((ext_vector_type(2)));
typedef unsigned u32x4 __attribute__((ext_vector_type(4)));
typedef __bf16 bf16x2_t __attribute__((ext_vector_type(2)));
typedef GAS unsigned gu32;

constexpr int NBATCH = 8, SEQ = 4096, DM = 1024, M = NBATCH * SEQ;
constexpr int NIN = 3584, SEGW = 512, NHEAD = 8, HD = 64;
constexpr int NEXP = 32, FF = 512, NGRP = 4, EPG = 8;
constexpr int CHUNK = 128, NCHUNK = SEQ / CHUNK;
constexpr float NORM_EPS = 1e-6f;
constexpr float LOG2E = 1.4426950408889634f, LN2 = 0.6931471805599453f;
constexpr int NWAVES = 8;
constexpr int MAXTILES = 288;

constexpr size_t MiB = 1u << 20;
constexpr size_t WS_CTL = 0, CTL_ZERO_BYTES = 1 * MiB;
constexpr size_t WS_WRT = 1 * MiB;
constexpr size_t WS_ROPE = 2 * MiB;
constexpr size_t WS_LSE = 4 * MiB;
constexpr size_t WS_LIST = 8 * MiB;
constexpr size_t WS_GATEL = 12 * MiB;
constexpr size_t WS_RSL = 16 * MiB;
constexpr size_t WS_WIN = 20 * MiB;
constexpr size_t WS_WOUT = 27 * MiB;
constexpr size_t WS_WD = 30 * MiB;
constexpr size_t WS_WGU = 62 * MiB;
constexpr size_t WS_ST = 126 * MiB;
constexpr size_t WS_XN = 158 * MiB;
constexpr size_t WS_OBR = 158 * MiB;
constexpr size_t WS_SEG = 254 * MiB;
constexpr size_t SEG_BYTES = (size_t)M * SEGW * 2;
constexpr size_t WS_MIXED = 254 * MiB;
constexpr size_t WS_H = 350 * MiB;
constexpr size_t WS_HG = 158 * MiB;
constexpr size_t WS_HID = 222 * MiB;
constexpr size_t WS_Y = 64 * MiB;
constexpr size_t WS_END = 478 * MiB;
constexpr int CW_CNT = 64;
constexpr int CW_BAR = 4096;
constexpr int CW_CHK = 16384;

constexpr int RING_BYTES = 131072;
constexpr int LDSCTL_OFF = RING_BYTES, MISC_OFF = LDSCTL_OFF + 320;
constexpr int TILE_OFF = MISC_OFF + 128;
constexpr int LDS_BYTES = 147456;

#define RLX_AGENT __ATOMIC_RELAXED, __HIP_MEMORY_SCOPE_AGENT
#define LDS_WAIT() asm volatile("s_waitcnt lgkmcnt(0)" ::: "memory")
#define VM_WAIT() asm volatile("s_waitcnt vmcnt(0)" ::: "memory")
__device__ __forceinline__ unsigned pk2(float lo, float hi) { f32x2 v = {lo, hi}; bf16x2_t b = __builtin_convertvector(v, bf16x2_t); return __builtin_bit_cast(unsigned, b); }
__device__ __forceinline__ float bflo(unsigned u) { return __uint_as_float(u << 16); }
__device__ __forceinline__ float bfhi(unsigned u) { return __uint_as_float(u & 0xffff0000u); }
__device__ __forceinline__ float bf2f(short s) { return __uint_as_float(((unsigned)(unsigned short)s) << 16); }
__device__ __forceinline__ int crow(int r, int hi) { return (r & 3) + 8 * (r >> 2) + 4 * hi; }
__device__ __forceinline__ float wave_sum(float v) {
#pragma unroll
    for (int o = 1; o < 64; o <<= 1) v += __shfl_xor(v, o);
    return v;
}
__device__ __forceinline__ float silu_f(float v) { return v / (1.f + __expf(-v)); }

namespace pg8 {
constexpr int BM = 256, BK = 64, HALF = 128, HTB = HALF * BK * 2, STAGE_BYTES = 8 * HTB, NXCD = 8, WGM = 8;
__host__ __device__ __forceinline__ int lds_byte(int r, int c) { const int st = (r >> 4) * 2 + (c >> 5), rr = r & 15, cc = c & 31, ob = rr * 64 + cc * 2; return st * 1024 + (ob ^ (((ob >> 9) & 1) << 5)); }
__host__ __device__ __forceinline__ void stage_rc(int b, int& R, int& C) { const int st = b / 1024, sb = b % 1024, swz = sb ^ (((sb >> 9) & 1) << 5); R = (st >> 1) * 16 + swz / 64; C = (st & 1) * 32 + (swz % 64) / 2; }
__host__ __device__ __forceinline__ int perm32(int rho) { const int n = rho >> 4, i = rho & 15; return 8 * (i >> 2) + 4 * n + (i & 3); }

struct Unit { int pm, pn; };
struct StaticOrder {
    int nM, nN, nwg, G, c;
    __device__ void init(int nM_, int nN_, int G_, int c_) { nM = nM_; nN = nN_; nwg = nM * nN; G = G_; c = c_; }
    __device__ bool next(int i, Unit& u) const {
        const long L = (long)i * G + c; if (L >= nwg) return false;
        int wgid = (int)L; { const int q = nwg / NXCD, r = nwg % NXCD, xcd = wgid % NXCD, off = wgid / NXCD; wgid = (xcd < r ? xcd * (q + 1) : r * (q + 1) + (xcd - r) * q) + off; }
        const int nig = WGM * nN, gid = wgid / nig, fm = gid * WGM, gsz = (nM - fm) < WGM ? (nM - fm) : WGM;
        u.pm = fm + ((wgid % nig) % gsz); u.pn = (wgid % nig) / gsz; return true;
    }
};

template <class Epi, class Sched, class Src, bool ALIGN_EPI, bool SP2>
__device__ __forceinline__ void gemm_phase(LAS unsigned char* lds, const int K, const Sched& S, const Src& SRC, const Epi& E) {
    const int tid = threadIdx.x, wid = __builtin_amdgcn_readfirstlane(tid >> 6), lane = tid & 63, wr = wid >> 2, wc = wid & 3, fr = lane & 15, fq = lane >> 4;
    const int nt = K / BK;
    unsigned voffB[2]; int RA[2], CA[2];
#pragma unroll
    for (int i = 0; i < 2; ++i) { int R, C; stage_rc(tid * 16 + i * 8192, R, C); const int Rb = Epi::PERM ? ((R & ~31) + perm32(R & 31)) : R;
        RA[i] = R; CA[i] = C; voffB[i] = (unsigned)(Rb * K + C) * 2u; }
    const size_t kstep = (size_t)(BK * 2);
    const size_t hstep = (size_t)HALF * K * 2;
    const unsigned ldsw = (unsigned)wid * 1024u;
    const int aoff = lds_byte(wr * 64 + fr, fq * 8), boff = lds_byte(wc * 32 + fr, fq * 8);
#define PG8_SA(b, h) (((b) * 2 + (h)) * HTB)
#define PG8_SB(b, h) ((4 + (b) * 2 + (h)) * HTB)
#define PG8_STAGE(bufoff, gbase, voff) do { _Pragma("unroll") for (int _i = 0; _i < 2; ++_i) \
        __builtin_amdgcn_global_load_lds((const unsigned*)((const char*)(gbase) + (voff)[_i]), (LAS unsigned*)(lds + (bufoff) + ldsw + _i * 8192), 16, 0, 0); } while (0)
#define PG8_LDA(dst, b, h) do { _Pragma("unroll") for (int m = 0; m < 4; ++m) _Pragma("unroll") for (int k = 0; k < 2; ++k) dst[m][k] = *(const LAS bf16x8*)(lds + PG8_SA(b, h) + aoff + m * 2048 + k * 1024); } while (0)
#define PG8_LDB(dst, b, h) do { _Pragma("unroll") for (int n = 0; n < 2; ++n) _Pragma("unroll") for (int k = 0; k < 2; ++k) dst[n][k] = *(const LAS bf16x8*)(lds + PG8_SB(b, h) + boff + n * 2048 + k * 1024); } while (0)
#define PG8_MMA(ai, bj, At, Bt) do { __builtin_amdgcn_s_setprio(1); _Pragma("unroll") for (int m = 0; m < 4; ++m) _Pragma("unroll") for (int n = 0; n < 2; ++n) _Pragma("unroll") for (int k = 0; k < 2; ++k) \
        acc[ai][bj][m][n] = __builtin_amdgcn_mfma_f32_16x16x32_bf16(Bt[n][k], At[m][k], acc[ai][bj][m][n], 0, 0, 0); __builtin_amdgcn_s_setprio(0); } while (0)
#define PG8_WAIT_V(n) asm volatile("s_waitcnt vmcnt(" #n ")" ::: "memory")
#define PG8_WAIT_L(n) asm volatile("s_waitcnt lgkmcnt(" #n ")" ::: "memory")
#define PG8_BAR __builtin_amdgcn_s_barrier()
#define PG8_SCHED __builtin_amdgcn_sched_barrier(0)
    Unit cur, nxt; int ui = 0;
    if (!S.next(0, cur)) return;
    f32x4 acc[2][2][4][2];
#pragma unroll
    for (int a = 0; a < 2; ++a)
#pragma unroll
        for (int b = 0; b < 2; ++b)
#pragma unroll
            for (int m = 0; m < 4; ++m)
#pragma unroll
                for (int n = 0; n < 2; ++n) acc[a][b][m][n] = (f32x4){0.f, 0.f, 0.f, 0.f};
    bf16x8 At[4][2], B0[2][2], B1[2][2];
    const char *cA, *cB; unsigned vA0[2], vA1[2];
    SRC.setup(cur, RA, CA, cA, cB, vA0, vA1);
    if constexpr (SP2) {
        PG8_STAGE(PG8_SB(0, 0), cB, voffB); PG8_STAGE(PG8_SB(0, 1), cB + hstep, voffB); PG8_STAGE(PG8_SA(0, 0), cA, vA0); PG8_STAGE(PG8_SA(0, 1), cA, vA1);
        if (wr == 1) PG8_BAR;
        PG8_WAIT_V(2); PG8_BAR;
        PG8_STAGE(PG8_SB(1, 0), cB + kstep, voffB); PG8_STAGE(PG8_SA(1, 0), cA + kstep, vA0); PG8_STAGE(PG8_SB(1, 1), cB + hstep + kstep, voffB);
        PG8_WAIT_V(6); PG8_BAR;
    } else {
        PG8_STAGE(PG8_SB(0, 0), cB, voffB); PG8_STAGE(PG8_SA(0, 0), cA, vA0); PG8_STAGE(PG8_SB(0, 1), cB + hstep, voffB); PG8_STAGE(PG8_SA(0, 1), cA, vA1);
        if (wr == 1) PG8_BAR;
        PG8_WAIT_V(4); PG8_BAR;
        PG8_STAGE(PG8_SB(1, 0), cB + kstep, voffB); PG8_STAGE(PG8_SA(1, 0), cA + kstep, vA0); PG8_STAGE(PG8_SB(1, 1), cB + hstep + kstep, voffB);
        PG8_WAIT_V(6); PG8_BAR;
    }
    for (;;) {
        const bool has_next = S.next(ui + 1, nxt);
        const char *nA = cA, *nB = cB; unsigned wA0[2] = {vA0[0], vA0[1]}, wA1[2] = {vA1[0], vA1[1]};
        if (has_next) SRC.setup(nxt, RA, CA, nA, nB, wA0, wA1);
        for (int t = 0; t < nt; t += 2) {
            const bool last = (t == nt - 2);
            const char* a1 = cA + (size_t)(t + 1) * kstep;
            const char* a2 = last ? nA : cA + (size_t)(t + 2) * kstep; const char* b2 = last ? nB : cB + (size_t)(t + 2) * kstep;
            const char* a3 = a2 + kstep; const char* b3 = b2 + kstep;
            unsigned x0[2], x1[2];
            x0[0] = last ? wA0[0] : vA0[0]; x0[1] = last ? wA0[1] : vA0[1]; x1[0] = last ? wA1[0] : vA1[0]; x1[1] = last ? wA1[1] : vA1[1];
            if constexpr (SP2) {
            PG8_LDB(B0, 0, 0); PG8_LDB(B1, 0, 1); PG8_SCHED; PG8_LDA(At, 0, 0); PG8_STAGE(PG8_SA(1, 1), a1, vA1);
            PG8_WAIT_V(8); PG8_WAIT_L(0); PG8_BAR; PG8_MMA(0, 0, At, B0); PG8_MMA(0, 1, At, B1); PG8_BAR; PG8_SCHED;
            PG8_LDA(At, 0, 1); PG8_STAGE(PG8_SB(0, 0), b2, voffB); PG8_STAGE(PG8_SB(0, 1), b2 + hstep, voffB); PG8_STAGE(PG8_SA(0, 0), a2, x0);
            PG8_WAIT_V(8); PG8_WAIT_L(0); PG8_BAR; PG8_MMA(1, 0, At, B0); PG8_MMA(1, 1, At, B1); PG8_BAR; PG8_SCHED;
            PG8_LDB(B0, 1, 0); PG8_LDB(B1, 1, 1); PG8_SCHED; PG8_LDA(At, 1, 0); PG8_STAGE(PG8_SA(0, 1), a2, x1);
            PG8_WAIT_V(8); PG8_WAIT_L(0); PG8_BAR; PG8_MMA(0, 0, At, B0); PG8_MMA(0, 1, At, B1); PG8_BAR; PG8_SCHED;
            PG8_LDA(At, 1, 1); PG8_STAGE(PG8_SB(1, 0), b3, voffB); PG8_STAGE(PG8_SB(1, 1), b3 + hstep, voffB); PG8_STAGE(PG8_SA(1, 0), a3, x0);
            PG8_WAIT_V(8); PG8_WAIT_L(0); PG8_BAR; PG8_MMA(1, 0, At, B0); PG8_MMA(1, 1, At, B1); PG8_BAR; PG8_SCHED;
            } else {
            PG8_LDB(B0, 0, 0); PG8_SCHED; PG8_LDA(At, 0, 0); PG8_STAGE(PG8_SA(1, 1), a1, vA1);
            PG8_WAIT_L(8); PG8_BAR; PG8_WAIT_L(0); PG8_MMA(0, 0, At, B0); PG8_BAR; PG8_SCHED;
            PG8_LDB(B1, 0, 1); PG8_STAGE(PG8_SB(0, 0), b2, voffB);
            PG8_BAR; PG8_WAIT_L(0); PG8_MMA(0, 1, At, B1); PG8_BAR;
            PG8_LDA(At, 0, 1); PG8_STAGE(PG8_SA(0, 0), a2, x0);
            PG8_BAR; PG8_WAIT_L(0); PG8_MMA(1, 0, At, B0); PG8_BAR; PG8_SCHED;
            PG8_STAGE(PG8_SB(0, 1), b2 + hstep, voffB);
            PG8_WAIT_V(6); PG8_BAR; PG8_MMA(1, 1, At, B1); PG8_BAR;
            PG8_LDB(B0, 1, 0); PG8_SCHED; PG8_LDA(At, 1, 0); PG8_STAGE(PG8_SA(0, 1), a2, x1);
            PG8_WAIT_L(8); PG8_BAR; PG8_WAIT_L(0); PG8_MMA(0, 0, At, B0); PG8_BAR; PG8_SCHED;
            PG8_LDB(B1, 1, 1); PG8_STAGE(PG8_SB(1, 0), b3, voffB);
            PG8_BAR; PG8_WAIT_L(0); PG8_MMA(0, 1, At, B1); PG8_BAR;
            PG8_LDA(At, 1, 1); PG8_STAGE(PG8_SA(1, 0), a3, x0);
            PG8_BAR; PG8_WAIT_L(0); PG8_MMA(1, 0, At, B0); PG8_BAR; PG8_SCHED;
            PG8_STAGE(PG8_SB(1, 1), b3 + hstep, voffB);
            PG8_WAIT_V(6); PG8_BAR; PG8_MMA(1, 1, At, B1); PG8_BAR;
            }
        }
        if constexpr (ALIGN_EPI) { if (wr == 0) PG8_BAR; }
        E(acc, cur, wr, wc, fr, fq);
        if (!has_next) break;
#pragma unroll
        for (int a = 0; a < 2; ++a)
#pragma unroll
            for (int b = 0; b < 2; ++b)
#pragma unroll
                for (int m = 0; m < 4; ++m)
#pragma unroll
                    for (int n = 0; n < 2; ++n) acc[a][b][m][n] = (f32x4){0.f, 0.f, 0.f, 0.f};
        cur = nxt; cA = nA; cB = nB; vA0[0] = wA0[0]; vA0[1] = wA0[1]; vA1[0] = wA1[0]; vA1[1] = wA1[1]; ++ui;
        if constexpr (ALIGN_EPI) { if (wr == 1) PG8_BAR; }
    }
    PG8_WAIT_V(0);
    if constexpr (!ALIGN_EPI) { if (wr == 0) PG8_BAR; }
    PG8_BAR;
#undef PG8_SA
#undef PG8_SB
#undef PG8_STAGE
#undef PG8_LDA
#undef PG8_LDB
#undef PG8_MMA
#undef PG8_WAIT_V
#undef PG8_WAIT_L
#undef PG8_BAR
#undef PG8_SCHED
}
}

#define XB_TMO      128
#define XB_XCNT(j)  (256  + 64 * (j))
#define XB_XSUB(j)  (1280 + 64 * (j))
#define XB_XGEN(j)  (2304 + 64 * (j))
#define XB_TOP      3328
#define XB_TOPGEN   3392
#define XCD_BAR_WORDS 3456
#define XB_SPIN_CAP (1u << 18)
__device__ __forceinline__ unsigned xb_ld(unsigned* p)              { return __hip_atomic_load(p, __ATOMIC_RELAXED, __HIP_MEMORY_SCOPE_AGENT); }
__device__ __forceinline__ unsigned xb_add(unsigned* p, unsigned v) { return __hip_atomic_fetch_add(p, v, __ATOMIC_RELAXED, __HIP_MEMORY_SCOPE_AGENT); }
__device__ __forceinline__ unsigned xb_xcc_id() { return (unsigned)__builtin_amdgcn_s_getreg((3 << 11) | 20) & 0xFu; }
#define XB_SPIN(cond, bar) do { unsigned _sp = 0; while (cond) { __builtin_amdgcn_s_sleep(1); \
    if ((++_sp & 255u) == 0u) { if (xb_ld(&(bar)[XB_TMO])) break; if (_sp > XB_SPIN_CAP) { atomicAdd(&(bar)[XB_TMO], 1u); break; } } } } while (0)
struct XcdBarrier { unsigned* bar; unsigned x; volatile LAS unsigned* st; };
__device__ __forceinline__ XcdBarrier xcd_barrier_post(unsigned* bar, volatile LAS unsigned* st) {
    XcdBarrier b; b.bar = bar; b.x = xb_xcc_id(); b.st = st;
    if (threadIdx.x == 0) (void)xb_add(&bar[XB_XCNT(b.x)], 1u);
    return b;
}
__device__ __forceinline__ void xcd_barrier_complete(unsigned* bar, unsigned x, unsigned& nloc, unsigned& nx) {
    const unsigned G = gridDim.x * gridDim.y * gridDim.z;
    unsigned sum, cnt, mine, sp = 0u;
    for (;;) {
        sum = 0u; cnt = 0u; mine = 0u;
#pragma unroll
        for (unsigned j = 0; j < 16; ++j) { const unsigned c = xb_ld(&bar[XB_XCNT(j)]); sum += c; cnt += (c > 0u) ? 1u : 0u; mine = (j == x) ? c : mine; }
        if (sum == G) break;
        __builtin_amdgcn_s_sleep(1);
        if ((++sp & 255u) == 0u) { if (xb_ld(&bar[XB_TMO])) break; if (sp > XB_SPIN_CAP) { atomicAdd(&bar[XB_TMO], 1u); break; } }
    }
    nloc = mine > 0u ? mine : 1u; nx = cnt > 0u ? cnt : 1u;
}
__device__ __forceinline__ void xcd_barrier(const XcdBarrier& b) {
    asm volatile("s_waitcnt vmcnt(0)" ::: "memory");
    __syncthreads();
    if (threadIdx.x == 0) {
        unsigned* bar = b.bar;
        __builtin_amdgcn_s_waitcnt(0);
        unsigned nloc = b.st[0], nx = b.st[1];
        if (nloc == 0u) { xcd_barrier_complete(bar, b.x, nloc, nx); b.st[0] = nloc; b.st[1] = nx; }
        const unsigned old = xb_add(&bar[XB_XSUB(b.x)], 1u);
        const unsigned gen = old / nloc;
        if (old + 1u == (gen + 1u) * nloc) {
            __builtin_amdgcn_fence(__ATOMIC_RELEASE, "agent");
            asm volatile("s_waitcnt vmcnt(0)" ::: "memory");
            const unsigned og = xb_add(&bar[XB_TOP], 1u);
            const unsigned tg = og / nx;
            if (og + 1u == (tg + 1u) * nx) xb_add(&bar[XB_TOPGEN], 1u);
            else XB_SPIN(xb_ld(&bar[XB_TOPGEN]) == tg, bar);
            __builtin_amdgcn_fence(__ATOMIC_ACQUIRE, "agent");
            xb_add(&bar[XB_XGEN(b.x)], 1u);
            asm volatile("s_waitcnt vmcnt(0)" ::: "memory");
        } else {
            XB_SPIN(xb_ld(&bar[XB_XGEN(b.x)]) == gen, bar);
            __builtin_amdgcn_fence(__ATOMIC_ACQUIRE, "agent");
            asm volatile("s_waitcnt vmcnt(0)" ::: "memory");
        }
    }
    __syncthreads();
}

struct Args {
    const float* in[17]; float* out; unsigned char* ws;
    double frev[40];
    int ph_lo, ph_hi, li, pad;
};
struct Frame {
    LAS unsigned char* lds;
    volatile LAS unsigned* MISC;
    gu32* ctl;
    int tid, lane, wave, vcu, G;
};

__device__ __forceinline__ int winperm(int n) {
    const int s = n >> 9, c = n & 511, hh = c >> 6, d = c & 63; int dp = d;
    if (s == 0 || s == 1) { if (d < 16) dp = 2 * (d & 7) + (d >> 3); }
    else if (s == 3 || s == 4) dp = 2 * (d & 31) + (d >> 5);
    return (s << 9) + (hh << 6) + dp;
}
template <int MODE>
__device__ __forceinline__ void p0_transpose_item(const float* S, int N, bf16* Dst, int Kd, LAS float* scr, int kb, int nb, int lane, const float* kscale) {
    const int k0 = 64 * kb, n0 = 32 * nb;
#pragma unroll 8
    for (int i = 0; i < 32; ++i) { const int kk = 2 * i + (lane >> 5); float v = S[(size_t)(k0 + kk) * N + n0 + (lane & 31)]; if (kscale) v *= kscale[k0 + kk]; scr[kk * 33 + (lane & 31)] = v; }
    LDS_WAIT(); asm volatile("" ::: "memory");
    const int c = lane & 7;
#pragma unroll
    for (int j = 0; j < 4; ++j) { const int n = (lane >> 3) + 8 * j; const LAS float* s = scr + (8 * c) * 33 + n;
        u32x4 o; o.x = pk2(s[0 * 33], s[1 * 33]); o.y = pk2(s[2 * 33], s[3 * 33]); o.z = pk2(s[4 * 33], s[5 * 33]); o.w = pk2(s[6 * 33], s[7 * 33]);
        const int ns = n0 + n; int row;
        if (MODE == 0) row = winperm(ns); else if (MODE == 1) row = ns; else if (MODE == 2) row = ((ns >> 7) << 8) + (ns & 127); else row = ((ns >> 7) << 8) + 128 + (ns & 127);
        *(GAS u32x4*)(Dst + (size_t)row * Kd + k0 + 8 * c) = o; }
    LDS_WAIT(); asm volatile("" ::: "memory");
}
__device__ __forceinline__ void p0_prologue(Frame& F, const Args& A) {
    unsigned char* ws = A.ws;
    LAS float* scr = (LAS float*)(F.lds + F.wave * 16384);
    const int gw = F.vcu * NWAVES + F.wave, NGW = F.G * NWAVES;
    constexpr int I_IN = 16 * 112, I_OUT = 16 * 32, I_G = 256, I_D = 256;
    constexpr int NITEMS = I_IN + I_OUT + NEXP * (2 * I_G + I_D);
    bf16* WIN = (bf16*)(ws + WS_WIN); bf16* WOUT = (bf16*)(ws + WS_WOUT); bf16* WGU = (bf16*)(ws + WS_WGU); bf16* WD = (bf16*)(ws + WS_WD);
    for (int it = gw; it < NITEMS; it += NGW) {
        int r = it;
        if (r < I_IN) { p0_transpose_item<0>(A.in[2], NIN, WIN, DM, scr, r / 112, r % 112, F.lane, nullptr); continue; } r -= I_IN;
        if (r < I_OUT) { const int kb = r / 32; p0_transpose_item<1>(A.in[7], DM, WOUT, DM, scr, kb, r % 32, F.lane, kb < 8 ? A.in[3] : A.in[6] - 512); continue; } r -= I_OUT;
        const int e = r / (2 * I_G + I_D); r -= e * (2 * I_G + I_D);
        if (r < I_G) { p0_transpose_item<2>(A.in[13] + (size_t)e * DM * FF, FF, WGU + (size_t)e * DM * DM, DM, scr, r / 16, r % 16, F.lane, nullptr); continue; } r -= I_G;
        if (r < I_G) { p0_transpose_item<3>(A.in[14] + (size_t)e * DM * FF, FF, WGU + (size_t)e * DM * DM, DM, scr, r / 16, r % 16, F.lane, nullptr); continue; } r -= I_G;
        p0_transpose_item<1>(A.in[15] + (size_t)e * FF * DM, DM, WD + (size_t)e * DM * FF, FF, scr, r / 32, r % 32, F.lane, nullptr);
    }
    { const float* x = A.in[0]; const float* g = A.in[1]; bf16* XN = (bf16*)(ws + WS_XN);
      f32x4 gv[4];
#pragma unroll
      for (int j = 0; j < 4; ++j) gv[j] = ((const f32x4*)g)[F.lane + 64 * j];
      for (int m = gw; m < M; m += NGW) {
        const GAS f32x4* xr = (const GAS f32x4*)(x + (size_t)m * DM) + F.lane;
        f32x4 v[4]; float s = 0.f;
#pragma unroll
        for (int j = 0; j < 4; ++j) { v[j] = xr[64 * j]; s += (v[j].x * v[j].x + v[j].y * v[j].y) + (v[j].z * v[j].z + v[j].w * v[j].w); }
        const float rstd = 1.f / sqrtf(wave_sum(s) * (1.f / DM) + NORM_EPS);
        GAS unsigned long long* o8 = (GAS unsigned long long*)(XN + (size_t)m * DM) + F.lane;
#pragma unroll
        for (int j = 0; j < 4; ++j) { const f32x4 t = v[j] * rstd * gv[j]; o8[64 * j] = (unsigned long long)pk2(t.x, t.y) | ((unsigned long long)pk2(t.z, t.w) << 32); }
      } }
    { const int gt = (F.vcu * NWAVES + F.wave) * 64 + F.lane, NT = NGW * 64;
      float* WRT = (float*)(ws + WS_WRT); const float* gf = A.in[8]; const float* wg = A.in[9]; const float* we = A.in[11];
      for (int idx = gt; idx < 48 * DM; idx += NT) { const int j = idx >> 10, i = idx & 1023;
          const float v = j < 32 ? we[i * 32 + j] : (j < 36 ? wg[i * 4 + (j - 32)] : 0.f); WRT[idx] = v * gf[i]; }
      float* RC = (float*)(ws + WS_ROPE); float* RS = RC + SEQ * 40;
      for (int idx = gt; idx < SEQ * 40; idx += NT) { const int pos = idx / 40, f = idx % 40;
          double rv = (double)pos * A.frev[f]; rv -= floor(rv); const float r = (float)rv;
          RC[idx] = __builtin_amdgcn_cosf(r); RS[idx] = __builtin_amdgcn_sinf(r); } }
}

struct SrcPlain {
    const bf16* A; const bf16* Bt; int K;
    __device__ __forceinline__ void setup(const pg8::Unit& u, const int (&RA)[2], const int (&CA)[2], const char*& cA, const char*& cB, unsigned (&v0)[2], unsigned (&v1)[2]) const {
        cA = (const char*)A + (size_t)u.pm * 256 * K * 2; cB = (const char*)Bt + (size_t)u.pn * 256 * K * 2;
#pragma unroll
        for (int i = 0; i < 2; ++i) { v0[i] = (unsigned)(RA[i] * K + CA[i]) * 2u; v1[i] = v0[i] + (unsigned)(128 * K * 2); }
    }
};
struct TileTab { const LAS int* TE; const LAS int* NE; const LAS int* T0; };
struct SrcGather {
    const bf16* HG; const bf16* WGU; const int* LIST; TileTab tt;
    __device__ __forceinline__ void setup(const pg8::Unit& u, const int (&RA)[2], const int (&CA)[2], const char*& cA, const char*& cB, unsigned (&v0)[2], unsigned (&v1)[2]) const {
        const int e = tt.TE[u.pm], ne = tt.NE[e], p0 = (u.pm - tt.T0[e]) * 256;
        cA = (const char*)HG; cB = (const char*)WGU + ((size_t)e * DM + (size_t)u.pn * 256) * DM * 2;
#pragma unroll
        for (int i = 0; i < 2; ++i) {
            const int pa = p0 + RA[i], pb = pa + 128;
            const int ta = pa < ne ? (LIST[e * M + pa] >> 1) : 0, tb = pb < ne ? (LIST[e * M + pb] >> 1) : 0;
            v0[i] = (unsigned)(ta * DM + CA[i]) * 2u; v1[i] = (unsigned)(tb * DM + CA[i]) * 2u; }
    }
};
struct SrcDown {
    const bf16* HID; const bf16* WD; TileTab tt;
    __device__ __forceinline__ void setup(const pg8::Unit& u, const int (&RA)[2], const int (&CA)[2], const char*& cA, const char*& cB, unsigned (&v0)[2], unsigned (&v1)[2]) const {
        const int e = tt.TE[u.pm];
        cA = (const char*)HID + (size_t)u.pm * 256 * FF * 2; cB = (const char*)WD + ((size_t)e * DM + (size_t)u.pn * 256) * FF * 2;
#pragma unroll
        for (int i = 0; i < 2; ++i) { v0[i] = (unsigned)(RA[i] * FF + CA[i]) * 2u; v1[i] = v0[i] + (unsigned)(128 * FF * 2); }
    }
};

struct EpiInProj {
    static constexpr bool PERM = true;
    bf16* SEG; const float* RC; const float* RS;
    __device__ __forceinline__ void operator()(const f32x4 (&acc)[2][2][4][2], const pg8::Unit& u, int wr, int wc, int fr, int fq) const {
        const int seg = u.pn >> 1, colt = (u.pn & 1) * 256;
        bf16* base = SEG + (size_t)seg * M * SEGW;
        const int dq = (wc & 1) * 32 + 8 * fq;
        const bool attn = seg < 2, ret = (seg == 3 || seg == 4);
        const bool rot = ret || (attn && dq < 16);
        const int i0 = ret ? 8 + (dq >> 1) : (dq >> 1);
        const float sc = seg == 0 ? 0.125f * LOG2E : (seg == 4 ? 0.125f : 1.f);
#pragma unroll
        for (int ai = 0; ai < 2; ++ai)
#pragma unroll
            for (int m = 0; m < 4; ++m) {
                const int row = u.pm * 256 + ai * 128 + wr * 64 + m * 16 + fr, pos = row & (SEQ - 1);
                f32x4 c4 = {1.f, 1.f, 1.f, 1.f}, s4 = {0.f, 0.f, 0.f, 0.f};
                if (rot) { c4 = *(const f32x4*)(RC + pos * 40 + i0); s4 = *(const f32x4*)(RS + pos * 40 + i0); }
                bf16* rowp = base + (size_t)row * SEGW + colt + wc * 32 + 8 * fq;
#pragma unroll
                for (int bj = 0; bj < 2; ++bj) {
                    f32x4 v0 = acc[ai][bj][m][0], v1 = acc[ai][bj][m][1];
                    if (attn || ret) {
                        f32x4 r0, r1;
                        r0[0] = v0[0] * c4[0] - v0[1] * s4[0]; r0[1] = v0[1] * c4[0] + v0[0] * s4[0];
                        r0[2] = v0[2] * c4[1] - v0[3] * s4[1]; r0[3] = v0[3] * c4[1] + v0[2] * s4[1];
                        r1[0] = v1[0] * c4[2] - v1[1] * s4[2]; r1[1] = v1[1] * c4[2] + v1[0] * s4[2];
                        r1[2] = v1[2] * c4[3] - v1[3] * s4[3]; r1[3] = v1[3] * c4[3] + v1[2] * s4[3];
                        v0 = r0 * sc; v1 = r1 * sc;
                    } else if (seg == 6) {
#pragma unroll
                        for (int e = 0; e < 4; ++e) { v0[e] = silu_f(v0[e]); v1[e] = silu_f(v1[e]); }
                    }
                    u32x4 w; w.x = pk2(v0[0], v0[1]); w.y = pk2(v0[2], v0[3]); w.z = pk2(v1[0], v1[1]); w.w = pk2(v1[2], v1[3]);
                    *(u32x4*)(rowp + bj * 128) = w;
                }
            }
    }
};
struct EpiOutProj {
    static constexpr bool PERM = false;
    const float* X; const float* GF; float* H; bf16* HG;
    __device__ __forceinline__ void operator()(const f32x4 (&acc)[2][2][4][2], const pg8::Unit& u, int wr, int wc, int fr, int fq) const {
        const int col0 = u.pn * 256 + wc * 32 + 4 * fq;
        f32x4 gv[2][2];
#pragma unroll
        for (int bj = 0; bj < 2; ++bj)
#pragma unroll
            for (int n = 0; n < 2; ++n) gv[bj][n] = *(const f32x4*)(GF + col0 + bj * 128 + n * 16);
#pragma unroll
        for (int ai = 0; ai < 2; ++ai)
#pragma unroll
            for (int m = 0; m < 4; ++m) { const size_t off = (size_t)(u.pm * 256 + ai * 128 + wr * 64 + m * 16 + fr) * DM + col0;
#pragma unroll
                for (int bj = 0; bj < 2; ++bj)
#pragma unroll
                    for (int n = 0; n < 2; ++n) { const f32x4 h = *(const f32x4*)(X + off + bj * 128 + n * 16) + acc[ai][bj][m][n];
                        *(f32x4*)(H + off + bj * 128 + n * 16) = h; const f32x4 t = h * gv[bj][n];
                        u32x2 w; w.x = pk2(t[0], t[1]); w.y = pk2(t[2], t[3]); *(u32x2*)(HG + off + bj * 128 + n * 16) = w; }
                if (m & 1) asm volatile("" ::: "memory"); }
    }
};
struct EpiGateUp {
    static constexpr bool PERM = true;
    bf16* HID; const float* GATEL; const float* RSL; TileTab tt;
    __device__ __forceinline__ void operator()(const f32x4 (&acc)[2][2][4][2], const pg8::Unit& u, int wr, int wc, int fr, int fq) const {
        const int e = tt.TE[u.pm], ne = tt.NE[e], p0 = (u.pm - tt.T0[e]) * 256;
#pragma unroll
        for (int ai = 0; ai < 2; ++ai)
#pragma unroll
            for (int m = 0; m < 4; ++m) {
                const int rr = ai * 128 + wr * 64 + m * 16 + fr, pos = p0 + rr;
                float rs = 0.f, gt = 0.f; if (pos < ne) { rs = RSL[e * M + pos]; gt = GATEL[e * M + pos]; }
                u32x4 w; unsigned* wp = (unsigned*)&w;
#pragma unroll
                for (int n = 0; n < 2; ++n) { const f32x4 g = acc[ai][0][m][n] * rs, up = acc[ai][1][m][n] * rs; float hv[4];
#pragma unroll
                    for (int q = 0; q < 4; ++q) hv[q] = silu_f(g[q]) * up[q] * gt;
                    wp[2 * n] = pk2(hv[0], hv[1]); wp[2 * n + 1] = pk2(hv[2], hv[3]); }
                *(u32x4*)(HID + (size_t)(u.pm * 256 + rr) * FF + u.pn * 128 + wc * 32 + 8 * fq) = w;
            }
    }
};
struct EpiDown {
    static constexpr bool PERM = true;
    bf16* Y; const int* LIST; TileTab tt;
    __device__ __forceinline__ void operator()(const f32x4 (&acc)[2][2][4][2], const pg8::Unit& u, int wr, int wc, int fr, int fq) const {
        const int e = tt.TE[u.pm], ne = tt.NE[e], p0 = (u.pm - tt.T0[e]) * 256;
#pragma unroll
        for (int ai = 0; ai < 2; ++ai)
#pragma unroll
            for (int m = 0; m < 4; ++m) {
                const int pos = p0 + ai * 128 + wr * 64 + m * 16 + fr;
                if (pos < ne) { const int tk = LIST[e * M + pos]; bf16* rowp = Y + (size_t)tk * DM + u.pn * 256 + wc * 32 + 8 * fq;
#pragma unroll
                    for (int bj = 0; bj < 2; ++bj) { const f32x4 v0 = acc[ai][bj][m][0], v1 = acc[ai][bj][m][1];
                        u32x4 w; w.x = pk2(v0[0], v0[1]); w.y = pk2(v0[2], v0[3]); w.z = pk2(v1[0], v1[1]); w.w = pk2(v1[2], v1[3]);
                        *(u32x4*)(rowp + bj * 128) = w; } }
            }
    }
};

typedef short v4i16_t __attribute__((ext_vector_type(4)));
__device__ __forceinline__ s16x4 vtr(const LAS unsigned char* p) { return __builtin_bit_cast(s16x4, __builtin_amdgcn_ds_read_tr16_b64_v4i16((LAS v4i16_t*)p)); }
#define MFMA32(a, b, c) __builtin_amdgcn_mfma_f32_32x32x16_bf16((a), (b), (c), 0, 0, 0)
__device__ __forceinline__ bf16x8 pack8(const f32x16& x, int s) {
    u32x4 p; p.x = pk2(x[8 * s], x[8 * s + 1]); p.y = pk2(x[8 * s + 2], x[8 * s + 3]); p.z = pk2(x[8 * s + 4], x[8 * s + 5]); p.w = pk2(x[8 * s + 6], x[8 * s + 7]);
    return __builtin_bit_cast(bf16x8, p);
}
__device__ __forceinline__ bf16x8 cat44(s16x4 lo, s16x4 hi) { return __builtin_shufflevector(lo, hi, 0, 1, 2, 3, 4, 5, 6, 7); }
__device__ __forceinline__ bf16x8 scale8(bf16x8 v, float s) {
    u32x4 u = __builtin_bit_cast(u32x4, v), o;
    o.x = pk2(bflo(u.x) * s, bfhi(u.x) * s); o.y = pk2(bflo(u.y) * s, bfhi(u.y) * s); o.z = pk2(bflo(u.z) * s, bfhi(u.z) * s); o.w = pk2(bflo(u.w) * s, bfhi(u.w) * s);
    return __builtin_bit_cast(bf16x8, o);
}
__device__ __forceinline__ void pv_tile(f32x16& ot0, f32x16& ot1, const f32x16& st, const LAS unsigned char* vl, int lane) {
    const int hi = lane >> 5;
    const LAS unsigned char* vr = vl + (4 * hi + ((lane & 15) >> 2)) * 128 + (16 * ((lane >> 4) & 1) + 4 * (lane & 3)) * 2;
    const bf16x8 pb0 = pack8(st, 0), pb1 = pack8(st, 1);
    { const bf16x8 va = cat44(vtr(vr), vtr(vr + 8 * 128)); ot0 = MFMA32(va, pb0, ot0); }
    { const bf16x8 va = cat44(vtr(vr + 16 * 128), vtr(vr + 24 * 128)); ot0 = MFMA32(va, pb1, ot0); }
    { const bf16x8 va = cat44(vtr(vr + 64), vtr(vr + 8 * 128 + 64)); ot1 = MFMA32(va, pb0, ot1); }
    { const bf16x8 va = cat44(vtr(vr + 16 * 128 + 64), vtr(vr + 24 * 128 + 64)); ot1 = MFMA32(va, pb1, ot1); }
}
__device__ __forceinline__ void attn_task(int task, const bf16* QA, const bf16* KA, const bf16* VA, bf16* OBR, float* LSE, LAS unsigned char* vl, int lane) {
    const int bh = task / 384, rem = task - bh * 384, br = rem >> 7, idx = rem & 127;
    const int dsh = 2 * br, dil = 1 << dsh, L = SEQ >> dsh, nblk = L >> 5;
    const int cls = idx / nblk, qb = idx - cls * nblk, p0 = qb * 32;
    const int b = bh >> 3, h = bh & 7, q = lane & 31, hi = lane >> 5;
    const size_t rowbase = (size_t)b * SEQ + cls;
    const size_t qrow = rowbase + (size_t)dil * (p0 + q);
    bf16x8 qr[4];
    { const bf16* qp = QA + qrow * SEGW + h * HD + hi * 8;
#pragma unroll
      for (int ks = 0; ks < 4; ++ks) qr[ks] = *(const bf16x8*)(qp + 16 * ks); }
    float mrun = -1e30f, lsum = 0.f; f32x16 ot0, ot1;
#pragma unroll
    for (int r = 0; r < 16; ++r) { ot0[r] = 0.f; ot1[r] = 0.f; }
    for (int kb = 0; kb < 5; ++kb) {
        const int kp0 = p0 - 64 + 32 * kb;
        if (kp0 < 0 || kp0 >= L) continue;
        const size_t krow = rowbase + (size_t)dil * (kp0 + q);
        const bf16* kp = KA + krow * SEGW + h * HD + hi * 8;
        const bf16* vp = VA + krow * SEGW + h * HD + hi * 32;
        bf16x8 kf[4], vv[4];
#pragma unroll
        for (int ks = 0; ks < 4; ++ks) { kf[ks] = *(const bf16x8*)(kp + 16 * ks); vv[ks] = *(const bf16x8*)(vp + 8 * ks); }
        f32x16 st;
#pragma unroll
        for (int r = 0; r < 16; ++r) st[r] = 0.f;
#pragma unroll
        for (int ks = 0; ks < 4; ++ks) st = MFMA32(kf[ks], qr[ks], st);
        if (kb == 0) {
#pragma unroll
            for (int r = 0; r < 16; ++r) if (crow(r, hi) < q) st[r] = -1e30f;
        }
        if (kb == 4) {
#pragma unroll
            for (int r = 0; r < 16; ++r) if (crow(r, hi) > q) st[r] = -1e30f;
        }
        float mx = st[0];
#pragma unroll
        for (int r = 1; r < 16; ++r) mx = fmaxf(mx, st[r]);
        mx = fmaxf(mx, __shfl_xor(mx, 32));
        const float mnew = fmaxf(mrun, mx), alpha = __builtin_amdgcn_exp2f(mrun - mnew); mrun = mnew;
        float ps = 0.f;
#pragma unroll
        for (int r = 0; r < 16; ++r) { st[r] = __builtin_amdgcn_exp2f(st[r] - mnew); ps += st[r]; }
        lsum = lsum * alpha + ps;
#pragma unroll
        for (int r = 0; r < 16; ++r) { ot0[r] *= alpha; ot1[r] *= alpha; }
        LAS unsigned char* vw = vl + q * 128 + hi * 64;
#pragma unroll
        for (int i = 0; i < 4; ++i) *(LAS bf16x8*)(vw + 16 * i) = vv[i];
        asm volatile("" ::: "memory");
        pv_tile(ot0, ot1, st, vl, lane);
        asm volatile("" ::: "memory");
    }
    lsum += __shfl_xor(lsum, 32);
    const float inv = 1.f / lsum, lse = (mrun + __log2f(lsum)) * LN2;
    bf16* op = OBR + ((size_t)br * M + qrow) * SEGW + h * HD + 4 * hi;
#pragma unroll
    for (int g = 0; g < 4; ++g) {
        u32x2 w0, w1; w0.x = pk2(ot0[4 * g] * inv, ot0[4 * g + 1] * inv); w0.y = pk2(ot0[4 * g + 2] * inv, ot0[4 * g + 3] * inv);
        w1.x = pk2(ot1[4 * g] * inv, ot1[4 * g + 1] * inv); w1.y = pk2(ot1[4 * g + 2] * inv, ot1[4 * g + 3] * inv);
        *(u32x2*)(op + 8 * g) = w0; *(u32x2*)(op + 32 + 8 * g) = w1; }
    if (hi == 0) LSE[((size_t)br * M + qrow) * NHEAD + h] = lse;
}
__device__ __forceinline__ void scan_task(int sid, const bf16* KR, const bf16* VR, bf16* ST, const float* dec_f, const float* dec_b, LAS unsigned char* sl, int lane) {
    const int bh = sid >> 3, dir = (sid >> 2) & 1, dkh = (sid >> 1) & 1, dvh = sid & 1, b = bh >> 3, h = bh & 7, hi = lane >> 5;
    const float lg2 = log1pf(-exp2f((dir ? dec_b : dec_f)[h])) * LOG2E;
    const float g128 = exp2f(128.f * lg2);
    LAS unsigned char* Kl = sl; LAS unsigned char* Vl = sl + 8192;
    f32x16 S;
#pragma unroll
    for (int r = 0; r < 16; ++r) S[r] = 0.f;
    const int troff = (8 * hi + ((lane & 15) >> 2)) * 64 + (16 * ((lane >> 4) & 1) + 4 * (lane & 3)) * 2;
    for (int step = 0; step < NCHUNK; ++step) {
        const int n = dir ? (NCHUNK - 1 - step) : step;
        bf16* sp = ST + ((((size_t)bh * 2 + dir) * NCHUNK + n) * 64 + (32 * dvh + (lane & 31))) * 64 + 32 * dkh + 4 * hi;
#pragma unroll
        for (int g = 0; g < 4; ++g) { u32x2 w; w.x = pk2(S[4 * g], S[4 * g + 1]); w.y = pk2(S[4 * g + 2], S[4 * g + 3]); *(u32x2*)(sp + 8 * g) = w; }
        if (step == NCHUNK - 1) break;
#pragma unroll
        for (int kk = 0; kk < 2; ++kk) {
            const int key = lane + 64 * kk; const size_t row = (size_t)b * SEQ + n * CHUNK + key;
            const float dcy = exp2f((dir ? (float)key : (float)(CHUNK - 1 - key)) * lg2);
            const bf16* kp = KR + row * SEGW + h * HD + 32 * dkh; const bf16* vp = VR + row * SEGW + h * HD + 32 * dvh;
#pragma unroll
            for (int i = 0; i < 4; ++i) { *(LAS bf16x8*)(Kl + key * 64 + 16 * i) = scale8(*(const bf16x8*)(kp + 8 * i), dcy); *(LAS bf16x8*)(Vl + key * 64 + 16 * i) = *(const bf16x8*)(vp + 8 * i); }
        }
        asm volatile("" ::: "memory");
        f32x16 kv;
#pragma unroll
        for (int r = 0; r < 16; ++r) kv[r] = 0.f;
#pragma unroll
        for (int s = 0; s < 8; ++s) {
            const bf16x8 a = cat44(vtr(Kl + troff + s * 1024), vtr(Kl + troff + s * 1024 + 256));
            const bf16x8 bb = cat44(vtr(Vl + troff + s * 1024), vtr(Vl + troff + s * 1024 + 256));
            kv = MFMA32(a, bb, kv);
        }
        asm volatile("" ::: "memory");
#pragma unroll
        for (int r = 0; r < 16; ++r) S[r] = S[r] * g128 + kv[r];
    }
}
__device__ __forceinline__ void ret_task(int cid, const bf16* QR, const bf16* KR, const bf16* VR, const bf16* GR, const bf16* ST, bf16* MIXED, const float* dec_f, const float* dec_b,
                                         LAS unsigned char* vl, int lane) {
    const int bh = cid >> 5, n = cid & 31, b = bh >> 3, h = bh & 7, q = lane & 31, hi = lane >> 5;
    const float lgf = log1pf(-exp2f(dec_f[h])) * LOG2E, lgb = log1pf(-exp2f(dec_b[h])) * LOG2E;
    const size_t row0 = (size_t)b * SEQ + n * CHUNK;
    const bf16* SF = ST + (((size_t)bh * 2 + 0) * NCHUNK + n) * 4096; const bf16* SB = ST + (((size_t)bh * 2 + 1) * NCHUNK + n) * 4096;
    for (int qb = 0; qb < 4; ++qb) {
        const int i = 32 * qb + q; const size_t qrow = row0 + i;
        bf16x8 qr[4];
        { const bf16* qp = QR + qrow * SEGW + h * HD + hi * 8;
#pragma unroll
          for (int ks = 0; ks < 4; ++ks) qr[ks] = *(const bf16x8*)(qp + 16 * ks); }
        f32x16 ot0, ot1;
#pragma unroll
        for (int r = 0; r < 16; ++r) { ot0[r] = 0.f; ot1[r] = 0.f; }
        for (int kb = 0; kb < 4; ++kb) {
            const size_t krow = row0 + 32 * kb + q;
            const bf16* kp = KR + krow * SEGW + h * HD + hi * 8; const bf16* vp = VR + krow * SEGW + h * HD + hi * 32;
            bf16x8 kf[4], vv[4];
#pragma unroll
            for (int ks = 0; ks < 4; ++ks) { kf[ks] = *(const bf16x8*)(kp + 16 * ks); vv[ks] = *(const bf16x8*)(vp + 8 * ks); }
            f32x16 st;
#pragma unroll
            for (int r = 0; r < 16; ++r) st[r] = 0.f;
#pragma unroll
            for (int ks = 0; ks < 4; ++ks) st = MFMA32(kf[ks], qr[ks], st);
#pragma unroll
            for (int r = 0; r < 16; ++r) { const int dl = i - (32 * kb + crow(r, hi)); const float w = dl >= 0 ? __builtin_amdgcn_exp2f((float)dl * lgf) : __builtin_amdgcn_exp2f((float)(-dl) * lgb); st[r] *= w; }
            LAS unsigned char* vw = vl + q * 128 + hi * 64;
#pragma unroll
            for (int k = 0; k < 4; ++k) *(LAS bf16x8*)(vw + 16 * k) = vv[k];
            asm volatile("" ::: "memory");
            pv_tile(ot0, ot1, st, vl, lane);
            asm volatile("" ::: "memory");
        }
        f32x16 tf0, tf1, tb0, tb1;
#pragma unroll
        for (int r = 0; r < 16; ++r) { tf0[r] = 0.f; tf1[r] = 0.f; tb0[r] = 0.f; tb1[r] = 0.f; }
#pragma unroll
        for (int ks = 0; ks < 4; ++ks) {
            tf0 = MFMA32(*(const bf16x8*)(SF + (size_t)q * 64 + 16 * ks + 8 * hi), qr[ks], tf0);
            tf1 = MFMA32(*(const bf16x8*)(SF + (size_t)(32 + q) * 64 + 16 * ks + 8 * hi), qr[ks], tf1);
            tb0 = MFMA32(*(const bf16x8*)(SB + (size_t)q * 64 + 16 * ks + 8 * hi), qr[ks], tb0);
            tb1 = MFMA32(*(const bf16x8*)(SB + (size_t)(32 + q) * 64 + 16 * ks + 8 * hi), qr[ks], tb1);
        }
        const float cf = exp2f((float)(i + 1) * lgf), cb = exp2f((float)(CHUNK - i) * lgb);
        float s1 = 0.f;
#pragma unroll
        for (int r = 0; r < 16; ++r) { ot0[r] += cf * tf0[r] + cb * tb0[r]; ot1[r] += cf * tf1[r] + cb * tb1[r]; s1 += ot0[r] + ot1[r]; }
        s1 += __shfl_xor(s1, 32);
        const float mean = s1 * (1.f / 64.f); float s2 = 0.f;
#pragma unroll
        for (int r = 0; r < 16; ++r) { ot0[r] -= mean; ot1[r] -= mean; s2 += ot0[r] * ot0[r] + ot1[r] * ot1[r]; }
        s2 += __shfl_xor(s2, 32);
        const float rstd = 1.f / sqrtf(s2 * (1.f / 64.f) + NORM_EPS);
        const bf16* gp = GR + qrow * SEGW + h * HD + 4 * hi; bf16* mp = MIXED + qrow * DM + 512 + h * HD + 4 * hi;
#pragma unroll
        for (int g = 0; g < 4; ++g) {
            const u32x2 g0 = *(const u32x2*)(gp + 8 * g), g1 = *(const u32x2*)(gp + 32 + 8 * g);
            u32x2 w0, w1;
            w0.x = pk2(ot0[4 * g] * rstd * bflo(g0.x), ot0[4 * g + 1] * rstd * bfhi(g0.x)); w0.y = pk2(ot0[4 * g + 2] * rstd * bflo(g0.y), ot0[4 * g + 3] * rstd * bfhi(g0.y));
            w1.x = pk2(ot1[4 * g] * rstd * bflo(g1.x), ot1[4 * g + 1] * rstd * bfhi(g1.x)); w1.y = pk2(ot1[4 * g + 2] * rstd * bflo(g1.y), ot1[4 * g + 3] * rstd * bfhi(g1.y));
            *(u32x2*)(mp + 8 * g) = w0; *(u32x2*)(mp + 32 + 8 * g) = w1; }
    }
}
__device__ __forceinline__ void combine_row(size_t row, const bf16* OBR, const float* LSE, bf16* MIXED, int lane) {
    const int hh = lane >> 3;
    const float l0 = LSE[((size_t)0 * M + row) * NHEAD + hh], l1 = LSE[((size_t)1 * M + row) * NHEAD + hh], l2 = LSE[((size_t)2 * M + row) * NHEAD + hh];
    const float mx = fmaxf(l0, fmaxf(l1, l2)); float w0 = __expf(l0 - mx), w1 = __expf(l1 - mx), w2 = __expf(l2 - mx);
    const float inv = 1.f / (w0 + w1 + w2); w0 *= inv; w1 *= inv; w2 *= inv;
    const u32x4 a0 = *(const u32x4*)(OBR + ((size_t)0 * M + row) * SEGW + 8 * lane), a1 = *(const u32x4*)(OBR + ((size_t)1 * M + row) * SEGW + 8 * lane), a2 = *(const u32x4*)(OBR + ((size_t)2 * M + row) * SEGW + 8 * lane);
    float o[8]; float ss = 0.f;
#pragma unroll
    for (int e = 0; e < 4; ++e) { o[2 * e] = w0 * bflo(a0[e]) + w1 * bflo(a1[e]) + w2 * bflo(a2[e]); o[2 * e + 1] = w0 * bfhi(a0[e]) + w1 * bfhi(a1[e]) + w2 * bfhi(a2[e]); ss += o[2 * e] * o[2 * e] + o[2 * e + 1] * o[2 * e + 1]; }
    const float rstd = 1.f / sqrtf(wave_sum(ss) * (1.f / 512.f) + NORM_EPS);
    u32x4 w; w.x = pk2(o[0] * rstd, o[1] * rstd); w.y = pk2(o[2] * rstd, o[3] * rstd); w.z = pk2(o[4] * rstd, o[5] * rstd); w.w = pk2(o[6] * rstd, o[7] * rstd);
    *(u32x4*)(MIXED + row * DM + 8 * lane) = w;
}
__device__ __forceinline__ void route_task(int grp, const float* H, const float* WRT, const float* bg, const float* be, gu32* ctl, int* LIST, float* GATEL, float* RSL, LAS float* sc, int lane) {
    const int r = lane & 15, g = lane >> 4; const size_t row = (size_t)grp * 16 + r;
    const f32x4* hp = (const f32x4*)(H + row * DM) + g;
    const f32x4* wp0 = (const f32x4*)(WRT + (size_t)r * DM) + g; const f32x4* wp1 = (const f32x4*)(WRT + (size_t)(16 + r) * DM) + g; const f32x4* wp2 = (const f32x4*)(WRT + (size_t)(32 + r) * DM) + g;
    f32x4 a0 = {0.f, 0.f, 0.f, 0.f}, a1 = a0, a2 = a0; float ss = 0.f;
#pragma unroll 4
    for (int s = 0; s < 64; ++s) {
        const f32x4 a = hp[4 * s], b0 = wp0[4 * s], b1 = wp1[4 * s], b2 = wp2[4 * s];
        ss += (a[0] * a[0] + a[1] * a[1]) + (a[2] * a[2] + a[3] * a[3]);
#pragma unroll
        for (int t = 0; t < 4; ++t) { a0 = __builtin_amdgcn_mfma_f32_16x16x4f32(a[t], b0[t], a0, 0, 0, 0); a1 = __builtin_amdgcn_mfma_f32_16x16x4f32(a[t], b1[t], a1, 0, 0, 0); a2 = __builtin_amdgcn_mfma_f32_16x16x4f32(a[t], b2[t], a2, 0, 0, 0); }
    }
    ss += __shfl_xor(ss, 16); ss += __shfl_xor(ss, 32);
    const float rstd = 1.f / sqrtf(ss * (1.f / DM) + NORM_EPS);
#pragma unroll
    for (int e = 0; e < 4; ++e) { sc[(4 * g + e) * 48 + r] = a0[e]; sc[(4 * g + e) * 48 + 16 + r] = a1[e]; sc[(4 * g + e) * 48 + 32 + r] = a2[e]; }
    if (g == 0) sc[768 + r] = rstd;
    LDS_WAIT(); asm volatile("" ::: "memory");
    if (lane < 16) {
        const size_t trow = (size_t)grp * 16 + lane; const float rs = sc[768 + lane]; const LAS float* lg = sc + lane * 48;
        float gmax = lg[32] * rs + bg[0]; int gi = 0; float gl[4]; gl[0] = gmax;
#pragma unroll
        for (int k = 1; k < 4; ++k) { gl[k] = lg[32 + k] * rs + bg[k]; if (gl[k] > gmax) { gmax = gl[k]; gi = k; } }
        float den = 0.f;
#pragma unroll
        for (int k = 0; k < 4; ++k) den += __expf(gl[k] - gmax);
        const float ggate = 1.f / den;
        float b1v = -3.0e38f, b2v = -3.0e38f; int i1 = 0, i2 = 0;
        for (int k = 0; k < 8; ++k) { const float v = lg[gi * 8 + k] * rs + be[gi * 8 + k]; if (v > b1v) { b1v = v; i1 = k; } }
        for (int k = 0; k < 8; ++k) { const float v = lg[gi * 8 + k] * rs + be[gi * 8 + k]; if (k != i1 && v > b2v) { b2v = v; i2 = k; } }
        const float p1 = 1.f / (1.f + __expf(b2v - b1v)), p2 = 1.f - p1;
        const int e1 = gi * 8 + i1, e2 = gi * 8 + i2;
        const int pos1 = (int)__hip_atomic_fetch_add(ctl + CW_CNT + 64 * e1, 1u, RLX_AGENT), pos2 = (int)__hip_atomic_fetch_add(ctl + CW_CNT + 64 * e2, 1u, RLX_AGENT);
        LIST[(size_t)e1 * M + pos1] = (int)(trow * 2); GATEL[(size_t)e1 * M + pos1] = ggate * p1; RSL[(size_t)e1 * M + pos1] = rs;
        LIST[(size_t)e2 * M + pos2] = (int)(trow * 2 + 1); GATEL[(size_t)e2 * M + pos2] = ggate * p2; RSL[(size_t)e2 * M + pos2] = rs;
    }
    LDS_WAIT(); asm volatile("" ::: "memory");
}
__device__ __forceinline__ void final_row(size_t row, const float* H, const bf16* Y, const f32x4 (&gv)[4], float* out, int lane) {
    const f32x4* hp = (const f32x4*)(H + row * DM) + lane; const u32x2* y0 = (const u32x2*)(Y + (row * 2) * DM) + lane; const u32x2* y1 = (const u32x2*)(Y + (row * 2 + 1) * DM) + lane;
    f32x4 z[4]; float ss = 0.f;
#pragma unroll
    for (int j = 0; j < 4; ++j) { const f32x4 hv = hp[64 * j]; const u32x2 a = y0[64 * j], b = y1[64 * j];
        z[j][0] = hv[0] + bflo(a.x) + bflo(b.x); z[j][1] = hv[1] + bfhi(a.x) + bfhi(b.x); z[j][2] = hv[2] + bflo(a.y) + bflo(b.y); z[j][3] = hv[3] + bfhi(a.y) + bfhi(b.y);
        ss += (z[j][0] * z[j][0] + z[j][1] * z[j][1]) + (z[j][2] * z[j][2] + z[j][3] * z[j][3]); }
    const float rstd = 1.f / sqrtf(wave_sum(ss) * (1.f / DM) + NORM_EPS);
    f32x4* op = (f32x4*)(out + row * DM) + lane;
#pragma unroll
    for (int j = 0; j < 4; ++j) op[64 * j] = z[j] * rstd * gv[j];
}
__device__ __forceinline__ TileTab build_tiles(Frame& F, int& ntiles) {
    LAS int* T = (LAS int*)(F.lds + TILE_OFF); LAS int* TE = T; LAS int* NE = T + MAXTILES; LAS int* T0 = NE + 32; LAS int* NT = T0 + 32;
    __syncthreads();
    if (F.tid == 0) { int t = 0;
        for (int e = 0; e < NEXP; ++e) { int n = (int)__hip_atomic_load(F.ctl + CW_CNT + 64 * e, RLX_AGENT); if (n > M) n = M; NE[e] = n; T0[e] = t; const int k = (n + 255) >> 8;
            for (int j = 0; j < k && t + j < MAXTILES; ++j) TE[t + j] = e; t += k; if (t > MAXTILES) t = MAXTILES; }
        NT[0] = t; }
    __syncthreads();
    ntiles = NT[0];
    TileTab tt; tt.TE = TE; tt.NE = NE; tt.T0 = T0; return tt;
}

constexpr int N_LAUNCHES = MK_N_LAUNCHES, PER_PHASE = 9;
__global__ void __launch_bounds__(NWAVES * 64, 2) mk_fwd(Args args) {
    extern __shared__ __attribute__((aligned(16))) unsigned char lds_raw[];
    Frame F;
    F.lds = (LAS unsigned char*)lds_raw;
    F.MISC = (volatile LAS unsigned*)(F.lds + MISC_OFF);
    F.tid = threadIdx.x; F.lane = F.tid & 63; F.wave = __builtin_amdgcn_readfirstlane(F.tid >> 6);
    F.G = gridDim.x; { const int bx = blockIdx.x; F.vcu = (F.G % 8 == 0) ? (bx % 8) * (F.G / 8) + bx / 8 : bx; }
    unsigned char* ws = args.ws;
    F.ctl = (gu32*)(ws + WS_CTL);
    for (int u = F.tid; u < (LDS_BYTES - LDSCTL_OFF) / 4; u += NWAVES * 64) ((LAS unsigned*)(F.lds + LDSCTL_OFF))[u] = 0u;
    __syncthreads();
    XcdBarrier bar; bar.bar = (unsigned*)(F.ctl + CW_BAR); bar.x = 0; bar.st = nullptr;
    if (N_LAUNCHES != PER_PHASE) bar = xcd_barrier_post((unsigned*)(F.ctl + CW_BAR) + args.li * XCD_BAR_WORDS, F.MISC + 8);
#define GRID_BAR() do { if (N_LAUNCHES != PER_PHASE) xcd_barrier(bar); } while (0)
    const int lo = args.ph_lo, hi = args.ph_hi;
#define IN(k) (lo <= (k) && (k) < hi)
#define BOTH(k) (IN(k) && IN((k) + 1))
    const int gw = F.vcu * NWAVES + F.wave, NGW = F.G * NWAVES;
    bf16* SEGB = (bf16*)(ws + WS_SEG);
    const bf16 *QA = SEGB, *KA = SEGB + (size_t)1 * M * SEGW, *VA = SEGB + (size_t)2 * M * SEGW, *QR = SEGB + (size_t)3 * M * SEGW, *KR = SEGB + (size_t)4 * M * SEGW, *VR = SEGB + (size_t)5 * M * SEGW, *GR = SEGB + (size_t)6 * M * SEGW;

    if (IN(0)) { p0_prologue(F, args); if (BOTH(0)) GRID_BAR(); }
    if (IN(1)) {
        pg8::StaticOrder S; S.init(M / 256, NIN / 256, F.G, (int)blockIdx.x);
        SrcPlain SRC{(const bf16*)(ws + WS_XN), (const bf16*)(ws + WS_WIN), DM};
        EpiInProj E{SEGB, (const float*)(ws + WS_ROPE), (const float*)(ws + WS_ROPE) + SEQ * 40};
        pg8::gemm_phase<EpiInProj, pg8::StaticOrder, SrcPlain, true, true>(F.lds, DM, S, SRC, E);
        if (BOTH(1)) GRID_BAR();
    }
    if (IN(2)) {
        LAS unsigned char* wl = F.lds + F.wave * 16384;
        bf16* OBR = (bf16*)(ws + WS_OBR); float* LSE = (float*)(ws + WS_LSE); bf16* ST = (bf16*)(ws + WS_ST);
        for (int grp = gw >> 2; grp < 512; grp += NGW >> 2) {
            const int k = gw & 3, base = grp * 48, t0 = k == 0 ? base : base + 9 + 13 * (k - 1), nt = k == 0 ? 9 : 13;
            if (k == 0) scan_task(grp, KR, VR, ST, args.in[4], args.in[5], wl, F.lane);
            for (int t = 0; t < nt; ++t) attn_task(t0 + t, QA, KA, VA, OBR, LSE, wl, F.lane);
        }
        if (BOTH(2)) GRID_BAR();
    }
    if (IN(3)) {
        LAS unsigned char* wl = F.lds + F.wave * 16384;
        bf16* MIXED = (bf16*)(ws + WS_MIXED);
        for (int cid = gw; cid < NBATCH * NHEAD * NCHUNK; cid += NGW) ret_task(cid, QR, KR, VR, GR, (const bf16*)(ws + WS_ST), MIXED, args.in[4], args.in[5], wl, F.lane);
        for (int row = gw; row < M; row += NGW) combine_row((size_t)row, (const bf16*)(ws + WS_OBR), (const float*)(ws + WS_LSE), MIXED, F.lane);
        if (BOTH(3)) GRID_BAR();
    }
    if (IN(4)) {
        pg8::StaticOrder S; S.init(M / 256, DM / 256, F.G, (int)blockIdx.x);
        SrcPlain SRC{(const bf16*)(ws + WS_MIXED), (const bf16*)(ws + WS_WOUT), DM};
        EpiOutProj E{args.in[0], args.in[8], (float*)(ws + WS_H), (bf16*)(ws + WS_HG)};
        pg8::gemm_phase<EpiOutProj, pg8::StaticOrder, SrcPlain, true, true>(F.lds, DM, S, SRC, E);
        if (BOTH(4)) GRID_BAR();
    }
    if (IN(5)) {
        LAS float* sc = (LAS float*)(F.lds + F.wave * 16384);
        for (int grp = gw; grp < M / 16; grp += NGW)
            route_task(grp, (const float*)(ws + WS_H), (const float*)(ws + WS_WRT), args.in[10], args.in[12], F.ctl, (int*)(ws + WS_LIST), (float*)(ws + WS_GATEL), (float*)(ws + WS_RSL), sc, F.lane);
        if (BOTH(5)) GRID_BAR();
    }
    if (IN(6)) {
        int ntiles; const TileTab tt = build_tiles(F, ntiles);
        pg8::StaticOrder S; S.init(ntiles, 4, F.G, (int)blockIdx.x);
        SrcGather SRC{(const bf16*)(ws + WS_HG), (const bf16*)(ws + WS_WGU), (const int*)(ws + WS_LIST), tt};
        EpiGateUp E{(bf16*)(ws + WS_HID), (const float*)(ws + WS_GATEL), (const float*)(ws + WS_RSL), tt};
        pg8::gemm_phase<EpiGateUp, pg8::StaticOrder, SrcGather, true, true>(F.lds, DM, S, SRC, E);
        if (BOTH(6)) GRID_BAR();
    }
    if (IN(7)) {
        int ntiles; const TileTab tt = build_tiles(F, ntiles);
        pg8::StaticOrder S; S.init(ntiles, 4, F.G, (int)blockIdx.x);
        SrcDown SRC{(const bf16*)(ws + WS_HID), (const bf16*)(ws + WS_WD), tt};
        EpiDown E{(bf16*)(ws + WS_Y), (const int*)(ws + WS_LIST), tt};
        pg8::gemm_phase<EpiDown, pg8::StaticOrder, SrcDown, true, true>(F.lds, FF, S, SRC, E);
        if (BOTH(7)) GRID_BAR();
    }
    if (IN(8)) {
        f32x4 gv[4];
#pragma unroll
        for (int j = 0; j < 4; ++j) gv[j] = ((const f32x4*)args.in[16])[F.lane + 64 * j];
        for (int row = gw; row < M; row += NGW) final_row((size_t)row, (const float*)(ws + WS_H), (const bf16*)(ws + WS_Y), gv, args.out, F.lane);
    }
#undef IN
#undef BOTH
#undef GRID_BAR
}

#if MK_CHECK
__device__ __forceinline__ unsigned hsh(unsigned x) { x ^= x >> 16; x *= 0x7feb352dU; x ^= x >> 15; x *= 0x846ca68bU; x ^= x >> 16; return x; }
__device__ __forceinline__ float ldb(const bf16* p, size_t i) { return __uint_as_float(((unsigned)p[i]) << 16); }
__device__ __forceinline__ float rbf(float x) { return bflo(pk2(x, 0.f) & 0xffffu); }
__device__ __forceinline__ void chk_put(gu32* ctl, int stage, float got, float ref, float atol) {
    float e = fabsf(got - ref) / (0.03f * fabsf(ref) + atol); if (!(e == e)) e = 1e30f; if (e > 1e30f) e = 1e30f;
    __hip_atomic_fetch_max(ctl + CW_CHK + stage, __float_as_uint(e), RLX_AGENT);
}
__global__ void __launch_bounds__(256) chk_kernel(Args A, int stage) {
    unsigned char* ws = A.ws; gu32* ctl = (gu32*)(ws + WS_CTL);
    const int gt = blockIdx.x * 256 + threadIdx.x, NT = gridDim.x * 256;
    const bf16* SEGB = (const bf16*)(ws + WS_SEG);
    const bf16 *QA = SEGB, *KA = SEGB + (size_t)1 * M * SEGW, *VA = SEGB + (size_t)2 * M * SEGW, *QR = SEGB + (size_t)3 * M * SEGW, *KR = SEGB + (size_t)4 * M * SEGW, *VR = SEGB + (size_t)5 * M * SEGW, *GR = SEGB + (size_t)6 * M * SEGW;
    if (stage == 0) {
        const bf16* WIN = (const bf16*)(ws + WS_WIN); const bf16* WOUT = (const bf16*)(ws + WS_WOUT); const bf16* WGU = (const bf16*)(ws + WS_WGU); const bf16* WD = (const bf16*)(ws + WS_WD);
        for (int s = gt; s < 65536; s += NT) { const unsigned r = hsh(s * 7 + 1), r2 = hsh(r);
            { const int n = r % NIN, k = r2 % DM; chk_put(ctl, 0, ldb(WIN, (size_t)winperm(n) * DM + k), A.in[2][(size_t)k * NIN + n], 1e-4f); }
            { const int n = r % DM, k = r2 % DM; chk_put(ctl, 0, ldb(WOUT, (size_t)n * DM + k), A.in[7][(size_t)k * DM + n] * (k < 512 ? A.in[3][k] : A.in[6][k - 512]), 1e-4f); }
            { const int e = (r >> 10) % NEXP, j = r % FF, k = r2 % DM;
              chk_put(ctl, 0, ldb(WGU, ((size_t)e * DM + ((j >> 7) << 8) + (j & 127)) * DM + k), A.in[13][((size_t)e * DM + k) * FF + j], 1e-4f);
              chk_put(ctl, 0, ldb(WGU, ((size_t)e * DM + ((j >> 7) << 8) + 128 + (j & 127)) * DM + k), A.in[14][((size_t)e * DM + k) * FF + j], 1e-4f); }
            { const int e = (r >> 10) % NEXP, n = r % DM, k = r2 % FF; chk_put(ctl, 0, ldb(WD, ((size_t)e * DM + n) * FF + k), A.in[15][((size_t)e * FF + k) * DM + n], 1e-4f); }
            { const int j = r % 36, i = r2 % DM; const float ref = (j < 32 ? A.in[11][i * 32 + j] : A.in[9][i * 4 + j - 32]) * A.in[8][i]; chk_put(ctl, 0, ((const float*)(ws + WS_WRT))[j * DM + i], ref, 1e-6f); }
            { const int pos = r % SEQ, f = r2 % 40; const float fr = f < 8 ? powf(500000.f, -(float)f / 8.f) : powf(10000.f, -(float)(f - 8) / 31.f); const float ang = (float)pos * fr;
              chk_put(ctl, 0, ((const float*)(ws + WS_ROPE))[pos * 40 + f], cosf(ang), 2e-3f); chk_put(ctl, 0, ((const float*)(ws + WS_ROPE))[SEQ * 40 + pos * 40 + f], sinf(ang), 2e-3f); }
        }
        for (int s = gt; s < 2048; s += NT) { const unsigned r = hsh(s * 13 + 5); const int row = r % M, c = hsh(r) % DM; const float* x = A.in[0] + (size_t)row * DM; float ss = 0.f;
            for (int k = 0; k < DM; ++k) ss += x[k] * x[k];
            chk_put(ctl, 0, ldb((const bf16*)(ws + WS_XN), (size_t)row * DM + c), x[c] / sqrtf(ss / DM + NORM_EPS) * A.in[1][c], 1e-3f); }
    }
    if (stage == 1) {
        const bf16* XN = (const bf16*)(ws + WS_XN);
        for (int s = gt; s < 8192; s += NT) { const unsigned r = hsh(s * 3 + 11), r2 = hsh(r); const int row = r % M, seg = r2 % 7, hh = (r2 >> 4) % 8, pos = row & (SEQ - 1);
            const int half = (seg == 0 || seg == 1) ? 8 : 32; const int i = (r2 >> 8) % half; const int d1 = i, d2 = i + half;
            float a1 = 0.f, a2 = 0.f; const float* w = A.in[2] + seg * 512 + hh * 64;
            for (int k = 0; k < DM; ++k) { const float xv = ldb(XN, (size_t)row * DM + k); a1 += xv * rbf(w[(size_t)k * NIN + d1]); a2 += xv * rbf(w[(size_t)k * NIN + d2]); }
            const bf16* O = SEGB + (size_t)seg * M * SEGW + (size_t)row * SEGW + hh * 64;
            if (seg == 0 || seg == 1 || seg == 3 || seg == 4) {
                const float fr = seg < 2 ? powf(500000.f, -(float)i / 8.f) : powf(10000.f, -(float)i / 31.f); const float ang = (float)pos * fr, c = cosf(ang), sn = sinf(ang);
                const float sc = seg == 0 ? 0.125f * LOG2E : (seg == 4 ? 0.125f : 1.f);
                chk_put(ctl, 1, ldb(O, 2 * i), (a1 * c - a2 * sn) * sc, 0.02f); chk_put(ctl, 1, ldb(O, 2 * i + 1), (a2 * c + a1 * sn) * sc, 0.02f);
                if (seg < 2) { const int d3 = 16 + (r2 >> 12) % 48; float a3 = 0.f; for (int k = 0; k < DM; ++k) a3 += ldb(XN, (size_t)row * DM + k) * rbf(w[(size_t)k * NIN + d3]); chk_put(ctl, 1, ldb(O, d3), a3 * sc, 0.02f); }
            } else { chk_put(ctl, 1, ldb(O, d1), seg == 6 ? silu_f(a1) : a1, 0.02f); chk_put(ctl, 1, ldb(O, d2), seg == 6 ? silu_f(a2) : a2, 0.02f); }
        }
    }
    if (stage == 2) {
        const bf16* OBR = (const bf16*)(ws + WS_OBR); const float* LSE = (const float*)(ws + WS_LSE); const bf16* ST = (const bf16*)(ws + WS_ST);
        for (int s = gt; s < 4096; s += NT) { const unsigned r = hsh(s * 5 + 3), r2 = hsh(r); const int b = r % NBATCH, pos = (s < 256) ? (s & 1 ? SEQ - 1 - (s >> 1) % 80 : (s >> 1) % 80) : (r >> 3) % SEQ, h = r2 % NHEAD, br = (r2 >> 3) % 3, dd = (r2 >> 8) % HD;
            const int dil = 1 << (2 * br); const size_t row = (size_t)b * SEQ + pos;
            float mx = -1e30f;
            for (int pass = 0; pass < 2; ++pass) { float l = 0.f, o = 0.f;
                for (int j = -64; j <= 64; ++j) { const int kp = pos + j * dil; if (kp < 0 || kp >= SEQ) continue; const size_t kr = (size_t)b * SEQ + kp; float d = 0.f;
                    for (int k = 0; k < HD; ++k) d += ldb(QA, row * SEGW + h * HD + k) * ldb(KA, kr * SEGW + h * HD + k);
                    if (pass == 0) mx = fmaxf(mx, d); else { const float p = exp2f(d - mx); l += p; o += p * ldb(VA, kr * SEGW + h * HD + dd); } }
                if (pass == 1) { chk_put(ctl, 2, ldb(OBR, ((size_t)br * M + row) * SEGW + h * HD + dd), o / l, 0.02f); chk_put(ctl, 2, LSE[((size_t)br * M + row) * NHEAD + h], (mx + log2f(l)) * LN2, 0.02f); } }
        }
        for (int s = gt; s < 2048; s += NT) { const unsigned r = hsh(s * 9 + 7), r2 = hsh(r); const int bh = r % 64, dir = (r >> 6) & 1, n = (r >> 7) % NCHUNK, dv = r2 % 64, dk = (r2 >> 6) % 64, b = bh >> 3, h = bh & 7;
            const float lg2 = log1pf(-exp2f((dir ? A.in[5] : A.in[4])[h])) * LOG2E; float S = 0.f;
            for (int m = 0; m < NCHUNK; ++m) { if (dir == 0 ? m >= n : m <= n) continue;
                for (int j = 0; j < CHUNK; ++j) { const size_t row = (size_t)b * SEQ + m * CHUNK + j;
                    const float ex = dir == 0 ? (float)(128 * (n - 1 - m) + 127 - j) : (float)(128 * (m - n - 1) + j);
                    S += exp2f(ex * lg2) * ldb(KR, row * SEGW + h * HD + dk) * ldb(VR, row * SEGW + h * HD + dv); } }
            chk_put(ctl, 2, ldb(ST, ((((size_t)bh * 2 + dir) * NCHUNK + n) * 64 + dv) * 64 + dk), S, 0.05f);
        }
    }
    if (stage == 3) {
        const bf16* MIXED = (const bf16*)(ws + WS_MIXED);
        for (int s = gt; s < 512; s += NT) { const unsigned r = hsh(s * 17 + 9), r2 = hsh(r); const int b = r % NBATCH, pos = (s < 64) ? (s & 1 ? SEQ - 1 - (s >> 1) * 5 : (s >> 1) * 5) : (r >> 3) % SEQ, h = r2 % NHEAD; const size_t row = (size_t)b * SEQ + pos;
            const float lgf = log1pf(-exp2f(A.in[4][h])) * LOG2E, lgb = log1pf(-exp2f(A.in[5][h])) * LOG2E;
            float o[HD], qv[HD];
#pragma unroll
            for (int k = 0; k < HD; ++k) { o[k] = 0.f; qv[k] = ldb(QR, row * SEGW + h * HD + k); }
            for (int kp = 0; kp < SEQ; ++kp) { const size_t kr = (size_t)b * SEQ + kp; const int dl = pos - kp; const float w = dl >= 0 ? exp2f((float)dl * lgf) : exp2f((float)(-dl) * lgb); if (w < 1e-12f) continue; float d = 0.f;
#pragma unroll
                for (int k = 0; k < HD; ++k) d += qv[k] * ldb(KR, kr * SEGW + h * HD + k);
                d *= w;
#pragma unroll
                for (int k = 0; k < HD; ++k) o[k] += d * ldb(VR, kr * SEGW + h * HD + k); }
            float mean = 0.f, var = 0.f;
#pragma unroll
            for (int k = 0; k < HD; ++k) mean += o[k];
            mean *= (1.f / HD);
#pragma unroll
            for (int k = 0; k < HD; ++k) var += (o[k] - mean) * (o[k] - mean);
            var *= (1.f / HD); const float rstd = 1.f / sqrtf(var + NORM_EPS);
#pragma unroll
            for (int k = 0; k < HD; ++k) if ((k & 7) == (int)(r2 >> 8) % 8) chk_put(ctl, 3, ldb(MIXED, row * DM + 512 + h * HD + k), (o[k] - mean) * rstd * ldb(GR, row * SEGW + h * HD + k), 0.03f);
        }
        {
            const bf16* OBR = (const bf16*)(ws + WS_OBR); const float* LSE = (const float*)(ws + WS_LSE);
            for (int s = gt; s < 4096; s += NT) { const unsigned r = hsh(s * 19 + 1), r2 = hsh(r); const int row = r % M, csel = r2 % 512; float ss = 0.f, osel = 0.f;
                for (int c = 0; c < 512; ++c) { const int h = c >> 6; const float l0 = LSE[((size_t)0 * M + row) * NHEAD + h], l1 = LSE[((size_t)1 * M + row) * NHEAD + h], l2 = LSE[((size_t)2 * M + row) * NHEAD + h];
                    const float mx = fmaxf(l0, fmaxf(l1, l2)), w0 = expf(l0 - mx), w1 = expf(l1 - mx), w2 = expf(l2 - mx);
                    const float o = (w0 * ldb(OBR, ((size_t)0 * M + row) * SEGW + c) + w1 * ldb(OBR, ((size_t)1 * M + row) * SEGW + c) + w2 * ldb(OBR, ((size_t)2 * M + row) * SEGW + c)) / (w0 + w1 + w2);
                    ss += o * o; if (c == csel) osel = o; }
                chk_put(ctl, 3, ldb(MIXED, (size_t)row * DM + csel), osel / sqrtf(ss / 512.f + NORM_EPS), 0.03f); }
        }
    }
    if (stage == 4) {
        const bf16* MIXED = (const bf16*)(ws + WS_MIXED); const bf16* WOUT = (const bf16*)(ws + WS_WOUT); const float* H = (const float*)(ws + WS_H); const bf16* HG = (const bf16*)(ws + WS_HG);
        for (int s = gt; s < 16384; s += NT) { const unsigned r = hsh(s * 23 + 3); const int row = r % M, c = hsh(r) % DM; float a = 0.f;
            for (int k = 0; k < DM; ++k) a += ldb(MIXED, (size_t)row * DM + k) * ldb(WOUT, (size_t)c * DM + k);
            const float h = a + A.in[0][(size_t)row * DM + c]; chk_put(ctl, 4, H[(size_t)row * DM + c], h, 0.02f); chk_put(ctl, 4, ldb(HG, (size_t)row * DM + c), h * A.in[8][c], 0.02f); }
    }
    if (stage == 5) {
        const float* H = (const float*)(ws + WS_H); const int* LIST = (const int*)(ws + WS_LIST); const float* GATEL = (const float*)(ws + WS_GATEL); const float* RSL = (const float*)(ws + WS_RSL);
        if (gt == 0) { unsigned tot = 0; for (int e = 0; e < NEXP; ++e) tot += ctl[CW_CNT + 64 * e]; chk_put(ctl, 5, (float)tot, (float)(2 * M), 0.5f); }
        for (int s = gt; s < 2048; s += NT) { const int t = hsh(s * 29 + 5) % M; const float* h = H + (size_t)t * DM; float ss = 0.f;
            for (int k = 0; k < DM; ++k) ss += h[k] * h[k];
            const float rs = 1.f / sqrtf(ss / DM + NORM_EPS); float gl[4]; int gi = 0;
            for (int g = 0; g < 4; ++g) { float a = 0.f; for (int k = 0; k < DM; ++k) a += h[k] * rs * A.in[8][k] * A.in[9][k * 4 + g]; gl[g] = a + A.in[10][g]; if (gl[g] > gl[gi]) gi = g; }
            float den = 0.f; for (int g = 0; g < 4; ++g) den += expf(gl[g] - gl[gi]);
            float b1 = -3e38f, b2 = -3e38f, b3 = -3e38f; int i1 = 0, i2 = 0;
            for (int e = 0; e < 8; ++e) { float a = 0.f; for (int k = 0; k < DM; ++k) a += h[k] * rs * A.in[8][k] * A.in[11][k * 32 + gi * 8 + e]; a += A.in[12][gi * 8 + e];
                if (a > b1) { b3 = b2; b2 = b1; i2 = i1; b1 = a; i1 = e; } else if (a > b2) { b3 = b2; b2 = a; i2 = e; } else if (a > b3) b3 = a; }
            float second = -3e38f; for (int g = 0; g < 4; ++g) if (g != gi) second = fmaxf(second, gl[g]);
            if (gl[gi] - second < 1e-3f || b2 - b3 < 1e-3f || b1 - b2 < 1e-3f) continue;
            const float p1 = 1.f / (1.f + expf(b2 - b1)); const float g1 = p1 / den, g2 = (1.f - p1) / den;
            for (int k = 0; k < 2; ++k) { const int e = gi * 8 + (k ? i2 : i1); const int n = (int)ctl[CW_CNT + 64 * e]; int found = -1;
                for (int p = 0; p < n && p < M; ++p) if (LIST[(size_t)e * M + p] == t * 2 + k) { found = p; break; }
                if (found < 0) chk_put(ctl, 5, 0.f, 100.f, 0.1f); else { chk_put(ctl, 5, GATEL[(size_t)e * M + found], k ? g2 : g1, 1e-3f); chk_put(ctl, 5, RSL[(size_t)e * M + found], rs, 1e-4f); } }
        }
    }
    if (stage == 6 || stage == 7) {
        const int* LIST = (const int*)(ws + WS_LIST); const float* GATEL = (const float*)(ws + WS_GATEL); const float* RSL = (const float*)(ws + WS_RSL);
        const bf16* HG = (const bf16*)(ws + WS_HG); const bf16* WGU = (const bf16*)(ws + WS_WGU); const bf16* HID = (const bf16*)(ws + WS_HID); const bf16* WD = (const bf16*)(ws + WS_WD); const bf16* Y = (const bf16*)(ws + WS_Y);
        for (int s = gt; s < 8192; s += NT) { const unsigned r = hsh(s * 31 + 7), r2 = hsh(r); const int e = r % NEXP; const int ne = (int)ctl[CW_CNT + 64 * e]; if (ne <= 0) continue;
            int t0 = 0; for (int q = 0; q < e; ++q) t0 += ((int)ctl[CW_CNT + 64 * q] + 255) >> 8;
            const int pos = (s & 3) == 0 ? ne - 1 - (int)((r >> 5) % (ne < 300 ? ne : 300)) : (int)((r >> 5) % ne); const size_t slot = (size_t)t0 * 256 + pos; const int tk = LIST[(size_t)e * M + pos], t = tk >> 1;
            if (stage == 6) { const int j = r2 % FF; float g = 0.f, u = 0.f; const bf16* wg = WGU + ((size_t)e * DM + ((j >> 7) << 8) + (j & 127)) * DM; const bf16* wu = wg + (size_t)128 * DM;
                for (int k = 0; k < DM; ++k) { const float xv = ldb(HG, (size_t)t * DM + k); g += xv * ldb(wg, k); u += xv * ldb(wu, k); }
                const float rs = RSL[(size_t)e * M + pos]; chk_put(ctl, 6, ldb(HID, slot * FF + j), silu_f(g * rs) * (u * rs) * GATEL[(size_t)e * M + pos], 0.01f); }
            else { const int c = r2 % DM; float a = 0.f; for (int k = 0; k < FF; ++k) a += ldb(HID, slot * FF + k) * ldb(WD, ((size_t)e * DM + c) * FF + k);
                chk_put(ctl, 7, ldb(Y, (size_t)tk * DM + c), a, 0.01f); }
        }
    }
    if (stage == 8) {
        const float* H = (const float*)(ws + WS_H); const bf16* Y = (const bf16*)(ws + WS_Y);
        for (int s = gt; s < 4096; s += NT) { const unsigned r = hsh(s * 37 + 1); const int row = r % M, c = hsh(r) % DM; float ss = 0.f, zc = 0.f;
            for (int k = 0; k < DM; ++k) { const float z = H[(size_t)row * DM + k] + ldb(Y, (size_t)(2 * row) * DM + k) + ldb(Y, (size_t)(2 * row + 1) * DM + k); ss += z * z; if (k == c) zc = z; }
            chk_put(ctl, 8, A.out[(size_t)row * DM + c], zc / sqrtf(ss / DM + NORM_EPS) * A.in[16][c], 0.01f); }
    }
}
__global__ void __launch_bounds__(256) chk_final(Args A) {
    gu32* ctl = (gu32*)(A.ws + WS_CTL); int bad = -1; float err = 0.f;
    for (int s = 0; s < 9; ++s) { const float e = __uint_as_float(ctl[CW_CHK + s]); if (e > 1.f) { bad = s; err = e; break; } }
    if (bad < 0 && ctl[CW_BAR + XB_TMO] != 0u) { bad = 10; err = 1.f; }
    if (bad < 0) return;
    float mant = 1.f + log10f(err); if (mant > 9.9f) mant = 9.9f; if (mant < 1.f) mant = 1.f;
    const float C = sqrtf(mant * powf(10.f, (float)(bad + 3)));
    for (size_t i = blockIdx.x * 256 + threadIdx.x; i < (size_t)M * DM; i += (size_t)gridDim.x * 256) A.out[i] = C;
}
#endif

extern "C" void kernel_launch(void* const* d_in, const int* in_sizes, int n_in, void* d_out, int out_size, void* d_ws, size_t ws_size, hipStream_t stream) {
    static int grid = 0;
    if (grid == 0) {
        if (n_in != 17 || in_sizes[0] != M * DM || out_size != M * DM || ws_size < WS_END) { fprintf(stderr, "kernel_launch: unexpected shapes (n_in %d, in0 %d, out %d, ws %zu); nothing launched\n", n_in, n_in > 0 ? in_sizes[0] : -1, out_size, ws_size); grid = -1; return; }
        int dev = 0, cus = 0, per_cu = 0;
        if (hipGetDevice(&dev) != hipSuccess || hipDeviceGetAttribute(&cus, hipDeviceAttributeMultiprocessorCount, dev) != hipSuccess) { grid = -1; return; }
        if (hipFuncSetAttribute((const void*)mk_fwd, hipFuncAttributeMaxDynamicSharedMemorySize, LDS_BYTES) != hipSuccess) { fprintf(stderr, "kernel_launch: hipFuncSetAttribute failed\n"); grid = -1; return; }
        if (hipOccupancyMaxActiveBlocksPerMultiprocessor(&per_cu, (const void*)mk_fwd, NWAVES * 64, LDS_BYTES) != hipSuccess || per_cu < 1) { fprintf(stderr, "kernel_launch: occupancy query says %d blocks per CU; nothing launched\n", per_cu); (void)hipGetLastError(); grid = -1; return; }
        grid = cus;
    }
    if (grid < 0) return;
    if (hipMemsetAsync((char*)d_ws + WS_CTL, 0, CTL_ZERO_BYTES, stream) != hipSuccess) { fprintf(stderr, "kernel_launch: memset failed\n"); return; }
    Args a{};
    for (int i = 0; i < 17; ++i) a.in[i] = (const float*)d_in[i];
    a.out = (float*)d_out; a.ws = (unsigned char*)d_ws;
    const double TWO_PI = 6.283185307179586476925286766559;
    for (int i = 0; i < 8; ++i) a.frev[i] = std::pow(500000.0, -(double)i / 8.0) / TWO_PI;
    for (int i = 0; i < 32; ++i) a.frev[8 + i] = std::pow(10000.0, -(double)i / 31.0) / TWO_PI;
    if (N_LAUNCHES == 1) {
        a.ph_lo = 0; a.ph_hi = PER_PHASE; a.li = 0;
        void* kargs[] = {&a};
        const hipError_t le = hipLaunchCooperativeKernel((const void*)mk_fwd, dim3(grid), dim3(NWAVES * 64), kargs, LDS_BYTES, stream);
        if (le != hipSuccess) fprintf(stderr, "kernel_launch: cooperative launch failed: %s (grid %d)\n", hipGetErrorName(le), grid);
    } else {
        for (int li = 0; li < PER_PHASE; ++li) {
            a.ph_lo = li; a.ph_hi = li + 1; a.li = 0;
            hipLaunchKernelGGL(mk_fwd, dim3(grid), dim3(NWAVES * 64), LDS_BYTES, stream, a);
#if MK_CHECK
            hipLaunchKernelGGL(chk_kernel, dim3(256), dim3(256), 0, stream, a, li);
#endif
        }
#if MK_CHECK
        hipLaunchKernelGGL(chk_final, dim3(1024), dim3(256), 0, stream, a);
#endif
    }
}
```

```cpp
#include <hip/hip_runtime.h>
#include <cstdio>
#include <cstdint>
#include <cmath>

#ifndef MK_N_LAUNCHES
#define MK_N_LAUNCHES 1
#endif
#ifndef MK_TIME
#define MK_TIME 0
#endif
#ifndef MK_REPEAT
#define MK_REPEAT -1
#endif
#ifndef MK_NREP
#define MK_NREP 2
#endif
#ifndef MK_CHECK
#define MK_CHECK 0
#endif

#define LAS __attribute__((address_space(3)))
#define GAS __attribute__((address_space(1)))
typedef unsigned short bf16;
typedef short bf16x8 __attribute__((ext_vector_type(8)));
typedef short s16x4 __attribute__((ext_vector_type(4)));
typedef float f32x2 __attribute__((ext_vector_type(2)));
typedef float f32x4 __attribute__((ext_vector_type(4)));
typedef float f32x16 __attribute__((ext_vector_type(16)));
typedef unsigned u32x2 __attribute__((ext_vector_type(2)));
typedef unsigned u32x4 __attribute__((ext_vector_type(4)));
typedef __bf16 bf16x2_t __attribute__((ext_vector_type(2)));
typedef GAS unsigned gu32;

constexpr int NBATCH = 8, SEQ = 4096, DM = 1024, M = NBATCH * SEQ;
constexpr int NIN = 3584, SEGW = 512, NHEAD = 8, HD = 64;
constexpr int NEXP = 32, FF = 512, NGRP = 4, EPG = 8;
constexpr int CHUNK = 128, NCHUNK = SEQ / CHUNK;
constexpr float NORM_EPS = 1e-6f;
constexpr float LOG2E = 1.4426950408889634f, LN2 = 0.6931471805599453f;
constexpr int NWAVES = 8;
constexpr int MAXTILES = 288;

constexpr size_t MiB = 1u << 20;
constexpr size_t WS_CTL = 0, CTL_ZERO_BYTES = 1 * MiB;
constexpr size_t WS_WRT = 1 * MiB;
constexpr size_t WS_ROPE = 2 * MiB;
constexpr size_t WS_LSE = 4 * MiB;
constexpr size_t WS_LIST = 8 * MiB;
constexpr size_t WS_GATEL = 12 * MiB;
constexpr size_t WS_RSL = 16 * MiB;
constexpr size_t WS_WIN = 20 * MiB;
constexpr size_t WS_WOUT = 27 * MiB;
constexpr size_t WS_WD = 30 * MiB;
constexpr size_t WS_WGU = 62 * MiB;
constexpr size_t WS_ST = 126 * MiB;
constexpr size_t WS_SBW = 478 * MiB;
constexpr size_t WS_XN = 158 * MiB;
constexpr size_t WS_OBR = 158 * MiB;
constexpr size_t WS_SEG = 254 * MiB;
constexpr size_t SEG_BYTES = (size_t)M * SEGW * 2;
constexpr size_t WS_MIXED = 254 * MiB;
constexpr size_t WS_H = 350 * MiB;
constexpr size_t WS_HG = 158 * MiB;
constexpr size_t WS_HID = 222 * MiB;
constexpr size_t WS_Y = 64 * MiB;
constexpr size_t WS_END = 494 * MiB;
constexpr int CW_CNT = 64;
constexpr int CW_BAR = 4096;
constexpr int CW_CHK = 16384;
constexpr int CW_TS = 20480;

constexpr int RING_BYTES = 147456;
constexpr int LDSCTL_OFF = RING_BYTES, MISC_OFF = LDSCTL_OFF + 320;
constexpr int TILE_OFF = MISC_OFF + 128;
constexpr int LDS_BYTES = 151552;

#define RLX_AGENT __ATOMIC_RELAXED, __HIP_MEMORY_SCOPE_AGENT
#define LDS_WAIT() asm volatile("s_waitcnt lgkmcnt(0)" ::: "memory")
#define VM_WAIT() asm volatile("s_waitcnt vmcnt(0)" ::: "memory")
__device__ __forceinline__ unsigned pk2(float lo, float hi) { f32x2 v = {lo, hi}; bf16x2_t b = __builtin_convertvector(v, bf16x2_t); return __builtin_bit_cast(unsigned, b); }
__device__ __forceinline__ float bflo(unsigned u) { return __uint_as_float(u << 16); }
__device__ __forceinline__ float bfhi(unsigned u) { return __uint_as_float(u & 0xffff0000u); }
__device__ __forceinline__ float bf2f(short s) { return __uint_as_float(((unsigned)(unsigned short)s) << 16); }
__device__ __forceinline__ int crow(int r, int hi) { return (r & 3) + 8 * (r >> 2) + 4 * hi; }
__device__ __forceinline__ float wave_sum(float v) {
#pragma unroll
    for (int o = 1; o < 64; o <<= 1) v += __shfl_xor(v, o);
    return v;
}
__device__ __forceinline__ float silu_f(float v) { return v / (1.f + __expf(-v)); }

namespace pg8 {
constexpr int BM = 256, BK = 64, HALF = 128, HTB = HALF * BK * 2, STAGE_BYTES = 8 * HTB, NXCD = 8, WGM = 8;
__host__ __device__ __forceinline__ int lds_byte(int r, int c) { const int st = (r >> 4) * 2 + (c >> 5), rr = r & 15, cc = c & 31, ob = rr * 64 + cc * 2; return st * 1024 + (ob ^ (((ob >> 9) & 1) << 5)); }
__host__ __device__ __forceinline__ void stage_rc(int b, int& R, int& C) { const int st = b / 1024, sb = b % 1024, swz = sb ^ (((sb >> 9) & 1) << 5); R = (st >> 1) * 16 + swz / 64; C = (st & 1) * 32 + (swz % 64) / 2; }
__host__ __device__ __forceinline__ int perm32(int rho) { const int n = rho >> 4, i = rho & 15; return 8 * (i >> 2) + 4 * n + (i & 3); }

struct Unit { int pm, pn; };
struct StaticOrder {
    int nM, nN, nwg, G, c;
    __device__ void init(int nM_, int nN_, int G_, int c_) { nM = nM_; nN = nN_; nwg = nM * nN; G = G_; c = c_; }
    __device__ bool next(int i, Unit& u) const {
        const long L = (long)i * G + c; if (L >= nwg) return false;
        int wgid = (int)L; { const int q = nwg / NXCD, r = nwg % NXCD, xcd = wgid % NXCD, off = wgid / NXCD; wgid = (xcd < r ? xcd * (q + 1) : r * (q + 1) + (xcd - r) * q) + off; }
        const int nig = WGM * nN, gid = wgid / nig, fm = gid * WGM, gsz = (nM - fm) < WGM ? (nM - fm) : WGM;
        u.pm = fm + ((wgid % nig) % gsz); u.pn = (wgid % nig) / gsz; return true;
    }
};

template <class Epi, class Sched, class Src, bool ALIGN_EPI, bool SP2>
__device__ __forceinline__ void gemm_phase(LAS unsigned char* lds, const int K, const Sched& S, const Src& SRC, const Epi& E) {
    int tid_ = threadIdx.x; asm volatile("" : "+v"(tid_));
    const int tid = tid_, wid = __builtin_amdgcn_readfirstlane(tid >> 6), lane = tid & 63, wr = wid >> 2, wc = wid & 3, fr = lane & 15, fq = lane >> 4;
    const int nt = K / BK;
    unsigned voffB[2]; int RA[2], CA[2];
#pragma unroll
    for (int i = 0; i < 2; ++i) { int R, C; stage_rc(tid * 16 + i * 8192, R, C); const int Rb = Epi::PERM ? ((R & ~31) + perm32(R & 31)) : R;
        RA[i] = R; CA[i] = C; voffB[i] = (unsigned)(Rb * K + C) * 2u; }
    const size_t kstep = (size_t)(BK * 2);
    const size_t hstep = (size_t)HALF * K * 2;
    const unsigned ldsw = (unsigned)wid * 1024u;
    const int aoff = lds_byte(wr * 64 + fr, fq * 8), boff = lds_byte(wc * 32 + fr, fq * 8);
#define PG8_SA(b, h) (((b) * 2 + (h)) * HTB)
#define PG8_SB(b, h) ((4 + (b) * 2 + (h)) * HTB)
#define PG8_STAGE(bufoff, gbase, voff) do { _Pragma("unroll") for (int _i = 0; _i < 2; ++_i) \
        __builtin_amdgcn_global_load_lds((const unsigned*)((const char*)(gbase) + (voff)[_i]), (LAS unsigned*)(lds + (bufoff) + ldsw + _i * 8192), 16, 0, 0); } while (0)
#define PG8_LDA(dst, b, h) do { _Pragma("unroll") for (int m = 0; m < 4; ++m) _Pragma("unroll") for (int k = 0; k < 2; ++k) dst[m][k] = *(const LAS bf16x8*)(lds + PG8_SA(b, h) + aoff + m * 2048 + k * 1024); } while (0)
#define PG8_LDB(dst, b, h) do { _Pragma("unroll") for (int n = 0; n < 2; ++n) _Pragma("unroll") for (int k = 0; k < 2; ++k) dst[n][k] = *(const LAS bf16x8*)(lds + PG8_SB(b, h) + boff + n * 2048 + k * 1024); } while (0)
#define PG8_MMA(ai, bj, At, Bt) do { __builtin_amdgcn_s_setprio(1); _Pragma("unroll") for (int m = 0; m < 4; ++m) _Pragma("unroll") for (int n = 0; n < 2; ++n) _Pragma("unroll") for (int k = 0; k < 2; ++k) \
        acc[ai][bj][m][n] = __builtin_amdgcn_mfma_f32_16x16x32_bf16(Bt[n][k], At[m][k], acc[ai][bj][m][n], 0, 0, 0); __builtin_amdgcn_s_setprio(0); } while (0)
#define PG8_WAIT_V(n) asm volatile("s_waitcnt vmcnt(" #n ")" ::: "memory")
#define PG8_WAIT_L(n) asm volatile("s_waitcnt lgkmcnt(" #n ")" ::: "memory")
#define PG8_BAR __builtin_amdgcn_s_barrier()
#define PG8_SCHED __builtin_amdgcn_sched_barrier(0)
    Unit cur, nxt; int ui = 0;
    if (!S.next(0, cur)) return;
    f32x4 acc[2][2][4][2];
#pragma unroll
    for (int a = 0; a < 2; ++a)
#pragma unroll
        for (int b = 0; b < 2; ++b)
#pragma unroll
            for (int m = 0; m < 4; ++m)
#pragma unroll
                for (int n = 0; n < 2; ++n) acc[a][b][m][n] = (f32x4){0.f, 0.f, 0.f, 0.f};
    bf16x8 At[4][2], B0[2][2], B1[2][2];
    const char *cA, *cB; unsigned vA0[2], vA1[2];
    SRC.setup(cur, RA, CA, cA, cB, vA0, vA1);
    if constexpr (SP2) {
        PG8_STAGE(PG8_SB(0, 0), cB, voffB); PG8_STAGE(PG8_SB(0, 1), cB + hstep, voffB); PG8_STAGE(PG8_SA(0, 0), cA, vA0); PG8_STAGE(PG8_SA(0, 1), cA, vA1);
        if (wr == 1) PG8_BAR;
        PG8_WAIT_V(2); PG8_BAR;
        PG8_STAGE(PG8_SB(1, 0), cB + kstep, voffB); PG8_STAGE(PG8_SA(1, 0), cA + kstep, vA0); PG8_STAGE(PG8_SB(1, 1), cB + hstep + kstep, voffB);
        PG8_WAIT_V(6); PG8_BAR;
    } else {
        PG8_STAGE(PG8_SB(0, 0), cB, voffB); PG8_STAGE(PG8_SA(0, 0), cA, vA0); PG8_STAGE(PG8_SB(0, 1), cB + hstep, voffB); PG8_STAGE(PG8_SA(0, 1), cA, vA1);
        if (wr == 1) PG8_BAR;
        PG8_WAIT_V(4); PG8_BAR;
        PG8_STAGE(PG8_SB(1, 0), cB + kstep, voffB); PG8_STAGE(PG8_SA(1, 0), cA + kstep, vA0); PG8_STAGE(PG8_SB(1, 1), cB + hstep + kstep, voffB);
        PG8_WAIT_V(6); PG8_BAR;
    }
    for (;;) {
        const bool has_next = S.next(ui + 1, nxt);
        const char *nA = cA, *nB = cB; unsigned wA0[2] = {vA0[0], vA0[1]}, wA1[2] = {vA1[0], vA1[1]};
        if (has_next) SRC.setup(nxt, RA, CA, nA, nB, wA0, wA1);
        for (int t = 0; t < nt; t += 2) {
            const bool last = (t == nt - 2);
            const char* a1 = cA + (size_t)(t + 1) * kstep;
            const char* a2 = last ? nA : cA + (size_t)(t + 2) * kstep; const char* b2 = last ? nB : cB + (size_t)(t + 2) * kstep;
            const char* a3 = a2 + kstep; const char* b3 = b2 + kstep;
            unsigned x0[2], x1[2];
            x0[0] = last ? wA0[0] : vA0[0]; x0[1] = last ? wA0[1] : vA0[1]; x1[0] = last ? wA1[0] : vA1[0]; x1[1] = last ? wA1[1] : vA1[1];
            if constexpr (SP2) {
            PG8_LDB(B0, 0, 0); PG8_LDB(B1, 0, 1); PG8_SCHED; PG8_LDA(At, 0, 0); PG8_STAGE(PG8_SA(1, 1), a1, vA1);
            PG8_WAIT_V(8); PG8_WAIT_L(0); PG8_BAR; PG8_MMA(0, 0, At, B0); PG8_MMA(0, 1, At, B1); PG8_BAR; PG8_SCHED;
            PG8_LDA(At, 0, 1); PG8_STAGE(PG8_SB(0, 0), b2, voffB); PG8_STAGE(PG8_SB(0, 1), b2 + hstep, voffB); PG8_STAGE(PG8_SA(0, 0), a2, x0);
            PG8_WAIT_V(8); PG8_WAIT_L(0); PG8_BAR; PG8_MMA(1, 0, At, B0); PG8_MMA(1, 1, At, B1); PG8_BAR; PG8_SCHED;
            PG8_LDB(B0, 1, 0); PG8_LDB(B1, 1, 1); PG8_SCHED; PG8_LDA(At, 1, 0); PG8_STAGE(PG8_SA(0, 1), a2, x1);
            PG8_WAIT_V(8); PG8_WAIT_L(0); PG8_BAR; PG8_MMA(0, 0, At, B0); PG8_MMA(0, 1, At, B1); PG8_BAR; PG8_SCHED;
            PG8_LDA(At, 1, 1); PG8_STAGE(PG8_SB(1, 0), b3, voffB); PG8_STAGE(PG8_SB(1, 1), b3 + hstep, voffB); PG8_STAGE(PG8_SA(1, 0), a3, x0);
            PG8_WAIT_V(8); PG8_WAIT_L(0); PG8_BAR; PG8_MMA(1, 0, At, B0); PG8_MMA(1, 1, At, B1); PG8_BAR; PG8_SCHED;
            } else {
            PG8_LDB(B0, 0, 0); PG8_SCHED; PG8_LDA(At, 0, 0); PG8_STAGE(PG8_SA(1, 1), a1, vA1);
            PG8_WAIT_L(8); PG8_BAR; PG8_WAIT_L(0); PG8_MMA(0, 0, At, B0); PG8_BAR; PG8_SCHED;
            PG8_LDB(B1, 0, 1); PG8_STAGE(PG8_SB(0, 0), b2, voffB);
            PG8_BAR; PG8_WAIT_L(0); PG8_MMA(0, 1, At, B1); PG8_BAR;
            PG8_LDA(At, 0, 1); PG8_STAGE(PG8_SA(0, 0), a2, x0);
            PG8_BAR; PG8_WAIT_L(0); PG8_MMA(1, 0, At, B0); PG8_BAR; PG8_SCHED;
            PG8_STAGE(PG8_SB(0, 1), b2 + hstep, voffB);
            PG8_WAIT_V(6); PG8_BAR; PG8_MMA(1, 1, At, B1); PG8_BAR;
            PG8_LDB(B0, 1, 0); PG8_SCHED; PG8_LDA(At, 1, 0); PG8_STAGE(PG8_SA(0, 1), a2, x1);
            PG8_WAIT_L(8); PG8_BAR; PG8_WAIT_L(0); PG8_MMA(0, 0, At, B0); PG8_BAR; PG8_SCHED;
            PG8_LDB(B1, 1, 1); PG8_STAGE(PG8_SB(1, 0), b3, voffB);
            PG8_BAR; PG8_WAIT_L(0); PG8_MMA(0, 1, At, B1); PG8_BAR;
            PG8_LDA(At, 1, 1); PG8_STAGE(PG8_SA(1, 0), a3, x0);
            PG8_BAR; PG8_WAIT_L(0); PG8_MMA(1, 0, At, B0); PG8_BAR; PG8_SCHED;
            PG8_STAGE(PG8_SB(1, 1), b3 + hstep, voffB);
            PG8_WAIT_V(6); PG8_BAR; PG8_MMA(1, 1, At, B1); PG8_BAR;
            }
        }
        if constexpr (ALIGN_EPI) { if (wr == 0) PG8_BAR; }
        E(acc, cur, wr, wc, fr, fq);
        if (!has_next) break;
#pragma unroll
        for (int a = 0; a < 2; ++a)
#pragma unroll
            for (int b = 0; b < 2; ++b)
#pragma unroll
                for (int m = 0; m < 4; ++m)
#pragma unroll
                    for (int n = 0; n < 2; ++n) acc[a][b][m][n] = (f32x4){0.f, 0.f, 0.f, 0.f};
        cur = nxt; cA = nA; cB = nB; vA0[0] = wA0[0]; vA0[1] = wA0[1]; vA1[0] = wA1[0]; vA1[1] = wA1[1]; ++ui;
        if constexpr (ALIGN_EPI) { if (wr == 1) PG8_BAR; }
    }
    PG8_WAIT_V(0);
    if constexpr (!ALIGN_EPI) { if (wr == 0) PG8_BAR; }
    PG8_BAR;
#undef PG8_SA
#undef PG8_SB
#undef PG8_STAGE
#undef PG8_LDA
#undef PG8_LDB
#undef PG8_MMA
#undef PG8_WAIT_V
#undef PG8_WAIT_L
#undef PG8_BAR
#undef PG8_SCHED
}
}

#define XB_TMO      128
#define XB_XCNT(j)  (256  + 64 * (j))
#define XB_XSUB(j)  (1280 + 64 * (j))
#define XB_XGEN(j)  (2304 + 64 * (j))
#define XB_TOP      3328
#define XB_TOPGEN   3392
#define XCD_BAR_WORDS 3456
#define XB_SPIN_CAP (1u << 18)
__device__ __forceinline__ unsigned xb_ld(unsigned* p)              { return __hip_atomic_load(p, __ATOMIC_RELAXED, __HIP_MEMORY_SCOPE_AGENT); }
__device__ __forceinline__ unsigned xb_add(unsigned* p, unsigned v) { return __hip_atomic_fetch_add(p, v, __ATOMIC_RELAXED, __HIP_MEMORY_SCOPE_AGENT); }
__device__ __forceinline__ unsigned xb_xcc_id() { return (unsigned)__builtin_amdgcn_s_getreg((3 << 11) | 20) & 0xFu; }
#define XB_SPIN(cond, bar) do { unsigned _sp = 0; while (cond) { __builtin_amdgcn_s_sleep(1); \
    if ((++_sp & 255u) == 0u) { if (xb_ld(&(bar)[XB_TMO])) break; if (_sp > XB_SPIN_CAP) { atomicAdd(&(bar)[XB_TMO], 1u); break; } } } } while (0)
struct XcdBarrier { unsigned* bar; unsigned x; volatile LAS unsigned* st; };
__device__ __forceinline__ XcdBarrier xcd_barrier_post(unsigned* bar, volatile LAS unsigned* st) {
    XcdBarrier b; b.bar = bar; b.x = xb_xcc_id(); b.st = st;
    if (threadIdx.x == 0) (void)xb_add(&bar[XB_XCNT(b.x)], 1u);
    return b;
}
__device__ __forceinline__ void xcd_barrier_complete(unsigned* bar, unsigned x, unsigned& nloc, unsigned& nx) {
    const unsigned G = gridDim.x * gridDim.y * gridDim.z;
    unsigned sum, cnt, mine, sp = 0u;
    for (;;) {
        sum = 0u; cnt = 0u; mine = 0u;
#pragma unroll
        for (unsigned j = 0; j < 16; ++j) { const unsigned c = xb_ld(&bar[XB_XCNT(j)]); sum += c; cnt += (c > 0u) ? 1u : 0u; mine = (j == x) ? c : mine; }
        if (sum == G) break;
        __builtin_amdgcn_s_sleep(1);
        if ((++sp & 255u) == 0u) { if (xb_ld(&bar[XB_TMO])) break; if (sp > XB_SPIN_CAP) { atomicAdd(&bar[XB_TMO], 1u); break; } }
    }
    nloc = mine > 0u ? mine : 1u; nx = cnt > 0u ? cnt : 1u;
}
__device__ __forceinline__ void xcd_barrier(const XcdBarrier& b) {
    asm volatile("s_waitcnt vmcnt(0)" ::: "memory");
    __syncthreads();
    if (threadIdx.x == 0) {
        unsigned* bar = b.bar;
        __builtin_amdgcn_s_waitcnt(0);
        unsigned nloc = b.st[0], nx = b.st[1];
        if (nloc == 0u) { xcd_barrier_complete(bar, b.x, nloc, nx); b.st[0] = nloc; b.st[1] = nx; }
        const unsigned old = xb_add(&bar[XB_XSUB(b.x)], 1u);
        const unsigned gen = old / nloc;
        if (old + 1u == (gen + 1u) * nloc) {
            __builtin_amdgcn_fence(__ATOMIC_RELEASE, "agent");
            asm volatile("s_waitcnt vmcnt(0)" ::: "memory");
            const unsigned og = xb_add(&bar[XB_TOP], 1u);
            const unsigned tg = og / nx;
            if (og + 1u == (tg + 1u) * nx) xb_add(&bar[XB_TOPGEN], 1u);
            else XB_SPIN(xb_ld(&bar[XB_TOPGEN]) == tg, bar);
            __builtin_amdgcn_fence(__ATOMIC_ACQUIRE, "agent");
            xb_add(&bar[XB_XGEN(b.x)], 1u);
            asm volatile("s_waitcnt vmcnt(0)" ::: "memory");
        } else {
            XB_SPIN(xb_ld(&bar[XB_XGEN(b.x)]) == gen, bar);
            __builtin_amdgcn_fence(__ATOMIC_ACQUIRE, "agent");
            asm volatile("s_waitcnt vmcnt(0)" ::: "memory");
        }
    }
    __syncthreads();
}

struct Args {
    const float* in[17]; float* out; unsigned char* ws;
    double frev[40];
    int ph_lo, ph_hi, li, pad;
};
struct Frame {
    LAS unsigned char* lds;
    volatile LAS unsigned* MISC;
    gu32* ctl;
    int tid, lane, wave, vcu, G;
};

__device__ __forceinline__ int winperm(int n) {
    const int s = n >> 9, c = n & 511, hh = c >> 6, d = c & 63; int dp = d;
    if (s == 0 || s == 1) { if (d < 16) dp = 2 * (d & 7) + (d >> 3); }
    else if (s == 3 || s == 4) dp = 2 * (d & 31) + (d >> 5);
    return (s << 9) + (hh << 6) + dp;
}
template <int MODE>
__device__ __forceinline__ void p0_transpose_item(const float* S, int N, bf16* Dst, int Kd, LAS float* scr, int kb, int nb, int lane, const float* kscale) {
    const int k0 = 64 * kb, n0 = 32 * nb;
#pragma unroll 8
    for (int i = 0; i < 32; ++i) { const int kk = 2 * i + (lane >> 5); float v = S[(size_t)(k0 + kk) * N + n0 + (lane & 31)]; if (kscale) v *= kscale[k0 + kk]; scr[kk * 33 + (lane & 31)] = v; }
    LDS_WAIT(); asm volatile("" ::: "memory");
    const int c = lane & 7;
#pragma unroll
    for (int j = 0; j < 4; ++j) { const int n = (lane >> 3) + 8 * j; const LAS float* s = scr + (8 * c) * 33 + n;
        u32x4 o; o.x = pk2(s[0 * 33], s[1 * 33]); o.y = pk2(s[2 * 33], s[3 * 33]); o.z = pk2(s[4 * 33], s[5 * 33]); o.w = pk2(s[6 * 33], s[7 * 33]);
        const int ns = n0 + n; int row;
        if (MODE == 0) row = winperm(ns); else if (MODE == 1) row = ns; else if (MODE == 2) row = ((ns >> 7) << 8) + (ns & 127); else row = ((ns >> 7) << 8) + 128 + (ns & 127);
        *(GAS u32x4*)(Dst + (size_t)row * Kd + k0 + 8 * c) = o; }
    LDS_WAIT(); asm volatile("" ::: "memory");
}
__device__ __forceinline__ void p0_prologue(Frame& F, const Args& A) {
    unsigned char* ws = A.ws;
    LAS float* scr = (LAS float*)(F.lds + F.wave * 16384);
    const int gw = F.vcu * NWAVES + F.wave, NGW = F.G * NWAVES;
    constexpr int I_IN = 16 * 112, I_OUT = 16 * 32, I_G = 256, I_D = 256;
    constexpr int NITEMS = I_IN + I_OUT + NEXP * (2 * I_G + I_D);
    bf16* WIN = (bf16*)(ws + WS_WIN); bf16* WOUT = (bf16*)(ws + WS_WOUT); bf16* WGU = (bf16*)(ws + WS_WGU); bf16* WD = (bf16*)(ws + WS_WD);
    for (int it = gw; it < NITEMS; it += NGW) {
        int r = it;
        if (r < I_IN) { p0_transpose_item<0>(A.in[2], NIN, WIN, DM, scr, r / 112, r % 112, F.lane, nullptr); continue; } r -= I_IN;
        if (r < I_OUT) { const int kb = r / 32; p0_transpose_item<1>(A.in[7], DM, WOUT, DM, scr, kb, r % 32, F.lane, kb < 8 ? A.in[3] : A.in[6] - 512); continue; } r -= I_OUT;
        const int e = r / (2 * I_G + I_D); r -= e * (2 * I_G + I_D);
        if (r < I_G) { p0_transpose_item<2>(A.in[13] + (size_t)e * DM * FF, FF, WGU + (size_t)e * DM * DM, DM, scr, r / 16, r % 16, F.lane, nullptr); continue; } r -= I_G;
        if (r < I_G) { p0_transpose_item<3>(A.in[14] + (size_t)e * DM * FF, FF, WGU + (size_t)e * DM * DM, DM, scr, r / 16, r % 16, F.lane, nullptr); continue; } r -= I_G;
        p0_transpose_item<1>(A.in[15] + (size_t)e * FF * DM, DM, WD + (size_t)e * DM * FF, FF, scr, r / 32, r % 32, F.lane, nullptr);
    }
    { const float* x = A.in[0]; const float* g = A.in[1]; bf16* XN = (bf16*)(ws + WS_XN);
      f32x4 gv[4];
#pragma unroll
      for (int j = 0; j < 4; ++j) gv[j] = ((const f32x4*)g)[F.lane + 64 * j];
      for (int m0 = gw; m0 < M; m0 += 4 * NGW) {
        f32x4 v[4][4];
#pragma unroll
        for (int k = 0; k < 4; ++k) { const GAS f32x4* xr = (const GAS f32x4*)(x + (size_t)(m0 + k * NGW) * DM) + F.lane;
#pragma unroll
            for (int j = 0; j < 4; ++j) v[k][j] = xr[64 * j]; }
#pragma unroll
        for (int k = 0; k < 4; ++k) { float s = 0.f;
#pragma unroll
            for (int j = 0; j < 4; ++j) s += (v[k][j].x * v[k][j].x + v[k][j].y * v[k][j].y) + (v[k][j].z * v[k][j].z + v[k][j].w * v[k][j].w);
            const float rstd = 1.f / sqrtf(wave_sum(s) * (1.f / DM) + NORM_EPS);
            GAS unsigned long long* o8 = (GAS unsigned long long*)(XN + (size_t)(m0 + k * NGW) * DM) + F.lane;
#pragma unroll
            for (int j = 0; j < 4; ++j) { const f32x4 t = v[k][j] * rstd * gv[j]; o8[64 * j] = (unsigned long long)pk2(t.x, t.y) | ((unsigned long long)pk2(t.z, t.w) << 32); } }
      } }
    { const int gt = (F.vcu * NWAVES + F.wave) * 64 + F.lane, NT = NGW * 64;
      float* WRT = (float*)(ws + WS_WRT); const float* gf = A.in[8]; const float* wg = A.in[9]; const float* we = A.in[11];
      for (int idx = gt; idx < 48 * DM; idx += NT) { const int j = idx >> 10, i = idx & 1023;
          const float v = j < 32 ? we[i * 32 + j] : (j < 36 ? wg[i * 4 + (j - 32)] : 0.f); WRT[idx] = v * gf[i]; }
      float* RC = (float*)(ws + WS_ROPE); float* RS = RC + SEQ * 40;
      for (int idx = gt; idx < SEQ * 40; idx += NT) { const int pos = idx / 40, f = idx % 40;
          double rv = (double)pos * A.frev[f]; rv -= floor(rv); const float r = (float)rv;
          RC[idx] = __builtin_amdgcn_cosf(r); RS[idx] = __builtin_amdgcn_sinf(r); } }
}

struct SrcPlain {
    const bf16* A; const bf16* Bt; int K;
    __device__ __forceinline__ void setup(const pg8::Unit& u, const int (&RA)[2], const int (&CA)[2], const char*& cA, const char*& cB, unsigned (&v0)[2], unsigned (&v1)[2]) const {
        cA = (const char*)A + (size_t)u.pm * 256 * K * 2; cB = (const char*)Bt + (size_t)u.pn * 256 * K * 2;
#pragma unroll
        for (int i = 0; i < 2; ++i) { v0[i] = (unsigned)(RA[i] * K + CA[i]) * 2u; v1[i] = v0[i] + (unsigned)(128 * K * 2); }
    }
};
struct TileTab { const LAS int* TE; const LAS int* NE; const LAS int* T0; };
struct SrcGather {
    const bf16* HG; const bf16* WGU; const int* LIST; TileTab tt;
    __device__ __forceinline__ void setup(const pg8::Unit& u, const int (&RA)[2], const int (&CA)[2], const char*& cA, const char*& cB, unsigned (&v0)[2], unsigned (&v1)[2]) const {
        const int e = tt.TE[u.pm], ne = tt.NE[e], p0 = (u.pm - tt.T0[e]) * 256;
        cA = (const char*)HG; cB = (const char*)WGU + ((size_t)e * DM + (size_t)u.pn * 256) * DM * 2;
#pragma unroll
        for (int i = 0; i < 2; ++i) {
            const int pa = p0 + RA[i], pb = pa + 128;
            const int ta = pa < ne ? (LIST[e * M + pa] >> 1) : 0, tb = pb < ne ? (LIST[e * M + pb] >> 1) : 0;
            v0[i] = (unsigned)(ta * DM + CA[i]) * 2u; v1[i] = (unsigned)(tb * DM + CA[i]) * 2u; }
    }
};
struct SrcDown {
    const bf16* HID; const bf16* WD; TileTab tt;
    __device__ __forceinline__ void setup(const pg8::Unit& u, const int (&RA)[2], const int (&CA)[2], const char*& cA, const char*& cB, unsigned (&v0)[2], unsigned (&v1)[2]) const {
        const int e = tt.TE[u.pm];
        cA = (const char*)HID + (size_t)u.pm * 256 * FF * 2; cB = (const char*)WD + ((size_t)e * DM + (size_t)u.pn * 256) * FF * 2;
#pragma unroll
        for (int i = 0; i < 2; ++i) { v0[i] = (unsigned)(RA[i] * FF + CA[i]) * 2u; v1[i] = v0[i] + (unsigned)(128 * FF * 2); }
    }
};

struct EpiInProj {
    static constexpr bool PERM = true;
    bf16* SEG; const float* RC; const float* RS;
    __device__ __forceinline__ void operator()(const f32x4 (&acc)[2][2][4][2], const pg8::Unit& u, int wr, int wc, int fr, int fq) const {
        const int seg = u.pn >> 1, colt = (u.pn & 1) * 256;
        bf16* base = SEG + (size_t)seg * M * SEGW;
        const int dq = (wc & 1) * 32 + 8 * fq;
        const bool attn = seg < 2, ret = (seg == 3 || seg == 4);
        const bool rot = ret || (attn && dq < 16);
        const int i0 = ret ? 8 + (dq >> 1) : (dq >> 1);
        const float sc = seg == 0 ? 0.125f * LOG2E : (seg == 4 ? 0.125f : 1.f);
#pragma unroll
        for (int ai = 0; ai < 2; ++ai)
#pragma unroll
            for (int m = 0; m < 4; ++m) {
                const int row = u.pm * 256 + ai * 128 + wr * 64 + m * 16 + fr, pos = row & (SEQ - 1);
                f32x4 c4 = {1.f, 1.f, 1.f, 1.f}, s4 = {0.f, 0.f, 0.f, 0.f};
                if (rot) { c4 = *(const f32x4*)(RC + pos * 40 + i0); s4 = *(const f32x4*)(RS + pos * 40 + i0); }
                bf16* rowp = base + (size_t)row * SEGW + colt + wc * 32 + 8 * fq;
#pragma unroll
                for (int bj = 0; bj < 2; ++bj) {
                    f32x4 v0 = acc[ai][bj][m][0], v1 = acc[ai][bj][m][1];
                    if (attn || ret) {
                        f32x4 r0, r1;
                        r0[0] = v0[0] * c4[0] - v0[1] * s4[0]; r0[1] = v0[1] * c4[0] + v0[0] * s4[0];
                        r0[2] = v0[2] * c4[1] - v0[3] * s4[1]; r0[3] = v0[3] * c4[1] + v0[2] * s4[1];
                        r1[0] = v1[0] * c4[2] - v1[1] * s4[2]; r1[1] = v1[1] * c4[2] + v1[0] * s4[2];
                        r1[2] = v1[2] * c4[3] - v1[3] * s4[3]; r1[3] = v1[3] * c4[3] + v1[2] * s4[3];
                        v0 = r0 * sc; v1 = r1 * sc;
                    } else if (seg == 6) {
#pragma unroll
                        for (int e = 0; e < 4; ++e) { v0[e] = silu_f(v0[e]); v1[e] = silu_f(v1[e]); }
                    }
                    u32x4 w; w.x = pk2(v0[0], v0[1]); w.y = pk2(v0[2], v0[3]); w.z = pk2(v1[0], v1[1]); w.w = pk2(v1[2], v1[3]);
                    *(u32x4*)(rowp + bj * 128) = w;
                }
            }
    }
};
struct EpiOutProj {
    static constexpr bool PERM = false;
    const float* X; const float* GF; float* H; bf16* HG;
    __device__ __forceinline__ void operator()(const f32x4 (&acc)[2][2][4][2], const pg8::Unit& u, int wr, int wc, int fr, int fq) const {
        const int col0 = u.pn * 256 + wc * 32 + 4 * fq;
        f32x4 gv[2][2];
#pragma unroll
        for (int bj = 0; bj < 2; ++bj)
#pragma unroll
            for (int n = 0; n < 2; ++n) gv[bj][n] = *(const f32x4*)(GF + col0 + bj * 128 + n * 16);
#pragma unroll
        for (int ai = 0; ai < 2; ++ai)
#pragma unroll
            for (int m = 0; m < 4; ++m) { const size_t off = (size_t)(u.pm * 256 + ai * 128 + wr * 64 + m * 16 + fr) * DM + col0;
#pragma unroll
                for (int bj = 0; bj < 2; ++bj)
#pragma unroll
                    for (int n = 0; n < 2; ++n) { const f32x4 h = *(const f32x4*)(X + off + bj * 128 + n * 16) + acc[ai][bj][m][n];
                        *(f32x4*)(H + off + bj * 128 + n * 16) = h; const f32x4 t = h * gv[bj][n];
                        u32x2 w; w.x = pk2(t[0], t[1]); w.y = pk2(t[2], t[3]); *(u32x2*)(HG + off + bj * 128 + n * 16) = w; }
                if (m & 1) asm volatile("" ::: "memory"); }
    }
};
struct EpiGateUp {
    static constexpr bool PERM = true;
    bf16* HID; const float* GATEL; const float* RSL; TileTab tt;
    __device__ __forceinline__ void operator()(const f32x4 (&acc)[2][2][4][2], const pg8::Unit& u, int wr, int wc, int fr, int fq) const {
        const int e = tt.TE[u.pm], ne = tt.NE[e], p0 = (u.pm - tt.T0[e]) * 256;
#pragma unroll
        for (int ai = 0; ai < 2; ++ai)
#pragma unroll
            for (int m = 0; m < 4; ++m) {
                const int rr = ai * 128 + wr * 64 + m * 16 + fr, pos = p0 + rr;
                float rs = 0.f, gt = 0.f; if (pos < ne) { rs = RSL[e * M + pos]; gt = GATEL[e * M + pos]; }
                u32x4 w; unsigned* wp = (unsigned*)&w;
#pragma unroll
                for (int n = 0; n < 2; ++n) { const f32x4 g = acc[ai][0][m][n] * rs, up = acc[ai][1][m][n] * rs; float hv[4];
#pragma unroll
                    for (int q = 0; q < 4; ++q) hv[q] = silu_f(g[q]) * up[q] * gt;
                    wp[2 * n] = pk2(hv[0], hv[1]); wp[2 * n + 1] = pk2(hv[2], hv[3]); }
                *(u32x4*)(HID + (size_t)(u.pm * 256 + rr) * FF + u.pn * 128 + wc * 32 + 8 * fq) = w;
            }
    }
};
struct EpiDown {
    static constexpr bool PERM = true;
    bf16* Y; const int* LIST; TileTab tt;
    __device__ __forceinline__ void operator()(const f32x4 (&acc)[2][2][4][2], const pg8::Unit& u, int wr, int wc, int fr, int fq) const {
        const int e = tt.TE[u.pm], ne = tt.NE[e], p0 = (u.pm - tt.T0[e]) * 256;
#pragma unroll
        for (int ai = 0; ai < 2; ++ai)
#pragma unroll
            for (int m = 0; m < 4; ++m) {
                const int pos = p0 + ai * 128 + wr * 64 + m * 16 + fr;
                if (pos < ne) { const int tk = LIST[e * M + pos]; bf16* rowp = Y + (size_t)tk * DM + u.pn * 256 + wc * 32 + 8 * fq;
#pragma unroll
                    for (int bj = 0; bj < 2; ++bj) { const f32x4 v0 = acc[ai][bj][m][0], v1 = acc[ai][bj][m][1];
                        u32x4 w; w.x = pk2(v0[0], v0[1]); w.y = pk2(v0[2], v0[3]); w.z = pk2(v1[0], v1[1]); w.w = pk2(v1[2], v1[3]);
                        *(u32x4*)(rowp + bj * 128) = w; } }
            }
    }
};

typedef short v4i16_t __attribute__((ext_vector_type(4)));
__device__ __forceinline__ s16x4 vtr(const LAS unsigned char* p) { return __builtin_bit_cast(s16x4, __builtin_amdgcn_ds_read_tr16_b64_v4i16((LAS v4i16_t*)p)); }
#define MFMA32(a, b, c) __builtin_amdgcn_mfma_f32_32x32x16_bf16((a), (b), (c), 0, 0, 0)
__device__ __forceinline__ bf16x8 pack8(const f32x16& x, int s) {
    u32x4 p; p.x = pk2(x[8 * s], x[8 * s + 1]); p.y = pk2(x[8 * s + 2], x[8 * s + 3]); p.z = pk2(x[8 * s + 4], x[8 * s + 5]); p.w = pk2(x[8 * s + 6], x[8 * s + 7]);
    return __builtin_bit_cast(bf16x8, p);
}
__device__ __forceinline__ bf16x8 cat44(s16x4 lo, s16x4 hi) { return __builtin_shufflevector(lo, hi, 0, 1, 2, 3, 4, 5, 6, 7); }
__device__ __forceinline__ bf16x8 scale8(bf16x8 v, float s) {
    u32x4 u = __builtin_bit_cast(u32x4, v), o;
    o.x = pk2(bflo(u.x) * s, bfhi(u.x) * s); o.y = pk2(bflo(u.y) * s, bfhi(u.y) * s); o.z = pk2(bflo(u.z) * s, bfhi(u.z) * s); o.w = pk2(bflo(u.w) * s, bfhi(u.w) * s);
    return __builtin_bit_cast(bf16x8, o);
}
__device__ __forceinline__ void pv_tile(f32x16& ot0, f32x16& ot1, const f32x16& st, const LAS unsigned char* vl, int lane) {
    const int hi = lane >> 5;
    const LAS unsigned char* vr = vl + (4 * hi + ((lane & 15) >> 2)) * 128 + (16 * ((lane >> 4) & 1) + 4 * (lane & 3)) * 2;
    const bf16x8 pb0 = pack8(st, 0), pb1 = pack8(st, 1);
    { const bf16x8 va = cat44(vtr(vr), vtr(vr + 8 * 128)); ot0 = MFMA32(va, pb0, ot0); }
    { const bf16x8 va = cat44(vtr(vr + 16 * 128), vtr(vr + 24 * 128)); ot0 = MFMA32(va, pb1, ot0); }
    { const bf16x8 va = cat44(vtr(vr + 64), vtr(vr + 8 * 128 + 64)); ot1 = MFMA32(va, pb0, ot1); }
    { const bf16x8 va = cat44(vtr(vr + 16 * 128 + 64), vtr(vr + 24 * 128 + 64)); ot1 = MFMA32(va, pb1, ot1); }
}
__device__ __forceinline__ void attn_task(int task, const bf16* QA, const bf16* KA, const bf16* VA, bf16* OBR, float* LSE, LAS unsigned char* vl, int lane) {
    const int bh = task / 384, rem = task - bh * 384, br = rem >> 7, idx = rem & 127;
    const int dsh = 2 * br, dil = 1 << dsh, L = SEQ >> dsh, nblk = L >> 5;
    const int cls = idx / nblk, qb = idx - cls * nblk, p0 = qb * 32;
    const int b = bh >> 3, h = bh & 7, q = lane & 31, hi = lane >> 5;
    const size_t rowbase = (size_t)b * SEQ + cls;
    const size_t qrow = rowbase + (size_t)dil * (p0 + q);
    bf16x8 qr[4];
    { const bf16* qp = QA + qrow * SEGW + h * HD + hi * 8;
#pragma unroll
      for (int ks = 0; ks < 4; ++ks) qr[ks] = *(const bf16x8*)(qp + 16 * ks); }
    float mrun = -1e30f, lsum = 0.f; f32x16 ot0, ot1;
#pragma unroll
    for (int r = 0; r < 16; ++r) { ot0[r] = 0.f; ot1[r] = 0.f; }
    for (int kb = 0; kb < 5; ++kb) {
        const int kp0 = p0 - 64 + 32 * kb;
        if (kp0 < 0 || kp0 >= L) continue;
        const size_t krow = rowbase + (size_t)dil * (kp0 + q);
        const bf16* kp = KA + krow * SEGW + h * HD + hi * 8;
        const bf16* vp = VA + krow * SEGW + h * HD + hi * 32;
        bf16x8 kf[4], vv[4];
#pragma unroll
        for (int ks = 0; ks < 4; ++ks) { kf[ks] = *(const bf16x8*)(kp + 16 * ks); vv[ks] = *(const bf16x8*)(vp + 8 * ks); }
        f32x16 st;
#pragma unroll
        for (int r = 0; r < 16; ++r) st[r] = 0.f;
#pragma unroll
        for (int ks = 0; ks < 4; ++ks) st = MFMA32(kf[ks], qr[ks], st);
        if (kb == 0) {
#pragma unroll
            for (int r = 0; r < 16; ++r) if (crow(r, hi) < q) st[r] = -1e30f;
        }
        if (kb == 4) {
#pragma unroll
            for (int r = 0; r < 16; ++r) if (crow(r, hi) > q) st[r] = -1e30f;
        }
        float mx = st[0];
#pragma unroll
        for (int r = 1; r < 16; ++r) mx = fmaxf(mx, st[r]);
        mx = fmaxf(mx, __shfl_xor(mx, 32));
        const float mnew = fmaxf(mrun, mx), alpha = __builtin_amdgcn_exp2f(mrun - mnew); mrun = mnew;
        float ps = 0.f;
#pragma unroll
        for (int r = 0; r < 16; ++r) { st[r] = __builtin_amdgcn_exp2f(st[r] - mnew); ps += st[r]; }
        lsum = lsum * alpha + ps;
#pragma unroll
        for (int r = 0; r < 16; ++r) { ot0[r] *= alpha; ot1[r] *= alpha; }
        LAS unsigned char* vw = vl + q * 128 + hi * 64;
#pragma unroll
        for (int i = 0; i < 4; ++i) *(LAS bf16x8*)(vw + 16 * i) = vv[i];
        asm volatile("" ::: "memory");
        pv_tile(ot0, ot1, st, vl, lane);
        asm volatile("" ::: "memory");
    }
    lsum += __shfl_xor(lsum, 32);
    const float inv = 1.f / lsum, lse = (mrun + __log2f(lsum)) * LN2;
    bf16* op = OBR + ((size_t)br * M + qrow) * SEGW + h * HD + 4 * hi;
#pragma unroll
    for (int g = 0; g < 4; ++g) {
        u32x2 w0, w1; w0.x = pk2(ot0[4 * g] * inv, ot0[4 * g + 1] * inv); w0.y = pk2(ot0[4 * g + 2] * inv, ot0[4 * g + 3] * inv);
        w1.x = pk2(ot1[4 * g] * inv, ot1[4 * g + 1] * inv); w1.y = pk2(ot1[4 * g + 2] * inv, ot1[4 * g + 3] * inv);
        *(u32x2*)(op + 8 * g) = w0; *(u32x2*)(op + 32 + 8 * g) = w1; }
    if (hi == 0) LSE[((size_t)br * M + qrow) * NHEAD + h] = lse;
}
constexpr int TP = 144;
struct AttnStep { size_t rowbase; int dil, p0, kp0, h, br, kb; bool valid; };
__device__ __forceinline__ AttnStep attn_decode(int task, int kb) {
    AttnStep a; const int bh = task / 384, rem = task - bh * 384, br = rem >> 7, idx = rem & 127;
    const int dsh = 2 * br, L = SEQ >> dsh, nblk = L >> 5;
    const int cls = idx / nblk, qb = idx - cls * nblk;
    a.dil = 1 << dsh; a.p0 = qb * 32; a.kp0 = a.p0 - 64 + 32 * kb; a.rowbase = (size_t)(bh >> 3) * SEQ + cls;
    a.h = bh & 7; a.br = br; a.kb = kb; a.valid = (a.kp0 >= 0 && a.kp0 < L);
    return a;
}
__device__ __forceinline__ void pv_tile_p(f32x16& ot0, f32x16& ot1, const f32x16& st, const LAS unsigned char* vl, int lane) {
    const int hi = lane >> 5;
    const LAS unsigned char* vr = vl + (4 * hi + ((lane & 15) >> 2)) * TP + (16 * ((lane >> 4) & 1) + 4 * (lane & 3)) * 2;
    const bf16x8 pb0 = pack8(st, 0), pb1 = pack8(st, 1);
    { const bf16x8 va = cat44(vtr(vr), vtr(vr + 8 * TP)); ot0 = MFMA32(va, pb0, ot0); }
    { const bf16x8 va = cat44(vtr(vr + 16 * TP), vtr(vr + 24 * TP)); ot0 = MFMA32(va, pb1, ot0); }
    { const bf16x8 va = cat44(vtr(vr + 64), vtr(vr + 8 * TP + 64)); ot1 = MFMA32(va, pb0, ot1); }
    { const bf16x8 va = cat44(vtr(vr + 16 * TP + 64), vtr(vr + 24 * TP + 64)); ot1 = MFMA32(va, pb1, ot1); }
}
__device__ __forceinline__ void attn_tasks(int t0, int nt, const bf16* QA, const bf16* KA, const bf16* VA, bf16* OBR, float* LSE, LAS unsigned char* wl, int lane) {
    const int q = lane & 31, hi = lane >> 5, ns = nt * 5, tr = lane >> 3, tc = (lane & 7) * 8;
    LAS unsigned char* Kt = wl; LAS unsigned char* Vt = wl + 32 * TP; LAS unsigned char* Qt = wl + 64 * TP;
    LAS unsigned char* tw = wl + tr * TP + tc * 2;
    bf16x8 nk[4], nv[4], nq[4], qr[4];
    float mrun = -1e30f, lsum = 0.f; f32x16 ot0, ot1;
#pragma unroll
    for (int r = 0; r < 16; ++r) { ot0[r] = 0.f; ot1[r] = 0.f; }
    AttnStep nx = attn_decode(t0, 0);
    {
#pragma unroll
        for (int i = 0; i < 4; ++i) nq[i] = *(const bf16x8*)(QA + (nx.rowbase + (size_t)nx.dil * (nx.p0 + tr + 8 * i)) * SEGW + nx.h * HD + tc);
        if (nx.valid) {
#pragma unroll
            for (int i = 0; i < 4; ++i) { const size_t off = (nx.rowbase + (size_t)nx.dil * (nx.kp0 + tr + 8 * i)) * SEGW + nx.h * HD + tc; nk[i] = *(const bf16x8*)(KA + off); nv[i] = *(const bf16x8*)(VA + off); } } }
#pragma unroll 1
    for (int s = 0; s < ns; ++s) {
        const AttnStep cu = nx;
        if (cu.valid) {
#pragma unroll
            for (int i = 0; i < 4; ++i) { *(LAS bf16x8*)(tw + 8 * i * TP) = nk[i]; *(LAS bf16x8*)(tw + 32 * TP + 8 * i * TP) = nv[i]; }
        }
        if (cu.kb == 0) {
#pragma unroll
            for (int i = 0; i < 4; ++i) *(LAS bf16x8*)(tw + 64 * TP + 8 * i * TP) = nq[i];
            mrun = -1e30f; lsum = 0.f;
#pragma unroll
            for (int r = 0; r < 16; ++r) { ot0[r] = 0.f; ot1[r] = 0.f; }
        }
        if (s + 1 < ns) {
            const int s1 = s + 1, tk = s1 / 5, kb1 = s1 - tk * 5;
            nx = attn_decode(t0 + tk, kb1);
            if (kb1 == 0) {
#pragma unroll
                for (int i = 0; i < 4; ++i) nq[i] = *(const bf16x8*)(QA + (nx.rowbase + (size_t)nx.dil * (nx.p0 + tr + 8 * i)) * SEGW + nx.h * HD + tc); }
            if (nx.valid) {
#pragma unroll
                for (int i = 0; i < 4; ++i) { const size_t off = (nx.rowbase + (size_t)nx.dil * (nx.kp0 + tr + 8 * i)) * SEGW + nx.h * HD + tc; nk[i] = *(const bf16x8*)(KA + off); nv[i] = *(const bf16x8*)(VA + off); } }
        }
        asm volatile("" ::: "memory");
        if (cu.kb == 0) {
#pragma unroll
            for (int ks = 0; ks < 4; ++ks) qr[ks] = *(const LAS bf16x8*)(Qt + q * TP + hi * 16 + 32 * ks);
        }
        if (cu.valid) {
            f32x16 st;
#pragma unroll
            for (int r = 0; r < 16; ++r) st[r] = 0.f;
#pragma unroll
            for (int ks = 0; ks < 4; ++ks) st = MFMA32(*(const LAS bf16x8*)(Kt + q * TP + hi * 16 + 32 * ks), qr[ks], st);
            if (cu.kb == 0) {
#pragma unroll
                for (int r = 0; r < 16; ++r) if (crow(r, hi) < q) st[r] = -1e30f;
            }
            if (cu.kb == 4) {
#pragma unroll
                for (int r = 0; r < 16; ++r) if (crow(r, hi) > q) st[r] = -1e30f;
            }
            float mx = st[0];
#pragma unroll
            for (int r = 1; r < 16; ++r) mx = fmaxf(mx, st[r]);
            mx = fmaxf(mx, __shfl_xor(mx, 32));
            const float mnew = fmaxf(mrun, mx), alpha = __builtin_amdgcn_exp2f(mrun - mnew); mrun = mnew;
            float ps = 0.f;
#pragma unroll
            for (int r = 0; r < 16; ++r) { st[r] = __builtin_amdgcn_exp2f(st[r] - mnew); ps += st[r]; }
            lsum = lsum * alpha + ps;
#pragma unroll
            for (int r = 0; r < 16; ++r) { ot0[r] *= alpha; ot1[r] *= alpha; }
            pv_tile_p(ot0, ot1, st, Vt, lane);
        }
        asm volatile("" ::: "memory");
        if (cu.kb == 4) {
            const float lt = lsum + __shfl_xor(lsum, 32);
            const float inv = 1.f / lt, lse = (mrun + __log2f(lt)) * LN2;
            LAS unsigned char* ow = Qt + q * TP + 8 * hi;
#pragma unroll
            for (int g = 0; g < 4; ++g) {
                u32x2 w0, w1; w0.x = pk2(ot0[4 * g] * inv, ot0[4 * g + 1] * inv); w0.y = pk2(ot0[4 * g + 2] * inv, ot0[4 * g + 3] * inv);
                w1.x = pk2(ot1[4 * g] * inv, ot1[4 * g + 1] * inv); w1.y = pk2(ot1[4 * g + 2] * inv, ot1[4 * g + 3] * inv);
                *(LAS u32x2*)(ow + 16 * g) = w0; *(LAS u32x2*)(ow + 64 + 16 * g) = w1; }
            asm volatile("" ::: "memory");
#pragma unroll
            for (int i = 0; i < 4; ++i) { const u32x4 v = *(const LAS u32x4*)(tw + 64 * TP + 8 * i * TP);
                *(u32x4*)(OBR + ((size_t)cu.br * M + cu.rowbase + (size_t)cu.dil * (cu.p0 + tr + 8 * i)) * SEGW + cu.h * HD + tc) = v; }
            if (hi == 0) LSE[((size_t)cu.br * M + cu.rowbase + (size_t)cu.dil * (cu.p0 + q)) * NHEAD + cu.h] = lse;
            asm volatile("" ::: "memory");
        }
    }
}
__device__ __forceinline__ void scan_task(int sid, const bf16* KR, const bf16* VR, bf16* ST, const float* dec_f, const float* dec_b, LAS unsigned char* sl, int lane) {
    const int bh = sid >> 3, dir = (sid >> 2) & 1, dkh = (sid >> 1) & 1, dvh = sid & 1, b = bh >> 3, h = bh & 7, hi = lane >> 5;
    const int lr = lane >> 2, lc = (lane & 3) * 8;
    const float lg2 = log1pf(-exp2f((dir ? dec_b : dec_f)[h])) * LOG2E;
    const float g128 = exp2f(128.f * lg2);
    float dcy[8];
#pragma unroll
    for (int j = 0; j < 8; ++j) { const int key = lr + 16 * j; dcy[j] = exp2f((dir ? (float)key : (float)(CHUNK - 1 - key)) * lg2); }
    LAS unsigned char* Kl = sl; LAS unsigned char* Vl = sl + 8192;
    f32x16 S;
#pragma unroll
    for (int r = 0; r < 16; ++r) S[r] = 0.f;
    const int troff = (8 * hi + ((lane & 15) >> 2)) * 64 + (16 * ((lane >> 4) & 1) + 4 * (lane & 3)) * 2;
    bf16x8 pk[8], pv[8];
    { const int n = dir ? (NCHUNK - 1) : 0; const size_t rb = ((size_t)b * SEQ + n * CHUNK + lr) * SEGW + h * HD + lc;
#pragma unroll
      for (int j = 0; j < 8; ++j) { pk[j] = *(const bf16x8*)(KR + rb + (size_t)16 * j * SEGW + 32 * dkh); pv[j] = *(const bf16x8*)(VR + rb + (size_t)16 * j * SEGW + 32 * dvh); } }
#pragma unroll 1
    for (int step = 0; step < NCHUNK; ++step) {
        const int n = dir ? (NCHUNK - 1 - step) : step;
        bf16* sp = ST + (((size_t)bh * 2 + dir) * NCHUNK + n) * 4096 + ((size_t)(dvh * 4 + 2 * dkh) * 64 + (lane & 31)) * 8 + 4 * hi;
#pragma unroll
        for (int g = 0; g < 4; ++g) { u32x2 w; w.x = pk2(S[4 * g], S[4 * g + 1]); w.y = pk2(S[4 * g + 2], S[4 * g + 3]); *(u32x2*)(sp + ((g >> 1) * 64 + 32 * (g & 1)) * 8) = w; }
        if (step == NCHUNK - 1) break;
#pragma unroll
        for (int j = 0; j < 8; ++j) { const int key = lr + 16 * j; *(LAS bf16x8*)(Kl + key * 64 + lc * 2) = scale8(pk[j], dcy[j]); *(LAS bf16x8*)(Vl + key * 64 + lc * 2) = pv[j]; }
        if (step + 2 < NCHUNK) { const int n1 = dir ? (NCHUNK - 2 - step) : step + 1; const size_t rb = ((size_t)b * SEQ + n1 * CHUNK + lr) * SEGW + h * HD + lc;
#pragma unroll
            for (int j = 0; j < 8; ++j) { pk[j] = *(const bf16x8*)(KR + rb + (size_t)16 * j * SEGW + 32 * dkh); pv[j] = *(const bf16x8*)(VR + rb + (size_t)16 * j * SEGW + 32 * dvh); } }
        asm volatile("" ::: "memory");
        f32x16 kv;
#pragma unroll
        for (int r = 0; r < 16; ++r) kv[r] = 0.f;
#pragma unroll
        for (int s = 0; s < 8; ++s) {
            const bf16x8 a = cat44(vtr(Kl + troff + s * 1024), vtr(Kl + troff + s * 1024 + 256));
            const bf16x8 bb = cat44(vtr(Vl + troff + s * 1024), vtr(Vl + troff + s * 1024 + 256));
            kv = MFMA32(a, bb, kv);
        }
        asm volatile("" ::: "memory");
#pragma unroll
        for (int r = 0; r < 16; ++r) S[r] = S[r] * g128 + kv[r];
    }
}
__device__ __forceinline__ void ret_task(int cid, const bf16* QR, const bf16* KR, const bf16* VR, const bf16* GR, const bf16* ST, bf16* MIXED, const float* dec_f, const float* dec_b,
                                         LAS unsigned char* wl, int lane) {
    const int bh = cid >> 5, n = cid & 31, b = bh >> 3, h = bh & 7, q = lane & 31, hi = lane >> 5, tr = lane >> 3, tc = (lane & 7) * 8;
    const float lgf = __uint_as_float(__builtin_amdgcn_readfirstlane(__float_as_uint(log1pf(-exp2f(dec_f[h])) * LOG2E))), lgb = __uint_as_float(__builtin_amdgcn_readfirstlane(__float_as_uint(log1pf(-exp2f(dec_b[h])) * LOG2E)));
    const size_t row0 = (size_t)b * SEQ + n * CHUNK;
    const int loff = tr * SEGW + tc;
    const bf16* Qb = QR + row0 * SEGW + h * HD; const bf16* Kb = KR + row0 * SEGW + h * HD; const bf16* Vb = VR + row0 * SEGW + h * HD; const bf16* Gb = GR + row0 * SEGW + h * HD;
    const bf16* SF = ST + (((size_t)bh * 2 + 0) * NCHUNK + n) * 4096 + lane * 8; const bf16* SB = ST + (((size_t)bh * 2 + 1) * NCHUNK + n) * 4096 + lane * 8;
    LAS unsigned char* Kt = wl; LAS unsigned char* Vt = wl + 32 * TP; LAS unsigned char* Qt = wl + 64 * TP;
    LAS unsigned char* tw = wl + tr * TP + tc * 2;
    bf16x8 nk[4], nv[4], nq[4], qr[4]; f32x16 ot0, ot1;
#pragma unroll
    for (int i = 0; i < 4; ++i) { nq[i] = *(const bf16x8*)(Qb + loff + 8 * i * SEGW); nk[i] = *(const bf16x8*)(Kb + loff + 8 * i * SEGW); nv[i] = *(const bf16x8*)(Vb + loff + 8 * i * SEGW); }
#pragma unroll 1
    for (int s = 0; s < 16; ++s) {
        const int qb = s >> 2, kb = s & 3, i_ = 32 * qb + q;
#pragma unroll
        for (int i = 0; i < 4; ++i) { *(LAS bf16x8*)(tw + 8 * i * TP) = nk[i]; *(LAS bf16x8*)(tw + 32 * TP + 8 * i * TP) = nv[i]; }
        if (s == 0 || (kb == 2 && qb < 3)) {
#pragma unroll
            for (int i = 0; i < 4; ++i) *(LAS bf16x8*)(tw + 64 * TP + 8 * i * TP) = nq[i];
        }
        if (s < 15) { const int kb1 = (s + 1) & 3;
#pragma unroll
            for (int i = 0; i < 4; ++i) { nk[i] = *(const bf16x8*)(Kb + 32 * kb1 * SEGW + loff + 8 * i * SEGW); nv[i] = *(const bf16x8*)(Vb + 32 * kb1 * SEGW + loff + 8 * i * SEGW); } }
        if (kb == 1 && qb < 3) {
#pragma unroll
            for (int i = 0; i < 4; ++i) nq[i] = *(const bf16x8*)(Qb + 32 * (qb + 1) * SEGW + loff + 8 * i * SEGW); }
        if (kb == 2) {
#pragma unroll
            for (int i = 0; i < 4; ++i) nq[i] = *(const bf16x8*)(Gb + 32 * qb * SEGW + loff + 8 * i * SEGW); }
        asm volatile("" ::: "memory");
        if (kb == 0) {
#pragma unroll
            for (int ks = 0; ks < 4; ++ks) qr[ks] = *(const LAS bf16x8*)(Qt + q * TP + hi * 16 + 32 * ks);
#pragma unroll
            for (int r = 0; r < 16; ++r) { ot0[r] = 0.f; ot1[r] = 0.f; }
        }
        f32x16 st;
#pragma unroll
        for (int r = 0; r < 16; ++r) st[r] = 0.f;
#pragma unroll
        for (int ks = 0; ks < 4; ++ks) st = MFMA32(*(const LAS bf16x8*)(Kt + q * TP + hi * 16 + 32 * ks), qr[ks], st);
#pragma unroll
        for (int r = 0; r < 16; ++r) { const int dl = i_ - (32 * kb + crow(r, hi)); const float e = dl >= 0 ? (float)dl * lgf : (float)(-dl) * lgb; st[r] *= __builtin_amdgcn_exp2f(e); }
        if (kb == 3) {
            asm volatile("" ::: "memory");
#pragma unroll
            for (int i = 0; i < 4; ++i) *(LAS bf16x8*)(tw + 8 * i * TP) = nq[i];
        }
        pv_tile_p(ot0, ot1, st, Vt, lane);
        asm volatile("" ::: "memory");
        if (kb == 3) {
            const float cf = exp2f((float)(i_ + 1) * lgf), cb = exp2f((float)(CHUNK - i_) * lgb);
#pragma unroll
            for (int dir = 0; dir < 2; ++dir)
#pragma unroll
                for (int db = 0; db < 2; ++db) {
                    const bf16* sp = (dir ? SB : SF) + (size_t)(db * 4) * 512; f32x16 t;
#pragma unroll
                    for (int r = 0; r < 16; ++r) t[r] = 0.f;
#pragma unroll
                    for (int ks = 0; ks < 4; ++ks) t = MFMA32(*(const bf16x8*)(sp + ks * 512), qr[ks], t);
                    const float c = dir ? cb : cf;
                    if (db == 0) {
#pragma unroll
                        for (int r = 0; r < 16; ++r) ot0[r] += c * t[r];
                    } else {
#pragma unroll
                        for (int r = 0; r < 16; ++r) ot1[r] += c * t[r];
                    }
                    __builtin_amdgcn_sched_barrier(0);
                }
            float s1 = 0.f;
#pragma unroll
            for (int r = 0; r < 16; ++r) s1 += ot0[r] + ot1[r];
            s1 += __shfl_xor(s1, 32);
            const float mean = s1 * (1.f / 64.f); float s2 = 0.f;
#pragma unroll
            for (int r = 0; r < 16; ++r) { ot0[r] -= mean; ot1[r] -= mean; s2 += ot0[r] * ot0[r] + ot1[r] * ot1[r]; }
            s2 += __shfl_xor(s2, 32);
            const float rstd = 1.f / sqrtf(s2 * (1.f / 64.f) + NORM_EPS);
            const LAS unsigned char* gp = Kt + q * TP + 8 * hi; LAS unsigned char* ow = Vt + q * TP + 8 * hi;
#pragma unroll
            for (int g = 0; g < 4; ++g) {
                const u32x2 g0 = *(const LAS u32x2*)(gp + 16 * g), g1 = *(const LAS u32x2*)(gp + 64 + 16 * g);
                u32x2 w0, w1;
                w0.x = pk2(ot0[4 * g] * rstd * bflo(g0.x), ot0[4 * g + 1] * rstd * bfhi(g0.x)); w0.y = pk2(ot0[4 * g + 2] * rstd * bflo(g0.y), ot0[4 * g + 3] * rstd * bfhi(g0.y));
                w1.x = pk2(ot1[4 * g] * rstd * bflo(g1.x), ot1[4 * g + 1] * rstd * bfhi(g1.x)); w1.y = pk2(ot1[4 * g + 2] * rstd * bflo(g1.y), ot1[4 * g + 3] * rstd * bfhi(g1.y));
                *(LAS u32x2*)(ow + 16 * g) = w0; *(LAS u32x2*)(ow + 64 + 16 * g) = w1; }
            asm volatile("" ::: "memory");
#pragma unroll
            for (int i = 0; i < 4; ++i) { const u32x4 v = *(const LAS u32x4*)(tw + 32 * TP + 8 * i * TP); *(u32x4*)(MIXED + (row0 + 32 * qb) * DM + 512 + h * HD + (tr + 8 * i) * DM + tc) = v; }
            asm volatile("" ::: "memory");
        }
    }
}
__device__ __forceinline__ void kv_task(int cid, const bf16* KR, const bf16* VR, bf16* KV, const float* dec_f, const float* dec_b, LAS unsigned char* wl, int lane) {
    const int bh = cid >> 5, n = cid & 31, b = bh >> 3, h = bh & 7, q = lane & 31, hi = lane >> 5, tr = lane >> 3, tc = (lane & 7) * 8;
    const float lgf = __uint_as_float(__builtin_amdgcn_readfirstlane(__float_as_uint(log1pf(-exp2f(dec_f[h])) * LOG2E))), lgb = __uint_as_float(__builtin_amdgcn_readfirstlane(__float_as_uint(log1pf(-exp2f(dec_b[h])) * LOG2E)));
    const size_t row0 = (size_t)b * SEQ + n * CHUNK; const int loff = tr * SEGW + tc;
    const bf16* Kb = KR + row0 * SEGW + h * HD; const bf16* Vb = VR + row0 * SEGW + h * HD;
    LAS unsigned char* Tf = wl; LAS unsigned char* Tb = wl + 32 * TP; LAS unsigned char* Tv = wl + 64 * TP; LAS unsigned char* tw = wl + tr * TP + tc * 2;
    const int tro = (8 * hi + ((lane & 15) >> 2)) * TP + (16 * ((lane >> 4) & 1) + 4 * (lane & 3)) * 2;
    f32x16 acc[2][2][2];
#pragma unroll
    for (int d = 0; d < 2; ++d)
#pragma unroll
        for (int a = 0; a < 2; ++a)
#pragma unroll
            for (int c = 0; c < 2; ++c)
#pragma unroll
                for (int r = 0; r < 16; ++r) acc[d][a][c][r] = 0.f;
    bf16x8 nk[4], nv[4];
#pragma unroll
    for (int i = 0; i < 4; ++i) { nk[i] = *(const bf16x8*)(Kb + loff + 8 * i * SEGW); nv[i] = *(const bf16x8*)(Vb + loff + 8 * i * SEGW); }
#pragma unroll 1
    for (int it = 0; it < 4; ++it) {
#pragma unroll
        for (int i = 0; i < 4; ++i) { const int key = 32 * it + tr + 8 * i;
            *(LAS bf16x8*)(tw + 8 * i * TP) = scale8(nk[i], __builtin_amdgcn_exp2f((float)(CHUNK - 1 - key) * lgf));
            *(LAS bf16x8*)(tw + 32 * TP + 8 * i * TP) = scale8(nk[i], __builtin_amdgcn_exp2f((float)key * lgb));
            *(LAS bf16x8*)(tw + 64 * TP + 8 * i * TP) = nv[i]; }
        if (it < 3) {
#pragma unroll
            for (int i = 0; i < 4; ++i) { nk[i] = *(const bf16x8*)(Kb + 32 * (it + 1) * SEGW + loff + 8 * i * SEGW); nv[i] = *(const bf16x8*)(Vb + 32 * (it + 1) * SEGW + loff + 8 * i * SEGW); } }
        asm volatile("" ::: "memory");
#pragma unroll
        for (int s2 = 0; s2 < 2; ++s2) {
            bf16x8 bv[2];
#pragma unroll
            for (int c = 0; c < 2; ++c) bv[c] = cat44(vtr(Tv + tro + s2 * 16 * TP + c * 64), vtr(Tv + tro + s2 * 16 * TP + 4 * TP + c * 64));
#pragma unroll
            for (int a = 0; a < 2; ++a) {
                const bf16x8 af = cat44(vtr(Tf + tro + s2 * 16 * TP + a * 64), vtr(Tf + tro + s2 * 16 * TP + 4 * TP + a * 64));
                const bf16x8 ab = cat44(vtr(Tb + tro + s2 * 16 * TP + a * 64), vtr(Tb + tro + s2 * 16 * TP + 4 * TP + a * 64));
#pragma unroll
                for (int c = 0; c < 2; ++c) { acc[0][a][c] = MFMA32(af, bv[c], acc[0][a][c]); acc[1][a][c] = MFMA32(ab, bv[c], acc[1][a][c]); }
            }
        }
        asm volatile("" ::: "memory");
    }
#pragma unroll
    for (int d = 0; d < 2; ++d) { bf16* ob = KV + (((size_t)bh * NCHUNK + n) * 2 + d) * 4096;
#pragma unroll
        for (int a = 0; a < 2; ++a)
#pragma unroll
            for (int c = 0; c < 2; ++c)
#pragma unroll
                for (int g = 0; g < 4; ++g) { u32x2 w; w.x = pk2(acc[d][a][c][4 * g], acc[d][a][c][4 * g + 1]); w.y = pk2(acc[d][a][c][4 * g + 2], acc[d][a][c][4 * g + 3]);
                    *(u32x2*)(ob + ((c * 4 + 2 * a + (g >> 1)) * 64 + q + 32 * (g & 1)) * 8 + 4 * hi) = w; } }
}

struct AttnRound { size_t rowbase; int dil, qb0, nblk, h, br; };
__device__ __forceinline__ AttnRound round_decode(int rg) {
    AttnRound a; const int bh = rg / 48, x = rg - bh * 48, br = x >> 4, w16 = x & 15; int cls, qb0;
    if (br == 0) { cls = 0; qb0 = 8 * w16; } else if (br == 1) { cls = w16 >> 2; qb0 = 8 * (w16 & 3); } else { cls = w16; qb0 = 0; }
    a.rowbase = (size_t)(bh >> 3) * SEQ + cls; a.dil = 1 << (2 * br); a.qb0 = qb0; a.nblk = (SEQ >> (2 * br)) >> 5; a.h = bh & 7; a.br = br; return a;
}
__device__ __forceinline__ void attn_rounds(int r0, int nr, const bf16* QA, const bf16* KA, const bf16* VA, bf16* OBR, float* LSE, LAS unsigned char* lds, int wave, int lane) {
    const int q = lane & 31, hi = lane >> 5, tr = lane >> 3, tc = (lane & 7) * 8;
    LAS unsigned char* Qt = lds + (24 + wave) * (32 * TP);
    const int twoff = tr * TP + tc * 2;
    bf16x8 pt[3][4], pq[4];
    AttnRound nx = round_decode(r0);
#define ATT_PREFETCH(R) do { \
        _Pragma("unroll") for (int x_ = 0; x_ < 3; ++x_) { const int tile = 3 * wave + x_, slot = tile >= 12 ? tile - 12 : tile, j_ = (R).qb0 - 2 + slot; \
            if (j_ >= 0 && j_ < (R).nblk) { const bf16* src = (tile >= 12 ? VA : KA) + ((R).rowbase + (size_t)(R).dil * (32 * j_ + tr)) * SEGW + (R).h * HD + tc; \
                _Pragma("unroll") for (int i_ = 0; i_ < 4; ++i_) pt[x_][i_] = *(const bf16x8*)(src + (size_t)(R).dil * 8 * i_ * SEGW); } } \
        { const bf16* src = QA + ((R).rowbase + (size_t)(R).dil * (32 * ((R).qb0 + wave) + tr)) * SEGW + (R).h * HD + tc; \
          _Pragma("unroll") for (int i_ = 0; i_ < 4; ++i_) pq[i_] = *(const bf16x8*)(src + (size_t)(R).dil * 8 * i_ * SEGW); } } while (0)
    ATT_PREFETCH(nx);
#pragma unroll 1
    for (int rr = 0; rr < nr; ++rr) {
        const AttnRound cu = nx;
        __syncthreads();
#pragma unroll
        for (int x = 0; x < 3; ++x) { const int tile = 3 * wave + x, slot = tile >= 12 ? tile - 12 : tile, j = cu.qb0 - 2 + slot;
            if (j >= 0 && j < cu.nblk) { LAS unsigned char* tb = lds + tile * (32 * TP) + twoff;
#pragma unroll
                for (int i = 0; i < 4; ++i) *(LAS bf16x8*)(tb + 8 * i * TP) = pt[x][i]; } }
#pragma unroll
        for (int i = 0; i < 4; ++i) *(LAS bf16x8*)(Qt + twoff + 8 * i * TP) = pq[i];
        if (rr + 1 < nr) { nx = round_decode(r0 + rr + 1); ATT_PREFETCH(nx); }
        __syncthreads();
        bf16x8 qr[4];
#pragma unroll
        for (int ks = 0; ks < 4; ++ks) qr[ks] = *(const LAS bf16x8*)(Qt + q * TP + hi * 16 + 32 * ks);
        float mrun = -1e30f, lsum = 0.f; f32x16 ot0, ot1;
#pragma unroll
        for (int r = 0; r < 16; ++r) { ot0[r] = 0.f; ot1[r] = 0.f; }
#pragma unroll 1
        for (int kb = 0; kb < 5; ++kb) {
            const int j = cu.qb0 + wave - 2 + kb;
            if (j < 0 || j >= cu.nblk) continue;
            const LAS unsigned char* Kt = lds + (wave + kb) * (32 * TP); const LAS unsigned char* Vt = Kt + 12 * (32 * TP);
            f32x16 st;
#pragma unroll
            for (int r = 0; r < 16; ++r) st[r] = 0.f;
#pragma unroll
            for (int ks = 0; ks < 4; ++ks) st = MFMA32(*(const LAS bf16x8*)(Kt + q * TP + hi * 16 + 32 * ks), qr[ks], st);
            if (kb == 0) {
#pragma unroll
                for (int r = 0; r < 16; ++r) if (crow(r, hi) < q) st[r] = -1e30f;
            }
            if (kb == 4) {
#pragma unroll
                for (int r = 0; r < 16; ++r) if (crow(r, hi) > q) st[r] = -1e30f;
            }
            float mx = st[0];
#pragma unroll
            for (int r = 1; r < 16; ++r) mx = fmaxf(mx, st[r]);
            mx = fmaxf(mx, __shfl_xor(mx, 32));
            const float mnew = fmaxf(mrun, mx), alpha = __builtin_amdgcn_exp2f(mrun - mnew); mrun = mnew;
            float ps = 0.f;
#pragma unroll
            for (int r = 0; r < 16; ++r) { st[r] = __builtin_amdgcn_exp2f(st[r] - mnew); ps += st[r]; }
            lsum = lsum * alpha + ps;
#pragma unroll
            for (int r = 0; r < 16; ++r) { ot0[r] *= alpha; ot1[r] *= alpha; }
            pv_tile_p(ot0, ot1, st, Vt, lane);
        }
        const float lt = lsum + __shfl_xor(lsum, 32);
        const float inv = 1.f / lt, lse = (mrun + __log2f(lt)) * LN2;
        asm volatile("" ::: "memory");
        LAS unsigned char* ow = Qt + q * TP + 8 * hi;
#pragma unroll
        for (int g = 0; g < 4; ++g) {
            u32x2 w0, w1; w0.x = pk2(ot0[4 * g] * inv, ot0[4 * g + 1] * inv); w0.y = pk2(ot0[4 * g + 2] * inv, ot0[4 * g + 3] * inv);
            w1.x = pk2(ot1[4 * g] * inv, ot1[4 * g + 1] * inv); w1.y = pk2(ot1[4 * g + 2] * inv, ot1[4 * g + 3] * inv);
            *(LAS u32x2*)(ow + 16 * g) = w0; *(LAS u32x2*)(ow + 64 + 16 * g) = w1; }
        asm volatile("" ::: "memory");
        const size_t qbase = cu.rowbase + (size_t)cu.dil * 32 * (cu.qb0 + wave);
#pragma unroll
        for (int i = 0; i < 4; ++i) { const u32x4 v = *(const LAS u32x4*)(Qt + twoff + 8 * i * TP);
            *(u32x4*)(OBR + ((size_t)cu.br * M + qbase + (size_t)cu.dil * (tr + 8 * i)) * SEGW + cu.h * HD + tc) = v; }
        if (hi == 0) LSE[((size_t)cu.br * M + qbase + (size_t)cu.dil * q) * NHEAD + cu.h] = lse;
        asm volatile("" ::: "memory");
    }
#undef ATT_PREFETCH
    __syncthreads();
}

constexpr int R_K = 0, R_V = 128 * TP, R_Q = 2 * 128 * TP, R_G = 3 * 128 * TP, R_O = 4 * 128 * TP, R_SF = 5 * 128 * TP, R_SB = R_SF + 8192, R_X = R_SB + 8192;
__device__ __forceinline__ void ret_wg(int wgt, const bf16* QR, const bf16* KR, const bf16* VR, const bf16* GR, const bf16* KV, bf16* SBW, bf16* MIXED, const float* dec_f, const float* dec_b,
                                       LAS unsigned char* lds, int tid, int wave, int lane) {
    const int bh = wgt >> 2, n0 = (wgt & 3) * 8, b = bh >> 3, h = bh & 7, q = lane & 31, hi = lane >> 5, tr = lane >> 3, tc = (lane & 7) * 8;
    const float lgf = __uint_as_float(__builtin_amdgcn_readfirstlane(__float_as_uint(log1pf(-exp2f(dec_f[h])) * LOG2E))), lgb = __uint_as_float(__builtin_amdgcn_readfirstlane(__float_as_uint(log1pf(-exp2f(dec_b[h])) * LOG2E)));
    const float gf128 = exp2f(128.f * lgf), gb128 = exp2f(128.f * lgb);
    const bf16* KVt = KV + (size_t)bh * NCHUNK * 2 * 4096 + 8 * tid;
    bf16* SBt = SBW + (size_t)bh * NCHUNK * 4096 + 8 * tid;
    float Sf[8], Sb[8];
#pragma unroll
    for (int e = 0; e < 8; ++e) { Sf[e] = 0.f; Sb[e] = 0.f; }
#define RET_AXPY(S, g, v) do { S[0] = S[0] * (g) + bflo((v).x); S[1] = S[1] * (g) + bfhi((v).x); S[2] = S[2] * (g) + bflo((v).y); S[3] = S[3] * (g) + bfhi((v).y); \
                               S[4] = S[4] * (g) + bflo((v).z); S[5] = S[5] * (g) + bfhi((v).z); S[6] = S[6] * (g) + bflo((v).w); S[7] = S[7] * (g) + bfhi((v).w); } while (0)
    for (int m0 = 0; m0 < n0; m0 += 8) { u32x4 v[8];
#pragma unroll
        for (int k = 0; k < 8; ++k) v[k] = *(const u32x4*)(KVt + (size_t)((m0 + k) * 2) * 4096);
#pragma unroll
        for (int k = 0; k < 8; ++k) RET_AXPY(Sf, gf128, v[k]); }
    for (int m0 = NCHUNK - 8; m0 >= n0 + 8; m0 -= 8) { u32x4 v[8];
#pragma unroll
        for (int k = 0; k < 8; ++k) v[k] = *(const u32x4*)(KVt + (size_t)((m0 + 7 - k) * 2 + 1) * 4096);
#pragma unroll
        for (int k = 0; k < 8; ++k) RET_AXPY(Sb, gb128, v[k]); }
    { u32x4 v[8];
#pragma unroll
      for (int k = 0; k < 8; ++k) v[k] = *(const u32x4*)(KVt + (size_t)((n0 + 7 - k) * 2 + 1) * 4096);
#pragma unroll
      for (int k = 0; k < 8; ++k) { u32x4 w; w.x = pk2(Sb[0], Sb[1]); w.y = pk2(Sb[2], Sb[3]); w.z = pk2(Sb[4], Sb[5]); w.w = pk2(Sb[6], Sb[7]);
          *(u32x4*)(SBt + (size_t)(n0 + 7 - k) * 4096) = w; RET_AXPY(Sb, gb128, v[k]); } }
    VM_WAIT();
    const int tsel = wave >> 1, rbase = 64 * (wave & 1) + tr;
    const bf16* tsrc = (tsel == 0 ? KR : tsel == 1 ? VR : tsel == 2 ? QR : GR) + ((size_t)b * SEQ + rbase) * SEGW + h * HD + tc;
    LAS unsigned char* tdst = lds + tsel * (128 * TP) + rbase * TP + tc * 2;
    const int qb = wave & 3, dvh = wave >> 2;
    bf16x8 pre[8]; u32x4 pkv, psb;
#define RET_PREFETCH(n_) do { _Pragma("unroll") for (int i_ = 0; i_ < 8; ++i_) pre[i_] = *(const bf16x8*)(tsrc + (size_t)((n_) * CHUNK + 8 * i_) * SEGW); \
        pkv = *(const u32x4*)(KVt + (size_t)((n_) * 2) * 4096); psb = *(const u32x4*)(SBt + (size_t)(n_) * 4096); } while (0)
    RET_PREFETCH(n0);
#pragma unroll 1
    for (int jn = 0; jn < 8; ++jn) {
        const int n = n0 + jn; const size_t row0 = (size_t)b * SEQ + n * CHUNK;
        __syncthreads();
        if (jn > 0) {
#pragma unroll
            for (int i = 0; i < 2; ++i) { const int r = 16 * wave + 8 * i + tr; const u32x4 v = *(const LAS u32x4*)(lds + R_O + r * TP + tc * 2);
                *(u32x4*)(MIXED + (row0 - CHUNK + r) * DM + 512 + h * HD + tc) = v; } }
#pragma unroll
        for (int i = 0; i < 8; ++i) *(LAS bf16x8*)(tdst + 8 * i * TP) = pre[i];
        { u32x4 w; w.x = pk2(Sf[0], Sf[1]); w.y = pk2(Sf[2], Sf[3]); w.z = pk2(Sf[4], Sf[5]); w.w = pk2(Sf[6], Sf[7]);
          *(LAS u32x4*)(lds + R_SF + tid * 16) = w; *(LAS u32x4*)(lds + R_SB + tid * 16) = psb; }
        RET_AXPY(Sf, gf128, pkv);
        if (jn < 7) RET_PREFETCH(n + 1);
        __syncthreads();
        const int i_ = 32 * qb + q;
        bf16x8 qr[4];
#pragma unroll
        for (int ks = 0; ks < 4; ++ks) qr[ks] = *(const LAS bf16x8*)(lds + R_Q + i_ * TP + hi * 16 + 32 * ks);
        f32x16 ot;
#pragma unroll
        for (int r = 0; r < 16; ++r) ot[r] = 0.f;
        const LAS unsigned char* vr = lds + R_V + (4 * hi + ((lane & 15) >> 2)) * TP + (32 * dvh + 16 * ((lane >> 4) & 1) + 4 * (lane & 3)) * 2;
#pragma unroll 1
        for (int kb = 0; kb < 4; ++kb) {
            f32x16 st;
#pragma unroll
            for (int r = 0; r < 16; ++r) st[r] = 0.f;
#pragma unroll
            for (int ks = 0; ks < 4; ++ks) st = MFMA32(*(const LAS bf16x8*)(lds + R_K + (32 * kb + q) * TP + hi * 16 + 32 * ks), qr[ks], st);
#pragma unroll
            for (int r = 0; r < 16; ++r) { const int dl = i_ - (32 * kb + crow(r, hi)); const float e = dl >= 0 ? (float)dl * lgf : (float)(-dl) * lgb; st[r] *= __builtin_amdgcn_exp2f(e); }
            const bf16x8 pb0 = pack8(st, 0), pb1 = pack8(st, 1);
            const LAS unsigned char* v0 = vr + 32 * kb * TP;
            ot = MFMA32(cat44(vtr(v0), vtr(v0 + 8 * TP)), pb0, ot);
            ot = MFMA32(cat44(vtr(v0 + 16 * TP), vtr(v0 + 24 * TP)), pb1, ot);
        }
        {   const float cf = exp2f((float)(i_ + 1) * lgf), cb = exp2f((float)(CHUNK - i_) * lgb);
            f32x16 t;
#pragma unroll
            for (int r = 0; r < 16; ++r) t[r] = 0.f;
#pragma unroll
            for (int ks = 0; ks < 4; ++ks) t = MFMA32(*(const LAS bf16x8*)(lds + R_SF + ((dvh * 4 + ks) * 64 + lane) * 16), qr[ks], t);
#pragma unroll
            for (int r = 0; r < 16; ++r) ot[r] += cf * t[r];
#pragma unroll
            for (int r = 0; r < 16; ++r) t[r] = 0.f;
#pragma unroll
            for (int ks = 0; ks < 4; ++ks) t = MFMA32(*(const LAS bf16x8*)(lds + R_SB + ((dvh * 4 + ks) * 64 + lane) * 16), qr[ks], t);
#pragma unroll
            for (int r = 0; r < 16; ++r) ot[r] += cb * t[r]; }
        float s1 = 0.f, s2 = 0.f;
#pragma unroll
        for (int r = 0; r < 16; ++r) { s1 += ot[r]; s2 += ot[r] * ot[r]; }
        s1 += __shfl_xor(s1, 32); s2 += __shfl_xor(s2, 32);
        if (hi == 0) *(LAS f32x2*)(lds + R_X + (wave * 32 + q) * 8) = (f32x2){s1, s2};
        __syncthreads();
        { const f32x2 p = *(const LAS f32x2*)(lds + R_X + ((wave ^ 4) * 32 + q) * 8); s1 += p.x; s2 += p.y; }
        const float mean = s1 * (1.f / 64.f), var = fmaxf(s2 * (1.f / 64.f) - mean * mean, 0.f), rstd = 1.f / sqrtf(var + NORM_EPS);
        const LAS unsigned char* gp = lds + R_G + i_ * TP + (32 * dvh + 4 * hi) * 2; LAS unsigned char* op = lds + R_O + i_ * TP + (32 * dvh + 4 * hi) * 2;
#pragma unroll
        for (int g = 0; g < 4; ++g) { const u32x2 gg = *(const LAS u32x2*)(gp + 16 * g); u32x2 w;
            w.x = pk2((ot[4 * g] - mean) * rstd * bflo(gg.x), (ot[4 * g + 1] - mean) * rstd * bfhi(gg.x)); w.y = pk2((ot[4 * g + 2] - mean) * rstd * bflo(gg.y), (ot[4 * g + 3] - mean) * rstd * bfhi(gg.y));
            *(LAS u32x2*)(op + 16 * g) = w; }
    }
    __syncthreads();
    { const size_t row0 = (size_t)b * SEQ + (n0 + 7) * CHUNK;
#pragma unroll
      for (int i = 0; i < 2; ++i) { const int r = 16 * wave + 8 * i + tr; const u32x4 v = *(const LAS u32x4*)(lds + R_O + r * TP + tc * 2);
          *(u32x4*)(MIXED + (row0 + r) * DM + 512 + h * HD + tc) = v; } }
    __syncthreads();
#undef RET_AXPY
#undef RET_PREFETCH
}

template <int NR>
__device__ __forceinline__ void combine_rows(const size_t (&rows)[NR], const bf16* OBR, const float* LSE, bf16* MIXED, int lane) {
    const int hh = lane >> 3;
    float l[NR][3]; u32x4 a[NR][3];
#pragma unroll
    for (int k = 0; k < NR; ++k)
#pragma unroll
        for (int br = 0; br < 3; ++br) { l[k][br] = LSE[((size_t)br * M + rows[k]) * NHEAD + hh]; a[k][br] = *(const u32x4*)(OBR + ((size_t)br * M + rows[k]) * SEGW + 8 * lane); }
#pragma unroll
    for (int k = 0; k < NR; ++k) {
        const float mx = fmaxf(l[k][0], fmaxf(l[k][1], l[k][2])); float w0 = __expf(l[k][0] - mx), w1 = __expf(l[k][1] - mx), w2 = __expf(l[k][2] - mx);
        const float inv = 1.f / (w0 + w1 + w2); w0 *= inv; w1 *= inv; w2 *= inv;
        float o[8]; float ss = 0.f;
#pragma unroll
        for (int e = 0; e < 4; ++e) { o[2 * e] = w0 * bflo(a[k][0][e]) + w1 * bflo(a[k][1][e]) + w2 * bflo(a[k][2][e]); o[2 * e + 1] = w0 * bfhi(a[k][0][e]) + w1 * bfhi(a[k][1][e]) + w2 * bfhi(a[k][2][e]); ss += o[2 * e] * o[2 * e] + o[2 * e + 1] * o[2 * e + 1]; }
        const float rstd = 1.f / sqrtf(wave_sum(ss) * (1.f / 512.f) + NORM_EPS);
        u32x4 w; w.x = pk2(o[0] * rstd, o[1] * rstd); w.y = pk2(o[2] * rstd, o[3] * rstd); w.z = pk2(o[4] * rstd, o[5] * rstd); w.w = pk2(o[6] * rstd, o[7] * rstd);
        *(u32x4*)(MIXED + rows[k] * DM + 8 * lane) = w;
    }
}
__device__ __forceinline__ void route_task(int grp, const float* H, const float* WRT, const float* bg, const float* be, gu32* ctl, int* LIST, float* GATEL, float* RSL, LAS float* sc, int lane) {
    const int r = lane & 15, g = lane >> 4; const size_t row = (size_t)grp * 16 + r;
    const f32x4* hp = (const f32x4*)(H + row * DM) + g;
    const f32x4* wp0 = (const f32x4*)(WRT + (size_t)r * DM) + g; const f32x4* wp1 = (const f32x4*)(WRT + (size_t)(16 + r) * DM) + g; const f32x4* wp2 = (const f32x4*)(WRT + (size_t)(32 + r) * DM) + g;
    f32x4 a0 = {0.f, 0.f, 0.f, 0.f}, a1 = a0, a2 = a0; float ss = 0.f;
#pragma unroll 4
    for (int s = 0; s < 64; ++s) {
        const f32x4 a = hp[4 * s], b0 = wp0[4 * s], b1 = wp1[4 * s], b2 = wp2[4 * s];
        ss += (a[0] * a[0] + a[1] * a[1]) + (a[2] * a[2] + a[3] * a[3]);
#pragma unroll
        for (int t = 0; t < 4; ++t) { a0 = __builtin_amdgcn_mfma_f32_16x16x4f32(a[t], b0[t], a0, 0, 0, 0); a1 = __builtin_amdgcn_mfma_f32_16x16x4f32(a[t], b1[t], a1, 0, 0, 0); a2 = __builtin_amdgcn_mfma_f32_16x16x4f32(a[t], b2[t], a2, 0, 0, 0); }
    }
    ss += __shfl_xor(ss, 16); ss += __shfl_xor(ss, 32);
    const float rstd = 1.f / sqrtf(ss * (1.f / DM) + NORM_EPS);
#pragma unroll
    for (int e = 0; e < 4; ++e) { sc[(4 * g + e) * 48 + r] = a0[e]; sc[(4 * g + e) * 48 + 16 + r] = a1[e]; sc[(4 * g + e) * 48 + 32 + r] = a2[e]; }
    if (g == 0) sc[768 + r] = rstd;
    LDS_WAIT(); asm volatile("" ::: "memory");
    if (lane < 16) {
        const size_t trow = (size_t)grp * 16 + lane; const float rs = sc[768 + lane]; const LAS float* lg = sc + lane * 48;
        float gmax = lg[32] * rs + bg[0]; int gi = 0; float gl[4]; gl[0] = gmax;
#pragma unroll
        for (int k = 1; k < 4; ++k) { gl[k] = lg[32 + k] * rs + bg[k]; if (gl[k] > gmax) { gmax = gl[k]; gi = k; } }
        float den = 0.f;
#pragma unroll
        for (int k = 0; k < 4; ++k) den += __expf(gl[k] - gmax);
        const float ggate = 1.f / den;
        float b1v = -3.0e38f, b2v = -3.0e38f; int i1 = 0, i2 = 0;
        for (int k = 0; k < 8; ++k) { const float v = lg[gi * 8 + k] * rs + be[gi * 8 + k]; if (v > b1v) { b1v = v; i1 = k; } }
        for (int k = 0; k < 8; ++k) { const float v = lg[gi * 8 + k] * rs + be[gi * 8 + k]; if (k != i1 && v > b2v) { b2v = v; i2 = k; } }
        const float p1 = 1.f / (1.f + __expf(b2v - b1v)), p2 = 1.f - p1;
        const int e1 = gi * 8 + i1, e2 = gi * 8 + i2;
        const int pos1 = (int)__hip_atomic_fetch_add(ctl + CW_CNT + 64 * e1, 1u, RLX_AGENT), pos2 = (int)__hip_atomic_fetch_add(ctl + CW_CNT + 64 * e2, 1u, RLX_AGENT);
        LIST[(size_t)e1 * M + pos1] = (int)(trow * 2); GATEL[(size_t)e1 * M + pos1] = ggate * p1; RSL[(size_t)e1 * M + pos1] = rs;
        LIST[(size_t)e2 * M + pos2] = (int)(trow * 2 + 1); GATEL[(size_t)e2 * M + pos2] = ggate * p2; RSL[(size_t)e2 * M + pos2] = rs;
    }
    LDS_WAIT(); asm volatile("" ::: "memory");
}
template <int NR>
__device__ __forceinline__ void final_rows(const size_t (&rows)[NR], const float* H, const bf16* Y, const f32x4 (&gv)[4], float* out, int lane) {
    f32x4 hv[NR][4]; u32x2 a[NR][4], b[NR][4];
#pragma unroll
    for (int k = 0; k < NR; ++k) { const f32x4* hp = (const f32x4*)(H + rows[k] * DM) + lane; const u32x2* y0 = (const u32x2*)(Y + (rows[k] * 2) * DM) + lane; const u32x2* y1 = (const u32x2*)(Y + (rows[k] * 2 + 1) * DM) + lane;
#pragma unroll
        for (int j = 0; j < 4; ++j) { hv[k][j] = hp[64 * j]; a[k][j] = y0[64 * j]; b[k][j] = y1[64 * j]; } }
#pragma unroll
    for (int k = 0; k < NR; ++k) { f32x4 z[4]; float ss = 0.f;
#pragma unroll
        for (int j = 0; j < 4; ++j) {
            z[j][0] = hv[k][j][0] + bflo(a[k][j].x) + bflo(b[k][j].x); z[j][1] = hv[k][j][1] + bfhi(a[k][j].x) + bfhi(b[k][j].x); z[j][2] = hv[k][j][2] + bflo(a[k][j].y) + bflo(b[k][j].y); z[j][3] = hv[k][j][3] + bfhi(a[k][j].y) + bfhi(b[k][j].y);
            ss += (z[j][0] * z[j][0] + z[j][1] * z[j][1]) + (z[j][2] * z[j][2] + z[j][3] * z[j][3]); }
        const float rstd = 1.f / sqrtf(wave_sum(ss) * (1.f / DM) + NORM_EPS);
        f32x4* op = (f32x4*)(out + rows[k] * DM) + lane;
#pragma unroll
        for (int j = 0; j < 4; ++j) op[64 * j] = z[j] * rstd * gv[j]; }
}
__device__ __forceinline__ TileTab build_tiles(Frame& F, int& ntiles) {
    LAS int* T = (LAS int*)(F.lds + TILE_OFF); LAS int* TE = T; LAS int* NE = T + MAXTILES; LAS int* T0 = NE + 32; LAS int* NT = T0 + 32;
    __syncthreads();
    if (F.tid == 0) { int t = 0;
        for (int e = 0; e < NEXP; ++e) { int n = (int)__hip_atomic_load(F.ctl + CW_CNT + 64 * e, RLX_AGENT); if (n > M) n = M; NE[e] = n; T0[e] = t; const int k = (n + 255) >> 8;
            for (int j = 0; j < k && t + j < MAXTILES; ++j) TE[t + j] = e; t += k; if (t > MAXTILES) t = MAXTILES; }
        NT[0] = t; }
    __syncthreads();
    ntiles = NT[0];
    TileTab tt; tt.TE = TE; tt.NE = NE; tt.T0 = T0; return tt;
}

__device__ __forceinline__ int fresh_lane() { int t = threadIdx.x; asm volatile("" : "+v"(t)); return t & 63; }
constexpr int N_LAUNCHES = MK_N_LAUNCHES, PER_PHASE = 9;
__global__ void __launch_bounds__(NWAVES * 64, 2) mk_fwd(Args args) {
    extern __shared__ __attribute__((aligned(16))) unsigned char lds_raw[];
    Frame F;
    F.lds = (LAS unsigned char*)lds_raw;
    F.MISC = (volatile LAS unsigned*)(F.lds + MISC_OFF);
    F.tid = threadIdx.x; F.lane = F.tid & 63; F.wave = __builtin_amdgcn_readfirstlane(F.tid >> 6);
    F.G = gridDim.x; { const int bx = blockIdx.x; F.vcu = (F.G % 8 == 0) ? (bx % 8) * (F.G / 8) + bx / 8 : bx; }
    unsigned char* ws = args.ws;
    F.ctl = (gu32*)(ws + WS_CTL);
    for (int u = F.tid; u < (LDS_BYTES - LDSCTL_OFF) / 4; u += NWAVES * 64) ((LAS unsigned*)(F.lds + LDSCTL_OFF))[u] = 0u;
    __syncthreads();
    XcdBarrier bar; bar.bar = (unsigned*)(F.ctl + CW_BAR); bar.x = 0; bar.st = nullptr;
    if (N_LAUNCHES != PER_PHASE) bar = xcd_barrier_post((unsigned*)(F.ctl + CW_BAR) + args.li * XCD_BAR_WORDS, F.MISC + 8);
#define GRID_BAR() do { if (N_LAUNCHES != PER_PHASE) xcd_barrier(bar); } while (0)
    const int lo = args.ph_lo, hi = args.ph_hi;
#define IN(k) (lo <= (k) && (k) < hi)
#define REPS(k) ((MK_REPEAT == (k)) ? MK_NREP : 1)
#define BOTH(k) (IN(k) && IN((k) + 1))
    const int gw = F.vcu * NWAVES + F.wave, NGW = F.G * NWAVES;
#if MK_TIME
    int n_stamp = 0;
#define STAMP() do { if (blockIdx.x == 0 && F.tid == 0) { const unsigned long long t_ = __builtin_amdgcn_s_memrealtime(); __hip_atomic_store(F.ctl + CW_TS + 2 * n_stamp, (unsigned)t_, RLX_AGENT); __hip_atomic_store(F.ctl + CW_TS + 2 * n_stamp + 1, (unsigned)(t_ >> 32), RLX_AGENT); } ++n_stamp; } while (0)
    STAMP();
#else
#define STAMP() do {} while (0)
#endif
    bf16* SEGB = (bf16*)(ws + WS_SEG);
    const bf16 *QA = SEGB, *KA = SEGB + (size_t)1 * M * SEGW, *VA = SEGB + (size_t)2 * M * SEGW, *QR = SEGB + (size_t)3 * M * SEGW, *KR = SEGB + (size_t)4 * M * SEGW, *VR = SEGB + (size_t)5 * M * SEGW, *GR = SEGB + (size_t)6 * M * SEGW;

    for (int rep_ = 0; rep_ < REPS(0); ++rep_) if (IN(0)) { p0_prologue(F, args); if (BOTH(0)) GRID_BAR(); STAMP(); }
    for (int rep_ = 0; rep_ < REPS(1); ++rep_) if (IN(1)) {
        pg8::StaticOrder S; S.init(M / 256, NIN / 256, F.G, (int)blockIdx.x);
        SrcPlain SRC{(const bf16*)(ws + WS_XN), (const bf16*)(ws + WS_WIN), DM};
        EpiInProj E{SEGB, (const float*)(ws + WS_ROPE), (const float*)(ws + WS_ROPE) + SEQ * 40};
        pg8::gemm_phase<EpiInProj, pg8::StaticOrder, SrcPlain, true, true>(F.lds, DM, S, SRC, E);
        if (BOTH(1)) GRID_BAR(); STAMP();
    }
    for (int rep_ = 0; rep_ < REPS(2); ++rep_) if (IN(2)) {
        bf16* OBR = (bf16*)(ws + WS_OBR); float* LSE = (float*)(ws + WS_LSE); bf16* KVB = (bf16*)(ws + WS_ST);
        for (int cid = gw; cid < NBATCH * NHEAD * NCHUNK; cid += NGW) kv_task(cid, KR, VR, KVB, args.in[4], args.in[5], F.lds + F.wave * 16384, fresh_lane());
        { const int nrt = NBATCH * NHEAD * 48, per = (nrt + F.G - 1) / F.G, r0 = F.vcu * per, nr = r0 + per <= nrt ? per : (nrt > r0 ? nrt - r0 : 0);
          __syncthreads();
          if (nr > 0) attn_rounds(r0, nr, QA, KA, VA, OBR, LSE, F.lds, F.wave, fresh_lane()); }
        if (BOTH(2)) GRID_BAR(); STAMP();
    }
    for (int rep_ = 0; rep_ < REPS(3); ++rep_) if (IN(3)) {
        bf16* MIXED = (bf16*)(ws + WS_MIXED);
        for (int wgt = F.vcu; wgt < NBATCH * NHEAD * 4; wgt += F.G) { int t_ = threadIdx.x; asm volatile("" : "+v"(t_));
            ret_wg(wgt, QR, KR, VR, GR, (const bf16*)(ws + WS_ST), (bf16*)(ws + WS_SBW), MIXED, args.in[4], args.in[5], F.lds, t_, F.wave, t_ & 63); }
        { const int ln = fresh_lane();
          for (int row = gw; row < M; row += 4 * NGW) { const size_t rows[4] = {(size_t)row, (size_t)(row + NGW), (size_t)(row + 2 * NGW), (size_t)(row + 3 * NGW)};
              combine_rows<4>(rows, (const bf16*)(ws + WS_OBR), (const float*)(ws + WS_LSE), MIXED, ln); } }
        if (BOTH(3)) GRID_BAR(); STAMP();
    }
    for (int rep_ = 0; rep_ < REPS(4); ++rep_) if (IN(4)) {
        pg8::StaticOrder S; S.init(M / 256, DM / 256, F.G, (int)blockIdx.x);
        SrcPlain SRC{(const bf16*)(ws + WS_MIXED), (const bf16*)(ws + WS_WOUT), DM};
        EpiOutProj E{args.in[0], args.in[8], (float*)(ws + WS_H), (bf16*)(ws + WS_HG)};
        pg8::gemm_phase<EpiOutProj, pg8::StaticOrder, SrcPlain, true, true>(F.lds, DM, S, SRC, E);
        if (BOTH(4)) GRID_BAR(); STAMP();
    }
    for (int rep_ = 0; rep_ < REPS(5); ++rep_) if (IN(5)) {
        LAS float* sc = (LAS float*)(F.lds + F.wave * 16384);
        if (rep_ > 0) { if (blockIdx.x == 0 && F.tid < NEXP) __hip_atomic_store(F.ctl + CW_CNT + 64 * F.tid, 0u, RLX_AGENT); GRID_BAR(); }
        for (int grp = gw; grp < M / 16; grp += NGW)
            route_task(grp, (const float*)(ws + WS_H), (const float*)(ws + WS_WRT), args.in[10], args.in[12], F.ctl, (int*)(ws + WS_LIST), (float*)(ws + WS_GATEL), (float*)(ws + WS_RSL), sc, fresh_lane());
        if (BOTH(5)) GRID_BAR(); STAMP();
    }
    for (int rep_ = 0; rep_ < REPS(6); ++rep_) if (IN(6)) {
        int ntiles; const TileTab tt = build_tiles(F, ntiles);
        pg8::StaticOrder S; S.init(ntiles, 4, F.G, (int)blockIdx.x);
        SrcGather SRC{(const bf16*)(ws + WS_HG), (const bf16*)(ws + WS_WGU), (const int*)(ws + WS_LIST), tt};
        EpiGateUp E{(bf16*)(ws + WS_HID), (const float*)(ws + WS_GATEL), (const float*)(ws + WS_RSL), tt};
        pg8::gemm_phase<EpiGateUp, pg8::StaticOrder, SrcGather, true, true>(F.lds, DM, S, SRC, E);
        if (BOTH(6)) GRID_BAR(); STAMP();
    }
    for (int rep_ = 0; rep_ < REPS(7); ++rep_) if (IN(7)) {
        int ntiles; const TileTab tt = build_tiles(F, ntiles);
        pg8::StaticOrder S; S.init(ntiles, 4, F.G, (int)blockIdx.x);
        SrcDown SRC{(const bf16*)(ws + WS_HID), (const bf16*)(ws + WS_WD), tt};
        EpiDown E{(bf16*)(ws + WS_Y), (const int*)(ws + WS_LIST), tt};
        pg8::gemm_phase<EpiDown, pg8::StaticOrder, SrcDown, true, true>(F.lds, FF, S, SRC, E);
        if (BOTH(7)) GRID_BAR(); STAMP();
    }
    for (int rep_ = 0; rep_ < REPS(8); ++rep_) if (IN(8)) {
        f32x4 gv[4];
#pragma unroll
        for (int j = 0; j < 4; ++j) gv[j] = ((const f32x4*)args.in[16])[fresh_lane() + 64 * j];
        { const int ln = fresh_lane();
          for (int row = gw; row < M; row += 2 * NGW) { const size_t rows[2] = {(size_t)row, (size_t)(row + NGW)}; final_rows<2>(rows, (const float*)(ws + WS_H), (const bf16*)(ws + WS_Y), gv, args.out, ln); } }
#if MK_TIME
        GRID_BAR(); STAMP(); GRID_BAR();
        { unsigned long long ts[10];
#pragma unroll
          for (int k = 0; k < 10; ++k) ts[k] = (unsigned long long)__hip_atomic_load(F.ctl + CW_TS + 2 * k, RLX_AGENT) | ((unsigned long long)__hip_atomic_load(F.ctl + CW_TS + 2 * k + 1, RLX_AGENT) << 32);
          constexpr int KA = 2 * MK_TIME - 2, KB = 2 * MK_TIME - 1;
          const float ta = (float)(ts[KA + 1] - ts[KA]) * 0.01f, tb = MK_TIME == 5 ? (float)(ts[9] - ts[0]) * 0.01f : (float)(ts[KB + 1] - ts[KB]) * 0.01f;
          const float c1 = sqrtf(ta);
          for (size_t i = (size_t)blockIdx.x * 512 + F.tid; i < (size_t)M * DM; i += (size_t)F.G * 512) args.out[i] = i == 0 ? tb : c1; }
#endif
    }
#undef IN
#undef BOTH
#undef GRID_BAR
}

#if MK_CHECK
__device__ __forceinline__ unsigned hsh(unsigned x) { x ^= x >> 16; x *= 0x7feb352dU; x ^= x >> 15; x *= 0x846ca68bU; x ^= x >> 16; return x; }
__device__ __forceinline__ float ldb(const bf16* p, size_t i) { return __uint_as_float(((unsigned)p[i]) << 16); }
__device__ __forceinline__ float rbf(float x) { return bflo(pk2(x, 0.f) & 0xffffu); }
__device__ __forceinline__ void chk_put(gu32* ctl, int stage, float got, float ref, float atol) {
    float e = fabsf(got - ref) / (0.03f * fabsf(ref) + atol); if (!(e == e)) e = 1e30f; if (e > 1e30f) e = 1e30f;
    __hip_atomic_fetch_max(ctl + CW_CHK + stage, __float_as_uint(e), RLX_AGENT);
}
__global__ void __launch_bounds__(256) chk_kernel(Args A, int stage) {
    unsigned char* ws = A.ws; gu32* ctl = (gu32*)(ws + WS_CTL);
    const int gt = blockIdx.x * 256 + threadIdx.x, NT = gridDim.x * 256;
    const bf16* SEGB = (const bf16*)(ws + WS_SEG);
    const bf16 *QA = SEGB, *KA = SEGB + (size_t)1 * M * SEGW, *VA = SEGB + (size_t)2 * M * SEGW, *QR = SEGB + (size_t)3 * M * SEGW, *KR = SEGB + (size_t)4 * M * SEGW, *VR = SEGB + (size_t)5 * M * SEGW, *GR = SEGB + (size_t)6 * M * SEGW;
    if (stage == 0) {
        const bf16* WIN = (const bf16*)(ws + WS_WIN); const bf16* WOUT = (const bf16*)(ws + WS_WOUT); const bf16* WGU = (const bf16*)(ws + WS_WGU); const bf16* WD = (const bf16*)(ws + WS_WD);
        for (int s = gt; s < 65536; s += NT) { const unsigned r = hsh(s * 7 + 1), r2 = hsh(r);
            { const int n = r % NIN, k = r2 % DM; chk_put(ctl, 0, ldb(WIN, (size_t)winperm(n) * DM + k), A.in[2][(size_t)k * NIN + n], 1e-4f); }
            { const int n = r % DM, k = r2 % DM; chk_put(ctl, 0, ldb(WOUT, (size_t)n * DM + k), A.in[7][(size_t)k * DM + n] * (k < 512 ? A.in[3][k] : A.in[6][k - 512]), 1e-4f); }
            { const int e = (r >> 10) % NEXP, j = r % FF, k = r2 % DM;
              chk_put(ctl, 0, ldb(WGU, ((size_t)e * DM + ((j >> 7) << 8) + (j & 127)) * DM + k), A.in[13][((size_t)e * DM + k) * FF + j], 1e-4f);
              chk_put(ctl, 0, ldb(WGU, ((size_t)e * DM + ((j >> 7) << 8) + 128 + (j & 127)) * DM + k), A.in[14][((size_t)e * DM + k) * FF + j], 1e-4f); }
            { const int e = (r >> 10) % NEXP, n = r % DM, k = r2 % FF; chk_put(ctl, 0, ldb(WD, ((size_t)e * DM + n) * FF + k), A.in[15][((size_t)e * FF + k) * DM + n], 1e-4f); }
            { const int j = r % 36, i = r2 % DM; const float ref = (j < 32 ? A.in[11][i * 32 + j] : A.in[9][i * 4 + j - 32]) * A.in[8][i]; chk_put(ctl, 0, ((const float*)(ws + WS_WRT))[j * DM + i], ref, 1e-6f); }
            { const int pos = r % SEQ, f = r2 % 40; const float fr = f < 8 ? powf(500000.f, -(float)f / 8.f) : powf(10000.f, -(float)(f - 8) / 31.f); const float ang = (float)pos * fr;
              chk_put(ctl, 0, ((const float*)(ws + WS_ROPE))[pos * 40 + f], cosf(ang), 2e-3f); chk_put(ctl, 0, ((const float*)(ws + WS_ROPE))[SEQ * 40 + pos * 40 + f], sinf(ang), 2e-3f); }
        }
        for (int s = gt; s < 2048; s += NT) { const unsigned r = hsh(s * 13 + 5); const int row = r % M, c = hsh(r) % DM; const float* x = A.in[0] + (size_t)row * DM; float ss = 0.f;
            for (int k = 0; k < DM; ++k) ss += x[k] * x[k];
            chk_put(ctl, 0, ldb((const bf16*)(ws + WS_XN), (size_t)row * DM + c), x[c] / sqrtf(ss / DM + NORM_EPS) * A.in[1][c], 1e-3f); }
    }
    if (stage == 1) {
        const bf16* XN = (const bf16*)(ws + WS_XN);
        for (int s = gt; s < 8192; s += NT) { const unsigned r = hsh(s * 3 + 11), r2 = hsh(r); const int row = r % M, seg = r2 % 7, hh = (r2 >> 4) % 8, pos = row & (SEQ - 1);
            const int half = (seg == 0 || seg == 1) ? 8 : 32; const int i = (r2 >> 8) % half; const int d1 = i, d2 = i + half;
            float a1 = 0.f, a2 = 0.f; const float* w = A.in[2] + seg * 512 + hh * 64;
            for (int k = 0; k < DM; ++k) { const float xv = ldb(XN, (size_t)row * DM + k); a1 += xv * rbf(w[(size_t)k * NIN + d1]); a2 += xv * rbf(w[(size_t)k * NIN + d2]); }
            const bf16* O = SEGB + (size_t)seg * M * SEGW + (size_t)row * SEGW + hh * 64;
            if (seg == 0 || seg == 1 || seg == 3 || seg == 4) {
                const float fr = seg < 2 ? powf(500000.f, -(float)i / 8.f) : powf(10000.f, -(float)i / 31.f); const float ang = (float)pos * fr, c = cosf(ang), sn = sinf(ang);
                const float sc = seg == 0 ? 0.125f * LOG2E : (seg == 4 ? 0.125f : 1.f);
                chk_put(ctl, 1, ldb(O, 2 * i), (a1 * c - a2 * sn) * sc, 0.02f); chk_put(ctl, 1, ldb(O, 2 * i + 1), (a2 * c + a1 * sn) * sc, 0.02f);
                if (seg < 2) { const int d3 = 16 + (r2 >> 12) % 48; float a3 = 0.f; for (int k = 0; k < DM; ++k) a3 += ldb(XN, (size_t)row * DM + k) * rbf(w[(size_t)k * NIN + d3]); chk_put(ctl, 1, ldb(O, d3), a3 * sc, 0.02f); }
            } else { chk_put(ctl, 1, ldb(O, d1), seg == 6 ? silu_f(a1) : a1, 0.02f); chk_put(ctl, 1, ldb(O, d2), seg == 6 ? silu_f(a2) : a2, 0.02f); }
        }
    }
    if (stage == 2) {
        const bf16* OBR = (const bf16*)(ws + WS_OBR); const float* LSE = (const float*)(ws + WS_LSE); const bf16* ST = (const bf16*)(ws + WS_ST);
        for (int s = gt; s < 4096; s += NT) { const unsigned r = hsh(s * 5 + 3), r2 = hsh(r); const int b = r % NBATCH, pos = (s < 256) ? (s & 1 ? SEQ - 1 - (s >> 1) % 80 : (s >> 1) % 80) : (r >> 3) % SEQ, h = r2 % NHEAD, br = (r2 >> 3) % 3, dd = (r2 >> 8) % HD;
            const int dil = 1 << (2 * br); const size_t row = (size_t)b * SEQ + pos;
            float mx = -1e30f;
            for (int pass = 0; pass < 2; ++pass) { float l = 0.f, o = 0.f;
                for (int j = -64; j <= 64; ++j) { const int kp = pos + j * dil; if (kp < 0 || kp >= SEQ) continue; const size_t kr = (size_t)b * SEQ + kp; float d = 0.f;
                    for (int k = 0; k < HD; ++k) d += ldb(QA, row * SEGW + h * HD + k) * ldb(KA, kr * SEGW + h * HD + k);
                    if (pass == 0) mx = fmaxf(mx, d); else { const float p = exp2f(d - mx); l += p; o += p * ldb(VA, kr * SEGW + h * HD + dd); } }
                if (pass == 1) { chk_put(ctl, 2, ldb(OBR, ((size_t)br * M + row) * SEGW + h * HD + dd), o / l, 0.02f); chk_put(ctl, 2, LSE[((size_t)br * M + row) * NHEAD + h], (mx + log2f(l)) * LN2, 0.02f); } }
        }
        for (int s = gt; s < 8192; s += NT) { const unsigned r = hsh(s * 9 + 7), r2 = hsh(r); const int bh = r % 64, dir = (r >> 6) & 1, n = (r >> 7) % NCHUNK, dv = r2 % 64, dk = (r2 >> 6) % 64, b = bh >> 3, h = bh & 7;
            const float lg2 = log1pf(-exp2f((dir ? A.in[5] : A.in[4])[h])) * LOG2E; float S = 0.f;
            for (int j = 0; j < CHUNK; ++j) { const size_t row = (size_t)b * SEQ + n * CHUNK + j; const float ex = dir == 0 ? (float)(127 - j) : (float)j;
                S += exp2f(ex * lg2) * ldb(KR, row * SEGW + h * HD + dk) * ldb(VR, row * SEGW + h * HD + dv); }
            chk_put(ctl, 2, ldb(ST, (((size_t)bh * NCHUNK + n) * 2 + dir) * 4096 + ((size_t)((dv >> 5) * 4 + (dk >> 4)) * 64 + (dv & 31) + 32 * ((dk >> 3) & 1)) * 8 + (dk & 7)), S, 0.05f);
        }
    }
    if (stage == 3) {
        const bf16* MIXED = (const bf16*)(ws + WS_MIXED);
        for (int s = gt; s < 512; s += NT) { const unsigned r = hsh(s * 17 + 9), r2 = hsh(r); const int b = r % NBATCH, pos = (s < 64) ? (s & 1 ? SEQ - 1 - (s >> 1) * 5 : (s >> 1) * 5) : (r >> 3) % SEQ, h = r2 % NHEAD; const size_t row = (size_t)b * SEQ + pos;
            const float lgf = log1pf(-exp2f(A.in[4][h])) * LOG2E, lgb = log1pf(-exp2f(A.in[5][h])) * LOG2E;
            float o[HD], qv[HD];
#pragma unroll
            for (int k = 0; k < HD; ++k) { o[k] = 0.f; qv[k] = ldb(QR, row * SEGW + h * HD + k); }
            for (int kp = 0; kp < SEQ; ++kp) { const size_t kr = (size_t)b * SEQ + kp; const int dl = pos - kp; const float w = dl >= 0 ? exp2f((float)dl * lgf) : exp2f((float)(-dl) * lgb); if (w < 1e-12f) continue; float d = 0.f;
#pragma unroll
                for (int k = 0; k < HD; ++k) d += qv[k] * ldb(KR, kr * SEGW + h * HD + k);
                d *= w;
#pragma unroll
                for (int k = 0; k < HD; ++k) o[k] += d * ldb(VR, kr * SEGW + h * HD + k); }
            float mean = 0.f, var = 0.f;
#pragma unroll
            for (int k = 0; k < HD; ++k) mean += o[k];
            mean *= (1.f / HD);
#pragma unroll
            for (int k = 0; k < HD; ++k) var += (o[k] - mean) * (o[k] - mean);
            var *= (1.f / HD); const float rstd = 1.f / sqrtf(var + NORM_EPS);
#pragma unroll
            for (int k = 0; k < HD; ++k) if ((k & 7) == (int)(r2 >> 8) % 8) chk_put(ctl, 3, ldb(MIXED, row * DM + 512 + h * HD + k), (o[k] - mean) * rstd * ldb(GR, row * SEGW + h * HD + k), 0.03f);
        }
        {
            const bf16* OBR = (const bf16*)(ws + WS_OBR); const float* LSE = (const float*)(ws + WS_LSE);
            for (int s = gt; s < 4096; s += NT) { const unsigned r = hsh(s * 19 + 1), r2 = hsh(r); const int row = r % M, csel = r2 % 512; float ss = 0.f, osel = 0.f;
                for (int c = 0; c < 512; ++c) { const int h = c >> 6; const float l0 = LSE[((size_t)0 * M + row) * NHEAD + h], l1 = LSE[((size_t)1 * M + row) * NHEAD + h], l2 = LSE[((size_t)2 * M + row) * NHEAD + h];
                    const float mx = fmaxf(l0, fmaxf(l1, l2)), w0 = expf(l0 - mx), w1 = expf(l1 - mx), w2 = expf(l2 - mx);
                    const float o = (w0 * ldb(OBR, ((size_t)0 * M + row) * SEGW + c) + w1 * ldb(OBR, ((size_t)1 * M + row) * SEGW + c) + w2 * ldb(OBR, ((size_t)2 * M + row) * SEGW + c)) / (w0 + w1 + w2);
                    ss += o * o; if (c == csel) osel = o; }
                chk_put(ctl, 3, ldb(MIXED, (size_t)row * DM + csel), osel / sqrtf(ss / 512.f + NORM_EPS), 0.03f); }
        }
    }
    if (stage == 4) {
        const bf16* MIXED = (const bf16*)(ws + WS_MIXED); const bf16* WOUT = (const bf16*)(ws + WS_WOUT); const float* H = (const float*)(ws + WS_H); const bf16* HG = (const bf16*)(ws + WS_HG);
        for (int s = gt; s < 16384; s += NT) { const unsigned r = hsh(s * 23 + 3); const int row = r % M, c = hsh(r) % DM; float a = 0.f;
            for (int k = 0; k < DM; ++k) a += ldb(MIXED, (size_t)row * DM + k) * ldb(WOUT, (size_t)c * DM + k);
            const float h = a + A.in[0][(size_t)row * DM + c]; chk_put(ctl, 4, H[(size_t)row * DM + c], h, 0.02f); chk_put(ctl, 4, ldb(HG, (size_t)row * DM + c), h * A.in[8][c], 0.02f); }
    }
    if (stage == 5) {
        const float* H = (const float*)(ws + WS_H); const int* LIST = (const int*)(ws + WS_LIST); const float* GATEL = (const float*)(ws + WS_GATEL); const float* RSL = (const float*)(ws + WS_RSL);
        if (gt == 0) { unsigned tot = 0; for (int e = 0; e < NEXP; ++e) tot += ctl[CW_CNT + 64 * e]; chk_put(ctl, 5, (float)tot, (float)(2 * M), 0.5f); }
        for (int s = gt; s < 2048; s += NT) { const int t = hsh(s * 29 + 5) % M; const float* h = H + (size_t)t * DM; float ss = 0.f;
            for (int k = 0; k < DM; ++k) ss += h[k] * h[k];
            const float rs = 1.f / sqrtf(ss / DM + NORM_EPS); float gl[4]; int gi = 0;
            for (int g = 0; g < 4; ++g) { float a = 0.f; for (int k = 0; k < DM; ++k) a += h[k] * rs * A.in[8][k] * A.in[9][k * 4 + g]; gl[g] = a + A.in[10][g]; if (gl[g] > gl[gi]) gi = g; }
            float den = 0.f; for (int g = 0; g < 4; ++g) den += expf(gl[g] - gl[gi]);
            float b1 = -3e38f, b2 = -3e38f, b3 = -3e38f; int i1 = 0, i2 = 0;
            for (int e = 0; e < 8; ++e) { float a = 0.f; for (int k = 0; k < DM; ++k) a += h[k] * rs * A.in[8][k] * A.in[11][k * 32 + gi * 8 + e]; a += A.in[12][gi * 8 + e];
                if (a > b1) { b3 = b2; b2 = b1; i2 = i1; b1 = a; i1 = e; } else if (a > b2) { b3 = b2; b2 = a; i2 = e; } else if (a > b3) b3 = a; }
            float second = -3e38f; for (int g = 0; g < 4; ++g) if (g != gi) second = fmaxf(second, gl[g]);
            if (gl[gi] - second < 1e-3f || b2 - b3 < 1e-3f || b1 - b2 < 1e-3f) continue;
            const float p1 = 1.f / (1.f + expf(b2 - b1)); const float g1 = p1 / den, g2 = (1.f - p1) / den;
            for (int k = 0; k < 2; ++k) { const int e = gi * 8 + (k ? i2 : i1); const int n = (int)ctl[CW_CNT + 64 * e]; int found = -1;
                for (int p = 0; p < n && p < M; ++p) if (LIST[(size_t)e * M + p] == t * 2 + k) { found = p; break; }
                if (found < 0) chk_put(ctl, 5, 0.f, 100.f, 0.1f); else { chk_put(ctl, 5, GATEL[(size_t)e * M + found], k ? g2 : g1, 1e-3f); chk_put(ctl, 5, RSL[(size_t)e * M + found], rs, 1e-4f); } }
        }
    }
    if (stage == 6 || stage == 7) {
        const int* LIST = (const int*)(ws + WS_LIST); const float* GATEL = (const float*)(ws + WS_GATEL); const float* RSL = (const float*)(ws + WS_RSL);
        const bf16* HG = (const bf16*)(ws + WS_HG); const bf16* WGU = (const bf16*)(ws + WS_WGU); const bf16* HID = (const bf16*)(ws + WS_HID); const bf16* WD = (const bf16*)(ws + WS_WD); const bf16* Y = (const bf16*)(ws + WS_Y);
        for (int s = gt; s < 8192; s += NT) { const unsigned r = hsh(s * 31 + 7), r2 = hsh(r); const int e = r % NEXP; const int ne = (int)ctl[CW_CNT + 64 * e]; if (ne <= 0) continue;
            int t0 = 0; for (int q = 0; q < e; ++q) t0 += ((int)ctl[CW_CNT + 64 * q] + 255) >> 8;
            const int pos = (s & 3) == 0 ? ne - 1 - (int)((r >> 5) % (ne < 300 ? ne : 300)) : (int)((r >> 5) % ne); const size_t slot = (size_t)t0 * 256 + pos; const int tk = LIST[(size_t)e * M + pos], t = tk >> 1;
            if (stage == 6) { const int j = r2 % FF; float g = 0.f, u = 0.f; const bf16* wg = WGU + ((size_t)e * DM + ((j >> 7) << 8) + (j & 127)) * DM; const bf16* wu = wg + (size_t)128 * DM;
                for (int k = 0; k < DM; ++k) { const float xv = ldb(HG, (size_t)t * DM + k); g += xv * ldb(wg, k); u += xv * ldb(wu, k); }
                const float rs = RSL[(size_t)e * M + pos]; chk_put(ctl, 6, ldb(HID, slot * FF + j), silu_f(g * rs) * (u * rs) * GATEL[(size_t)e * M + pos], 0.01f); }
            else { const int c = r2 % DM; float a = 0.f; for (int k = 0; k < FF; ++k) a += ldb(HID, slot * FF + k) * ldb(WD, ((size_t)e * DM + c) * FF + k);
                chk_put(ctl, 7, ldb(Y, (size_t)tk * DM + c), a, 0.01f); }
        }
    }
    if (stage == 8) {
        const float* H = (const float*)(ws + WS_H); const bf16* Y = (const bf16*)(ws + WS_Y);
        for (int s = gt; s < 4096; s += NT) { const unsigned r = hsh(s * 37 + 1); const int row = r % M, c = hsh(r) % DM; float ss = 0.f, zc = 0.f;
            for (int k = 0; k < DM; ++k) { const float z = H[(size_t)row * DM + k] + ldb(Y, (size_t)(2 * row) * DM + k) + ldb(Y, (size_t)(2 * row + 1) * DM + k); ss += z * z; if (k == c) zc = z; }
            chk_put(ctl, 8, A.out[(size_t)row * DM + c], zc / sqrtf(ss / DM + NORM_EPS) * A.in[16][c], 0.01f); }
    }
}
__global__ void __launch_bounds__(256) chk_final(Args A) {
    gu32* ctl = (gu32*)(A.ws + WS_CTL); int bad = -1; float err = 0.f;
    for (int s = 0; s < 9; ++s) { const float e = __uint_as_float(ctl[CW_CHK + s]); if (e > 1.f) { bad = s; err = e; break; } }
    if (bad < 0 && ctl[CW_BAR + XB_TMO] != 0u) { bad = 10; err = 1.f; }
    if (bad < 0) return;
    float mant = 1.f + log10f(err); if (mant > 9.9f) mant = 9.9f; if (mant < 1.f) mant = 1.f;
    const float C = sqrtf(mant * powf(10.f, (float)(bad + 3)));
    for (size_t i = blockIdx.x * 256 + threadIdx.x; i < (size_t)M * DM; i += (size_t)gridDim.x * 256) A.out[i] = C;
}
#endif

extern "C" void kernel_launch(void* const* d_in, const int* in_sizes, int n_in, void* d_out, int out_size, void* d_ws, size_t ws_size, hipStream_t stream) {
    static int grid = 0;
    if (grid == 0) {
        if (n_in != 17 || in_sizes[0] != M * DM || out_size != M * DM || ws_size < WS_END) { fprintf(stderr, "kernel_launch: unexpected shapes (n_in %d, in0 %d, out %d, ws %zu); nothing launched\n", n_in, n_in > 0 ? in_sizes[0] : -1, out_size, ws_size); grid = -1; return; }
        int dev = 0, cus = 0, per_cu = 0;
        if (hipGetDevice(&dev) != hipSuccess || hipDeviceGetAttribute(&cus, hipDeviceAttributeMultiprocessorCount, dev) != hipSuccess) { grid = -1; return; }
        if (hipFuncSetAttribute((const void*)mk_fwd, hipFuncAttributeMaxDynamicSharedMemorySize, LDS_BYTES) != hipSuccess) { fprintf(stderr, "kernel_launch: hipFuncSetAttribute failed\n"); grid = -1; return; }
        if (hipOccupancyMaxActiveBlocksPerMultiprocessor(&per_cu, (const void*)mk_fwd, NWAVES * 64, LDS_BYTES) != hipSuccess || per_cu < 1) { fprintf(stderr, "kernel_launch: occupancy query says %d blocks per CU; nothing launched\n", per_cu); (void)hipGetLastError(); grid = -1; return; }
        grid = cus;
    }
    if (grid < 0) return;
    if (hipMemsetAsync((char*)d_ws + WS_CTL, 0, CTL_ZERO_BYTES, stream) != hipSuccess) { fprintf(stderr, "kernel_launch: memset failed\n"); return; }
    Args a{};
    for (int i = 0; i < 17; ++i) a.in[i] = (const float*)d_in[i];
    a.out = (float*)d_out; a.ws = (unsigned char*)d_ws;
    const double TWO_PI = 6.283185307179586476925286766559;
    for (int i = 0; i < 8; ++i) a.frev[i] = std::pow(500000.0, -(double)i / 8.0) / TWO_PI;
    for (int i = 0; i < 32; ++i) a.frev[8 + i] = std::pow(10000.0, -(double)i / 31.0) / TWO_PI;
    if (N_LAUNCHES == 1) {
        a.ph_lo = 0; a.ph_hi = PER_PHASE; a.li = 0;
        void* kargs[] = {&a};
        const hipError_t le = hipLaunchCooperativeKernel((const void*)mk_fwd, dim3(grid), dim3(NWAVES * 64), kargs, LDS_BYTES, stream);
        if (le != hipSuccess) fprintf(stderr, "kernel_launch: cooperative launch failed: %s (grid %d)\n", hipGetErrorName(le), grid);
    } else {
        for (int li = 0; li < PER_PHASE; ++li) {
            a.ph_lo = li; a.ph_hi = li + 1; a.li = 0;
            hipLaunchKernelGGL(mk_fwd, dim3(grid), dim3(NWAVES * 64), LDS_BYTES, stream, a);
#if MK_CHECK
            hipLaunchKernelGGL(chk_kernel, dim3(256), dim3(256), 0, stream, a, li);
#endif
        }
#if MK_CHECK
        hipLaunchKernelGGL(chk_final, dim3(1024), dim3(256), 0, stream, a);
#endif
    }
}
```

```cpp
#include <hip/hip_runtime.h>
#include <cstdio>
#include <cstdint>
#include <cmath>

#ifndef MK_N_LAUNCHES
#define MK_N_LAUNCHES 1
#endif
#ifndef MK_TIME
#define MK_TIME 0
#endif
#ifndef MK_REPEAT
#define MK_REPEAT -1
#endif
#ifndef MK_NREP
#define MK_NREP 2
#endif
#ifndef MK_COOP
#define MK_COOP 1
#endif
#ifndef MK_TSCALE
#define MK_TSCALE 1.0f
#endif
#ifndef MK_CHECK
#define MK_CHECK 0
#endif

#define LAS __attribute__((address_space(3)))
#define GAS __attribute__((address_space(1)))
typedef unsigned short bf16;
typedef short bf16x8 __attribute__((ext_vector_type(8)));
typedef short s16x4 __attribute__((ext_vector_type(4)));
typedef float f32x2 __attribute__((ext_vector_type(2)));
typedef float f32x4 __attribute__((ext_vector_type(4)));
typedef float f32x16 __attribute__((ext_vector_type(16)));
typedef unsigned u32x2 __attribute__((ext_vector_type(2)));
typedef unsigned u32x4 __attribute__((ext_vector_type(4)));
typedef __bf16 bf16x2_t __attribute__((ext_vector_type(2)));
typedef GAS unsigned gu32;

constexpr int NBATCH = 8, SEQ = 4096, DM = 1024, M = NBATCH * SEQ;
constexpr int NIN = 3584, SEGW = 512, NHEAD = 8, HD = 64;
constexpr int NEXP = 32, FF = 512, NGRP = 4, EPG = 8;
constexpr int CHUNK = 128, NCHUNK = SEQ / CHUNK;
constexpr float NORM_EPS = 1e-6f;
constexpr float LOG2E = 1.4426950408889634f, LN2 = 0.6931471805599453f;
constexpr int NWAVES = 8;
constexpr int N_CONV_P1 = 66 * 256;
constexpr int MAXTILES = 288;

constexpr size_t MiB = 1u << 20;
constexpr size_t WS_CTL = 0, CTL_ZERO_BYTES = 1 * MiB;
constexpr size_t WS_WRT = 1 * MiB;
constexpr size_t WS_ROPE = 2 * MiB;
constexpr size_t WS_LSE = 4 * MiB;
constexpr size_t WS_LIST = 8 * MiB;
constexpr size_t WS_GATEL = 12 * MiB;
constexpr size_t WS_RSL = 16 * MiB;
constexpr size_t WS_WIN = 20 * MiB;
constexpr size_t WS_WOUT = 27 * MiB;
constexpr size_t WS_WD = 30 * MiB;
constexpr size_t WS_WGU = 62 * MiB;
constexpr size_t WS_ST = 126 * MiB;
constexpr size_t WS_SBW = 478 * MiB;
constexpr size_t WS_XN = 158 * MiB;
constexpr size_t WS_OBR = 158 * MiB;
constexpr size_t WS_SEG = 254 * MiB;
constexpr size_t SEG_BYTES = (size_t)M * SEGW * 2;
constexpr size_t WS_MIXED = 254 * MiB;
constexpr size_t WS_H = 350 * MiB;
constexpr size_t WS_HG = 350 * MiB;
constexpr size_t WS_HID = 222 * MiB;
constexpr size_t WS_Y = 64 * MiB;
constexpr size_t WS_END = 494 * MiB;
constexpr int CW_CNT = 64;
constexpr int CW_BAR = 4096;
constexpr int CW_CHK = 16384;
constexpr int CW_TS = 20480;

constexpr int RING_BYTES = 147456;
constexpr int LDSCTL_OFF = RING_BYTES, MISC_OFF = LDSCTL_OFF + 320;
constexpr int TILE_OFF = MISC_OFF + 128;
constexpr int LDS_BYTES = 151552;

#define RLX_AGENT __ATOMIC_RELAXED, __HIP_MEMORY_SCOPE_AGENT
#define LDS_WAIT() asm volatile("s_waitcnt lgkmcnt(0)" ::: "memory")
#define VM_WAIT() asm volatile("s_waitcnt vmcnt(0)" ::: "memory")
__device__ __forceinline__ unsigned pk2(float lo, float hi) { f32x2 v = {lo, hi}; bf16x2_t b = __builtin_convertvector(v, bf16x2_t); return __builtin_bit_cast(unsigned, b); }
__device__ __forceinline__ float bflo(unsigned u) { return __uint_as_float(u << 16); }
__device__ __forceinline__ float bfhi(unsigned u) { return __uint_as_float(u & 0xffff0000u); }
__device__ __forceinline__ float bf2f(short s) { return __uint_as_float(((unsigned)(unsigned short)s) << 16); }
__device__ __forceinline__ int crow(int r, int hi) { return (r & 3) + 8 * (r >> 2) + 4 * hi; }
__device__ __forceinline__ float wave_sum(float v) {
#pragma unroll
    for (int o = 1; o < 64; o <<= 1) v += __shfl_xor(v, o);
    return v;
}
__device__ __forceinline__ float silu_f(float v) { return v / (1.f + __expf(-v)); }

namespace pg8 {
constexpr int BM = 256, BK = 64, HALF = 128, HTB = HALF * BK * 2, STAGE_BYTES = 8 * HTB, NXCD = 8, WGM = 8;
__host__ __device__ __forceinline__ int lds_byte(int r, int c) { const int st = (r >> 4) * 2 + (c >> 5), rr = r & 15, cc = c & 31, ob = rr * 64 + cc * 2; return st * 1024 + (ob ^ (((ob >> 9) & 1) << 5)); }
__host__ __device__ __forceinline__ void stage_rc(int b, int& R, int& C) { const int st = b / 1024, sb = b % 1024, swz = sb ^ (((sb >> 9) & 1) << 5); R = (st >> 1) * 16 + swz / 64; C = (st & 1) * 32 + (swz % 64) / 2; }
__host__ __device__ __forceinline__ int perm32(int rho) { const int n = rho >> 4, i = rho & 15; return 8 * (i >> 2) + 4 * n + (i & 3); }

struct Unit { int pm, pn; };
struct StaticOrder {
    int nM, nN, nwg, G, c;
    __device__ void init(int nM_, int nN_, int G_, int c_) { nM = nM_; nN = nN_; nwg = nM * nN; G = G_; c = c_; }
    __device__ bool next(int i, Unit& u) const {
        const long L = (long)i * G + c; if (L >= nwg) return false;
        int wgid = (int)L; { const int q = nwg / NXCD, r = nwg % NXCD, xcd = wgid % NXCD, off = wgid / NXCD; wgid = (xcd < r ? xcd * (q + 1) : r * (q + 1) + (xcd - r) * q) + off; }
        const int nig = WGM * nN, gid = wgid / nig, fm = gid * WGM, gsz = (nM - fm) < WGM ? (nM - fm) : WGM;
        u.pm = fm + ((wgid % nig) % gsz); u.pn = (wgid % nig) / gsz; return true;
    }
};

template <class Epi, class Sched, class Src, bool ALIGN_EPI, bool SP2>
__device__ __forceinline__ void gemm_phase(LAS unsigned char* lds, const int K, const Sched& S, const Src& SRC, const Epi& E) {
    int tid_ = threadIdx.x; asm volatile("" : "+v"(tid_));
    const int tid = tid_, wid = __builtin_amdgcn_readfirstlane(tid >> 6), lane = tid & 63, wr = wid >> 2, wc = wid & 3, fr = lane & 15, fq = lane >> 4;
    const int nt = K / BK;
    unsigned voffB[2]; int RA[2], CA[2];
#pragma unroll
    for (int i = 0; i < 2; ++i) { int R, C; stage_rc(tid * 16 + i * 8192, R, C); const int Rb = Epi::PERM ? ((R & ~31) + perm32(R & 31)) : R;
        RA[i] = R; CA[i] = C; voffB[i] = (unsigned)(Rb * K + C) * 2u; }
    const size_t kstep = (size_t)(BK * 2);
    const size_t hstep = (size_t)HALF * K * 2;
    const unsigned ldsw = (unsigned)wid * 1024u;
    const int aoff = lds_byte(wr * 64 + fr, fq * 8), boff = lds_byte(wc * 32 + fr, fq * 8);
#define PG8_SA(b, h) (((b) * 2 + (h)) * HTB)
#define PG8_SB(b, h) ((4 + (b) * 2 + (h)) * HTB)
#define PG8_STAGE(bufoff, gbase, voff) do { _Pragma("unroll") for (int _i = 0; _i < 2; ++_i) \
        __builtin_amdgcn_global_load_lds((const unsigned*)((const char*)(gbase) + (voff)[_i]), (LAS unsigned*)(lds + (bufoff) + ldsw + _i * 8192), 16, 0, 0); } while (0)
#define PG8_LDA(dst, b, h) do { _Pragma("unroll") for (int m = 0; m < 4; ++m) _Pragma("unroll") for (int k = 0; k < 2; ++k) dst[m][k] = *(const LAS bf16x8*)(lds + PG8_SA(b, h) + aoff + m * 2048 + k * 1024); } while (0)
#define PG8_LDB(dst, b, h) do { _Pragma("unroll") for (int n = 0; n < 2; ++n) _Pragma("unroll") for (int k = 0; k < 2; ++k) dst[n][k] = *(const LAS bf16x8*)(lds + PG8_SB(b, h) + boff + n * 2048 + k * 1024); } while (0)
#define PG8_MMA(ai, bj, At, Bt) do { __builtin_amdgcn_s_setprio(1); _Pragma("unroll") for (int m = 0; m < 4; ++m) _Pragma("unroll") for (int n = 0; n < 2; ++n) _Pragma("unroll") for (int k = 0; k < 2; ++k) \
        acc[ai][bj][m][n] = __builtin_amdgcn_mfma_f32_16x16x32_bf16(Bt[n][k], At[m][k], acc[ai][bj][m][n], 0, 0, 0); __builtin_amdgcn_s_setprio(0); } while (0)
#define PG8_WAIT_V(n) asm volatile("s_waitcnt vmcnt(" #n ")" ::: "memory")
#define PG8_WAIT_L(n) asm volatile("s_waitcnt lgkmcnt(" #n ")" ::: "memory")
#define PG8_BAR __builtin_amdgcn_s_barrier()
#define PG8_SCHED __builtin_amdgcn_sched_barrier(0)
    Unit cur, nxt; int ui = 0;
    if (!S.next(0, cur)) return;
    f32x4 acc[2][2][4][2];
#pragma unroll
    for (int a = 0; a < 2; ++a)
#pragma unroll
        for (int b = 0; b < 2; ++b)
#pragma unroll
            for (int m = 0; m < 4; ++m)
#pragma unroll
                for (int n = 0; n < 2; ++n) acc[a][b][m][n] = (f32x4){0.f, 0.f, 0.f, 0.f};
    bf16x8 At[4][2], B0[2][2], B1[2][2];
    const char *cA, *cB; unsigned vA0[2], vA1[2];
    SRC.setup(cur, RA, CA, cA, cB, vA0, vA1);
    if constexpr (SP2) {
        PG8_STAGE(PG8_SB(0, 0), cB, voffB); PG8_STAGE(PG8_SB(0, 1), cB + hstep, voffB); PG8_STAGE(PG8_SA(0, 0), cA, vA0); PG8_STAGE(PG8_SA(0, 1), cA, vA1);
        if (wr == 1) PG8_BAR;
        PG8_WAIT_V(2); PG8_BAR;
        PG8_STAGE(PG8_SB(1, 0), cB + kstep, voffB); PG8_STAGE(PG8_SA(1, 0), cA + kstep, vA0); PG8_STAGE(PG8_SB(1, 1), cB + hstep + kstep, voffB);
        PG8_WAIT_V(6); PG8_BAR;
    } else {
        PG8_STAGE(PG8_SB(0, 0), cB, voffB); PG8_STAGE(PG8_SA(0, 0), cA, vA0); PG8_STAGE(PG8_SB(0, 1), cB + hstep, voffB); PG8_STAGE(PG8_SA(0, 1), cA, vA1);
        if (wr == 1) PG8_BAR;
        PG8_WAIT_V(4); PG8_BAR;
        PG8_STAGE(PG8_SB(1, 0), cB + kstep, voffB); PG8_STAGE(PG8_SA(1, 0), cA + kstep, vA0); PG8_STAGE(PG8_SB(1, 1), cB + hstep + kstep, voffB);
        PG8_WAIT_V(6); PG8_BAR;
    }
    for (;;) {
        const bool has_next = S.next(ui + 1, nxt);
        const char *nA = cA, *nB = cB; unsigned wA0[2] = {vA0[0], vA0[1]}, wA1[2] = {vA1[0], vA1[1]};
        if (has_next) SRC.setup(nxt, RA, CA, nA, nB, wA0, wA1);
        for (int t = 0; t < nt; t += 2) {
            const bool last = (t == nt - 2);
            const char* a1 = cA + (size_t)(t + 1) * kstep;
            const char* a2 = last ? nA : cA + (size_t)(t + 2) * kstep; const char* b2 = last ? nB : cB + (size_t)(t + 2) * kstep;
            const char* a3 = a2 + kstep; const char* b3 = b2 + kstep;
            unsigned x0[2], x1[2];
            x0[0] = last ? wA0[0] : vA0[0]; x0[1] = last ? wA0[1] : vA0[1]; x1[0] = last ? wA1[0] : vA1[0]; x1[1] = last ? wA1[1] : vA1[1];
            if constexpr (SP2) {
            PG8_LDB(B0, 0, 0); PG8_LDB(B1, 0, 1); PG8_SCHED; PG8_LDA(At, 0, 0); PG8_STAGE(PG8_SA(1, 1), a1, vA1);
            PG8_WAIT_V(8); PG8_WAIT_L(0); PG8_BAR; PG8_MMA(0, 0, At, B0); PG8_MMA(0, 1, At, B1); PG8_BAR; PG8_SCHED;
            PG8_LDA(At, 0, 1); PG8_STAGE(PG8_SB(0, 0), b2, voffB); PG8_STAGE(PG8_SB(0, 1), b2 + hstep, voffB); PG8_STAGE(PG8_SA(0, 0), a2, x0);
            PG8_WAIT_V(8); PG8_WAIT_L(0); PG8_BAR; PG8_MMA(1, 0, At, B0); PG8_MMA(1, 1, At, B1); PG8_BAR; PG8_SCHED;
            PG8_LDB(B0, 1, 0); PG8_LDB(B1, 1, 1); PG8_SCHED; PG8_LDA(At, 1, 0); PG8_STAGE(PG8_SA(0, 1), a2, x1);
            PG8_WAIT_V(8); PG8_WAIT_L(0); PG8_BAR; PG8_MMA(0, 0, At, B0); PG8_MMA(0, 1, At, B1); PG8_BAR; PG8_SCHED;
            PG8_LDA(At, 1, 1); PG8_STAGE(PG8_SB(1, 0), b3, voffB); PG8_STAGE(PG8_SB(1, 1), b3 + hstep, voffB); PG8_STAGE(PG8_SA(1, 0), a3, x0);
            PG8_WAIT_V(8); PG8_WAIT_L(0); PG8_BAR; PG8_MMA(1, 0, At, B0); PG8_MMA(1, 1, At, B1); PG8_BAR; PG8_SCHED;
            } else {
            PG8_LDB(B0, 0, 0); PG8_SCHED; PG8_LDA(At, 0, 0); PG8_STAGE(PG8_SA(1, 1), a1, vA1);
            PG8_WAIT_L(8); PG8_BAR; PG8_WAIT_L(0); PG8_MMA(0, 0, At, B0); PG8_BAR; PG8_SCHED;
            PG8_LDB(B1, 0, 1); PG8_STAGE(PG8_SB(0, 0), b2, voffB);
            PG8_BAR; PG8_WAIT_L(0); PG8_MMA(0, 1, At, B1); PG8_BAR;
            PG8_LDA(At, 0, 1); PG8_STAGE(PG8_SA(0, 0), a2, x0);
            PG8_BAR; PG8_WAIT_L(0); PG8_MMA(1, 0, At, B0); PG8_BAR; PG8_SCHED;
            PG8_STAGE(PG8_SB(0, 1), b2 + hstep, voffB);
            PG8_WAIT_V(6); PG8_BAR; PG8_MMA(1, 1, At, B1); PG8_BAR;
            PG8_LDB(B0, 1, 0); PG8_SCHED; PG8_LDA(At, 1, 0); PG8_STAGE(PG8_SA(0, 1), a2, x1);
            PG8_WAIT_L(8); PG8_BAR; PG8_WAIT_L(0); PG8_MMA(0, 0, At, B0); PG8_BAR; PG8_SCHED;
            PG8_LDB(B1, 1, 1); PG8_STAGE(PG8_SB(1, 0), b3, voffB);
            PG8_BAR; PG8_WAIT_L(0); PG8_MMA(0, 1, At, B1); PG8_BAR;
            PG8_LDA(At, 1, 1); PG8_STAGE(PG8_SA(1, 0), a3, x0);
            PG8_BAR; PG8_WAIT_L(0); PG8_MMA(1, 0, At, B0); PG8_BAR; PG8_SCHED;
            PG8_STAGE(PG8_SB(1, 1), b3 + hstep, voffB);
            PG8_WAIT_V(6); PG8_BAR; PG8_MMA(1, 1, At, B1); PG8_BAR;
            }
        }
        if constexpr (ALIGN_EPI) { if (wr == 0) PG8_BAR; }
        E(acc, cur, wr, wc, fr, fq);
        if (!has_next) break;
#pragma unroll
        for (int a = 0; a < 2; ++a)
#pragma unroll
            for (int b = 0; b < 2; ++b)
#pragma unroll
                for (int m = 0; m < 4; ++m)
#pragma unroll
                    for (int n = 0; n < 2; ++n) acc[a][b][m][n] = (f32x4){0.f, 0.f, 0.f, 0.f};
        cur = nxt; cA = nA; cB = nB; vA0[0] = wA0[0]; vA0[1] = wA0[1]; vA1[0] = wA1[0]; vA1[1] = wA1[1]; ++ui;
        if constexpr (ALIGN_EPI) { if (wr == 1) PG8_BAR; }
    }
    PG8_WAIT_V(0);
    if constexpr (!ALIGN_EPI) { if (wr == 0) PG8_BAR; }
    PG8_BAR;
#undef PG8_SA
#undef PG8_SB
#undef PG8_STAGE
#undef PG8_LDA
#undef PG8_LDB
#undef PG8_MMA
#undef PG8_WAIT_V
#undef PG8_WAIT_L
#undef PG8_BAR
#undef PG8_SCHED
}
}

#define XB_TMO      128
#define XB_XCNT(j)  (256  + 64 * (j))
#define XB_XSUB(j)  (1280 + 64 * (j))
#define XB_XGEN(j)  (2304 + 64 * (j))
#define XB_TOP      3328
#define XB_TOPGEN   3392
#define XCD_BAR_WORDS 3456
#define XB_SPIN_CAP (1u << 18)
__device__ __forceinline__ unsigned xb_ld(unsigned* p)              { return __hip_atomic_load(p, __ATOMIC_RELAXED, __HIP_MEMORY_SCOPE_AGENT); }
__device__ __forceinline__ unsigned xb_add(unsigned* p, unsigned v) { return __hip_atomic_fetch_add(p, v, __ATOMIC_RELAXED, __HIP_MEMORY_SCOPE_AGENT); }
__device__ __forceinline__ unsigned xb_xcc_id() { return (unsigned)__builtin_amdgcn_s_getreg((3 << 11) | 20) & 0xFu; }
#define XB_SPIN(cond, bar) do { unsigned _sp = 0; while (cond) { __builtin_amdgcn_s_sleep(1); \
    if ((++_sp & 255u) == 0u) { if (xb_ld(&(bar)[XB_TMO])) break; if (_sp > XB_SPIN_CAP) { atomicAdd(&(bar)[XB_TMO], 1u); break; } } } } while (0)
struct XcdBarrier { unsigned* bar; unsigned x; volatile LAS unsigned* st; };
__device__ __forceinline__ XcdBarrier xcd_barrier_post(unsigned* bar, volatile LAS unsigned* st) {
    XcdBarrier b; b.bar = bar; b.x = xb_xcc_id(); b.st = st;
    if (threadIdx.x == 0) (void)xb_add(&bar[XB_XCNT(b.x)], 1u);
    return b;
}
__device__ __forceinline__ void xcd_barrier_complete(unsigned* bar, unsigned x, unsigned& nloc, unsigned& nx) {
    const unsigned G = gridDim.x * gridDim.y * gridDim.z;
    unsigned sum, cnt, mine, sp = 0u;
    for (;;) {
        sum = 0u; cnt = 0u; mine = 0u;
#pragma unroll
        for (unsigned j = 0; j < 16; ++j) { const unsigned c = xb_ld(&bar[XB_XCNT(j)]); sum += c; cnt += (c > 0u) ? 1u : 0u; mine = (j == x) ? c : mine; }
        if (sum == G) break;
        __builtin_amdgcn_s_sleep(1);
        if ((++sp & 255u) == 0u) { if (xb_ld(&bar[XB_TMO])) break; if (sp > XB_SPIN_CAP) { atomicAdd(&bar[XB_TMO], 1u); break; } }
    }
    nloc = mine > 0u ? mine : 1u; nx = cnt > 0u ? cnt : 1u;
}
__device__ __forceinline__ void xcd_barrier(const XcdBarrier& b) {
    asm volatile("s_waitcnt vmcnt(0)" ::: "memory");
    __syncthreads();
    if (threadIdx.x == 0) {
        unsigned* bar = b.bar;
        __builtin_amdgcn_s_waitcnt(0);
        unsigned nloc = b.st[0], nx = b.st[1];
        if (nloc == 0u) { xcd_barrier_complete(bar, b.x, nloc, nx); b.st[0] = nloc; b.st[1] = nx; }
        const unsigned old = xb_add(&bar[XB_XSUB(b.x)], 1u);
        const unsigned gen = old / nloc;
        if (old + 1u == (gen + 1u) * nloc) {
            __builtin_amdgcn_fence(__ATOMIC_RELEASE, "agent");
            asm volatile("s_waitcnt vmcnt(0)" ::: "memory");
            const unsigned og = xb_add(&bar[XB_TOP], 1u);
            const unsigned tg = og / nx;
            if (og + 1u == (tg + 1u) * nx) xb_add(&bar[XB_TOPGEN], 1u);
            else XB_SPIN(xb_ld(&bar[XB_TOPGEN]) == tg, bar);
            __builtin_amdgcn_fence(__ATOMIC_ACQUIRE, "agent");
            xb_add(&bar[XB_XGEN(b.x)], 1u);
            asm volatile("s_waitcnt vmcnt(0)" ::: "memory");
        } else {
            XB_SPIN(xb_ld(&bar[XB_XGEN(b.x)]) == gen, bar);
            __builtin_amdgcn_fence(__ATOMIC_ACQUIRE, "agent");
            asm volatile("s_waitcnt vmcnt(0)" ::: "memory");
        }
    }
    __syncthreads();
}

struct Args {
    const float* in[17]; float* out; unsigned char* ws;
    double frev[40];
    int ph_lo, ph_hi, li, pad;
};
struct Frame {
    LAS unsigned char* lds;
    volatile LAS unsigned* MISC;
    gu32* ctl;
    int tid, lane, wave, vcu, G;
};

__device__ __forceinline__ int winperm(int n) {
    const int s = n >> 9, c = n & 511, hh = c >> 6, d = c & 63; int dp = d;
    if (s == 0 || s == 1) { if (d < 16) dp = 2 * (d & 7) + (d >> 3); }
    else if (s == 3 || s == 4) dp = 2 * (d & 31) + (d >> 5);
    return (s << 9) + (hh << 6) + dp;
}
template <int MODE>
__device__ __forceinline__ int tr_row(int ns) { return MODE == 0 ? winperm(ns) : MODE == 1 ? ns : MODE == 2 ? ((ns >> 7) << 8) + (ns & 127) : ((ns >> 7) << 8) + 128 + (ns & 127); }
__device__ __forceinline__ void tr_load(f32x4 (&v)[8], const float* S, int N, int kb, int nb, int lane) {
    const float* p = S + (size_t)(64 * kb + (lane >> 3)) * N + 32 * nb + (lane & 7) * 4;
#pragma unroll
    for (int i = 0; i < 8; ++i) v[i] = *(const f32x4*)(p + (size_t)8 * i * N);
}
template <int MODE>
__device__ __forceinline__ void tr_store(const f32x4 (&v)[8], bf16* Dst, int Kd, LAS float* scr, int kb, int nb, int lane, const float* kscale) {
    const int k0 = 64 * kb, n0 = 32 * nb;
#pragma unroll
    for (int i = 0; i < 8; ++i) { const int kk = 8 * i + (lane >> 3); const float sc = kscale ? kscale[k0 + kk] : 1.f; LAS float* d = scr + kk * 33 + (lane & 7) * 4;
        d[0] = v[i][0] * sc; d[1] = v[i][1] * sc; d[2] = v[i][2] * sc; d[3] = v[i][3] * sc; }
    LDS_WAIT(); asm volatile("" ::: "memory");
    const int c = lane & 7;
#pragma unroll
    for (int j = 0; j < 4; ++j) { const int n = (lane >> 3) + 8 * j; const LAS float* s = scr + (8 * c) * 33 + n;
        u32x4 o; o.x = pk2(s[0 * 33], s[1 * 33]); o.y = pk2(s[2 * 33], s[3 * 33]); o.z = pk2(s[4 * 33], s[5 * 33]); o.w = pk2(s[6 * 33], s[7 * 33]);
        *(GAS u32x4*)(Dst + (size_t)tr_row<MODE>(n0 + n) * Kd + k0 + 8 * c) = o; }
    LDS_WAIT(); asm volatile("" ::: "memory");
}
template <int MODE>
__device__ __forceinline__ void p0_transpose_item(const float* S, int N, bf16* Dst, int Kd, LAS float* scr, int kb, int nb, int lane, const float* kscale) {
    f32x4 v[8]; tr_load(v, S, N, kb, nb, lane); tr_store<MODE>(v, Dst, Kd, scr, kb, nb, lane, kscale);
}
__device__ __forceinline__ void expert_src(const Args& A, int it, const float*& S, int& N, int& kb, int& nb) {
    const int e = it / 768, r = it - e * 768;
    if (r < 256) { S = A.in[13] + (size_t)e * DM * FF; N = FF; kb = r >> 4; nb = r & 15; }
    else if (r < 512) { S = A.in[14] + (size_t)e * DM * FF; N = FF; kb = (r - 256) >> 4; nb = (r - 256) & 15; }
    else { S = A.in[15] + (size_t)e * FF * DM; N = DM; kb = (r - 512) >> 5; nb = (r - 512) & 31; }
}
__device__ __forceinline__ void expert_store(const Args& A, unsigned char* ws, int it, const f32x4 (&v)[8], LAS float* scr, int lane) {
    bf16* WGU = (bf16*)(ws + WS_WGU); bf16* WD = (bf16*)(ws + WS_WD);
    const int e = it / 768, r = it - e * 768;
    if (r < 256) tr_store<2>(v, WGU + (size_t)e * DM * DM, DM, scr, r >> 4, r & 15, lane, A.in[8]);
    else if (r < 512) tr_store<3>(v, WGU + (size_t)e * DM * DM, DM, scr, (r - 256) >> 4, (r - 256) & 15, lane, A.in[8]);
    else tr_store<1>(v, WD + (size_t)e * DM * FF, FF, scr, (r - 512) >> 5, (r - 512) & 31, lane, nullptr);
}
__device__ __forceinline__ void expert_items(const Args& A, unsigned char* ws, LAS float* scr, int lo, int NI, int w0, int nw, int lane) {
    for (int it = lo + w0; it < NI; it += 4 * nw) {
        f32x4 v0[8], v1[8], v2[8], v3[8]; const float* S; int N, kb, nb;
        expert_src(A, it, S, N, kb, nb); tr_load(v0, S, N, kb, nb, lane);
        if (it + nw < NI) { expert_src(A, it + nw, S, N, kb, nb); tr_load(v1, S, N, kb, nb, lane); }
        if (it + 2 * nw < NI) { expert_src(A, it + 2 * nw, S, N, kb, nb); tr_load(v2, S, N, kb, nb, lane); }
        if (it + 3 * nw < NI) { expert_src(A, it + 3 * nw, S, N, kb, nb); tr_load(v3, S, N, kb, nb, lane); }
        expert_store(A, ws, it, v0, scr, lane);
        if (it + nw < NI) expert_store(A, ws, it + nw, v1, scr, lane);
        if (it + 2 * nw < NI) expert_store(A, ws, it + 2 * nw, v2, scr, lane);
        if (it + 3 * nw < NI) expert_store(A, ws, it + 3 * nw, v3, scr, lane);
    }
}
__device__ __forceinline__ void p0_prologue(Frame& F, const Args& A) {
    unsigned char* ws = A.ws;
    LAS float* scr = (LAS float*)(F.lds + F.wave * 16384);
    const int gw = F.vcu * NWAVES + F.wave, NGW = F.G * NWAVES;
    constexpr int I_IN = 16 * 112, I_OUT = 16 * 32;
    bf16* WIN = (bf16*)(ws + WS_WIN); bf16* WOUT = (bf16*)(ws + WS_WOUT);
    for (int it = gw; it < I_IN + I_OUT; it += NGW) {
        int r = it;
        if (r < I_IN) { p0_transpose_item<0>(A.in[2], NIN, WIN, DM, scr, r / 112, r % 112, F.lane, nullptr); continue; } r -= I_IN;
        const int kb = r / 32; p0_transpose_item<1>(A.in[7], DM, WOUT, DM, scr, kb, r % 32, F.lane, kb < 8 ? A.in[3] : A.in[6] - 512);
    }
    expert_items(A, ws, scr, F.G == 256 ? N_CONV_P1 : 0, 768 * NEXP, gw, NGW, F.lane);
    { const float* x = A.in[0]; const float* g = A.in[1]; bf16* XN = (bf16*)(ws + WS_XN);
      f32x4 gv[4];
#pragma unroll
      for (int j = 0; j < 4; ++j) gv[j] = ((const f32x4*)g)[F.lane + 64 * j];
      for (int m0 = gw; m0 < M; m0 += 4 * NGW) {
        f32x4 v[4][4];
#pragma unroll
        for (int k = 0; k < 4; ++k) { const GAS f32x4* xr = (const GAS f32x4*)(x + (size_t)(m0 + k * NGW) * DM) + F.lane;
#pragma unroll
            for (int j = 0; j < 4; ++j) v[k][j] = xr[64 * j]; }
#pragma unroll
        for (int k = 0; k < 4; ++k) { float s = 0.f;
#pragma unroll
            for (int j = 0; j < 4; ++j) s += (v[k][j].x * v[k][j].x + v[k][j].y * v[k][j].y) + (v[k][j].z * v[k][j].z + v[k][j].w * v[k][j].w);
            const float rstd = 1.f / sqrtf(wave_sum(s) * (1.f / DM) + NORM_EPS);
            GAS unsigned long long* o8 = (GAS unsigned long long*)(XN + (size_t)(m0 + k * NGW) * DM) + F.lane;
#pragma unroll
            for (int j = 0; j < 4; ++j) { const f32x4 t = v[k][j] * rstd * gv[j]; o8[64 * j] = (unsigned long long)pk2(t.x, t.y) | ((unsigned long long)pk2(t.z, t.w) << 32); } }
      } }
    { const int gt = (F.vcu * NWAVES + F.wave) * 64 + F.lane, NT = NGW * 64;
      bf16* WRH = (bf16*)(ws + WS_WRT); bf16* WRL = WRH + 48 * DM; const float* gf = A.in[8]; const float* wg = A.in[9]; const float* we = A.in[11];
      for (int idx = gt; idx < 48 * DM; idx += NT) { const int j = idx >> 10, i = idx & 1023;
          const float v = (j < 32 ? we[i * 32 + j] : (j < 36 ? wg[i * 4 + (j - 32)] : 0.f)) * gf[i];
          const unsigned hb = pk2(v, 0.f) & 0xffffu; const float lo = v - bflo(hb); WRH[idx] = (bf16)hb; WRL[idx] = (bf16)(pk2(lo, 0.f) & 0xffffu); }
      float* RC = (float*)(ws + WS_ROPE); float* RS = RC + SEQ * 40;
      for (int idx = gt; idx < SEQ * 40; idx += NT) { const int pos = idx / 40, f = idx % 40;
          double rv = (double)pos * A.frev[f]; rv -= floor(rv); const float r = (float)rv;
          RC[idx] = __builtin_amdgcn_cosf(r); RS[idx] = __builtin_amdgcn_sinf(r); } }
}

struct SrcPlain {
    const bf16* A; const bf16* Bt; int K;
    __device__ __forceinline__ void setup(const pg8::Unit& u, const int (&RA)[2], const int (&CA)[2], const char*& cA, const char*& cB, unsigned (&v0)[2], unsigned (&v1)[2]) const {
        cA = (const char*)A + (size_t)u.pm * 256 * K * 2; cB = (const char*)Bt + (size_t)u.pn * 256 * K * 2;
#pragma unroll
        for (int i = 0; i < 2; ++i) { v0[i] = (unsigned)(RA[i] * K + CA[i]) * 2u; v1[i] = v0[i] + (unsigned)(128 * K * 2); }
    }
};
struct TileTab { const LAS int* TE; const LAS int* NE; const LAS int* T0; };
struct SrcGather {
    const bf16* HG; const bf16* WGU; const int* LIST; TileTab tt;
    __device__ __forceinline__ void setup(const pg8::Unit& u, const int (&RA)[2], const int (&CA)[2], const char*& cA, const char*& cB, unsigned (&v0)[2], unsigned (&v1)[2]) const {
        const int e = tt.TE[u.pm], ne = tt.NE[e], p0 = (u.pm - tt.T0[e]) * 256;
        cA = (const char*)HG; cB = (const char*)WGU + ((size_t)e * DM + (size_t)u.pn * 256) * DM * 2;
#pragma unroll
        for (int i = 0; i < 2; ++i) {
            const int pa = p0 + RA[i], pb = pa + 128;
            const int ta = pa < ne ? (LIST[e * M + pa] >> 1) : 0, tb = pb < ne ? (LIST[e * M + pb] >> 1) : 0;
            v0[i] = (unsigned)(ta * DM + CA[i]) * 2u; v1[i] = (unsigned)(tb * DM + CA[i]) * 2u; }
    }
};
struct SrcDown {
    const bf16* HID; const bf16* WD; TileTab tt;
    __device__ __forceinline__ void setup(const pg8::Unit& u, const int (&RA)[2], const int (&CA)[2], const char*& cA, const char*& cB, unsigned (&v0)[2], unsigned (&v1)[2]) const {
        const int e = tt.TE[u.pm];
        cA = (const char*)HID + (size_t)u.pm * 256 * FF * 2; cB = (const char*)WD + ((size_t)e * DM + (size_t)u.pn * 256) * FF * 2;
#pragma unroll
        for (int i = 0; i < 2; ++i) { v0[i] = (unsigned)(RA[i] * FF + CA[i]) * 2u; v1[i] = v0[i] + (unsigned)(128 * FF * 2); }
    }
};

struct EpiInProj {
    static constexpr bool PERM = true;
    bf16* SEG; const float* RC; const float* RS;
    __device__ __forceinline__ void operator()(const f32x4 (&acc)[2][2][4][2], const pg8::Unit& u, int wr, int wc, int fr, int fq) const {
        const int seg = u.pn >> 1, colt = (u.pn & 1) * 256;
        bf16* base = SEG + (size_t)seg * M * SEGW;
        const int dq = (wc & 1) * 32 + 8 * fq;
        const bool attn = seg < 2, ret = (seg == 3 || seg == 4);
        const bool rot = ret || (attn && dq < 16);
        const int i0 = ret ? 8 + (dq >> 1) : (dq >> 1);
        const float sc = seg == 0 ? 0.125f * LOG2E : (seg == 4 ? 0.125f : 1.f);
#pragma unroll
        for (int ai = 0; ai < 2; ++ai)
#pragma unroll
            for (int m = 0; m < 4; ++m) {
                const int row = u.pm * 256 + ai * 128 + wr * 64 + m * 16 + fr, pos = row & (SEQ - 1);
                f32x4 c4 = {1.f, 1.f, 1.f, 1.f}, s4 = {0.f, 0.f, 0.f, 0.f};
                if (rot) { c4 = *(const f32x4*)(RC + pos * 40 + i0); s4 = *(const f32x4*)(RS + pos * 40 + i0); }
                bf16* rowp = base + (size_t)row * SEGW + colt + wc * 32 + 8 * fq;
#pragma unroll
                for (int bj = 0; bj < 2; ++bj) {
                    f32x4 v0 = acc[ai][bj][m][0], v1 = acc[ai][bj][m][1];
                    if (attn || ret) {
                        f32x4 r0, r1;
                        r0[0] = v0[0] * c4[0] - v0[1] * s4[0]; r0[1] = v0[1] * c4[0] + v0[0] * s4[0];
                        r0[2] = v0[2] * c4[1] - v0[3] * s4[1]; r0[3] = v0[3] * c4[1] + v0[2] * s4[1];
                        r1[0] = v1[0] * c4[2] - v1[1] * s4[2]; r1[1] = v1[1] * c4[2] + v1[0] * s4[2];
                        r1[2] = v1[2] * c4[3] - v1[3] * s4[3]; r1[3] = v1[3] * c4[3] + v1[2] * s4[3];
                        v0 = r0 * sc; v1 = r1 * sc;
                    } else if (seg == 6) {
#pragma unroll
                        for (int e = 0; e < 4; ++e) { v0[e] = silu_f(v0[e]); v1[e] = silu_f(v1[e]); }
                    }
                    u32x4 w; w.x = pk2(v0[0], v0[1]); w.y = pk2(v0[2], v0[3]); w.z = pk2(v1[0], v1[1]); w.w = pk2(v1[2], v1[3]);
                    *(u32x4*)(rowp + bj * 128) = w;
                }
            }
    }
};
struct EpiOutProj {
    static constexpr bool PERM = true;
    const float* X; bf16* HB;
    __device__ __forceinline__ void operator()(const f32x4 (&acc)[2][2][4][2], const pg8::Unit& u, int wr, int wc, int fr, int fq) const {
        const int col0 = u.pn * 256 + wc * 32 + 8 * fq;
#pragma unroll
        for (int ai = 0; ai < 2; ++ai)
#pragma unroll
            for (int m = 0; m < 4; ++m) { const size_t off = (size_t)(u.pm * 256 + ai * 128 + wr * 64 + m * 16 + fr) * DM + col0;
#pragma unroll
                for (int bj = 0; bj < 2; ++bj) { const f32x4 h0 = *(const f32x4*)(X + off + bj * 128) + acc[ai][bj][m][0], h1 = *(const f32x4*)(X + off + bj * 128 + 4) + acc[ai][bj][m][1];
                    u32x4 w; w.x = pk2(h0[0], h0[1]); w.y = pk2(h0[2], h0[3]); w.z = pk2(h1[0], h1[1]); w.w = pk2(h1[2], h1[3]); *(u32x4*)(HB + off + bj * 128) = w; }
                if (m & 1) asm volatile("" ::: "memory"); }
    }
};
struct EpiGateUp {
    static constexpr bool PERM = true;
    bf16* HID; const float* GATEL; const float* RSL; TileTab tt;
    __device__ __forceinline__ void operator()(const f32x4 (&acc)[2][2][4][2], const pg8::Unit& u, int wr, int wc, int fr, int fq) const {
        const int e = tt.TE[u.pm], ne = tt.NE[e], p0 = (u.pm - tt.T0[e]) * 256;
#pragma unroll
        for (int ai = 0; ai < 2; ++ai)
#pragma unroll
            for (int m = 0; m < 4; ++m) {
                const int rr = ai * 128 + wr * 64 + m * 16 + fr, pos = p0 + rr;
                float rs = 0.f, gt = 0.f; if (pos < ne) { rs = RSL[e * M + pos]; gt = GATEL[e * M + pos]; }
                u32x4 w; unsigned* wp = (unsigned*)&w;
#pragma unroll
                for (int n = 0; n < 2; ++n) { const f32x4 g = acc[ai][0][m][n] * rs, up = acc[ai][1][m][n] * rs; float hv[4];
#pragma unroll
                    for (int q = 0; q < 4; ++q) hv[q] = silu_f(g[q]) * up[q] * gt;
                    wp[2 * n] = pk2(hv[0], hv[1]); wp[2 * n + 1] = pk2(hv[2], hv[3]); }
                *(u32x4*)(HID + (size_t)(u.pm * 256 + rr) * FF + u.pn * 128 + wc * 32 + 8 * fq) = w;
            }
    }
};
struct EpiDown {
    static constexpr bool PERM = true;
    bf16* Y; const int* LIST; TileTab tt;
    __device__ __forceinline__ void operator()(const f32x4 (&acc)[2][2][4][2], const pg8::Unit& u, int wr, int wc, int fr, int fq) const {
        const int e = tt.TE[u.pm], ne = tt.NE[e], p0 = (u.pm - tt.T0[e]) * 256;
#pragma unroll
        for (int ai = 0; ai < 2; ++ai)
#pragma unroll
            for (int m = 0; m < 4; ++m) {
                const int pos = p0 + ai * 128 + wr * 64 + m * 16 + fr;
                if (pos < ne) { const int tk = LIST[e * M + pos]; bf16* rowp = Y + (size_t)tk * DM + u.pn * 256 + wc * 32 + 8 * fq;
#pragma unroll
                    for (int bj = 0; bj < 2; ++bj) { const f32x4 v0 = acc[ai][bj][m][0], v1 = acc[ai][bj][m][1];
                        u32x4 w; w.x = pk2(v0[0], v0[1]); w.y = pk2(v0[2], v0[3]); w.z = pk2(v1[0], v1[1]); w.w = pk2(v1[2], v1[3]);
                        *(u32x4*)(rowp + bj * 128) = w; } }
            }
    }
};

typedef short v4i16_t __attribute__((ext_vector_type(4)));
__device__ __forceinline__ s16x4 vtr(const LAS unsigned char* p) { return __builtin_bit_cast(s16x4, __builtin_amdgcn_ds_read_tr16_b64_v4i16((LAS v4i16_t*)p)); }
#define MFMA32(a, b, c) __builtin_amdgcn_mfma_f32_32x32x16_bf16((a), (b), (c), 0, 0, 0)
__device__ __forceinline__ bf16x8 pack8(const f32x16& x, int s) {
    u32x4 p; p.x = pk2(x[8 * s], x[8 * s + 1]); p.y = pk2(x[8 * s + 2], x[8 * s + 3]); p.z = pk2(x[8 * s + 4], x[8 * s + 5]); p.w = pk2(x[8 * s + 6], x[8 * s + 7]);
    return __builtin_bit_cast(bf16x8, p);
}
__device__ __forceinline__ bf16x8 cat44(s16x4 lo, s16x4 hi) { return __builtin_shufflevector(lo, hi, 0, 1, 2, 3, 4, 5, 6, 7); }
__device__ __forceinline__ bf16x8 scale8(bf16x8 v, float s) {
    u32x4 u = __builtin_bit_cast(u32x4, v), o;
    o.x = pk2(bflo(u.x) * s, bfhi(u.x) * s); o.y = pk2(bflo(u.y) * s, bfhi(u.y) * s); o.z = pk2(bflo(u.z) * s, bfhi(u.z) * s); o.w = pk2(bflo(u.w) * s, bfhi(u.w) * s);
    return __builtin_bit_cast(bf16x8, o);
}
__device__ __forceinline__ void pv_tile(f32x16& ot0, f32x16& ot1, const f32x16& st, const LAS unsigned char* vl, int lane) {
    const int hi = lane >> 5;
    const LAS unsigned char* vr = vl + (4 * hi + ((lane & 15) >> 2)) * 128 + (16 * ((lane >> 4) & 1) + 4 * (lane & 3)) * 2;
    const bf16x8 pb0 = pack8(st, 0), pb1 = pack8(st, 1);
    { const bf16x8 va = cat44(vtr(vr), vtr(vr + 8 * 128)); ot0 = MFMA32(va, pb0, ot0); }
    { const bf16x8 va = cat44(vtr(vr + 16 * 128), vtr(vr + 24 * 128)); ot0 = MFMA32(va, pb1, ot0); }
    { const bf16x8 va = cat44(vtr(vr + 64), vtr(vr + 8 * 128 + 64)); ot1 = MFMA32(va, pb0, ot1); }
    { const bf16x8 va = cat44(vtr(vr + 16 * 128 + 64), vtr(vr + 24 * 128 + 64)); ot1 = MFMA32(va, pb1, ot1); }
}
__device__ __forceinline__ void attn_task(int task, const bf16* QA, const bf16* KA, const bf16* VA, bf16* OBR, float* LSE, LAS unsigned char* vl, int lane) {
    const int bh = task / 384, rem = task - bh * 384, br = rem >> 7, idx = rem & 127;
    const int dsh = 2 * br, dil = 1 << dsh, L = SEQ >> dsh, nblk = L >> 5;
    const int cls = idx / nblk, qb = idx - cls * nblk, p0 = qb * 32;
    const int b = bh >> 3, h = bh & 7, q = lane & 31, hi = lane >> 5;
    const size_t rowbase = (size_t)b * SEQ + cls;
    const size_t qrow = rowbase + (size_t)dil * (p0 + q);
    bf16x8 qr[4];
    { const bf16* qp = QA + qrow * SEGW + h * HD + hi * 8;
#pragma unroll
      for (int ks = 0; ks < 4; ++ks) qr[ks] = *(const bf16x8*)(qp + 16 * ks); }
    float mrun = -1e30f, lsum = 0.f; f32x16 ot0, ot1;
#pragma unroll
    for (int r = 0; r < 16; ++r) { ot0[r] = 0.f; ot1[r] = 0.f; }
    for (int kb = 0; kb < 5; ++kb) {
        const int kp0 = p0 - 64 + 32 * kb;
        if (kp0 < 0 || kp0 >= L) continue;
        const size_t krow = rowbase + (size_t)dil * (kp0 + q);
        const bf16* kp = KA + krow * SEGW + h * HD + hi * 8;
        const bf16* vp = VA + krow * SEGW + h * HD + hi * 32;
        bf16x8 kf[4], vv[4];
#pragma unroll
        for (int ks = 0; ks < 4; ++ks) { kf[ks] = *(const bf16x8*)(kp + 16 * ks); vv[ks] = *(const bf16x8*)(vp + 8 * ks); }
        f32x16 st;
#pragma unroll
        for (int r = 0; r < 16; ++r) st[r] = 0.f;
#pragma unroll
        for (int ks = 0; ks < 4; ++ks) st = MFMA32(kf[ks], qr[ks], st);
        if (kb == 0) {
#pragma unroll
            for (int r = 0; r < 16; ++r) if (crow(r, hi) < q) st[r] = -1e30f;
        }
        if (kb == 4) {
#pragma unroll
            for (int r = 0; r < 16; ++r) if (crow(r, hi) > q) st[r] = -1e30f;
        }
        float mx = st[0];
#pragma unroll
        for (int r = 1; r < 16; ++r) mx = fmaxf(mx, st[r]);
        mx = fmaxf(mx, __shfl_xor(mx, 32));
        const float mnew = fmaxf(mrun, mx), alpha = __builtin_amdgcn_exp2f(mrun - mnew); mrun = mnew;
        float ps = 0.f;
#pragma unroll
        for (int r = 0; r < 16; ++r) { st[r] = __builtin_amdgcn_exp2f(st[r] - mnew); ps += st[r]; }
        lsum = lsum * alpha + ps;
#pragma unroll
        for (int r = 0; r < 16; ++r) { ot0[r] *= alpha; ot1[r] *= alpha; }
        LAS unsigned char* vw = vl + q * 128 + hi * 64;
#pragma unroll
        for (int i = 0; i < 4; ++i) *(LAS bf16x8*)(vw + 16 * i) = vv[i];
        asm volatile("" ::: "memory");
        pv_tile(ot0, ot1, st, vl, lane);
        asm volatile("" ::: "memory");
    }
    lsum += __shfl_xor(lsum, 32);
    const float inv = 1.f / lsum, lse = (mrun + __log2f(lsum)) * LN2;
    bf16* op = OBR + ((size_t)br * M + qrow) * SEGW + h * HD + 4 * hi;
#pragma unroll
    for (int g = 0; g < 4; ++g) {
        u32x2 w0, w1; w0.x = pk2(ot0[4 * g] * inv, ot0[4 * g + 1] * inv); w0.y = pk2(ot0[4 * g + 2] * inv, ot0[4 * g + 3] * inv);
        w1.x = pk2(ot1[4 * g] * inv, ot1[4 * g + 1] * inv); w1.y = pk2(ot1[4 * g + 2] * inv, ot1[4 * g + 3] * inv);
        *(u32x2*)(op + 8 * g) = w0; *(u32x2*)(op + 32 + 8 * g) = w1; }
    if (hi == 0) LSE[((size_t)br * M + qrow) * NHEAD + h] = lse;
}
constexpr int TP = 144;
struct AttnStep { size_t rowbase; int dil, p0, kp0, h, br, kb; bool valid; };
__device__ __forceinline__ AttnStep attn_decode(int task, int kb) {
    AttnStep a; const int bh = task / 384, rem = task - bh * 384, br = rem >> 7, idx = rem & 127;
    const int dsh = 2 * br, L = SEQ >> dsh, nblk = L >> 5;
    const int cls = idx / nblk, qb = idx - cls * nblk;
    a.dil = 1 << dsh; a.p0 = qb * 32; a.kp0 = a.p0 - 64 + 32 * kb; a.rowbase = (size_t)(bh >> 3) * SEQ + cls;
    a.h = bh & 7; a.br = br; a.kb = kb; a.valid = (a.kp0 >= 0 && a.kp0 < L);
    return a;
}
__device__ __forceinline__ void pv_tile_p(f32x16& ot0, f32x16& ot1, const f32x16& st, const LAS unsigned char* vl, int lane) {
    const int hi = lane >> 5;
    const LAS unsigned char* vr = vl + (4 * hi + ((lane & 15) >> 2)) * TP + (16 * ((lane >> 4) & 1) + 4 * (lane & 3)) * 2;
    const bf16x8 pb0 = pack8(st, 0), pb1 = pack8(st, 1);
    { const bf16x8 va = cat44(vtr(vr), vtr(vr + 8 * TP)); ot0 = MFMA32(va, pb0, ot0); }
    { const bf16x8 va = cat44(vtr(vr + 16 * TP), vtr(vr + 24 * TP)); ot0 = MFMA32(va, pb1, ot0); }
    { const bf16x8 va = cat44(vtr(vr + 64), vtr(vr + 8 * TP + 64)); ot1 = MFMA32(va, pb0, ot1); }
    { const bf16x8 va = cat44(vtr(vr + 16 * TP + 64), vtr(vr + 24 * TP + 64)); ot1 = MFMA32(va, pb1, ot1); }
}
__device__ __forceinline__ void attn_tasks(int t0, int nt, const bf16* QA, const bf16* KA, const bf16* VA, bf16* OBR, float* LSE, LAS unsigned char* wl, int lane) {
    const int q = lane & 31, hi = lane >> 5, ns = nt * 5, tr = lane >> 3, tc = (lane & 7) * 8;
    LAS unsigned char* Kt = wl; LAS unsigned char* Vt = wl + 32 * TP; LAS unsigned char* Qt = wl + 64 * TP;
    LAS unsigned char* tw = wl + tr * TP + tc * 2;
    bf16x8 nk[4], nv[4], nq[4], qr[4];
    float mrun = -1e30f, lsum = 0.f; f32x16 ot0, ot1;
#pragma unroll
    for (int r = 0; r < 16; ++r) { ot0[r] = 0.f; ot1[r] = 0.f; }
    AttnStep nx = attn_decode(t0, 0);
    {
#pragma unroll
        for (int i = 0; i < 4; ++i) nq[i] = *(const bf16x8*)(QA + (nx.rowbase + (size_t)nx.dil * (nx.p0 + tr + 8 * i)) * SEGW + nx.h * HD + tc);
        if (nx.valid) {
#pragma unroll
            for (int i = 0; i < 4; ++i) { const size_t off = (nx.rowbase + (size_t)nx.dil * (nx.kp0 + tr + 8 * i)) * SEGW + nx.h * HD + tc; nk[i] = *(const bf16x8*)(KA + off); nv[i] = *(const bf16x8*)(VA + off); } } }
#pragma unroll 1
    for (int s = 0; s < ns; ++s) {
        const AttnStep cu = nx;
        if (cu.valid) {
#pragma unroll
            for (int i = 0; i < 4; ++i) { *(LAS bf16x8*)(tw + 8 * i * TP) = nk[i]; *(LAS bf16x8*)(tw + 32 * TP + 8 * i * TP) = nv[i]; }
        }
        if (cu.kb == 0) {
#pragma unroll
            for (int i = 0; i < 4; ++i) *(LAS bf16x8*)(tw + 64 * TP + 8 * i * TP) = nq[i];
            mrun = -1e30f; lsum = 0.f;
#pragma unroll
            for (int r = 0; r < 16; ++r) { ot0[r] = 0.f; ot1[r] = 0.f; }
        }
        if (s + 1 < ns) {
            const int s1 = s + 1, tk = s1 / 5, kb1 = s1 - tk * 5;
            nx = attn_decode(t0 + tk, kb1);
            if (kb1 == 0) {
#pragma unroll
                for (int i = 0; i < 4; ++i) nq[i] = *(const bf16x8*)(QA + (nx.rowbase + (size_t)nx.dil * (nx.p0 + tr + 8 * i)) * SEGW + nx.h * HD + tc); }
            if (nx.valid) {
#pragma unroll
                for (int i = 0; i < 4; ++i) { const size_t off = (nx.rowbase + (size_t)nx.dil * (nx.kp0 + tr + 8 * i)) * SEGW + nx.h * HD + tc; nk[i] = *(const bf16x8*)(KA + off); nv[i] = *(const bf16x8*)(VA + off); } }
        }
        asm volatile("" ::: "memory");
        if (cu.kb == 0) {
#pragma unroll
            for (int ks = 0; ks < 4; ++ks) qr[ks] = *(const LAS bf16x8*)(Qt + q * TP + hi * 16 + 32 * ks);
        }
        if (cu.valid) {
            f32x16 st;
#pragma unroll
            for (int r = 0; r < 16; ++r) st[r] = 0.f;
#pragma unroll
            for (int ks = 0; ks < 4; ++ks) st = MFMA32(*(const LAS bf16x8*)(Kt + q * TP + hi * 16 + 32 * ks), qr[ks], st);
            if (cu.kb == 0) {
#pragma unroll
                for (int r = 0; r < 16; ++r) if (crow(r, hi) < q) st[r] = -1e30f;
            }
            if (cu.kb == 4) {
#pragma unroll
                for (int r = 0; r < 16; ++r) if (crow(r, hi) > q) st[r] = -1e30f;
            }
            float mx = st[0];
#pragma unroll
            for (int r = 1; r < 16; ++r) mx = fmaxf(mx, st[r]);
            mx = fmaxf(mx, __shfl_xor(mx, 32));
            const float mnew = fmaxf(mrun, mx), alpha = __builtin_amdgcn_exp2f(mrun - mnew); mrun = mnew;
            float ps = 0.f;
#pragma unroll
            for (int r = 0; r < 16; ++r) { st[r] = __builtin_amdgcn_exp2f(st[r] - mnew); ps += st[r]; }
            lsum = lsum * alpha + ps;
#pragma unroll
            for (int r = 0; r < 16; ++r) { ot0[r] *= alpha; ot1[r] *= alpha; }
            pv_tile_p(ot0, ot1, st, Vt, lane);
        }
        asm volatile("" ::: "memory");
        if (cu.kb == 4) {
            const float lt = lsum + __shfl_xor(lsum, 32);
            const float inv = 1.f / lt, lse = (mrun + __log2f(lt)) * LN2;
            LAS unsigned char* ow = Qt + q * TP + 8 * hi;
#pragma unroll
            for (int g = 0; g < 4; ++g) {
                u32x2 w0, w1; w0.x = pk2(ot0[4 * g] * inv, ot0[4 * g + 1] * inv); w0.y = pk2(ot0[4 * g + 2] * inv, ot0[4 * g + 3] * inv);
                w1.x = pk2(ot1[4 * g] * inv, ot1[4 * g + 1] * inv); w1.y = pk2(ot1[4 * g + 2] * inv, ot1[4 * g + 3] * inv);
                *(LAS u32x2*)(ow + 16 * g) = w0; *(LAS u32x2*)(ow + 64 + 16 * g) = w1; }
            asm volatile("" ::: "memory");
#pragma unroll
            for (int i = 0; i < 4; ++i) { const u32x4 v = *(const LAS u32x4*)(tw + 64 * TP + 8 * i * TP);
                *(u32x4*)(OBR + ((size_t)cu.br * M + cu.rowbase + (size_t)cu.dil * (cu.p0 + tr + 8 * i)) * SEGW + cu.h * HD + tc) = v; }
            if (hi == 0) LSE[((size_t)cu.br * M + cu.rowbase + (size_t)cu.dil * (cu.p0 + q)) * NHEAD + cu.h] = lse;
            asm volatile("" ::: "memory");
        }
    }
}
__device__ __forceinline__ void scan_task(int sid, const bf16* KR, const bf16* VR, bf16* ST, const float* dec_f, const float* dec_b, LAS unsigned char* sl, int lane) {
    const int bh = sid >> 3, dir = (sid >> 2) & 1, dkh = (sid >> 1) & 1, dvh = sid & 1, b = bh >> 3, h = bh & 7, hi = lane >> 5;
    const int lr = lane >> 2, lc = (lane & 3) * 8;
    const float lg2 = log1pf(-exp2f((dir ? dec_b : dec_f)[h])) * LOG2E;
    const float g128 = exp2f(128.f * lg2);
    float dcy[8];
#pragma unroll
    for (int j = 0; j < 8; ++j) { const int key = lr + 16 * j; dcy[j] = exp2f((dir ? (float)key : (float)(CHUNK - 1 - key)) * lg2); }
    LAS unsigned char* Kl = sl; LAS unsigned char* Vl = sl + 8192;
    f32x16 S;
#pragma unroll
    for (int r = 0; r < 16; ++r) S[r] = 0.f;
    const int troff = (8 * hi + ((lane & 15) >> 2)) * 64 + (16 * ((lane >> 4) & 1) + 4 * (lane & 3)) * 2;
    bf16x8 pk[8], pv[8];
    { const int n = dir ? (NCHUNK - 1) : 0; const size_t rb = ((size_t)b * SEQ + n * CHUNK + lr) * SEGW + h * HD + lc;
#pragma unroll
      for (int j = 0; j < 8; ++j) { pk[j] = *(const bf16x8*)(KR + rb + (size_t)16 * j * SEGW + 32 * dkh); pv[j] = *(const bf16x8*)(VR + rb + (size_t)16 * j * SEGW + 32 * dvh); } }
#pragma unroll 1
    for (int step = 0; step < NCHUNK; ++step) {
        const int n = dir ? (NCHUNK - 1 - step) : step;
        bf16* sp = ST + (((size_t)bh * 2 + dir) * NCHUNK + n) * 4096 + ((size_t)(dvh * 4 + 2 * dkh) * 64 + (lane & 31)) * 8 + 4 * hi;
#pragma unroll
        for (int g = 0; g < 4; ++g) { u32x2 w; w.x = pk2(S[4 * g], S[4 * g + 1]); w.y = pk2(S[4 * g + 2], S[4 * g + 3]); *(u32x2*)(sp + ((g >> 1) * 64 + 32 * (g & 1)) * 8) = w; }
        if (step == NCHUNK - 1) break;
#pragma unroll
        for (int j = 0; j < 8; ++j) { const int key = lr + 16 * j; *(LAS bf16x8*)(Kl + key * 64 + lc * 2) = scale8(pk[j], dcy[j]); *(LAS bf16x8*)(Vl + key * 64 + lc * 2) = pv[j]; }
        if (step + 2 < NCHUNK) { const int n1 = dir ? (NCHUNK - 2 - step) : step + 1; const size_t rb = ((size_t)b * SEQ + n1 * CHUNK + lr) * SEGW + h * HD + lc;
#pragma unroll
            for (int j = 0; j < 8; ++j) { pk[j] = *(const bf16x8*)(KR + rb + (size_t)16 * j * SEGW + 32 * dkh); pv[j] = *(const bf16x8*)(VR + rb + (size_t)16 * j * SEGW + 32 * dvh); } }
        asm volatile("" ::: "memory");
        f32x16 kv;
#pragma unroll
        for (int r = 0; r < 16; ++r) kv[r] = 0.f;
#pragma unroll
        for (int s = 0; s < 8; ++s) {
            const bf16x8 a = cat44(vtr(Kl + troff + s * 1024), vtr(Kl + troff + s * 1024 + 256));
            const bf16x8 bb = cat44(vtr(Vl + troff + s * 1024), vtr(Vl + troff + s * 1024 + 256));
            kv = MFMA32(a, bb, kv);
        }
        asm volatile("" ::: "memory");
#pragma unroll
        for (int r = 0; r < 16; ++r) S[r] = S[r] * g128 + kv[r];
    }
}
__device__ __forceinline__ void ret_task(int cid, const bf16* QR, const bf16* KR, const bf16* VR, const bf16* GR, const bf16* ST, bf16* MIXED, const float* dec_f, const float* dec_b,
                                         LAS unsigned char* wl, int lane) {
    const int bh = cid >> 5, n = cid & 31, b = bh >> 3, h = bh & 7, q = lane & 31, hi = lane >> 5, tr = lane >> 3, tc = (lane & 7) * 8;
    const float lgf = __uint_as_float(__builtin_amdgcn_readfirstlane(__float_as_uint(log1pf(-exp2f(dec_f[h])) * LOG2E))), lgb = __uint_as_float(__builtin_amdgcn_readfirstlane(__float_as_uint(log1pf(-exp2f(dec_b[h])) * LOG2E)));
    const size_t row0 = (size_t)b * SEQ + n * CHUNK;
    const int loff = tr * SEGW + tc;
    const bf16* Qb = QR + row0 * SEGW + h * HD; const bf16* Kb = KR + row0 * SEGW + h * HD; const bf16* Vb = VR + row0 * SEGW + h * HD; const bf16* Gb = GR + row0 * SEGW + h * HD;
    const bf16* SF = ST + (((size_t)bh * 2 + 0) * NCHUNK + n) * 4096 + lane * 8; const bf16* SB = ST + (((size_t)bh * 2 + 1) * NCHUNK + n) * 4096 + lane * 8;
    LAS unsigned char* Kt = wl; LAS unsigned char* Vt = wl + 32 * TP; LAS unsigned char* Qt = wl + 64 * TP;
    LAS unsigned char* tw = wl + tr * TP + tc * 2;
    bf16x8 nk[4], nv[4], nq[4], qr[4]; f32x16 ot0, ot1;
#pragma unroll
    for (int i = 0; i < 4; ++i) { nq[i] = *(const bf16x8*)(Qb + loff + 8 * i * SEGW); nk[i] = *(const bf16x8*)(Kb + loff + 8 * i * SEGW); nv[i] = *(const bf16x8*)(Vb + loff + 8 * i * SEGW); }
#pragma unroll 1
    for (int s = 0; s < 16; ++s) {
        const int qb = s >> 2, kb = s & 3, i_ = 32 * qb + q;
#pragma unroll
        for (int i = 0; i < 4; ++i) { *(LAS bf16x8*)(tw + 8 * i * TP) = nk[i]; *(LAS bf16x8*)(tw + 32 * TP + 8 * i * TP) = nv[i]; }
        if (s == 0 || (kb == 2 && qb < 3)) {
#pragma unroll
            for (int i = 0; i < 4; ++i) *(LAS bf16x8*)(tw + 64 * TP + 8 * i * TP) = nq[i];
        }
        if (s < 15) { const int kb1 = (s + 1) & 3;
#pragma unroll
            for (int i = 0; i < 4; ++i) { nk[i] = *(const bf16x8*)(Kb + 32 * kb1 * SEGW + loff + 8 * i * SEGW); nv[i] = *(const bf16x8*)(Vb + 32 * kb1 * SEGW + loff + 8 * i * SEGW); } }
        if (kb == 1 && qb < 3) {
#pragma unroll
            for (int i = 0; i < 4; ++i) nq[i] = *(const bf16x8*)(Qb + 32 * (qb + 1) * SEGW + loff + 8 * i * SEGW); }
        if (kb == 2) {
#pragma unroll
            for (int i = 0; i < 4; ++i) nq[i] = *(const bf16x8*)(Gb + 32 * qb * SEGW + loff + 8 * i * SEGW); }
        asm volatile("" ::: "memory");
        if (kb == 0) {
#pragma unroll
            for (int ks = 0; ks < 4; ++ks) qr[ks] = *(const LAS bf16x8*)(Qt + q * TP + hi * 16 + 32 * ks);
#pragma unroll
            for (int r = 0; r < 16; ++r) { ot0[r] = 0.f; ot1[r] = 0.f; }
        }
        f32x16 st;
#pragma unroll
        for (int r = 0; r < 16; ++r) st[r] = 0.f;
#pragma unroll
        for (int ks = 0; ks < 4; ++ks) st = MFMA32(*(const LAS bf16x8*)(Kt + q * TP + hi * 16 + 32 * ks), qr[ks], st);
#pragma unroll
        for (int r = 0; r < 16; ++r) { const int dl = i_ - (32 * kb + crow(r, hi)); const float e = dl >= 0 ? (float)dl * lgf : (float)(-dl) * lgb; st[r] *= __builtin_amdgcn_exp2f(e); }
        if (kb == 3) {
            asm volatile("" ::: "memory");
#pragma unroll
            for (int i = 0; i < 4; ++i) *(LAS bf16x8*)(tw + 8 * i * TP) = nq[i];
        }
        pv_tile_p(ot0, ot1, st, Vt, lane);
        asm volatile("" ::: "memory");
        if (kb == 3) {
            const float cf = exp2f((float)(i_ + 1) * lgf), cb = exp2f((float)(CHUNK - i_) * lgb);
#pragma unroll
            for (int dir = 0; dir < 2; ++dir)
#pragma unroll
                for (int db = 0; db < 2; ++db) {
                    const bf16* sp = (dir ? SB : SF) + (size_t)(db * 4) * 512; f32x16 t;
#pragma unroll
                    for (int r = 0; r < 16; ++r) t[r] = 0.f;
#pragma unroll
                    for (int ks = 0; ks < 4; ++ks) t = MFMA32(*(const bf16x8*)(sp + ks * 512), qr[ks], t);
                    const float c = dir ? cb : cf;
                    if (db == 0) {
#pragma unroll
                        for (int r = 0; r < 16; ++r) ot0[r] += c * t[r];
                    } else {
#pragma unroll
                        for (int r = 0; r < 16; ++r) ot1[r] += c * t[r];
                    }
                    __builtin_amdgcn_sched_barrier(0);
                }
            float s1 = 0.f;
#pragma unroll
            for (int r = 0; r < 16; ++r) s1 += ot0[r] + ot1[r];
            s1 += __shfl_xor(s1, 32);
            const float mean = s1 * (1.f / 64.f); float s2 = 0.f;
#pragma unroll
            for (int r = 0; r < 16; ++r) { ot0[r] -= mean; ot1[r] -= mean; s2 += ot0[r] * ot0[r] + ot1[r] * ot1[r]; }
            s2 += __shfl_xor(s2, 32);
            const float rstd = 1.f / sqrtf(s2 * (1.f / 64.f) + NORM_EPS);
            const LAS unsigned char* gp = Kt + q * TP + 8 * hi; LAS unsigned char* ow = Vt + q * TP + 8 * hi;
#pragma unroll
            for (int g = 0; g < 4; ++g) {
                const u32x2 g0 = *(const LAS u32x2*)(gp + 16 * g), g1 = *(const LAS u32x2*)(gp + 64 + 16 * g);
                u32x2 w0, w1;
                w0.x = pk2(ot0[4 * g] * rstd * bflo(g0.x), ot0[4 * g + 1] * rstd * bfhi(g0.x)); w0.y = pk2(ot0[4 * g + 2] * rstd * bflo(g0.y), ot0[4 * g + 3] * rstd * bfhi(g0.y));
                w1.x = pk2(ot1[4 * g] * rstd * bflo(g1.x), ot1[4 * g + 1] * rstd * bfhi(g1.x)); w1.y = pk2(ot1[4 * g + 2] * rstd * bflo(g1.y), ot1[4 * g + 3] * rstd * bfhi(g1.y));
                *(LAS u32x2*)(ow + 16 * g) = w0; *(LAS u32x2*)(ow + 64 + 16 * g) = w1; }
            asm volatile("" ::: "memory");
#pragma unroll
            for (int i = 0; i < 4; ++i) { const u32x4 v = *(const LAS u32x4*)(tw + 32 * TP + 8 * i * TP); *(u32x4*)(MIXED + (row0 + 32 * qb) * DM + 512 + h * HD + (tr + 8 * i) * DM + tc) = v; }
            asm volatile("" ::: "memory");
        }
    }
}
__device__ __forceinline__ void kv_task(int cid, const bf16* KR, const bf16* VR, bf16* KV, const float* dec_f, const float* dec_b, LAS unsigned char* wl, int lane) {
    const int bh = cid >> 5, n = cid & 31, b = bh >> 3, h = bh & 7, q = lane & 31, hi = lane >> 5, tr = lane >> 3, tc = (lane & 7) * 8;
    const float lgf = __uint_as_float(__builtin_amdgcn_readfirstlane(__float_as_uint(log1pf(-exp2f(dec_f[h])) * LOG2E))), lgb = __uint_as_float(__builtin_amdgcn_readfirstlane(__float_as_uint(log1pf(-exp2f(dec_b[h])) * LOG2E)));
    const size_t row0 = (size_t)b * SEQ + n * CHUNK; const int loff = tr * SEGW + tc;
    const bf16* Kb = KR + row0 * SEGW + h * HD; const bf16* Vb = VR + row0 * SEGW + h * HD;
    LAS unsigned char* Tf = wl; LAS unsigned char* Tb = wl + 32 * TP; LAS unsigned char* Tv = wl + 64 * TP; LAS unsigned char* tw = wl + tr * TP + tc * 2;
    const int tro = (8 * hi + ((lane & 15) >> 2)) * TP + (16 * ((lane >> 4) & 1) + 4 * (lane & 3)) * 2;
    f32x16 acc[2][2][2];
#pragma unroll
    for (int d = 0; d < 2; ++d)
#pragma unroll
        for (int a = 0; a < 2; ++a)
#pragma unroll
            for (int c = 0; c < 2; ++c)
#pragma unroll
                for (int r = 0; r < 16; ++r) acc[d][a][c][r] = 0.f;
    bf16x8 nk[4], nv[4];
#pragma unroll
    for (int i = 0; i < 4; ++i) { nk[i] = *(const bf16x8*)(Kb + loff + 8 * i * SEGW); nv[i] = *(const bf16x8*)(Vb + loff + 8 * i * SEGW); }
#pragma unroll 1
    for (int it = 0; it < 4; ++it) {
#pragma unroll
        for (int i = 0; i < 4; ++i) { const int key = 32 * it + tr + 8 * i;
            *(LAS bf16x8*)(tw + 8 * i * TP) = scale8(nk[i], __builtin_amdgcn_exp2f((float)(CHUNK - 1 - key) * lgf));
            *(LAS bf16x8*)(tw + 32 * TP + 8 * i * TP) = scale8(nk[i], __builtin_amdgcn_exp2f((float)key * lgb));
            *(LAS bf16x8*)(tw + 64 * TP + 8 * i * TP) = nv[i]; }
        if (it < 3) {
#pragma unroll
            for (int i = 0; i < 4; ++i) { nk[i] = *(const bf16x8*)(Kb + 32 * (it + 1) * SEGW + loff + 8 * i * SEGW); nv[i] = *(const bf16x8*)(Vb + 32 * (it + 1) * SEGW + loff + 8 * i * SEGW); } }
        asm volatile("" ::: "memory");
#pragma unroll
        for (int s2 = 0; s2 < 2; ++s2) {
            bf16x8 bv[2];
#pragma unroll
            for (int c = 0; c < 2; ++c) bv[c] = cat44(vtr(Tv + tro + s2 * 16 * TP + c * 64), vtr(Tv + tro + s2 * 16 * TP + 4 * TP + c * 64));
#pragma unroll
            for (int a = 0; a < 2; ++a) {
                const bf16x8 af = cat44(vtr(Tf + tro + s2 * 16 * TP + a * 64), vtr(Tf + tro + s2 * 16 * TP + 4 * TP + a * 64));
                const bf16x8 ab = cat44(vtr(Tb + tro + s2 * 16 * TP + a * 64), vtr(Tb + tro + s2 * 16 * TP + 4 * TP + a * 64));
#pragma unroll
                for (int c = 0; c < 2; ++c) { acc[0][a][c] = MFMA32(af, bv[c], acc[0][a][c]); acc[1][a][c] = MFMA32(ab, bv[c], acc[1][a][c]); }
            }
        }
        asm volatile("" ::: "memory");
    }
#pragma unroll
    for (int d = 0; d < 2; ++d) { bf16* ob = KV + (((size_t)bh * NCHUNK + n) * 2 + d) * 4096;
#pragma unroll
        for (int a = 0; a < 2; ++a)
#pragma unroll
            for (int c = 0; c < 2; ++c)
#pragma unroll
                for (int g = 0; g < 4; ++g) { u32x2 w; w.x = pk2(acc[d][a][c][4 * g], acc[d][a][c][4 * g + 1]); w.y = pk2(acc[d][a][c][4 * g + 2], acc[d][a][c][4 * g + 3]);
                    *(u32x2*)(ob + ((c * 4 + 2 * a + (g >> 1)) * 64 + q + 32 * (g & 1)) * 8 + 4 * hi) = w; } }
}

struct AttnRound { size_t rowbase; int dil, qb0, nblk, h, br; };
__device__ __forceinline__ AttnRound round_decode(int rg) {
    AttnRound a; const int bh = rg / 48, x = rg - bh * 48, br = x >> 4, w16 = x & 15; int cls, qb0;
    if (br == 0) { cls = 0; qb0 = 8 * w16; } else if (br == 1) { cls = w16 >> 2; qb0 = 8 * (w16 & 3); } else { cls = w16; qb0 = 0; }
    a.rowbase = (size_t)(bh >> 3) * SEQ + cls; a.dil = 1 << (2 * br); a.qb0 = qb0; a.nblk = (SEQ >> (2 * br)) >> 5; a.h = bh & 7; a.br = br; return a;
}
__device__ __forceinline__ void attn_rounds(int r0, int nr, const bf16* QA, const bf16* KA, const bf16* VA, bf16* OBR, float* LSE, LAS unsigned char* lds, int wave, int lane) {
    const int q = lane & 31, hi = lane >> 5, tr = lane >> 3, tc = (lane & 7) * 8;
    LAS unsigned char* Qt = lds + (24 + wave) * (32 * TP);
    const int twoff = tr * TP + tc * 2;
    bf16x8 pt[3][4], pq[4];
    AttnRound nx = round_decode(r0);
#define ATT_PREFETCH(R) do { \
        _Pragma("unroll") for (int x_ = 0; x_ < 3; ++x_) { const int tile = 3 * wave + x_, slot = tile >= 12 ? tile - 12 : tile, j_ = (R).qb0 - 2 + slot; \
            if (j_ >= 0 && j_ < (R).nblk) { const bf16* src = (tile >= 12 ? VA : KA) + ((R).rowbase + (size_t)(R).dil * (32 * j_ + tr)) * SEGW + (R).h * HD + tc; \
                _Pragma("unroll") for (int i_ = 0; i_ < 4; ++i_) pt[x_][i_] = *(const bf16x8*)(src + (size_t)(R).dil * 8 * i_ * SEGW); } } \
        { const bf16* src = QA + ((R).rowbase + (size_t)(R).dil * (32 * ((R).qb0 + wave) + tr)) * SEGW + (R).h * HD + tc; \
          _Pragma("unroll") for (int i_ = 0; i_ < 4; ++i_) pq[i_] = *(const bf16x8*)(src + (size_t)(R).dil * 8 * i_ * SEGW); } } while (0)
    ATT_PREFETCH(nx);
#pragma unroll 1
    for (int rr = 0; rr < nr; ++rr) {
        const AttnRound cu = nx;
        __syncthreads();
#pragma unroll
        for (int x = 0; x < 3; ++x) { const int tile = 3 * wave + x, slot = tile >= 12 ? tile - 12 : tile, j = cu.qb0 - 2 + slot;
            if (j >= 0 && j < cu.nblk) { LAS unsigned char* tb = lds + tile * (32 * TP) + twoff;
#pragma unroll
                for (int i = 0; i < 4; ++i) *(LAS bf16x8*)(tb + 8 * i * TP) = pt[x][i]; } }
#pragma unroll
        for (int i = 0; i < 4; ++i) *(LAS bf16x8*)(Qt + twoff + 8 * i * TP) = pq[i];
        if (rr + 1 < nr) { nx = round_decode(r0 + rr + 1); ATT_PREFETCH(nx); }
        __syncthreads();
        bf16x8 qr[4];
#pragma unroll
        for (int ks = 0; ks < 4; ++ks) qr[ks] = *(const LAS bf16x8*)(Qt + q * TP + hi * 16 + 32 * ks);
        float mrun = -1e30f, lsum = 0.f; f32x16 ot0, ot1;
#pragma unroll
        for (int r = 0; r < 16; ++r) { ot0[r] = 0.f; ot1[r] = 0.f; }
#pragma unroll 1
        for (int kb = 0; kb < 5; ++kb) {
            const int j = cu.qb0 + wave - 2 + kb;
            if (j < 0 || j >= cu.nblk) continue;
            const LAS unsigned char* Kt = lds + (wave + kb) * (32 * TP); const LAS unsigned char* Vt = Kt + 12 * (32 * TP);
            f32x16 st;
#pragma unroll
            for (int r = 0; r < 16; ++r) st[r] = 0.f;
#pragma unroll
            for (int ks = 0; ks < 4; ++ks) st = MFMA32(*(const LAS bf16x8*)(Kt + q * TP + hi * 16 + 32 * ks), qr[ks], st);
            if (kb == 0) {
#pragma unroll
                for (int r = 0; r < 16; ++r) if (crow(r, hi) < q) st[r] = -1e30f;
            }
            if (kb == 4) {
#pragma unroll
                for (int r = 0; r < 16; ++r) if (crow(r, hi) > q) st[r] = -1e30f;
            }
            float mx = st[0];
#pragma unroll
            for (int r = 1; r < 16; ++r) mx = fmaxf(mx, st[r]);
            mx = fmaxf(mx, __shfl_xor(mx, 32));
            const float mnew = fmaxf(mrun, mx), alpha = __builtin_amdgcn_exp2f(mrun - mnew); mrun = mnew;
            float ps = 0.f;
#pragma unroll
            for (int r = 0; r < 16; ++r) { st[r] = __builtin_amdgcn_exp2f(st[r] - mnew); ps += st[r]; }
            lsum = lsum * alpha + ps;
#pragma unroll
            for (int r = 0; r < 16; ++r) { ot0[r] *= alpha; ot1[r] *= alpha; }
            pv_tile_p(ot0, ot1, st, Vt, lane);
        }
        const float lt = lsum + __shfl_xor(lsum, 32);
        const float inv = 1.f / lt, lse = (mrun + __log2f(lt)) * LN2;
        asm volatile("" ::: "memory");
        LAS unsigned char* ow = Qt + q * TP + 8 * hi;
#pragma unroll
        for (int g = 0; g < 4; ++g) {
            u32x2 w0, w1; w0.x = pk2(ot0[4 * g] * inv, ot0[4 * g + 1] * inv); w0.y = pk2(ot0[4 * g + 2] * inv, ot0[4 * g + 3] * inv);
            w1.x = pk2(ot1[4 * g] * inv, ot1[4 * g + 1] * inv); w1.y = pk2(ot1[4 * g + 2] * inv, ot1[4 * g + 3] * inv);
            *(LAS u32x2*)(ow + 16 * g) = w0; *(LAS u32x2*)(ow + 64 + 16 * g) = w1; }
        asm volatile("" ::: "memory");
        const size_t qbase = cu.rowbase + (size_t)cu.dil * 32 * (cu.qb0 + wave);
#pragma unroll
        for (int i = 0; i < 4; ++i) { const u32x4 v = *(const LAS u32x4*)(Qt + twoff + 8 * i * TP);
            *(u32x4*)(OBR + ((size_t)cu.br * M + qbase + (size_t)cu.dil * (tr + 8 * i)) * SEGW + cu.h * HD + tc) = v; }
        if (hi == 0) LSE[((size_t)cu.br * M + qbase + (size_t)cu.dil * q) * NHEAD + cu.h] = lse;
        asm volatile("" ::: "memory");
    }
#undef ATT_PREFETCH
    __syncthreads();
}

constexpr int R_K = 0, R_V = 128 * TP, R_Q = 2 * 128 * TP, R_G = 3 * 128 * TP, R_O = 4 * 128 * TP, R_SF = 5 * 128 * TP, R_SB = R_SF + 8192, R_X = R_SB + 8192;
__device__ __forceinline__ void ret_wg(int wgt, const bf16* QR, const bf16* KR, const bf16* VR, const bf16* GR, const bf16* KV, bf16* SBW, bf16* MIXED, const float* dec_f, const float* dec_b,
                                       LAS unsigned char* lds, int tid, int wave, int lane) {
    const int bh = wgt >> 2, n0 = (wgt & 3) * 8, b = bh >> 3, h = bh & 7, q = lane & 31, hi = lane >> 5, tr = lane >> 3, tc = (lane & 7) * 8;
    const float lgf = __uint_as_float(__builtin_amdgcn_readfirstlane(__float_as_uint(log1pf(-exp2f(dec_f[h])) * LOG2E))), lgb = __uint_as_float(__builtin_amdgcn_readfirstlane(__float_as_uint(log1pf(-exp2f(dec_b[h])) * LOG2E)));
    const float gf128 = exp2f(128.f * lgf), gb128 = exp2f(128.f * lgb);
    const bf16* KVt = KV + (size_t)bh * NCHUNK * 2 * 4096 + 8 * tid;
    bf16* SBt = SBW + (size_t)bh * NCHUNK * 4096 + 8 * tid;
    float Sf[8], Sb[8];
#pragma unroll
    for (int e = 0; e < 8; ++e) { Sf[e] = 0.f; Sb[e] = 0.f; }
#define RET_AXPY(S, g, v) do { S[0] = S[0] * (g) + bflo((v).x); S[1] = S[1] * (g) + bfhi((v).x); S[2] = S[2] * (g) + bflo((v).y); S[3] = S[3] * (g) + bfhi((v).y); \
                               S[4] = S[4] * (g) + bflo((v).z); S[5] = S[5] * (g) + bfhi((v).z); S[6] = S[6] * (g) + bflo((v).w); S[7] = S[7] * (g) + bfhi((v).w); } while (0)
    for (int m0 = 0; m0 < n0; m0 += 8) { u32x4 v[8];
#pragma unroll
        for (int k = 0; k < 8; ++k) v[k] = *(const u32x4*)(KVt + (size_t)((m0 + k) * 2) * 4096);
#pragma unroll
        for (int k = 0; k < 8; ++k) RET_AXPY(Sf, gf128, v[k]); }
    for (int m0 = NCHUNK - 8; m0 >= n0 + 8; m0 -= 8) { u32x4 v[8];
#pragma unroll
        for (int k = 0; k < 8; ++k) v[k] = *(const u32x4*)(KVt + (size_t)((m0 + 7 - k) * 2 + 1) * 4096);
#pragma unroll
        for (int k = 0; k < 8; ++k) RET_AXPY(Sb, gb128, v[k]); }
    { u32x4 v[8];
#pragma unroll
      for (int k = 0; k < 8; ++k) v[k] = *(const u32x4*)(KVt + (size_t)((n0 + 7 - k) * 2 + 1) * 4096);
#pragma unroll
      for (int k = 0; k < 8; ++k) { u32x4 w; w.x = pk2(Sb[0], Sb[1]); w.y = pk2(Sb[2], Sb[3]); w.z = pk2(Sb[4], Sb[5]); w.w = pk2(Sb[6], Sb[7]);
          *(u32x4*)(SBt + (size_t)(n0 + 7 - k) * 4096) = w; RET_AXPY(Sb, gb128, v[k]); } }
    VM_WAIT();
    const int tsel = wave >> 1, rbase = 64 * (wave & 1) + tr;
    const bf16* tsrc = (tsel == 0 ? KR : tsel == 1 ? VR : tsel == 2 ? QR : GR) + ((size_t)b * SEQ + rbase) * SEGW + h * HD + tc;
    LAS unsigned char* tdst = lds + tsel * (128 * TP) + rbase * TP + tc * 2;
    const int qb = wave & 3, dvh = wave >> 2;
    bf16x8 pre[8]; u32x4 pkv, psb;
#define RET_PREFETCH(n_) do { _Pragma("unroll") for (int i_ = 0; i_ < 8; ++i_) pre[i_] = *(const bf16x8*)(tsrc + (size_t)((n_) * CHUNK + 8 * i_) * SEGW); \
        pkv = *(const u32x4*)(KVt + (size_t)((n_) * 2) * 4096); psb = *(const u32x4*)(SBt + (size_t)(n_) * 4096); } while (0)
    RET_PREFETCH(n0);
#pragma unroll 1
    for (int jn = 0; jn < 8; ++jn) {
        const int n = n0 + jn; const size_t row0 = (size_t)b * SEQ + n * CHUNK;
        __syncthreads();
        if (jn > 0) {
#pragma unroll
            for (int i = 0; i < 2; ++i) { const int r = 16 * wave + 8 * i + tr; const u32x4 v = *(const LAS u32x4*)(lds + R_O + r * TP + tc * 2);
                *(u32x4*)(MIXED + (row0 - CHUNK + r) * DM + 512 + h * HD + tc) = v; } }
#pragma unroll
        for (int i = 0; i < 8; ++i) *(LAS bf16x8*)(tdst + 8 * i * TP) = pre[i];
        { u32x4 w; w.x = pk2(Sf[0], Sf[1]); w.y = pk2(Sf[2], Sf[3]); w.z = pk2(Sf[4], Sf[5]); w.w = pk2(Sf[6], Sf[7]);
          *(LAS u32x4*)(lds + R_SF + tid * 16) = w; *(LAS u32x4*)(lds + R_SB + tid * 16) = psb; }
        RET_AXPY(Sf, gf128, pkv);
        if (jn < 7) RET_PREFETCH(n + 1);
        __syncthreads();
        const int i_ = 32 * qb + q;
        bf16x8 qr[4];
#pragma unroll
        for (int ks = 0; ks < 4; ++ks) qr[ks] = *(const LAS bf16x8*)(lds + R_Q + i_ * TP + hi * 16 + 32 * ks);
        f32x16 ot;
#pragma unroll
        for (int r = 0; r < 16; ++r) ot[r] = 0.f;
        const LAS unsigned char* vr = lds + R_V + (4 * hi + ((lane & 15) >> 2)) * TP + (32 * dvh + 16 * ((lane >> 4) & 1) + 4 * (lane & 3)) * 2;
#pragma unroll 1
        for (int kb = 0; kb < 4; ++kb) {
            f32x16 st;
#pragma unroll
            for (int r = 0; r < 16; ++r) st[r] = 0.f;
#pragma unroll
            for (int ks = 0; ks < 4; ++ks) st = MFMA32(*(const LAS bf16x8*)(lds + R_K + (32 * kb + q) * TP + hi * 16 + 32 * ks), qr[ks], st);
#pragma unroll
            for (int r = 0; r < 16; ++r) { const int dl = i_ - (32 * kb + crow(r, hi)); const float e = dl >= 0 ? (float)dl * lgf : (float)(-dl) * lgb; st[r] *= __builtin_amdgcn_exp2f(e); }
            const bf16x8 pb0 = pack8(st, 0), pb1 = pack8(st, 1);
            const LAS unsigned char* v0 = vr + 32 * kb * TP;
            ot = MFMA32(cat44(vtr(v0), vtr(v0 + 8 * TP)), pb0, ot);
            ot = MFMA32(cat44(vtr(v0 + 16 * TP), vtr(v0 + 24 * TP)), pb1, ot);
        }
        {   const float cf = exp2f((float)(i_ + 1) * lgf), cb = exp2f((float)(CHUNK - i_) * lgb);
            f32x16 t;
#pragma unroll
            for (int r = 0; r < 16; ++r) t[r] = 0.f;
#pragma unroll
            for (int ks = 0; ks < 4; ++ks) t = MFMA32(*(const LAS bf16x8*)(lds + R_SF + ((dvh * 4 + ks) * 64 + lane) * 16), qr[ks], t);
#pragma unroll
            for (int r = 0; r < 16; ++r) ot[r] += cf * t[r];
#pragma unroll
            for (int r = 0; r < 16; ++r) t[r] = 0.f;
#pragma unroll
            for (int ks = 0; ks < 4; ++ks) t = MFMA32(*(const LAS bf16x8*)(lds + R_SB + ((dvh * 4 + ks) * 64 + lane) * 16), qr[ks], t);
#pragma unroll
            for (int r = 0; r < 16; ++r) ot[r] += cb * t[r]; }
        float s1 = 0.f, s2 = 0.f;
#pragma unroll
        for (int r = 0; r < 16; ++r) { s1 += ot[r]; s2 += ot[r] * ot[r]; }
        s1 += __shfl_xor(s1, 32); s2 += __shfl_xor(s2, 32);
        if (hi == 0) *(LAS f32x2*)(lds + R_X + (wave * 32 + q) * 8) = (f32x2){s1, s2};
        __syncthreads();
        { const f32x2 p = *(const LAS f32x2*)(lds + R_X + ((wave ^ 4) * 32 + q) * 8); s1 += p.x; s2 += p.y; }
        const float mean = s1 * (1.f / 64.f), var = fmaxf(s2 * (1.f / 64.f) - mean * mean, 0.f), rstd = 1.f / sqrtf(var + NORM_EPS);
        const LAS unsigned char* gp = lds + R_G + i_ * TP + (32 * dvh + 4 * hi) * 2; LAS unsigned char* op = lds + R_O + i_ * TP + (32 * dvh + 4 * hi) * 2;
#pragma unroll
        for (int g = 0; g < 4; ++g) { const u32x2 gg = *(const LAS u32x2*)(gp + 16 * g); u32x2 w;
            w.x = pk2((ot[4 * g] - mean) * rstd * bflo(gg.x), (ot[4 * g + 1] - mean) * rstd * bfhi(gg.x)); w.y = pk2((ot[4 * g + 2] - mean) * rstd * bflo(gg.y), (ot[4 * g + 3] - mean) * rstd * bfhi(gg.y));
            *(LAS u32x2*)(op + 16 * g) = w; }
    }
    __syncthreads();
    { const size_t row0 = (size_t)b * SEQ + (n0 + 7) * CHUNK;
#pragma unroll
      for (int i = 0; i < 2; ++i) { const int r = 16 * wave + 8 * i + tr; const u32x4 v = *(const LAS u32x4*)(lds + R_O + r * TP + tc * 2);
          *(u32x4*)(MIXED + (row0 + r) * DM + 512 + h * HD + tc) = v; } }
    __syncthreads();
#undef RET_AXPY
#undef RET_PREFETCH
}

template <int NR>
__device__ __forceinline__ void combine_rows(const size_t (&rows)[NR], const bf16* OBR, const float* LSE, bf16* MIXED, int lane) {
    const int hh = lane >> 3;
    float l[NR][3]; u32x4 a[NR][3];
#pragma unroll
    for (int k = 0; k < NR; ++k)
#pragma unroll
        for (int br = 0; br < 3; ++br) { l[k][br] = LSE[((size_t)br * M + rows[k]) * NHEAD + hh]; a[k][br] = *(const u32x4*)(OBR + ((size_t)br * M + rows[k]) * SEGW + 8 * lane); }
#pragma unroll
    for (int k = 0; k < NR; ++k) {
        const float mx = fmaxf(l[k][0], fmaxf(l[k][1], l[k][2])); float w0 = __expf(l[k][0] - mx), w1 = __expf(l[k][1] - mx), w2 = __expf(l[k][2] - mx);
        const float inv = 1.f / (w0 + w1 + w2); w0 *= inv; w1 *= inv; w2 *= inv;
        float o[8]; float ss = 0.f;
#pragma unroll
        for (int e = 0; e < 4; ++e) { o[2 * e] = w0 * bflo(a[k][0][e]) + w1 * bflo(a[k][1][e]) + w2 * bflo(a[k][2][e]); o[2 * e + 1] = w0 * bfhi(a[k][0][e]) + w1 * bfhi(a[k][1][e]) + w2 * bfhi(a[k][2][e]); ss += o[2 * e] * o[2 * e] + o[2 * e + 1] * o[2 * e + 1]; }
        const float rstd = 1.f / sqrtf(wave_sum(ss) * (1.f / 512.f) + NORM_EPS);
        u32x4 w; w.x = pk2(o[0] * rstd, o[1] * rstd); w.y = pk2(o[2] * rstd, o[3] * rstd); w.z = pk2(o[4] * rstd, o[5] * rstd); w.w = pk2(o[6] * rstd, o[7] * rstd);
        *(u32x4*)(MIXED + rows[k] * DM + 8 * lane) = w;
    }
}
constexpr int RP = 528;
constexpr int R5_W = 0, R5_A = 2 * 48 * RP, R5_SC = R5_A + 8 * 16 * RP, R5_CNT = R5_SC + 8 * 3200;
__device__ __forceinline__ void route_wg(int wgt, const bf16* HB, const bf16* WR, const float* bg, const float* be, gu32* ctl, int* LIST, float* GATEL, float* RSL, LAS unsigned char* lds, int tid, int wave, int lane) {
    const size_t row0 = (size_t)wgt * 128;
    LAS unsigned* cntL = (LAS unsigned*)(lds + R5_CNT); LAS unsigned* baseL = cntL + 32;
    if (tid < 32) cntL[tid] = 0u;
    u32x4 pw[6], pa[8];
#define R5_PREF(kc) do { _Pragma("unroll") for (int i_ = 0; i_ < 6; ++i_) { const int idx = tid + 512 * i_; pw[i_] = *(const u32x4*)(WR + (size_t)(idx >> 5) * DM + 256 * (kc) + 8 * (idx & 31)); } \
        _Pragma("unroll") for (int i_ = 0; i_ < 8; ++i_) pa[i_] = *(const u32x4*)(HB + (row0 + 16 * wave + 2 * i_ + (lane >> 5)) * DM + 256 * (kc) + 8 * (lane & 31)); } while (0)
    R5_PREF(0);
    f32x4 acc[3]; float ss = 0.f;
#pragma unroll
    for (int c = 0; c < 3; ++c) acc[c] = (f32x4){0.f, 0.f, 0.f, 0.f};
    const LAS unsigned char* Aw = lds + R5_A + wave * 16 * RP;
#pragma unroll 1
    for (int kc = 0; kc < 4; ++kc) {
        __syncthreads();
#pragma unroll
        for (int i = 0; i < 6; ++i) { const int idx = tid + 512 * i; *(LAS u32x4*)(lds + R5_W + (idx >> 5) * RP + (idx & 31) * 16) = pw[i]; }
#pragma unroll
        for (int i = 0; i < 8; ++i) *(LAS u32x4*)(lds + R5_A + (wave * 16 + 2 * i + (lane >> 5)) * RP + (lane & 31) * 16) = pa[i];
        if (kc < 3) R5_PREF(kc + 1);
        __syncthreads();
#pragma unroll
        for (int ks = 0; ks < 8; ++ks) {
            const int ko = (32 * ks + 8 * (lane >> 4)) * 2;
            const bf16x8 a = *(const LAS bf16x8*)(Aw + (lane & 15) * RP + ko);
            { const u32x4 au = __builtin_bit_cast(u32x4, a);
#pragma unroll
              for (int e = 0; e < 4; ++e) { const float lo = bflo(au[e]), hi_ = bfhi(au[e]); ss += lo * lo + hi_ * hi_; } }
#pragma unroll
            for (int c = 0; c < 3; ++c)
#pragma unroll
                for (int p = 0; p < 2; ++p) { const bf16x8 bb = *(const LAS bf16x8*)(lds + R5_W + (p * 48 + 16 * c + (lane & 15)) * RP + ko);
                    acc[c] = __builtin_amdgcn_mfma_f32_16x16x32_bf16(a, bb, acc[c], 0, 0, 0); }
        }
    }
#undef R5_PREF
    ss += __shfl_xor(ss, 16); ss += __shfl_xor(ss, 32);
    const float rstd = 1.f / sqrtf(ss * (1.f / DM) + NORM_EPS);
    LAS float* sc = (LAS float*)(lds + R5_SC + wave * 3200);
    { const int r = lane & 15, g = lane >> 4;
#pragma unroll
      for (int e = 0; e < 4; ++e) { sc[(4 * g + e) * 48 + r] = acc[0][e]; sc[(4 * g + e) * 48 + 16 + r] = acc[1][e]; sc[(4 * g + e) * 48 + 32 + r] = acc[2][e]; }
      if (g == 0) sc[768 + r] = rstd; }
    LDS_WAIT(); asm volatile("" ::: "memory");
    int e1 = 0, e2 = 0; unsigned r1 = 0, r2 = 0; float g1 = 0.f, g2 = 0.f, rs = 0.f;
    if (lane < 16) {
        rs = sc[768 + lane]; const LAS float* lg = sc + lane * 48;
        float gmax = lg[32] * rs + bg[0]; int gi = 0; float gl[4]; gl[0] = gmax;
#pragma unroll
        for (int k = 1; k < 4; ++k) { gl[k] = lg[32 + k] * rs + bg[k]; if (gl[k] > gmax) { gmax = gl[k]; gi = k; } }
        float den = 0.f;
#pragma unroll
        for (int k = 0; k < 4; ++k) den += __expf(gl[k] - gmax);
        const float ggate = 1.f / den;
        float b1v = -3.0e38f, b2v = -3.0e38f; int i1 = 0, i2 = 0;
        for (int k = 0; k < 8; ++k) { const float v = lg[gi * 8 + k] * rs + be[gi * 8 + k]; if (v > b1v) { b1v = v; i1 = k; } }
        for (int k = 0; k < 8; ++k) { const float v = lg[gi * 8 + k] * rs + be[gi * 8 + k]; if (k != i1 && v > b2v) { b2v = v; i2 = k; } }
        const float p1 = 1.f / (1.f + __expf(b2v - b1v));
        g1 = ggate * p1; g2 = ggate * (1.f - p1); e1 = gi * 8 + i1; e2 = gi * 8 + i2;
        r1 = __hip_atomic_fetch_add(cntL + e1, 1u, __ATOMIC_RELAXED, __HIP_MEMORY_SCOPE_WORKGROUP); r2 = __hip_atomic_fetch_add(cntL + e2, 1u, __ATOMIC_RELAXED, __HIP_MEMORY_SCOPE_WORKGROUP);
    }
    __syncthreads();
    if (tid < 32) { const unsigned c = cntL[tid]; baseL[tid] = c ? __hip_atomic_fetch_add(ctl + CW_CNT + 64 * tid, c, RLX_AGENT) : 0u; }
    __syncthreads();
    if (lane < 16) {
        const size_t trow = row0 + 16 * wave + lane; const size_t s1 = (size_t)e1 * M + baseL[e1] + r1, s2 = (size_t)e2 * M + baseL[e2] + r2;
        LIST[s1] = (int)(trow * 2); GATEL[s1] = g1; RSL[s1] = rs;
        LIST[s2] = (int)(trow * 2 + 1); GATEL[s2] = g2; RSL[s2] = rs;
    }
    __syncthreads();
}
template <int NR>
__device__ __forceinline__ void final_rows(const size_t (&rows)[NR], const bf16* H, const bf16* Y, const f32x4 (&gv)[4], float* out, int lane) {
    u32x2 hv[NR][4], a[NR][4], b[NR][4];
#pragma unroll
    for (int k = 0; k < NR; ++k) { const u32x2* hp = (const u32x2*)(H + rows[k] * DM) + lane; const u32x2* y0 = (const u32x2*)(Y + (rows[k] * 2) * DM) + lane; const u32x2* y1 = (const u32x2*)(Y + (rows[k] * 2 + 1) * DM) + lane;
#pragma unroll
        for (int j = 0; j < 4; ++j) { hv[k][j] = hp[64 * j]; a[k][j] = y0[64 * j]; b[k][j] = y1[64 * j]; } }
#pragma unroll
    for (int k = 0; k < NR; ++k) { f32x4 z[4]; float ss = 0.f;
#pragma unroll
        for (int j = 0; j < 4; ++j) {
            z[j][0] = bflo(hv[k][j].x) + bflo(a[k][j].x) + bflo(b[k][j].x); z[j][1] = bfhi(hv[k][j].x) + bfhi(a[k][j].x) + bfhi(b[k][j].x); z[j][2] = bflo(hv[k][j].y) + bflo(a[k][j].y) + bflo(b[k][j].y); z[j][3] = bfhi(hv[k][j].y) + bfhi(a[k][j].y) + bfhi(b[k][j].y);
            ss += (z[j][0] * z[j][0] + z[j][1] * z[j][1]) + (z[j][2] * z[j][2] + z[j][3] * z[j][3]); }
        const float rstd = 1.f / sqrtf(wave_sum(ss) * (1.f / DM) + NORM_EPS);
        f32x4* op = (f32x4*)(out + rows[k] * DM) + lane;
#pragma unroll
        for (int j = 0; j < 4; ++j) op[64 * j] = z[j] * rstd * gv[j]; }
}
__device__ __forceinline__ TileTab build_tiles(Frame& F, int& ntiles) {
    LAS int* T = (LAS int*)(F.lds + TILE_OFF); LAS int* TE = T; LAS int* NE = T + MAXTILES; LAS int* T0 = NE + 32; LAS int* NT = T0 + 32;
    __syncthreads();
    if (F.tid == 0) { int t = 0;
        for (int e = 0; e < NEXP; ++e) { int n = (int)__hip_atomic_load(F.ctl + CW_CNT + 64 * e, RLX_AGENT); if (n > M) n = M; NE[e] = n; T0[e] = t; const int k = (n + 255) >> 8;
            for (int j = 0; j < k && t + j < MAXTILES; ++j) TE[t + j] = e; t += k; if (t > MAXTILES) t = MAXTILES; }
        NT[0] = t; }
    __syncthreads();
    ntiles = NT[0];
    TileTab tt; tt.TE = TE; tt.NE = NE; tt.T0 = T0; return tt;
}

__device__ __forceinline__ int fresh_lane() { int t = threadIdx.x; asm volatile("" : "+v"(t)); return t & 63; }
constexpr int N_LAUNCHES = MK_N_LAUNCHES, PER_PHASE = 9;
__global__ void __launch_bounds__(NWAVES * 64, 2) mk_fwd(Args args) {
    extern __shared__ __attribute__((aligned(16))) unsigned char lds_raw[];
    Frame F;
    F.lds = (LAS unsigned char*)lds_raw;
    F.MISC = (volatile LAS unsigned*)(F.lds + MISC_OFF);
    F.tid = threadIdx.x; F.lane = F.tid & 63; F.wave = __builtin_amdgcn_readfirstlane(F.tid >> 6);
    F.G = gridDim.x; { const int bx = blockIdx.x; F.vcu = (F.G % 8 == 0) ? (bx % 8) * (F.G / 8) + bx / 8 : bx; }
    unsigned char* ws = args.ws;
    F.ctl = (gu32*)(ws + WS_CTL);
    for (int u = F.tid; u < (LDS_BYTES - LDSCTL_OFF) / 4; u += NWAVES * 64) ((LAS unsigned*)(F.lds + LDSCTL_OFF))[u] = 0u;
    __syncthreads();
    XcdBarrier bar; bar.bar = (unsigned*)(F.ctl + CW_BAR); bar.x = 0; bar.st = nullptr;
    if (N_LAUNCHES != PER_PHASE) bar = xcd_barrier_post((unsigned*)(F.ctl + CW_BAR) + args.li * XCD_BAR_WORDS, F.MISC + 8);
#define GRID_BAR() do { if (N_LAUNCHES != PER_PHASE) xcd_barrier(bar); } while (0)
    const int lo = args.ph_lo, hi = args.ph_hi;
#define IN(k) (lo <= (k) && (k) < hi)
#define REPS(k) ((MK_REPEAT == (k)) ? MK_NREP : 1)
#define BOTH(k) (IN(k) && IN((k) + 1))
    const int gw = F.vcu * NWAVES + F.wave, NGW = F.G * NWAVES;
#if MK_TIME
    int n_stamp = 0;
#define STAMP() do { if (blockIdx.x == 0 && F.tid == 0) { const unsigned long long t_ = __builtin_amdgcn_s_memrealtime(); __hip_atomic_store(F.ctl + CW_TS + 2 * n_stamp, (unsigned)t_, RLX_AGENT); __hip_atomic_store(F.ctl + CW_TS + 2 * n_stamp + 1, (unsigned)(t_ >> 32), RLX_AGENT); } ++n_stamp; } while (0)
    STAMP();
#else
#define STAMP() do {} while (0)
#endif
    bf16* SEGB = (bf16*)(ws + WS_SEG);
    const bf16 *QA = SEGB, *KA = SEGB + (size_t)1 * M * SEGW, *VA = SEGB + (size_t)2 * M * SEGW, *QR = SEGB + (size_t)3 * M * SEGW, *KR = SEGB + (size_t)4 * M * SEGW, *VR = SEGB + (size_t)5 * M * SEGW, *GR = SEGB + (size_t)6 * M * SEGW;

    for (int rep_ = 0; rep_ < REPS(0); ++rep_) if (IN(0)) { p0_prologue(F, args); if (BOTH(0)) GRID_BAR(); STAMP(); }
    for (int rep_ = 0; rep_ < REPS(1); ++rep_) if (IN(1)) {
        const int bx = (int)blockIdx.x, rowg = bx >> 3; const bool split = (F.G == 256), conv = split && ((rowg & 7) == 7);
        if (conv) {
            expert_items(args, ws, (LAS float*)(F.lds + F.wave * 16384), 0, N_CONV_P1, (((rowg >> 3) << 3) + (bx & 7)) * NWAVES + F.wave, 32 * NWAVES, fresh_lane());
        } else {
            pg8::StaticOrder S; if (split) S.init(M / 256, NIN / 256, 224, (rowg - ((rowg + 1) >> 3)) * 8 + (bx & 7)); else S.init(M / 256, NIN / 256, F.G, bx);
            SrcPlain SRC{(const bf16*)(ws + WS_XN), (const bf16*)(ws + WS_WIN), DM};
            EpiInProj E{SEGB, (const float*)(ws + WS_ROPE), (const float*)(ws + WS_ROPE) + SEQ * 40};
            pg8::gemm_phase<EpiInProj, pg8::StaticOrder, SrcPlain, true, true>(F.lds, DM, S, SRC, E);
        }
        if (BOTH(1)) GRID_BAR(); STAMP();
    }
    for (int rep_ = 0; rep_ < REPS(2); ++rep_) if (IN(2)) {
        bf16* OBR = (bf16*)(ws + WS_OBR); float* LSE = (float*)(ws + WS_LSE); bf16* KVB = (bf16*)(ws + WS_ST);
        for (int cid = gw; cid < NBATCH * NHEAD * NCHUNK; cid += NGW) kv_task(cid, KR, VR, KVB, args.in[4], args.in[5], F.lds + F.wave * 16384, fresh_lane());
        { const int nrt = NBATCH * NHEAD * 48, per = (nrt + F.G - 1) / F.G, r0 = F.vcu * per, nr = r0 + per <= nrt ? per : (nrt > r0 ? nrt - r0 : 0);
          __syncthreads();
          if (nr > 0) attn_rounds(r0, nr, QA, KA, VA, OBR, LSE, F.lds, F.wave, fresh_lane()); }
        if (BOTH(2)) GRID_BAR(); STAMP();
    }
    for (int rep_ = 0; rep_ < REPS(3); ++rep_) if (IN(3)) {
        bf16* MIXED = (bf16*)(ws + WS_MIXED);
        for (int wgt = F.vcu; wgt < NBATCH * NHEAD * 4; wgt += F.G) { int t_ = threadIdx.x; asm volatile("" : "+v"(t_));
            ret_wg(wgt, QR, KR, VR, GR, (const bf16*)(ws + WS_ST), (bf16*)(ws + WS_SBW), MIXED, args.in[4], args.in[5], F.lds, t_, F.wave, t_ & 63); }
        { const int ln = fresh_lane();
          for (int row = gw; row < M; row += 4 * NGW) { const size_t rows[4] = {(size_t)row, (size_t)(row + NGW), (size_t)(row + 2 * NGW), (size_t)(row + 3 * NGW)};
              combine_rows<4>(rows, (const bf16*)(ws + WS_OBR), (const float*)(ws + WS_LSE), MIXED, ln); } }
        if (BOTH(3)) GRID_BAR(); STAMP();
    }
    for (int rep_ = 0; rep_ < REPS(4); ++rep_) if (IN(4)) {
        pg8::StaticOrder S; S.init(M / 256, DM / 256, F.G, (int)blockIdx.x);
        SrcPlain SRC{(const bf16*)(ws + WS_MIXED), (const bf16*)(ws + WS_WOUT), DM};
        EpiOutProj E{args.in[0], (bf16*)(ws + WS_HG)};
        pg8::gemm_phase<EpiOutProj, pg8::StaticOrder, SrcPlain, true, true>(F.lds, DM, S, SRC, E);
        if (BOTH(4)) GRID_BAR(); STAMP();
    }
    for (int rep_ = 0; rep_ < REPS(5); ++rep_) if (IN(5)) {
        if (rep_ > 0) { if (blockIdx.x == 0 && F.tid < NEXP) __hip_atomic_store(F.ctl + CW_CNT + 64 * F.tid, 0u, RLX_AGENT); GRID_BAR(); }
        for (int wgt = F.vcu; wgt < M / 128; wgt += F.G) { int t_ = threadIdx.x; asm volatile("" : "+v"(t_));
            route_wg(wgt, (const bf16*)(ws + WS_HG), (const bf16*)(ws + WS_WRT), args.in[10], args.in[12], F.ctl, (int*)(ws + WS_LIST), (float*)(ws + WS_GATEL), (float*)(ws + WS_RSL), F.lds, t_, F.wave, t_ & 63); }
        if (BOTH(5)) GRID_BAR(); STAMP();
    }
    for (int rep_ = 0; rep_ < REPS(6); ++rep_) if (IN(6)) {
        int ntiles; const TileTab tt = build_tiles(F, ntiles);
        pg8::StaticOrder S; S.init(ntiles, 4, F.G, (int)blockIdx.x);
        SrcGather SRC{(const bf16*)(ws + WS_HG), (const bf16*)(ws + WS_WGU), (const int*)(ws + WS_LIST), tt};
        EpiGateUp E{(bf16*)(ws + WS_HID), (const float*)(ws + WS_GATEL), (const float*)(ws + WS_RSL), tt};
        pg8::gemm_phase<EpiGateUp, pg8::StaticOrder, SrcGather, true, true>(F.lds, DM, S, SRC, E);
        if (BOTH(6)) GRID_BAR(); STAMP();
    }
    for (int rep_ = 0; rep_ < REPS(7); ++rep_) if (IN(7)) {
        int ntiles; const TileTab tt = build_tiles(F, ntiles);
        pg8::StaticOrder S; S.init(ntiles, 4, F.G, (int)blockIdx.x);
        SrcDown SRC{(const bf16*)(ws + WS_HID), (const bf16*)(ws + WS_WD), tt};
        EpiDown E{(bf16*)(ws + WS_Y), (const int*)(ws + WS_LIST), tt};
        pg8::gemm_phase<EpiDown, pg8::StaticOrder, SrcDown, true, true>(F.lds, FF, S, SRC, E);
        if (BOTH(7)) GRID_BAR(); STAMP();
    }
    for (int rep_ = 0; rep_ < REPS(8); ++rep_) if (IN(8)) {
        f32x4 gv[4];
#pragma unroll
        for (int j = 0; j < 4; ++j) gv[j] = ((const f32x4*)args.in[16])[fresh_lane() + 64 * j];
        { const int ln = fresh_lane();
          for (int row = gw; row < M; row += 2 * NGW) { const size_t rows[2] = {(size_t)row, (size_t)(row + NGW)}; final_rows<2>(rows, (const bf16*)(ws + WS_HG), (const bf16*)(ws + WS_Y), gv, args.out, ln); } }
#if MK_TIME
        GRID_BAR(); STAMP(); GRID_BAR();
        { unsigned long long ts[10];
#pragma unroll
          for (int k = 0; k < 10; ++k) ts[k] = (unsigned long long)__hip_atomic_load(F.ctl + CW_TS + 2 * k, RLX_AGENT) | ((unsigned long long)__hip_atomic_load(F.ctl + CW_TS + 2 * k + 1, RLX_AGENT) << 32);
          constexpr int KA = 2 * MK_TIME - 2, KB = 2 * MK_TIME - 1;
          const float ta = (float)(ts[KA + 1] - ts[KA]) * 0.01f, tb = MK_TIME == 5 ? (float)(ts[9] - ts[0]) * 0.01f : (float)(ts[KB + 1] - ts[KB]) * 0.01f;
          const float c1 = sqrtf(ta);
          for (size_t i = (size_t)blockIdx.x * 512 + F.tid; i < (size_t)M * DM; i += (size_t)F.G * 512) args.out[i] = i == 0 ? tb : c1; }
#endif
    }
#undef IN
#undef BOTH
#undef GRID_BAR
}

#if MK_CHECK
__device__ __forceinline__ unsigned hsh(unsigned x) { x ^= x >> 16; x *= 0x7feb352dU; x ^= x >> 15; x *= 0x846ca68bU; x ^= x >> 16; return x; }
__device__ __forceinline__ float ldb(const bf16* p, size_t i) { return __uint_as_float(((unsigned)p[i]) << 16); }
__device__ __forceinline__ float rbf(float x) { return bflo(pk2(x, 0.f) & 0xffffu); }
__device__ __forceinline__ void chk_put(gu32* ctl, int stage, float got, float ref, float atol) {
    float e = fabsf(got - ref) / (0.03f * fabsf(ref) + atol); if (!(e == e)) e = 1e30f; if (e > 1e30f) e = 1e30f;
    __hip_atomic_fetch_max(ctl + CW_CHK + stage, __float_as_uint(e), RLX_AGENT);
}
__global__ void __launch_bounds__(256) chk_kernel(Args A, int stage) {
    unsigned char* ws = A.ws; gu32* ctl = (gu32*)(ws + WS_CTL);
    const int gt = blockIdx.x * 256 + threadIdx.x, NT = gridDim.x * 256;
    const bf16* SEGB = (const bf16*)(ws + WS_SEG);
    const bf16 *QA = SEGB, *KA = SEGB + (size_t)1 * M * SEGW, *VA = SEGB + (size_t)2 * M * SEGW, *QR = SEGB + (size_t)3 * M * SEGW, *KR = SEGB + (size_t)4 * M * SEGW, *VR = SEGB + (size_t)5 * M * SEGW, *GR = SEGB + (size_t)6 * M * SEGW;
    if (stage == 0) {
        const bf16* WIN = (const bf16*)(ws + WS_WIN); const bf16* WOUT = (const bf16*)(ws + WS_WOUT); const bf16* WGU = (const bf16*)(ws + WS_WGU); const bf16* WD = (const bf16*)(ws + WS_WD);
        for (int s = gt; s < 65536; s += NT) { const unsigned r = hsh(s * 7 + 1), r2 = hsh(r);
            { const int n = r % NIN, k = r2 % DM; chk_put(ctl, 0, ldb(WIN, (size_t)winperm(n) * DM + k), A.in[2][(size_t)k * NIN + n], 1e-4f); }
            { const int n = r % DM, k = r2 % DM; chk_put(ctl, 0, ldb(WOUT, (size_t)n * DM + k), A.in[7][(size_t)k * DM + n] * (k < 512 ? A.in[3][k] : A.in[6][k - 512]), 1e-4f); }
            { const int e = (r >> 10) % NEXP, j = r % FF, k = r2 % DM;
              chk_put(ctl, 0, ldb(WGU, ((size_t)e * DM + ((j >> 7) << 8) + (j & 127)) * DM + k), A.in[13][((size_t)e * DM + k) * FF + j] * A.in[8][k], 1e-4f);
              chk_put(ctl, 0, ldb(WGU, ((size_t)e * DM + ((j >> 7) << 8) + 128 + (j & 127)) * DM + k), A.in[14][((size_t)e * DM + k) * FF + j] * A.in[8][k], 1e-4f); }
            { const int e = (r >> 10) % NEXP, n = r % DM, k = r2 % FF; chk_put(ctl, 0, ldb(WD, ((size_t)e * DM + n) * FF + k), A.in[15][((size_t)e * FF + k) * DM + n], 1e-4f); }
            { const int j = r % 36, i = r2 % DM; const float ref = (j < 32 ? A.in[11][i * 32 + j] : A.in[9][i * 4 + j - 32]) * A.in[8][i]; chk_put(ctl, 0, 1000.f * (ldb((const bf16*)(ws + WS_WRT), j * DM + i) + ldb((const bf16*)(ws + WS_WRT), (48 + j) * DM + i)), 1000.f * ref, 1e-3f); }
            { const int pos = r % SEQ, f = r2 % 40; const float fr = f < 8 ? powf(500000.f, -(float)f / 8.f) : powf(10000.f, -(float)(f - 8) / 31.f); const float ang = (float)pos * fr;
              chk_put(ctl, 0, ((const float*)(ws + WS_ROPE))[pos * 40 + f], cosf(ang), 2e-3f); chk_put(ctl, 0, ((const float*)(ws + WS_ROPE))[SEQ * 40 + pos * 40 + f], sinf(ang), 2e-3f); }
        }
        for (int s = gt; s < 2048; s += NT) { const unsigned r = hsh(s * 13 + 5); const int row = r % M, c = hsh(r) % DM; const float* x = A.in[0] + (size_t)row * DM; float ss = 0.f;
            for (int k = 0; k < DM; ++k) ss += x[k] * x[k];
            chk_put(ctl, 0, ldb((const bf16*)(ws + WS_XN), (size_t)row * DM + c), x[c] / sqrtf(ss / DM + NORM_EPS) * A.in[1][c], 1e-3f); }
    }
    if (stage == 1) {
        const bf16* XN = (const bf16*)(ws + WS_XN);
        for (int s = gt; s < 8192; s += NT) { const unsigned r = hsh(s * 3 + 11), r2 = hsh(r); const int row = r % M, seg = r2 % 7, hh = (r2 >> 4) % 8, pos = row & (SEQ - 1);
            const int half = (seg == 0 || seg == 1) ? 8 : 32; const int i = (r2 >> 8) % half; const int d1 = i, d2 = i + half;
            float a1 = 0.f, a2 = 0.f; const float* w = A.in[2] + seg * 512 + hh * 64;
            for (int k = 0; k < DM; ++k) { const float xv = ldb(XN, (size_t)row * DM + k); a1 += xv * rbf(w[(size_t)k * NIN + d1]); a2 += xv * rbf(w[(size_t)k * NIN + d2]); }
            const bf16* O = SEGB + (size_t)seg * M * SEGW + (size_t)row * SEGW + hh * 64;
            if (seg == 0 || seg == 1 || seg == 3 || seg == 4) {
                const float fr = seg < 2 ? powf(500000.f, -(float)i / 8.f) : powf(10000.f, -(float)i / 31.f); const float ang = (float)pos * fr, c = cosf(ang), sn = sinf(ang);
                const float sc = seg == 0 ? 0.125f * LOG2E : (seg == 4 ? 0.125f : 1.f);
                chk_put(ctl, 1, ldb(O, 2 * i), (a1 * c - a2 * sn) * sc, 0.02f); chk_put(ctl, 1, ldb(O, 2 * i + 1), (a2 * c + a1 * sn) * sc, 0.02f);
                if (seg < 2) { const int d3 = 16 + (r2 >> 12) % 48; float a3 = 0.f; for (int k = 0; k < DM; ++k) a3 += ldb(XN, (size_t)row * DM + k) * rbf(w[(size_t)k * NIN + d3]); chk_put(ctl, 1, ldb(O, d3), a3 * sc, 0.02f); }
            } else { chk_put(ctl, 1, ldb(O, d1), seg == 6 ? silu_f(a1) : a1, 0.02f); chk_put(ctl, 1, ldb(O, d2), seg == 6 ? silu_f(a2) : a2, 0.02f); }
        }
    }
    if (stage == 2) {
        const bf16* OBR = (const bf16*)(ws + WS_OBR); const float* LSE = (const float*)(ws + WS_LSE); const bf16* ST = (const bf16*)(ws + WS_ST);
        for (int s = gt; s < 4096; s += NT) { const unsigned r = hsh(s * 5 + 3), r2 = hsh(r); const int b = r % NBATCH, pos = (s < 256) ? (s & 1 ? SEQ - 1 - (s >> 1) % 80 : (s >> 1) % 80) : (r >> 3) % SEQ, h = r2 % NHEAD, br = (r2 >> 3) % 3, dd = (r2 >> 8) % HD;
            const int dil = 1 << (2 * br); const size_t row = (size_t)b * SEQ + pos;
            float mx = -1e30f;
            for (int pass = 0; pass < 2; ++pass) { float l = 0.f, o = 0.f;
                for (int j = -64; j <= 64; ++j) { const int kp = pos + j * dil; if (kp < 0 || kp >= SEQ) continue; const size_t kr = (size_t)b * SEQ + kp; float d = 0.f;
                    for (int k = 0; k < HD; ++k) d += ldb(QA, row * SEGW + h * HD + k) * ldb(KA, kr * SEGW + h * HD + k);
                    if (pass == 0) mx = fmaxf(mx, d); else { const float p = exp2f(d - mx); l += p; o += p * ldb(VA, kr * SEGW + h * HD + dd); } }
                if (pass == 1) { chk_put(ctl, 2, ldb(OBR, ((size_t)br * M + row) * SEGW + h * HD + dd), o / l, 0.02f); chk_put(ctl, 2, LSE[((size_t)br * M + row) * NHEAD + h], (mx + log2f(l)) * LN2, 0.02f); } }
        }
        for (int s = gt; s < 8192; s += NT) { const unsigned r = hsh(s * 9 + 7), r2 = hsh(r); const int bh = r % 64, dir = (r >> 6) & 1, n = (r >> 7) % NCHUNK, dv = r2 % 64, dk = (r2 >> 6) % 64, b = bh >> 3, h = bh & 7;
            const float lg2 = log1pf(-exp2f((dir ? A.in[5] : A.in[4])[h])) * LOG2E; float S = 0.f;
            for (int j = 0; j < CHUNK; ++j) { const size_t row = (size_t)b * SEQ + n * CHUNK + j; const float ex = dir == 0 ? (float)(127 - j) : (float)j;
                S += exp2f(ex * lg2) * ldb(KR, row * SEGW + h * HD + dk) * ldb(VR, row * SEGW + h * HD + dv); }
            chk_put(ctl, 2, ldb(ST, (((size_t)bh * NCHUNK + n) * 2 + dir) * 4096 + ((size_t)((dv >> 5) * 4 + (dk >> 4)) * 64 + (dv & 31) + 32 * ((dk >> 3) & 1)) * 8 + (dk & 7)), S, 0.05f);
        }
    }
    if (stage == 3) {
        const bf16* MIXED = (const bf16*)(ws + WS_MIXED);
        for (int s = gt; s < 512; s += NT) { const unsigned r = hsh(s * 17 + 9), r2 = hsh(r); const int b = r % NBATCH, pos = (s < 64) ? (s & 1 ? SEQ - 1 - (s >> 1) * 5 : (s >> 1) * 5) : (r >> 3) % SEQ, h = r2 % NHEAD; const size_t row = (size_t)b * SEQ + pos;
            const float lgf = log1pf(-exp2f(A.in[4][h])) * LOG2E, lgb = log1pf(-exp2f(A.in[5][h])) * LOG2E;
            float o[HD], qv[HD];
#pragma unroll
            for (int k = 0; k < HD; ++k) { o[k] = 0.f; qv[k] = ldb(QR, row * SEGW + h * HD + k); }
            for (int kp = 0; kp < SEQ; ++kp) { const size_t kr = (size_t)b * SEQ + kp; const int dl = pos - kp; const float w = dl >= 0 ? exp2f((float)dl * lgf) : exp2f((float)(-dl) * lgb); if (w < 1e-12f) continue; float d = 0.f;
#pragma unroll
                for (int k = 0; k < HD; ++k) d += qv[k] * ldb(KR, kr * SEGW + h * HD + k);
                d *= w;
#pragma unroll
                for (int k = 0; k < HD; ++k) o[k] += d * ldb(VR, kr * SEGW + h * HD + k); }
            float mean = 0.f, var = 0.f;
#pragma unroll
            for (int k = 0; k < HD; ++k) mean += o[k];
            mean *= (1.f / HD);
#pragma unroll
            for (int k = 0; k < HD; ++k) var += (o[k] - mean) * (o[k] - mean);
            var *= (1.f / HD); const float rstd = 1.f / sqrtf(var + NORM_EPS);
#pragma unroll
            for (int k = 0; k < HD; ++k) if ((k & 7) == (int)(r2 >> 8) % 8) chk_put(ctl, 3, ldb(MIXED, row * DM + 512 + h * HD + k), (o[k] - mean) * rstd * ldb(GR, row * SEGW + h * HD + k), 0.03f);
        }
        {
            const bf16* OBR = (const bf16*)(ws + WS_OBR); const float* LSE = (const float*)(ws + WS_LSE);
            for (int s = gt; s < 4096; s += NT) { const unsigned r = hsh(s * 19 + 1), r2 = hsh(r); const int row = r % M, csel = r2 % 512; float ss = 0.f, osel = 0.f;
                for (int c = 0; c < 512; ++c) { const int h = c >> 6; const float l0 = LSE[((size_t)0 * M + row) * NHEAD + h], l1 = LSE[((size_t)1 * M + row) * NHEAD + h], l2 = LSE[((size_t)2 * M + row) * NHEAD + h];
                    const float mx = fmaxf(l0, fmaxf(l1, l2)), w0 = expf(l0 - mx), w1 = expf(l1 - mx), w2 = expf(l2 - mx);
                    const float o = (w0 * ldb(OBR, ((size_t)0 * M + row) * SEGW + c) + w1 * ldb(OBR, ((size_t)1 * M + row) * SEGW + c) + w2 * ldb(OBR, ((size_t)2 * M + row) * SEGW + c)) / (w0 + w1 + w2);
                    ss += o * o; if (c == csel) osel = o; }
                chk_put(ctl, 3, ldb(MIXED, (size_t)row * DM + csel), osel / sqrtf(ss / 512.f + NORM_EPS), 0.03f); }
        }
    }
    if (stage == 4) {
        const bf16* MIXED = (const bf16*)(ws + WS_MIXED); const bf16* WOUT = (const bf16*)(ws + WS_WOUT); const float* H = (const float*)(ws + WS_H); const bf16* HG = (const bf16*)(ws + WS_HG);
        for (int s = gt; s < 16384; s += NT) { const unsigned r = hsh(s * 23 + 3); const int row = r % M, c = hsh(r) % DM; float a = 0.f;
            for (int k = 0; k < DM; ++k) a += ldb(MIXED, (size_t)row * DM + k) * ldb(WOUT, (size_t)c * DM + k);
            const float h = a + A.in[0][(size_t)row * DM + c]; chk_put(ctl, 4, ldb(HG, (size_t)row * DM + c), h, 0.02f); (void)H; }
    }
    if (stage == 5) {
        const float* H = (const float*)(ws + WS_H); const int* LIST = (const int*)(ws + WS_LIST); const float* GATEL = (const float*)(ws + WS_GATEL); const float* RSL = (const float*)(ws + WS_RSL);
        if (gt == 0) { unsigned tot = 0; for (int e = 0; e < NEXP; ++e) tot += ctl[CW_CNT + 64 * e]; chk_put(ctl, 5, (float)tot, (float)(2 * M), 0.5f); }
        const bf16* HBc = (const bf16*)(ws + WS_HG); (void)H;
        for (int s = gt; s < 2048; s += NT) { const int t = hsh(s * 29 + 5) % M; const bf16* h_ = HBc + (size_t)t * DM; float ss = 0.f;
#define h_AT(k) ldb(h_, (k))
            for (int k = 0; k < DM; ++k) ss += h_AT(k) * h_AT(k);
            const float rs = 1.f / sqrtf(ss / DM + NORM_EPS); float gl[4]; int gi = 0;
            for (int g = 0; g < 4; ++g) { float a = 0.f; for (int k = 0; k < DM; ++k) a += h_AT(k) * rs * A.in[8][k] * A.in[9][k * 4 + g]; gl[g] = a + A.in[10][g]; if (gl[g] > gl[gi]) gi = g; }
            float den = 0.f; for (int g = 0; g < 4; ++g) den += expf(gl[g] - gl[gi]);
            float b1 = -3e38f, b2 = -3e38f, b3 = -3e38f; int i1 = 0, i2 = 0;
            for (int e = 0; e < 8; ++e) { float a = 0.f; for (int k = 0; k < DM; ++k) a += h_AT(k) * rs * A.in[8][k] * A.in[11][k * 32 + gi * 8 + e]; a += A.in[12][gi * 8 + e];
                if (a > b1) { b3 = b2; b2 = b1; i2 = i1; b1 = a; i1 = e; } else if (a > b2) { b3 = b2; b2 = a; i2 = e; } else if (a > b3) b3 = a; }
            float second = -3e38f; for (int g = 0; g < 4; ++g) if (g != gi) second = fmaxf(second, gl[g]);
            if (gl[gi] - second < 1e-3f || b2 - b3 < 1e-3f || b1 - b2 < 1e-3f) continue;
            const float p1 = 1.f / (1.f + expf(b2 - b1)); const float g1 = p1 / den, g2 = (1.f - p1) / den;
            for (int k = 0; k < 2; ++k) { const int e = gi * 8 + (k ? i2 : i1); const int n = (int)ctl[CW_CNT + 64 * e]; int found = -1;
                for (int p = 0; p < n && p < M; ++p) if (LIST[(size_t)e * M + p] == t * 2 + k) { found = p; break; }
                if (found < 0) chk_put(ctl, 5, 0.f, 100.f, 0.1f); else { chk_put(ctl, 5, GATEL[(size_t)e * M + found], k ? g2 : g1, 1e-3f); chk_put(ctl, 5, RSL[(size_t)e * M + found], rs, 1e-4f); } }
        }
    }
    if (stage == 6 || stage == 7) {
        const int* LIST = (const int*)(ws + WS_LIST); const float* GATEL = (const float*)(ws + WS_GATEL); const float* RSL = (const float*)(ws + WS_RSL);
        const bf16* HG = (const bf16*)(ws + WS_HG); const bf16* WGU = (const bf16*)(ws + WS_WGU); const bf16* HID = (const bf16*)(ws + WS_HID); const bf16* WD = (const bf16*)(ws + WS_WD); const bf16* Y = (const bf16*)(ws + WS_Y);
        for (int s = gt; s < 8192; s += NT) { const unsigned r = hsh(s * 31 + 7), r2 = hsh(r); const int e = r % NEXP; const int ne = (int)ctl[CW_CNT + 64 * e]; if (ne <= 0) continue;
            int t0 = 0; for (int q = 0; q < e; ++q) t0 += ((int)ctl[CW_CNT + 64 * q] + 255) >> 8;
            const int pos = (s & 3) == 0 ? ne - 1 - (int)((r >> 5) % (ne < 300 ? ne : 300)) : (int)((r >> 5) % ne); const size_t slot = (size_t)t0 * 256 + pos; const int tk = LIST[(size_t)e * M + pos], t = tk >> 1;
            if (stage == 6) { const int j = r2 % FF; float g = 0.f, u = 0.f; const bf16* wg = WGU + ((size_t)e * DM + ((j >> 7) << 8) + (j & 127)) * DM; const bf16* wu = wg + (size_t)128 * DM;
                for (int k = 0; k < DM; ++k) { const float xv = ldb(HG, (size_t)t * DM + k); g += xv * ldb(wg, k); u += xv * ldb(wu, k); }
                const float rs = RSL[(size_t)e * M + pos]; chk_put(ctl, 6, ldb(HID, slot * FF + j), silu_f(g * rs) * (u * rs) * GATEL[(size_t)e * M + pos], 0.01f); }
            else { const int c = r2 % DM; float a = 0.f; for (int k = 0; k < FF; ++k) a += ldb(HID, slot * FF + k) * ldb(WD, ((size_t)e * DM + c) * FF + k);
                chk_put(ctl, 7, ldb(Y, (size_t)tk * DM + c), a, 0.01f); }
        }
    }
    if (stage == 8) {
        const float* H = (const float*)(ws + WS_H); const bf16* Y = (const bf16*)(ws + WS_Y);
        for (int s = gt; s < 4096; s += NT) { const unsigned r = hsh(s * 37 + 1); const int row = r % M, c = hsh(r) % DM; float ss = 0.f, zc = 0.f;
            for (int k = 0; k < DM; ++k) { const float z = ldb((const bf16*)(ws + WS_HG), (size_t)row * DM + k) + ldb(Y, (size_t)(2 * row) * DM + k) + ldb(Y, (size_t)(2 * row + 1) * DM + k); (void)H; ss += z * z; if (k == c) zc = z; }
            chk_put(ctl, 8, A.out[(size_t)row * DM + c], zc / sqrtf(ss / DM + NORM_EPS) * A.in[16][c], 0.01f); }
    }
}
__global__ void __launch_bounds__(256) chk_final(Args A) {
    gu32* ctl = (gu32*)(A.ws + WS_CTL); int bad = -1; float err = 0.f;
    for (int s = 0; s < 9; ++s) { const float e = __uint_as_float(ctl[CW_CHK + s]); if (e > 1.f) { bad = s; err = e; break; } }
    if (bad < 0 && ctl[CW_BAR + XB_TMO] != 0u) { bad = 10; err = 1.f; }
    if (bad < 0) return;
    float mant = 1.f + log10f(err); if (mant > 9.9f) mant = 9.9f; if (mant < 1.f) mant = 1.f;
    const float C = sqrtf(mant * powf(10.f, (float)(bad + 3)));
    for (size_t i = blockIdx.x * 256 + threadIdx.x; i < (size_t)M * DM; i += (size_t)gridDim.x * 256) A.out[i] = C;
}
#endif

extern "C" void kernel_launch(void* const* d_in, const int* in_sizes, int n_in, void* d_out, int out_size, void* d_ws, size_t ws_size, hipStream_t stream) {
    static int grid = 0;
    if (grid == 0) {
        if (n_in != 17 || in_sizes[0] != M * DM || out_size != M * DM || ws_size < WS_END) { fprintf(stderr, "kernel_launch: unexpected shapes (n_in %d, in0 %d, out %d, ws %zu); nothing launched\n", n_in, n_in > 0 ? in_sizes[0] : -1, out_size, ws_size); grid = -1; return; }
        int dev = 0, cus = 0, per_cu = 0;
        if (hipGetDevice(&dev) != hipSuccess || hipDeviceGetAttribute(&cus, hipDeviceAttributeMultiprocessorCount, dev) != hipSuccess) { grid = -1; return; }
        if (hipFuncSetAttribute((const void*)mk_fwd, hipFuncAttributeMaxDynamicSharedMemorySize, LDS_BYTES) != hipSuccess) { fprintf(stderr, "kernel_launch: hipFuncSetAttribute failed\n"); grid = -1; return; }
        if (hipOccupancyMaxActiveBlocksPerMultiprocessor(&per_cu, (const void*)mk_fwd, NWAVES * 64, LDS_BYTES) != hipSuccess || per_cu < 1) { fprintf(stderr, "kernel_launch: occupancy query says %d blocks per CU; nothing launched\n", per_cu); (void)hipGetLastError(); grid = -1; return; }
        grid = cus;
    }
    if (grid < 0) return;
    if (hipMemsetAsync((char*)d_ws + WS_CTL, 0, CTL_ZERO_BYTES, stream) != hipSuccess) { fprintf(stderr, "kernel_launch: memset failed\n"); return; }
    Args a{};
    for (int i = 0; i < 17; ++i) a.in[i] = (const float*)d_in[i];
    a.out = (float*)d_out; a.ws = (unsigned char*)d_ws;
    const double TWO_PI = 6.283185307179586476925286766559;
    for (int i = 0; i < 8; ++i) a.frev[i] = std::pow(500000.0, -(double)i / 8.0) / TWO_PI;
    for (int i = 0; i < 32; ++i) a.frev[8 + i] = std::pow(10000.0, -(double)i / 31.0) / TWO_PI;
    if (N_LAUNCHES == 1) {
        a.ph_lo = 0; a.ph_hi = PER_PHASE; a.li = 0;
#if MK_COOP
        void* kargs[] = {&a};
        const hipError_t le = hipLaunchCooperativeKernel((const void*)mk_fwd, dim3(grid), dim3(NWAVES * 64), kargs, LDS_BYTES, stream);
        if (le != hipSuccess) fprintf(stderr, "kernel_launch: cooperative launch failed: %s (grid %d)\n", hipGetErrorName(le), grid);
#else
        hipLaunchKernelGGL(mk_fwd, dim3(grid), dim3(NWAVES * 64), LDS_BYTES, stream, a);
#endif
    } else {
        for (int li = 0; li < PER_PHASE; ++li) {
            a.ph_lo = li; a.ph_hi = li + 1; a.li = 0;
            hipLaunchKernelGGL(mk_fwd, dim3(grid), dim3(NWAVES * 64), LDS_BYTES, stream, a);
#if MK_CHECK
            hipLaunchKernelGGL(chk_kernel, dim3(256), dim3(256), 0, stream, a, li);
#endif
        }
#if MK_CHECK
        hipLaunchKernelGGL(chk_final, dim3(1024), dim3(256), 0, stream, a);
#endif
    }
}
```

```cpp
#include <hip/hip_runtime.h>
#include <cstdio>
#include <cstdint>
#include <cmath>

#ifndef MK_N_LAUNCHES
#define MK_N_LAUNCHES 1
#endif
#ifndef MK_TIME
#define MK_TIME 0
#endif
#ifndef MK_REPEAT
#define MK_REPEAT -1
#endif
#ifndef MK_NREP
#define MK_NREP 2
#endif
#ifndef MK_COOP
#define MK_COOP 1
#endif
#ifndef MK_TSCALE
#define MK_TSCALE 1.0f
#endif
#ifndef MK_CHECK
#define MK_CHECK 0
#endif

#define LAS __attribute__((address_space(3)))
#define GAS __attribute__((address_space(1)))
typedef unsigned short bf16;
typedef short bf16x8 __attribute__((ext_vector_type(8)));
typedef short s16x4 __attribute__((ext_vector_type(4)));
typedef float f32x2 __attribute__((ext_vector_type(2)));
typedef float f32x4 __attribute__((ext_vector_type(4)));
typedef float f32x16 __attribute__((ext_vector_type(16)));
typedef unsigned u32x2 __attribute__((ext_vector_type(2)));
typedef unsigned u32x4 __attribute__((ext_vector_type(4)));
typedef __bf16 bf16x2_t __attribute__((ext_vector_type(2)));
typedef GAS unsigned gu32;

constexpr int NBATCH = 8, SEQ = 4096, DM = 1024, M = NBATCH * SEQ;
constexpr int NIN = 3584, SEGW = 512, NHEAD = 8, HD = 64;
constexpr int NEXP = 32, FF = 512, NGRP = 4, EPG = 8;
constexpr int CHUNK = 128, NCHUNK = SEQ / CHUNK;
constexpr float NORM_EPS = 1e-6f;
constexpr float LOG2E = 1.4426950408889634f, LN2 = 0.6931471805599453f;
constexpr int NWAVES = 8;
constexpr int N_CONV_P1 = 66 * 256;
constexpr int MAXTILES = 288;

constexpr size_t MiB = 1u << 20;
constexpr size_t WS_CTL = 0, CTL_ZERO_BYTES = 1 * MiB;
constexpr size_t WS_WRT = 1 * MiB;
constexpr size_t WS_ROPE = 2 * MiB;
constexpr size_t WS_LSE = 4 * MiB;
constexpr size_t WS_LIST = 8 * MiB;
constexpr size_t WS_GATEL = 12 * MiB;
constexpr size_t WS_RSL = 16 * MiB;
constexpr size_t WS_WIN = 20 * MiB;
constexpr size_t WS_WOUT = 27 * MiB;
constexpr size_t WS_WD = 30 * MiB;
constexpr size_t WS_WGU = 62 * MiB;
constexpr size_t WS_ST = 126 * MiB;
constexpr size_t WS_SBW = 478 * MiB;
constexpr size_t WS_XN = 158 * MiB;
constexpr size_t WS_OBR = 158 * MiB;
constexpr size_t WS_SEG = 254 * MiB;
constexpr size_t SEG_BYTES = (size_t)M * SEGW * 2;
constexpr size_t WS_MIXED = 254 * MiB;
constexpr size_t WS_H = 350 * MiB;
constexpr size_t WS_HG = 350 * MiB;
constexpr size_t WS_HID = 222 * MiB;
constexpr size_t WS_Y = 64 * MiB;
constexpr size_t WS_END = 494 * MiB;
constexpr int CW_CNT = 64;
constexpr int CW_BAR = 4096;
constexpr int CW_CHK = 16384;
constexpr int CW_TS = 20480;

constexpr int RING_BYTES = 147456;
constexpr int LDSCTL_OFF = RING_BYTES, MISC_OFF = LDSCTL_OFF + 320;
constexpr int TILE_OFF = MISC_OFF + 128;
constexpr int LDS_BYTES = 151552;

#define RLX_AGENT __ATOMIC_RELAXED, __HIP_MEMORY_SCOPE_AGENT
#define LDS_WAIT() asm volatile("s_waitcnt lgkmcnt(0)" ::: "memory")
#define VM_WAIT() asm volatile("s_waitcnt vmcnt(0)" ::: "memory")
__device__ __forceinline__ unsigned pk2(float lo, float hi) { f32x2 v = {lo, hi}; bf16x2_t b = __builtin_convertvector(v, bf16x2_t); return __builtin_bit_cast(unsigned, b); }
__device__ __forceinline__ float bflo(unsigned u) { return __uint_as_float(u << 16); }
__device__ __forceinline__ float bfhi(unsigned u) { return __uint_as_float(u & 0xffff0000u); }
__device__ __forceinline__ float bf2f(short s) { return __uint_as_float(((unsigned)(unsigned short)s) << 16); }
__device__ __forceinline__ int crow(int r, int hi) { return (r & 3) + 8 * (r >> 2) + 4 * hi; }
__device__ __forceinline__ float wave_sum(float v) {
#pragma unroll
    for (int o = 1; o < 64; o <<= 1) v += __shfl_xor(v, o);
    return v;
}
__device__ __forceinline__ float silu_f(float v) { return v / (1.f + __expf(-v)); }

namespace pg8 {
constexpr int BM = 256, BK = 64, HALF = 128, HTB = HALF * BK * 2, STAGE_BYTES = 8 * HTB, NXCD = 8, WGM = 8;
__host__ __device__ __forceinline__ int lds_byte(int r, int c) { const int st = (r >> 4) * 2 + (c >> 5), rr = r & 15, cc = c & 31, ob = rr * 64 + cc * 2; return st * 1024 + (ob ^ (((ob >> 9) & 1) << 5)); }
__host__ __device__ __forceinline__ void stage_rc(int b, int& R, int& C) { const int st = b / 1024, sb = b % 1024, swz = sb ^ (((sb >> 9) & 1) << 5); R = (st >> 1) * 16 + swz / 64; C = (st & 1) * 32 + (swz % 64) / 2; }
__host__ __device__ __forceinline__ int perm32(int rho) { const int n = rho >> 4, i = rho & 15; return 8 * (i >> 2) + 4 * n + (i & 3); }

struct Unit { int pm, pn; };
struct StaticOrder {
    int nM, nN, nwg, G, c;
    __device__ void init(int nM_, int nN_, int G_, int c_) { nM = nM_; nN = nN_; nwg = nM * nN; G = G_; c = c_; }
    __device__ bool next(int i, Unit& u) const {
        const long L = (long)i * G + c; if (L >= nwg) return false;
        int wgid = (int)L; { const int q = nwg / NXCD, r = nwg % NXCD, xcd = wgid % NXCD, off = wgid / NXCD; wgid = (xcd < r ? xcd * (q + 1) : r * (q + 1) + (xcd - r) * q) + off; }
        const int nig = WGM * nN, gid = wgid / nig, fm = gid * WGM, gsz = (nM - fm) < WGM ? (nM - fm) : WGM;
        u.pm = fm + ((wgid % nig) % gsz); u.pn = (wgid % nig) / gsz; return true;
    }
};

template <class Epi, class Sched, class Src, bool ALIGN_EPI, bool SP2>
__device__ __forceinline__ void gemm_phase(LAS unsigned char* lds, const int K, const Sched& S, const Src& SRC, const Epi& E) {
    int tid_ = threadIdx.x; asm volatile("" : "+v"(tid_));
    const int tid = tid_, wid = __builtin_amdgcn_readfirstlane(tid >> 6), lane = tid & 63, wr = wid >> 2, wc = wid & 3, fr = lane & 15, fq = lane >> 4;
    const int nt = K / BK;
    unsigned voffB[2]; int RA[2], CA[2];
#pragma unroll
    for (int i = 0; i < 2; ++i) { int R, C; stage_rc(tid * 16 + i * 8192, R, C); const int Rb = Epi::PERM ? ((R & ~31) + perm32(R & 31)) : R;
        RA[i] = R; CA[i] = C; voffB[i] = (unsigned)(Rb * K + C) * 2u; }
    const size_t kstep = (size_t)(BK * 2);
    const size_t hstep = (size_t)HALF * K * 2;
    const unsigned ldsw = (unsigned)wid * 1024u;
    const int aoff = lds_byte(wr * 64 + fr, fq * 8), boff = lds_byte(wc * 32 + fr, fq * 8);
#define PG8_SA(b, h) (((b) * 2 + (h)) * HTB)
#define PG8_SB(b, h) ((4 + (b) * 2 + (h)) * HTB)
#define PG8_STAGE(bufoff, gbase, voff) do { _Pragma("unroll") for (int _i = 0; _i < 2; ++_i) \
        __builtin_amdgcn_global_load_lds((const unsigned*)((const char*)(gbase) + (voff)[_i]), (LAS unsigned*)(lds + (bufoff) + ldsw + _i * 8192), 16, 0, 0); } while (0)
#define PG8_LDA(dst, b, h) do { _Pragma("unroll") for (int m = 0; m < 4; ++m) _Pragma("unroll") for (int k = 0; k < 2; ++k) dst[m][k] = *(const LAS bf16x8*)(lds + PG8_SA(b, h) + aoff + m * 2048 + k * 1024); } while (0)
#define PG8_LDB(dst, b, h) do { _Pragma("unroll") for (int n = 0; n < 2; ++n) _Pragma("unroll") for (int k = 0; k < 2; ++k) dst[n][k] = *(const LAS bf16x8*)(lds + PG8_SB(b, h) + boff + n * 2048 + k * 1024); } while (0)
#define PG8_MMA(ai, bj, At, Bt) do { __builtin_amdgcn_s_setprio(1); _Pragma("unroll") for (int m = 0; m < 4; ++m) _Pragma("unroll") for (int n = 0; n < 2; ++n) _Pragma("unroll") for (int k = 0; k < 2; ++k) \
        acc[ai][bj][m][n] = __builtin_amdgcn_mfma_f32_16x16x32_bf16(Bt[n][k], At[m][k], acc[ai][bj][m][n], 0, 0, 0); __builtin_amdgcn_s_setprio(0); } while (0)
#define PG8_WAIT_V(n) asm volatile("s_waitcnt vmcnt(" #n ")" ::: "memory")
#define PG8_WAIT_L(n) asm volatile("s_waitcnt lgkmcnt(" #n ")" ::: "memory")
#define PG8_BAR __builtin_amdgcn_s_barrier()
#define PG8_SCHED __builtin_amdgcn_sched_barrier(0)
    Unit cur, nxt; int ui = 0;
    if (!S.next(0, cur)) return;
    f32x4 acc[2][2][4][2];
#pragma unroll
    for (int a = 0; a < 2; ++a)
#pragma unroll
        for (int b = 0; b < 2; ++b)
#pragma unroll
            for (int m = 0; m < 4; ++m)
#pragma unroll
                for (int n = 0; n < 2; ++n) acc[a][b][m][n] = (f32x4){0.f, 0.f, 0.f, 0.f};
    bf16x8 At[4][2], B0[2][2], B1[2][2];
    const char *cA, *cB; unsigned vA0[2], vA1[2];
    SRC.setup(cur, RA, CA, cA, cB, vA0, vA1);
    if constexpr (SP2) {
        PG8_STAGE(PG8_SB(0, 0), cB, voffB); PG8_STAGE(PG8_SB(0, 1), cB + hstep, voffB); PG8_STAGE(PG8_SA(0, 0), cA, vA0); PG8_STAGE(PG8_SA(0, 1), cA, vA1);
        if (wr == 1) PG8_BAR;
        PG8_WAIT_V(2); PG8_BAR;
        PG8_STAGE(PG8_SB(1, 0), cB + kstep, voffB); PG8_STAGE(PG8_SA(1, 0), cA + kstep, vA0); PG8_STAGE(PG8_SB(1, 1), cB + hstep + kstep, voffB);
        PG8_WAIT_V(6); PG8_BAR;
    } else {
        PG8_STAGE(PG8_SB(0, 0), cB, voffB); PG8_STAGE(PG8_SA(0, 0), cA, vA0); PG8_STAGE(PG8_SB(0, 1), cB + hstep, voffB); PG8_STAGE(PG8_SA(0, 1), cA, vA1);
        if (wr == 1) PG8_BAR;
        PG8_WAIT_V(4); PG8_BAR;
        PG8_STAGE(PG8_SB(1, 0), cB + kstep, voffB); PG8_STAGE(PG8_SA(1, 0), cA + kstep, vA0); PG8_STAGE(PG8_SB(1, 1), cB + hstep + kstep, voffB);
        PG8_WAIT_V(6); PG8_BAR;
    }
    for (;;) {
        const bool has_next = S.next(ui + 1, nxt);
        const char *nA = cA, *nB = cB; unsigned wA0[2] = {vA0[0], vA0[1]}, wA1[2] = {vA1[0], vA1[1]};
        if (has_next) SRC.setup(nxt, RA, CA, nA, nB, wA0, wA1);
        for (int t = 0; t < nt; t += 2) {
            const bool last = (t == nt - 2);
            const char* a1 = cA + (size_t)(t + 1) * kstep;
            const char* a2 = last ? nA : cA + (size_t)(t + 2) * kstep; const char* b2 = last ? nB : cB + (size_t)(t + 2) * kstep;
            const char* a3 = a2 + kstep; const char* b3 = b2 + kstep;
            unsigned x0[2], x1[2];
            x0[0] = last ? wA0[0] : vA0[0]; x0[1] = last ? wA0[1] : vA0[1]; x1[0] = last ? wA1[0] : vA1[0]; x1[1] = last ? wA1[1] : vA1[1];
            if constexpr (SP2) {
            PG8_LDB(B0, 0, 0); PG8_LDB(B1, 0, 1); PG8_SCHED; PG8_LDA(At, 0, 0); PG8_STAGE(PG8_SA(1, 1), a1, vA1);
            PG8_WAIT_V(8); PG8_WAIT_L(0); PG8_BAR; PG8_MMA(0, 0, At, B0); PG8_MMA(0, 1, At, B1); PG8_BAR; PG8_SCHED;
            PG8_LDA(At, 0, 1); PG8_STAGE(PG8_SB(0, 0), b2, voffB); PG8_STAGE(PG8_SB(0, 1), b2 + hstep, voffB); PG8_STAGE(PG8_SA(0, 0), a2, x0);
            PG8_WAIT_V(8); PG8_WAIT_L(0); PG8_BAR; PG8_MMA(1, 0, At, B0); PG8_MMA(1, 1, At, B1); PG8_BAR; PG8_SCHED;
            PG8_LDB(B0, 1, 0); PG8_LDB(B1, 1, 1); PG8_SCHED; PG8_LDA(At, 1, 0); PG8_STAGE(PG8_SA(0, 1), a2, x1);
            PG8_WAIT_V(8); PG8_WAIT_L(0); PG8_BAR; PG8_MMA(0, 0, At, B0); PG8_MMA(0, 1, At, B1); PG8_BAR; PG8_SCHED;
            PG8_LDA(At, 1, 1); PG8_STAGE(PG8_SB(1, 0), b3, voffB); PG8_STAGE(PG8_SB(1, 1), b3 + hstep, voffB); PG8_STAGE(PG8_SA(1, 0), a3, x0);
            PG8_WAIT_V(8); PG8_WAIT_L(0); PG8_BAR; PG8_MMA(1, 0, At, B0); PG8_MMA(1, 1, At, B1); PG8_BAR; PG8_SCHED;
            } else {
            PG8_LDB(B0, 0, 0); PG8_SCHED; PG8_LDA(At, 0, 0); PG8_STAGE(PG8_SA(1, 1), a1, vA1);
            PG8_WAIT_L(8); PG8_BAR; PG8_WAIT_L(0); PG8_MMA(0, 0, At, B0); PG8_BAR; PG8_SCHED;
            PG8_LDB(B1, 0, 1); PG8_STAGE(PG8_SB(0, 0), b2, voffB);
            PG8_BAR; PG8_WAIT_L(0); PG8_MMA(0, 1, At, B1); PG8_BAR;
            PG8_LDA(At, 0, 1); PG8_STAGE(PG8_SA(0, 0), a2, x0);
            PG8_BAR; PG8_WAIT_L(0); PG8_MMA(1, 0, At, B0); PG8_BAR; PG8_SCHED;
            PG8_STAGE(PG8_SB(0, 1), b2 + hstep, voffB);
            PG8_WAIT_V(6); PG8_BAR; PG8_MMA(1, 1, At, B1); PG8_BAR;
            PG8_LDB(B0, 1, 0); PG8_SCHED; PG8_LDA(At, 1, 0); PG8_STAGE(PG8_SA(0, 1), a2, x1);
            PG8_WAIT_L(8); PG8_BAR; PG8_WAIT_L(0); PG8_MMA(0, 0, At, B0); PG8_BAR; PG8_SCHED;
            PG8_LDB(B1, 1, 1); PG8_STAGE(PG8_SB(1, 0), b3, voffB);
            PG8_BAR; PG8_WAIT_L(0); PG8_MMA(0, 1, At, B1); PG8_BAR;
            PG8_LDA(At, 1, 1); PG8_STAGE(PG8_SA(1, 0), a3, x0);
            PG8_BAR; PG8_WAIT_L(0); PG8_MMA(1, 0, At, B0); PG8_BAR; PG8_SCHED;
            PG8_STAGE(PG8_SB(1, 1), b3 + hstep, voffB);
            PG8_WAIT_V(6); PG8_BAR; PG8_MMA(1, 1, At, B1); PG8_BAR;
            }
        }
        if constexpr (ALIGN_EPI) { if (wr == 0) PG8_BAR; }
        E(acc, cur, wr, wc, fr, fq);
        if (!has_next) break;
#pragma unroll
        for (int a = 0; a < 2; ++a)
#pragma unroll
            for (int b = 0; b < 2; ++b)
#pragma unroll
                for (int m = 0; m < 4; ++m)
#pragma unroll
                    for (int n = 0; n < 2; ++n) acc[a][b][m][n] = (f32x4){0.f, 0.f, 0.f, 0.f};
        cur = nxt; cA = nA; cB = nB; vA0[0] = wA0[0]; vA0[1] = wA0[1]; vA1[0] = wA1[0]; vA1[1] = wA1[1]; ++ui;
        if constexpr (ALIGN_EPI) { if (wr == 1) PG8_BAR; }
    }
    PG8_WAIT_V(0);
    if constexpr (!ALIGN_EPI) { if (wr == 0) PG8_BAR; }
    PG8_BAR;
#undef PG8_SA
#undef PG8_SB
#undef PG8_STAGE
#undef PG8_LDA
#undef PG8_LDB
#undef PG8_MMA
#undef PG8_WAIT_V
#undef PG8_WAIT_L
#undef PG8_BAR
#undef PG8_SCHED
}
}

#define XB_TMO      128
#define XB_XCNT(j)  (256  + 64 * (j))
#define XB_XSUB(j)  (1280 + 64 * (j))
#define XB_XGEN(j)  (2304 + 64 * (j))
#define XB_TOP      3328
#define XB_TOPGEN   3392
#define XCD_BAR_WORDS 3456
#define XB_SPIN_CAP (1u << 18)
__device__ __forceinline__ unsigned xb_ld(unsigned* p)              { return __hip_atomic_load(p, __ATOMIC_RELAXED, __HIP_MEMORY_SCOPE_AGENT); }
__device__ __forceinline__ unsigned xb_add(unsigned* p, unsigned v) { return __hip_atomic_fetch_add(p, v, __ATOMIC_RELAXED, __HIP_MEMORY_SCOPE_AGENT); }
__device__ __forceinline__ unsigned xb_xcc_id() { return (unsigned)__builtin_amdgcn_s_getreg((3 << 11) | 20) & 0xFu; }
#define XB_SPIN(cond, bar) do { unsigned _sp = 0; while (cond) { __builtin_amdgcn_s_sleep(1); \
    if ((++_sp & 255u) == 0u) { if (xb_ld(&(bar)[XB_TMO])) break; if (_sp > XB_SPIN_CAP) { atomicAdd(&(bar)[XB_TMO], 1u); break; } } } } while (0)
struct XcdBarrier { unsigned* bar; unsigned x; volatile LAS unsigned* st; };
__device__ __forceinline__ XcdBarrier xcd_barrier_post(unsigned* bar, volatile LAS unsigned* st) {
    XcdBarrier b; b.bar = bar; b.x = xb_xcc_id(); b.st = st;
    if (threadIdx.x == 0) (void)xb_add(&bar[XB_XCNT(b.x)], 1u);
    return b;
}
__device__ __forceinline__ void xcd_barrier_complete(unsigned* bar, unsigned x, unsigned& nloc, unsigned& nx) {
    const unsigned G = gridDim.x * gridDim.y * gridDim.z;
    unsigned sum, cnt, mine, sp = 0u;
    for (;;) {
        sum = 0u; cnt = 0u; mine = 0u;
#pragma unroll
        for (unsigned j = 0; j < 16; ++j) { const unsigned c = xb_ld(&bar[XB_XCNT(j)]); sum += c; cnt += (c > 0u) ? 1u : 0u; mine = (j == x) ? c : mine; }
        if (sum == G) break;
        __builtin_amdgcn_s_sleep(1);
        if ((++sp & 255u) == 0u) { if (xb_ld(&bar[XB_TMO])) break; if (sp > XB_SPIN_CAP) { atomicAdd(&bar[XB_TMO], 1u); break; } }
    }
    nloc = mine > 0u ? mine : 1u; nx = cnt > 0u ? cnt : 1u;
}
__device__ __forceinline__ void xcd_barrier(const XcdBarrier& b) {
    asm volatile("s_waitcnt vmcnt(0)" ::: "memory");
    __syncthreads();
    if (threadIdx.x == 0) {
        unsigned* bar = b.bar;
        __builtin_amdgcn_s_waitcnt(0);
        unsigned nloc = b.st[0], nx = b.st[1];
        if (nloc == 0u) { xcd_barrier_complete(bar, b.x, nloc, nx); b.st[0] = nloc; b.st[1] = nx; }
        const unsigned old = xb_add(&bar[XB_XSUB(b.x)], 1u);
        const unsigned gen = old / nloc;
        if (old + 1u == (gen + 1u) * nloc) {
            __builtin_amdgcn_fence(__ATOMIC_RELEASE, "agent");
            asm volatile("s_waitcnt vmcnt(0)" ::: "memory");
            const unsigned og = xb_add(&bar[XB_TOP], 1u);
            const unsigned tg = og / nx;
            if (og + 1u == (tg + 1u) * nx) xb_add(&bar[XB_TOPGEN], 1u);
            else XB_SPIN(xb_ld(&bar[XB_TOPGEN]) == tg, bar);
            __builtin_amdgcn_fence(__ATOMIC_ACQUIRE, "agent");
            xb_add(&bar[XB_XGEN(b.x)], 1u);
            asm volatile("s_waitcnt vmcnt(0)" ::: "memory");
        } else {
            XB_SPIN(xb_ld(&bar[XB_XGEN(b.x)]) == gen, bar);
            __builtin_amdgcn_fence(__ATOMIC_ACQUIRE, "agent");
            asm volatile("s_waitcnt vmcnt(0)" ::: "memory");
        }
    }
    __syncthreads();
}

struct Args {
    const float* in[17]; float* out; unsigned char* ws;
    double frev[40];
    int ph_lo, ph_hi, li, pad;
};
struct Frame {
    LAS unsigned char* lds;
    volatile LAS unsigned* MISC;
    gu32* ctl;
    int tid, lane, wave, vcu, G;
};

__device__ __forceinline__ int winperm(int n) {
    const int s = n >> 9, c = n & 511, hh = c >> 6, d = c & 63; int dp = d;
    if (s == 0 || s == 1) { if (d < 16) dp = 2 * (d & 7) + (d >> 3); }
    else if (s == 3 || s == 4) dp = 2 * (d & 31) + (d >> 5);
    return (s << 9) + (hh << 6) + dp;
}
template <int MODE>
__device__ __forceinline__ int tr_row(int ns) { return MODE == 0 ? winperm(ns) : MODE == 1 ? ns : MODE == 2 ? ((ns >> 7) << 8) + (ns & 127) : ((ns >> 7) << 8) + 128 + (ns & 127); }
__device__ __forceinline__ void tr_load(f32x4 (&v)[8], const float* S, int N, int kb, int nb, int lane) {
    const float* p = S + (size_t)(64 * kb + (lane >> 3)) * N + 32 * nb + (lane & 7) * 4;
#pragma unroll
    for (int i = 0; i < 8; ++i) v[i] = *(const f32x4*)(p + (size_t)8 * i * N);
}
template <int MODE>
__device__ __forceinline__ void tr_store(const f32x4 (&v)[8], bf16* Dst, int Kd, LAS float* scr, int kb, int nb, int lane, const float* kscale) {
    const int k0 = 64 * kb, n0 = 32 * nb;
#pragma unroll
    for (int i = 0; i < 8; ++i) { const int kk = 8 * i + (lane >> 3); const float sc = kscale ? kscale[k0 + kk] : 1.f; LAS float* d = scr + kk * 33 + (lane & 7) * 4;
        d[0] = v[i][0] * sc; d[1] = v[i][1] * sc; d[2] = v[i][2] * sc; d[3] = v[i][3] * sc; }
    LDS_WAIT(); asm volatile("" ::: "memory");
    const int c = lane & 7;
#pragma unroll
    for (int j = 0; j < 4; ++j) { const int n = (lane >> 3) + 8 * j; const LAS float* s = scr + (8 * c) * 33 + n;
        u32x4 o; o.x = pk2(s[0 * 33], s[1 * 33]); o.y = pk2(s[2 * 33], s[3 * 33]); o.z = pk2(s[4 * 33], s[5 * 33]); o.w = pk2(s[6 * 33], s[7 * 33]);
        *(GAS u32x4*)(Dst + (size_t)tr_row<MODE>(n0 + n) * Kd + k0 + 8 * c) = o; }
    LDS_WAIT(); asm volatile("" ::: "memory");
}
template <int MODE>
__device__ __forceinline__ void p0_transpose_item(const float* S, int N, bf16* Dst, int Kd, LAS float* scr, int kb, int nb, int lane, const float* kscale) {
    f32x4 v[8]; tr_load(v, S, N, kb, nb, lane); tr_store<MODE>(v, Dst, Kd, scr, kb, nb, lane, kscale);
}
__device__ __forceinline__ void expert_src(const Args& A, int it, const float*& S, int& N, int& kb, int& nb) {
    const int e = it / 768, r = it - e * 768;
    if (r < 256) { S = A.in[13] + (size_t)e * DM * FF; N = FF; kb = r >> 4; nb = r & 15; }
    else if (r < 512) { S = A.in[14] + (size_t)e * DM * FF; N = FF; kb = (r - 256) >> 4; nb = (r - 256) & 15; }
    else { S = A.in[15] + (size_t)e * FF * DM; N = DM; kb = (r - 512) >> 5; nb = (r - 512) & 31; }
}
__device__ __forceinline__ void expert_store(const Args& A, unsigned char* ws, int it, const f32x4 (&v)[8], LAS float* scr, int lane) {
    bf16* WGU = (bf16*)(ws + WS_WGU); bf16* WD = (bf16*)(ws + WS_WD);
    const int e = it / 768, r = it - e * 768;
    if (r < 256) tr_store<2>(v, WGU + (size_t)e * DM * DM, DM, scr, r >> 4, r & 15, lane, A.in[8]);
    else if (r < 512) tr_store<3>(v, WGU + (size_t)e * DM * DM, DM, scr, (r - 256) >> 4, (r - 256) & 15, lane, A.in[8]);
    else tr_store<1>(v, WD + (size_t)e * DM * FF, FF, scr, (r - 512) >> 5, (r - 512) & 31, lane, nullptr);
}
__device__ __forceinline__ void expert_items(const Args& A, unsigned char* ws, LAS float* scr, int lo, int NI, int w0, int nw, int lane) {
    for (int it = lo + w0; it < NI; it += 4 * nw) {
        f32x4 v0[8], v1[8], v2[8], v3[8]; const float* S; int N, kb, nb;
        expert_src(A, it, S, N, kb, nb); tr_load(v0, S, N, kb, nb, lane);
        if (it + nw < NI) { expert_src(A, it + nw, S, N, kb, nb); tr_load(v1, S, N, kb, nb, lane); }
        if (it + 2 * nw < NI) { expert_src(A, it + 2 * nw, S, N, kb, nb); tr_load(v2, S, N, kb, nb, lane); }
        if (it + 3 * nw < NI) { expert_src(A, it + 3 * nw, S, N, kb, nb); tr_load(v3, S, N, kb, nb, lane); }
        expert_store(A, ws, it, v0, scr, lane);
        if (it + nw < NI) expert_store(A, ws, it + nw, v1, scr, lane);
        if (it + 2 * nw < NI) expert_store(A, ws, it + 2 * nw, v2, scr, lane);
        if (it + 3 * nw < NI) expert_store(A, ws, it + 3 * nw, v3, scr, lane);
    }
}
__device__ __forceinline__ void p0_prologue(Frame& F, const Args& A) {
    unsigned char* ws = A.ws;
    LAS float* scr = (LAS float*)(F.lds + F.wave * 16384);
    const int gw = F.vcu * NWAVES + F.wave, NGW = F.G * NWAVES;
    constexpr int I_IN = 16 * 112, I_OUT = 16 * 32;
    bf16* WIN = (bf16*)(ws + WS_WIN); bf16* WOUT = (bf16*)(ws + WS_WOUT);
    for (int it = gw; it < I_IN + I_OUT; it += NGW) {
        int r = it;
        if (r < I_IN) { p0_transpose_item<0>(A.in[2], NIN, WIN, DM, scr, r / 112, r % 112, F.lane, nullptr); continue; } r -= I_IN;
        const int kb = r / 32; p0_transpose_item<1>(A.in[7], DM, WOUT, DM, scr, kb, r % 32, F.lane, kb < 8 ? A.in[3] : A.in[6] - 512);
    }
    expert_items(A, ws, scr, F.G == 256 ? N_CONV_P1 : 0, 768 * NEXP, gw, NGW, F.lane);
    { const float* x = A.in[0]; const float* g = A.in[1]; bf16* XN = (bf16*)(ws + WS_XN);
      f32x4 gv[4];
#pragma unroll
      for (int j = 0; j < 4; ++j) gv[j] = ((const f32x4*)g)[F.lane + 64 * j];
      for (int m0 = gw; m0 < M; m0 += 4 * NGW) {
        f32x4 v[4][4];
#pragma unroll
        for (int k = 0; k < 4; ++k) { const GAS f32x4* xr = (const GAS f32x4*)(x + (size_t)(m0 + k * NGW) * DM) + F.lane;
#pragma unroll
            for (int j = 0; j < 4; ++j) v[k][j] = xr[64 * j]; }
#pragma unroll
        for (int k = 0; k < 4; ++k) { float s = 0.f;
#pragma unroll
            for (int j = 0; j < 4; ++j) s += (v[k][j].x * v[k][j].x + v[k][j].y * v[k][j].y) + (v[k][j].z * v[k][j].z + v[k][j].w * v[k][j].w);
            const float rstd = 1.f / sqrtf(wave_sum(s) * (1.f / DM) + NORM_EPS);
            GAS unsigned long long* o8 = (GAS unsigned long long*)(XN + (size_t)(m0 + k * NGW) * DM) + F.lane;
#pragma unroll
            for (int j = 0; j < 4; ++j) { const f32x4 t = v[k][j] * rstd * gv[j]; o8[64 * j] = (unsigned long long)pk2(t.x, t.y) | ((unsigned long long)pk2(t.z, t.w) << 32); } }
      } }
    { const int gt = (F.vcu * NWAVES + F.wave) * 64 + F.lane, NT = NGW * 64;
      bf16* WRH = (bf16*)(ws + WS_WRT); bf16* WRL = WRH + 48 * DM; const float* gf = A.in[8]; const float* wg = A.in[9]; const float* we = A.in[11];
      for (int idx = gt; idx < 48 * DM; idx += NT) { const int j = idx >> 10, i = idx & 1023;
          const float v = (j < 32 ? we[i * 32 + j] : (j < 36 ? wg[i * 4 + (j - 32)] : 0.f)) * gf[i];
          const unsigned hb = pk2(v, 0.f) & 0xffffu; const float lo = v - bflo(hb); WRH[idx] = (bf16)hb; WRL[idx] = (bf16)(pk2(lo, 0.f) & 0xffffu); }
      float* RC = (float*)(ws + WS_ROPE); float* RS = RC + SEQ * 40;
      for (int idx = gt; idx < SEQ * 40; idx += NT) { const int pos = idx / 40, f = idx % 40;
          double rv = (double)pos * A.frev[f]; rv -= floor(rv); const float r = (float)rv;
          RC[idx] = __builtin_amdgcn_cosf(r); RS[idx] = __builtin_amdgcn_sinf(r); } }
}

struct SrcPlain {
    const bf16* A; const bf16* Bt; int K;
    __device__ __forceinline__ void setup(const pg8::Unit& u, const int (&RA)[2], const int (&CA)[2], const char*& cA, const char*& cB, unsigned (&v0)[2], unsigned (&v1)[2]) const {
        cA = (const char*)A + (size_t)u.pm * 256 * K * 2; cB = (const char*)Bt + (size_t)u.pn * 256 * K * 2;
#pragma unroll
        for (int i = 0; i < 2; ++i) { v0[i] = (unsigned)(RA[i] * K + CA[i]) * 2u; v1[i] = v0[i] + (unsigned)(128 * K * 2); }
    }
};
struct TileTab { const LAS int* TE; const LAS int* NE; const LAS int* T0; };
struct SrcGather {
    const bf16* HG; const bf16* WGU; const int* LIST; TileTab tt;
    __device__ __forceinline__ void setup(const pg8::Unit& u, const int (&RA)[2], const int (&CA)[2], const char*& cA, const char*& cB, unsigned (&v0)[2], unsigned (&v1)[2]) const {
        const int e = tt.TE[u.pm], ne = tt.NE[e], p0 = (u.pm - tt.T0[e]) * 256;
        cA = (const char*)HG; cB = (const char*)WGU + ((size_t)e * DM + (size_t)u.pn * 256) * DM * 2;
#pragma unroll
        for (int i = 0; i < 2; ++i) {
            const int pa = p0 + RA[i], pb = pa + 128;
            const int ta = pa < ne ? (LIST[e * M + pa] >> 1) : 0, tb = pb < ne ? (LIST[e * M + pb] >> 1) : 0;
            v0[i] = (unsigned)(ta * DM + CA[i]) * 2u; v1[i] = (unsigned)(tb * DM + CA[i]) * 2u; }
    }
};
struct SrcDown {
    const bf16* HID; const bf16* WD; TileTab tt;
    __device__ __forceinline__ void setup(const pg8::Unit& u, const int (&RA)[2], const int (&CA)[2], const char*& cA, const char*& cB, unsigned (&v0)[2], unsigned (&v1)[2]) const {
        const int e = tt.TE[u.pm];
        cA = (const char*)HID + (size_t)u.pm * 256 * FF * 2; cB = (const char*)WD + ((size_t)e * DM + (size_t)u.pn * 256) * FF * 2;
#pragma unroll
        for (int i = 0; i < 2; ++i) { v0[i] = (unsigned)(RA[i] * FF + CA[i]) * 2u; v1[i] = v0[i] + (unsigned)(128 * FF * 2); }
    }
};

struct EpiInProj {
    static constexpr bool PERM = true;
    bf16* SEG; const float* RC; const float* RS;
    __device__ __forceinline__ void operator()(const f32x4 (&acc)[2][2][4][2], const pg8::Unit& u, int wr, int wc, int fr, int fq) const {
        const int seg = u.pn >> 1, colt = (u.pn & 1) * 256;
        bf16* base = SEG + (size_t)seg * M * SEGW;
        const int dq = (wc & 1) * 32 + 8 * fq;
        const bool attn = seg < 2, ret = (seg == 3 || seg == 4);
        const bool rot = ret || (attn && dq < 16);
        const int i0 = ret ? 8 + (dq >> 1) : (dq >> 1);
        const float sc = seg == 0 ? 0.125f * LOG2E : (seg == 4 ? 0.125f : 1.f);
#pragma unroll
        for (int ai = 0; ai < 2; ++ai)
#pragma unroll
            for (int m = 0; m < 4; ++m) {
                const int row = u.pm * 256 + ai * 128 + wr * 64 + m * 16 + fr, pos = row & (SEQ - 1);
                f32x4 c4 = {1.f, 1.f, 1.f, 1.f}, s4 = {0.f, 0.f, 0.f, 0.f};
                if (rot) { c4 = *(const f32x4*)(RC + pos * 40 + i0); s4 = *(const f32x4*)(RS + pos * 40 + i0); }
                bf16* rowp = base + (size_t)row * SEGW + colt + wc * 32 + 8 * fq;
#pragma unroll
                for (int bj = 0; bj < 2; ++bj) {
                    f32x4 v0 = acc[ai][bj][m][0], v1 = acc[ai][bj][m][1];
                    if (attn || ret) {
                        f32x4 r0, r1;
                        r0[0] = v0[0] * c4[0] - v0[1] * s4[0]; r0[1] = v0[1] * c4[0] + v0[0] * s4[0];
                        r0[2] = v0[2] * c4[1] - v0[3] * s4[1]; r0[3] = v0[3] * c4[1] + v0[2] * s4[1];
                        r1[0] = v1[0] * c4[2] - v1[1] * s4[2]; r1[1] = v1[1] * c4[2] + v1[0] * s4[2];
                        r1[2] = v1[2] * c4[3] - v1[3] * s4[3]; r1[3] = v1[3] * c4[3] + v1[2] * s4[3];
                        v0 = r0 * sc; v1 = r1 * sc;
                    } else if (seg == 6) {
#pragma unroll
                        for (int e = 0; e < 4; ++e) { v0[e] = silu_f(v0[e]); v1[e] = silu_f(v1[e]); }
                    }
                    u32x4 w; w.x = pk2(v0[0], v0[1]); w.y = pk2(v0[2], v0[3]); w.z = pk2(v1[0], v1[1]); w.w = pk2(v1[2], v1[3]);
                    *(u32x4*)(rowp + bj * 128) = w;
                }
            }
    }
};
struct EpiOutProj {
    static constexpr bool PERM = true;
    const float* X; bf16* HB;
    __device__ __forceinline__ void operator()(const f32x4 (&acc)[2][2][4][2], const pg8::Unit& u, int wr, int wc, int fr, int fq) const {
        const int col0 = u.pn * 256 + wc * 32 + 8 * fq;
#pragma unroll
        for (int ai = 0; ai < 2; ++ai)
#pragma unroll
            for (int m = 0; m < 4; ++m) { const size_t off = (size_t)(u.pm * 256 + ai * 128 + wr * 64 + m * 16 + fr) * DM + col0;
#pragma unroll
                for (int bj = 0; bj < 2; ++bj) { const f32x4 h0 = *(const f32x4*)(X + off + bj * 128) + acc[ai][bj][m][0], h1 = *(const f32x4*)(X + off + bj * 128 + 4) + acc[ai][bj][m][1];
                    u32x4 w; w.x = pk2(h0[0], h0[1]); w.y = pk2(h0[2], h0[3]); w.z = pk2(h1[0], h1[1]); w.w = pk2(h1[2], h1[3]); *(u32x4*)(HB + off + bj * 128) = w; }
                if (m & 1) asm volatile("" ::: "memory"); }
    }
};
struct EpiGateUp {
    static constexpr bool PERM = true;
    bf16* HID; const float* GATEL; const float* RSL; TileTab tt;
    __device__ __forceinline__ void operator()(const f32x4 (&acc)[2][2][4][2], const pg8::Unit& u, int wr, int wc, int fr, int fq) const {
        const int e = tt.TE[u.pm], ne = tt.NE[e], p0 = (u.pm - tt.T0[e]) * 256;
#pragma unroll
        for (int ai = 0; ai < 2; ++ai)
#pragma unroll
            for (int m = 0; m < 4; ++m) {
                const int rr = ai * 128 + wr * 64 + m * 16 + fr, pos = p0 + rr;
                float rs = 0.f, gt = 0.f; if (pos < ne) { rs = RSL[e * M + pos]; gt = GATEL[e * M + pos]; }
                u32x4 w; unsigned* wp = (unsigned*)&w;
#pragma unroll
                for (int n = 0; n < 2; ++n) { const f32x4 g = acc[ai][0][m][n] * rs, up = acc[ai][1][m][n] * rs; float hv[4];
#pragma unroll
                    for (int q = 0; q < 4; ++q) hv[q] = silu_f(g[q]) * up[q] * gt;
                    wp[2 * n] = pk2(hv[0], hv[1]); wp[2 * n + 1] = pk2(hv[2], hv[3]); }
                *(u32x4*)(HID + (size_t)(u.pm * 256 + rr) * FF + u.pn * 128 + wc * 32 + 8 * fq) = w;
            }
    }
};
struct EpiDown {
    static constexpr bool PERM = true;
    bf16* Y; const int* LIST; TileTab tt;
    __device__ __forceinline__ void operator()(const f32x4 (&acc)[2][2][4][2], const pg8::Unit& u, int wr, int wc, int fr, int fq) const {
        const int e = tt.TE[u.pm], ne = tt.NE[e], p0 = (u.pm - tt.T0[e]) * 256;
#pragma unroll
        for (int ai = 0; ai < 2; ++ai)
#pragma unroll
            for (int m = 0; m < 4; ++m) {
                const int pos = p0 + ai * 128 + wr * 64 + m * 16 + fr;
                if (pos < ne) { const int tk = LIST[e * M + pos]; bf16* rowp = Y + (size_t)tk * DM + u.pn * 256 + wc * 32 + 8 * fq;
#pragma unroll
                    for (int bj = 0; bj < 2; ++bj) { const f32x4 v0 = acc[ai][bj][m][0], v1 = acc[ai][bj][m][1];
                        u32x4 w; w.x = pk2(v0[0], v0[1]); w.y = pk2(v0[2], v0[3]); w.z = pk2(v1[0], v1[1]); w.w = pk2(v1[2], v1[3]);
                        *(u32x4*)(rowp + bj * 128) = w; } }
            }
    }
};

typedef short v4i16_t __attribute__((ext_vector_type(4)));
__device__ __forceinline__ s16x4 vtr(const LAS unsigned char* p) { return __builtin_bit_cast(s16x4, __builtin_amdgcn_ds_read_tr16_b64_v4i16((LAS v4i16_t*)p)); }
#define MFMA32(a, b, c) __builtin_amdgcn_mfma_f32_32x32x16_bf16((a), (b), (c), 0, 0, 0)
__device__ __forceinline__ bf16x8 pack8(const f32x16& x, int s) {
    u32x4 p; p.x = pk2(x[8 * s], x[8 * s + 1]); p.y = pk2(x[8 * s + 2], x[8 * s + 3]); p.z = pk2(x[8 * s + 4], x[8 * s + 5]); p.w = pk2(x[8 * s + 6], x[8 * s + 7]);
    return __builtin_bit_cast(bf16x8, p);
}
__device__ __forceinline__ bf16x8 cat44(s16x4 lo, s16x4 hi) { return __builtin_shufflevector(lo, hi, 0, 1, 2, 3, 4, 5, 6, 7); }
__device__ __forceinline__ bf16x8 scale8(bf16x8 v, float s) {
    u32x4 u = __builtin_bit_cast(u32x4, v), o;
    o.x = pk2(bflo(u.x) * s, bfhi(u.x) * s); o.y = pk2(bflo(u.y) * s, bfhi(u.y) * s); o.z = pk2(bflo(u.z) * s, bfhi(u.z) * s); o.w = pk2(bflo(u.w) * s, bfhi(u.w) * s);
    return __builtin_bit_cast(bf16x8, o);
}
constexpr int TP = 144;
__device__ __forceinline__ void pv_tile_p(f32x16& ot0, f32x16& ot1, const f32x16& st, const LAS unsigned char* vl, int lane) {
    const int hi = lane >> 5;
    const LAS unsigned char* vr = vl + (4 * hi + ((lane & 15) >> 2)) * TP + (16 * ((lane >> 4) & 1) + 4 * (lane & 3)) * 2;
    const bf16x8 pb0 = pack8(st, 0), pb1 = pack8(st, 1);
    { const bf16x8 va = cat44(vtr(vr), vtr(vr + 8 * TP)); ot0 = MFMA32(va, pb0, ot0); }
    { const bf16x8 va = cat44(vtr(vr + 16 * TP), vtr(vr + 24 * TP)); ot0 = MFMA32(va, pb1, ot0); }
    { const bf16x8 va = cat44(vtr(vr + 64), vtr(vr + 8 * TP + 64)); ot1 = MFMA32(va, pb0, ot1); }
    { const bf16x8 va = cat44(vtr(vr + 16 * TP + 64), vtr(vr + 24 * TP + 64)); ot1 = MFMA32(va, pb1, ot1); }
}
__device__ __forceinline__ void kv_task(int cid, const bf16* KR, const bf16* VR, bf16* KV, const float* dec_f, const float* dec_b, LAS unsigned char* wl, int lane) {
    const int bh = cid >> 5, n = cid & 31, b = bh >> 3, h = bh & 7, q = lane & 31, hi = lane >> 5, tr = lane >> 3, tc = (lane & 7) * 8;
    const float lgf = __uint_as_float(__builtin_amdgcn_readfirstlane(__float_as_uint(log1pf(-exp2f(dec_f[h])) * LOG2E))), lgb = __uint_as_float(__builtin_amdgcn_readfirstlane(__float_as_uint(log1pf(-exp2f(dec_b[h])) * LOG2E)));
    const size_t row0 = (size_t)b * SEQ + n * CHUNK; const int loff = tr * SEGW + tc;
    const bf16* Kb = KR + row0 * SEGW + h * HD; const bf16* Vb = VR + row0 * SEGW + h * HD;
    LAS unsigned char* Tf = wl; LAS unsigned char* Tb = wl + 32 * TP; LAS unsigned char* Tv = wl + 64 * TP; LAS unsigned char* tw = wl + tr * TP + tc * 2;
    const int tro = (8 * hi + ((lane & 15) >> 2)) * TP + (16 * ((lane >> 4) & 1) + 4 * (lane & 3)) * 2;
    f32x16 acc[2][2][2];
#pragma unroll
    for (int d = 0; d < 2; ++d)
#pragma unroll
        for (int a = 0; a < 2; ++a)
#pragma unroll
            for (int c = 0; c < 2; ++c)
#pragma unroll
                for (int r = 0; r < 16; ++r) acc[d][a][c][r] = 0.f;
    bf16x8 nk[4], nv[4];
#pragma unroll
    for (int i = 0; i < 4; ++i) { nk[i] = *(const bf16x8*)(Kb + loff + 8 * i * SEGW); nv[i] = *(const bf16x8*)(Vb + loff + 8 * i * SEGW); }
#pragma unroll 1
    for (int it = 0; it < 4; ++it) {
#pragma unroll
        for (int i = 0; i < 4; ++i) { const int key = 32 * it + tr + 8 * i;
            *(LAS bf16x8*)(tw + 8 * i * TP) = scale8(nk[i], __builtin_amdgcn_exp2f((float)(CHUNK - 1 - key) * lgf));
            *(LAS bf16x8*)(tw + 32 * TP + 8 * i * TP) = scale8(nk[i], __builtin_amdgcn_exp2f((float)key * lgb));
            *(LAS bf16x8*)(tw + 64 * TP + 8 * i * TP) = nv[i]; }
        if (it < 3) {
#pragma unroll
            for (int i = 0; i < 4; ++i) { nk[i] = *(const bf16x8*)(Kb + 32 * (it + 1) * SEGW + loff + 8 * i * SEGW); nv[i] = *(const bf16x8*)(Vb + 32 * (it + 1) * SEGW + loff + 8 * i * SEGW); } }
        asm volatile("" ::: "memory");
#pragma unroll
        for (int s2 = 0; s2 < 2; ++s2) {
            bf16x8 bv[2];
#pragma unroll
            for (int c = 0; c < 2; ++c) bv[c] = cat44(vtr(Tv + tro + s2 * 16 * TP + c * 64), vtr(Tv + tro + s2 * 16 * TP + 4 * TP + c * 64));
#pragma unroll
            for (int a = 0; a < 2; ++a) {
                const bf16x8 af = cat44(vtr(Tf + tro + s2 * 16 * TP + a * 64), vtr(Tf + tro + s2 * 16 * TP + 4 * TP + a * 64));
                const bf16x8 ab = cat44(vtr(Tb + tro + s2 * 16 * TP + a * 64), vtr(Tb + tro + s2 * 16 * TP + 4 * TP + a * 64));
#pragma unroll
                for (int c = 0; c < 2; ++c) { acc[0][a][c] = MFMA32(af, bv[c], acc[0][a][c]); acc[1][a][c] = MFMA32(ab, bv[c], acc[1][a][c]); }
            }
        }
        asm volatile("" ::: "memory");
    }
#pragma unroll
    for (int d = 0; d < 2; ++d) { bf16* ob = KV + (((size_t)bh * NCHUNK + n) * 2 + d) * 4096;
#pragma unroll
        for (int a = 0; a < 2; ++a)
#pragma unroll
            for (int c = 0; c < 2; ++c)
#pragma unroll
                for (int g = 0; g < 4; ++g) { u32x2 w; w.x = pk2(acc[d][a][c][4 * g], acc[d][a][c][4 * g + 1]); w.y = pk2(acc[d][a][c][4 * g + 2], acc[d][a][c][4 * g + 3]);
                    *(u32x2*)(ob + ((c * 4 + 2 * a + (g >> 1)) * 64 + q + 32 * (g & 1)) * 8 + 4 * hi) = w; } }
}

struct AttnRound { size_t rowbase; int dil, qb0, nblk, h, br; };
__device__ __forceinline__ AttnRound round_decode(int rg) {
    AttnRound a; const int bh = rg / 48, x = rg - bh * 48, br = x >> 4, w16 = x & 15; int cls, qb0;
    if (br == 0) { cls = 0; qb0 = 8 * w16; } else if (br == 1) { cls = w16 >> 2; qb0 = 8 * (w16 & 3); } else { cls = w16; qb0 = 0; }
    a.rowbase = (size_t)(bh >> 3) * SEQ + cls; a.dil = 1 << (2 * br); a.qb0 = qb0; a.nblk = (SEQ >> (2 * br)) >> 5; a.h = bh & 7; a.br = br; return a;
}
__device__ __forceinline__ int round_id(int r0, int xl, int rr) { if (xl < 0) return r0 + rr; const int t = rr / 3, i = rr - 3 * t; return (r0 + 2 * t + (xl >> 4)) * 48 + 3 * (xl & 15) + i; }
__device__ __forceinline__ void attn_rounds(int r0, int xl, int nr, const bf16* QA, const bf16* KA, const bf16* VA, bf16* OBR, float* LSE, LAS unsigned char* lds, int wave, int lane) {
    const int q = lane & 31, hi = lane >> 5, tr = lane >> 3, tc = (lane & 7) * 8;
    LAS unsigned char* Qt = lds + (24 + wave) * (32 * TP);
    const int twoff = tr * TP + tc * 2;
    bf16x8 pt[3][4], pq[4];
    AttnRound nx = round_decode(round_id(r0, xl, 0));
#define ATT_PREFETCH(R) do { \
        _Pragma("unroll") for (int x_ = 0; x_ < 3; ++x_) { const int tile = 3 * wave + x_, slot = tile >= 12 ? tile - 12 : tile, j_ = (R).qb0 - 2 + slot; \
            if (j_ >= 0 && j_ < (R).nblk) { const bf16* src = (tile >= 12 ? VA : KA) + ((R).rowbase + (size_t)(R).dil * (32 * j_ + tr)) * SEGW + (R).h * HD + tc; \
                _Pragma("unroll") for (int i_ = 0; i_ < 4; ++i_) pt[x_][i_] = *(const bf16x8*)(src + (size_t)(R).dil * 8 * i_ * SEGW); } } \
        { const bf16* src = QA + ((R).rowbase + (size_t)(R).dil * (32 * ((R).qb0 + wave) + tr)) * SEGW + (R).h * HD + tc; \
          _Pragma("unroll") for (int i_ = 0; i_ < 4; ++i_) pq[i_] = *(const bf16x8*)(src + (size_t)(R).dil * 8 * i_ * SEGW); } } while (0)
    ATT_PREFETCH(nx);
#pragma unroll 1
    for (int rr = 0; rr < nr; ++rr) {
        const AttnRound cu = nx;
        __syncthreads();
#pragma unroll
        for (int x = 0; x < 3; ++x) { const int tile = 3 * wave + x, slot = tile >= 12 ? tile - 12 : tile, j = cu.qb0 - 2 + slot;
            if (j >= 0 && j < cu.nblk) { LAS unsigned char* tb = lds + tile * (32 * TP) + twoff;
#pragma unroll
                for (int i = 0; i < 4; ++i) *(LAS bf16x8*)(tb + 8 * i * TP) = pt[x][i]; } }
#pragma unroll
        for (int i = 0; i < 4; ++i) *(LAS bf16x8*)(Qt + twoff + 8 * i * TP) = pq[i];
        if (rr + 1 < nr) { nx = round_decode(round_id(r0, xl, rr + 1)); ATT_PREFETCH(nx); }
        __syncthreads();
        bf16x8 qr[4];
#pragma unroll
        for (int ks = 0; ks < 4; ++ks) qr[ks] = *(const LAS bf16x8*)(Qt + q * TP + hi * 16 + 32 * ks);
        float mrun = -1e30f, lsum = 0.f; f32x16 ot0, ot1;
#pragma unroll
        for (int r = 0; r < 16; ++r) { ot0[r] = 0.f; ot1[r] = 0.f; }
        const int jb = cu.qb0 + wave - 2, klo = jb < 0 ? -jb : 0, khi = jb + 4 >= cu.nblk ? cu.nblk - 1 - jb : 4;
        f32x16 stn;
#define ATT_QK(dst, kb_) do { const LAS unsigned char* Kt_ = lds + (wave + (kb_)) * (32 * TP); _Pragma("unroll") for (int r_ = 0; r_ < 16; ++r_) dst[r_] = 0.f; \
            _Pragma("unroll") for (int ks_ = 0; ks_ < 4; ++ks_) dst = MFMA32(*(const LAS bf16x8*)(Kt_ + q * TP + hi * 16 + 32 * ks_), qr[ks_], dst); } while (0)
        ATT_QK(stn, klo);
#pragma unroll 1
        for (int kb = klo; kb <= khi; ++kb) {
            f32x16 st = stn;
            if (kb < khi) ATT_QK(stn, kb + 1);
            const LAS unsigned char* Vt = lds + (12 + wave + kb) * (32 * TP);
            if (kb == 0) {
#pragma unroll
                for (int r = 0; r < 16; ++r) if (crow(r, hi) < q) st[r] = -1e30f;
            }
            if (kb == 4) {
#pragma unroll
                for (int r = 0; r < 16; ++r) if (crow(r, hi) > q) st[r] = -1e30f;
            }
            float mx = st[0];
#pragma unroll
            for (int r = 1; r < 16; ++r) mx = fmaxf(mx, st[r]);
            mx = fmaxf(mx, __shfl_xor(mx, 32));
            if (!__all(mx <= mrun + 8.f)) {
                const float mnew = fmaxf(mrun, mx), alpha = __builtin_amdgcn_exp2f(mrun - mnew); mrun = mnew; lsum *= alpha;
#pragma unroll
                for (int r = 0; r < 16; ++r) { ot0[r] *= alpha; ot1[r] *= alpha; }
            }
            float ps = 0.f;
#pragma unroll
            for (int r = 0; r < 16; ++r) { st[r] = __builtin_amdgcn_exp2f(st[r] - mrun); ps += st[r]; }
            lsum += ps;
            pv_tile_p(ot0, ot1, st, Vt, lane);
        }
#undef ATT_QK
        const float lt = lsum + __shfl_xor(lsum, 32);
        const float inv = 1.f / lt, lse = (mrun + __log2f(lt)) * LN2;
        asm volatile("" ::: "memory");
        LAS unsigned char* ow = Qt + q * TP + 8 * hi;
#pragma unroll
        for (int g = 0; g < 4; ++g) {
            u32x2 w0, w1; w0.x = pk2(ot0[4 * g] * inv, ot0[4 * g + 1] * inv); w0.y = pk2(ot0[4 * g + 2] * inv, ot0[4 * g + 3] * inv);
            w1.x = pk2(ot1[4 * g] * inv, ot1[4 * g + 1] * inv); w1.y = pk2(ot1[4 * g + 2] * inv, ot1[4 * g + 3] * inv);
            *(LAS u32x2*)(ow + 16 * g) = w0; *(LAS u32x2*)(ow + 64 + 16 * g) = w1; }
        asm volatile("" ::: "memory");
        const size_t qbase = cu.rowbase + (size_t)cu.dil * 32 * (cu.qb0 + wave);
#pragma unroll
        for (int i = 0; i < 4; ++i) { const u32x4 v = *(const LAS u32x4*)(Qt + twoff + 8 * i * TP);
            *(u32x4*)(OBR + ((size_t)cu.br * M + qbase + (size_t)cu.dil * (tr + 8 * i)) * SEGW + cu.h * HD + tc) = v; }
        if (hi == 0) LSE[((size_t)cu.br * M + qbase + (size_t)cu.dil * q) * NHEAD + cu.h] = lse;
        asm volatile("" ::: "memory");
    }
#undef ATT_PREFETCH
    __syncthreads();
}

constexpr int R_K = 0, R_V = 128 * TP, R_Q = 2 * 128 * TP, R_G = 3 * 128 * TP, R_O = 4 * 128 * TP, R_SF = 5 * 128 * TP, R_SB = R_SF + 8192, R_X = R_SB + 8192;
__device__ __forceinline__ void ret_wg(int wgt, const bf16* QR, const bf16* KR, const bf16* VR, const bf16* GR, const bf16* KV, bf16* SBW, bf16* MIXED, const float* dec_f, const float* dec_b,
                                       const bf16* OBR, const float* LSE, long crow0, LAS unsigned char* lds, int tid, int wave, int lane) {
    const int bh = wgt >> 2, n0 = (wgt & 3) * 8, b = bh >> 3, h = bh & 7, q = lane & 31, hi = lane >> 5, tr = lane >> 3, tc = (lane & 7) * 8;
    const float lgf = __uint_as_float(__builtin_amdgcn_readfirstlane(__float_as_uint(log1pf(-exp2f(dec_f[h])) * LOG2E))), lgb = __uint_as_float(__builtin_amdgcn_readfirstlane(__float_as_uint(log1pf(-exp2f(dec_b[h])) * LOG2E)));
    const float gf128 = exp2f(128.f * lgf), gb128 = exp2f(128.f * lgb);
    float pf[16], pb[16];
#pragma unroll
    for (int r = 0; r < 16; ++r) { const int dl = q - crow(r, hi); pf[r] = exp2f((float)dl * lgf); pb[r] = exp2f((float)(-dl) * lgb); }
    const bf16* KVt = KV + (size_t)bh * NCHUNK * 2 * 4096 + 8 * tid;
    bf16* SBt = SBW + (size_t)bh * NCHUNK * 4096 + 8 * tid;
    float Sf[8], Sb[8];
#pragma unroll
    for (int e = 0; e < 8; ++e) { Sf[e] = 0.f; Sb[e] = 0.f; }
#define RET_AXPY(S, g, v) do { S[0] = S[0] * (g) + bflo((v).x); S[1] = S[1] * (g) + bfhi((v).x); S[2] = S[2] * (g) + bflo((v).y); S[3] = S[3] * (g) + bfhi((v).y); \
                               S[4] = S[4] * (g) + bflo((v).z); S[5] = S[5] * (g) + bfhi((v).z); S[6] = S[6] * (g) + bflo((v).w); S[7] = S[7] * (g) + bfhi((v).w); } while (0)
    for (int m0 = 0; m0 < n0; m0 += 8) { u32x4 v[8];
#pragma unroll
        for (int k = 0; k < 8; ++k) v[k] = *(const u32x4*)(KVt + (size_t)((m0 + k) * 2) * 4096);
#pragma unroll
        for (int k = 0; k < 8; ++k) RET_AXPY(Sf, gf128, v[k]); }
    for (int m0 = NCHUNK - 8; m0 >= n0 + 8; m0 -= 8) { u32x4 v[8];
#pragma unroll
        for (int k = 0; k < 8; ++k) v[k] = *(const u32x4*)(KVt + (size_t)((m0 + 7 - k) * 2 + 1) * 4096);
#pragma unroll
        for (int k = 0; k < 8; ++k) RET_AXPY(Sb, gb128, v[k]); }
    { u32x4 v[8];
#pragma unroll
      for (int k = 0; k < 8; ++k) v[k] = *(const u32x4*)(KVt + (size_t)((n0 + 7 - k) * 2 + 1) * 4096);
#pragma unroll
      for (int k = 0; k < 8; ++k) { u32x4 w; w.x = pk2(Sb[0], Sb[1]); w.y = pk2(Sb[2], Sb[3]); w.z = pk2(Sb[4], Sb[5]); w.w = pk2(Sb[6], Sb[7]);
          *(u32x4*)(SBt + (size_t)(n0 + 7 - k) * 4096) = w; RET_AXPY(Sb, gb128, v[k]); } }
    VM_WAIT();
    const int tsel = wave >> 1, rbase = 64 * (wave & 1) + tr;
    const bf16* tsrc = (tsel == 0 ? KR : tsel == 1 ? VR : tsel == 2 ? QR : GR) + ((size_t)b * SEQ + rbase) * SEGW + h * HD + tc;
    LAS unsigned char* tdst = lds + tsel * (128 * TP) + rbase * TP + tc * 2;
    const int qb = wave & 3, dvh = wave >> 2;
    bf16x8 pre[8]; u32x4 pkv, psb;
#define RET_PREFETCH(n_) do { _Pragma("unroll") for (int i_ = 0; i_ < 8; ++i_) pre[i_] = *(const bf16x8*)(tsrc + (size_t)((n_) * CHUNK + 8 * i_) * SEGW); \
        pkv = *(const u32x4*)(KVt + (size_t)((n_) * 2) * 4096); psb = *(const u32x4*)(SBt + (size_t)(n_) * 4096); } while (0)
    RET_PREFETCH(n0);
#pragma unroll 1
    for (int jn = 0; jn < 8; ++jn) {
        const int n = n0 + jn; const size_t row0 = (size_t)b * SEQ + n * CHUNK;
        __syncthreads();
        if (jn > 0) {
#pragma unroll
            for (int i = 0; i < 2; ++i) { const int r = 16 * wave + 8 * i + tr; const u32x4 v = *(const LAS u32x4*)(lds + R_O + r * TP + tc * 2);
                *(u32x4*)(MIXED + (row0 - CHUNK + r) * DM + 512 + h * HD + tc) = v; } }
#pragma unroll
        for (int i = 0; i < 8; ++i) *(LAS bf16x8*)(tdst + 8 * i * TP) = pre[i];
        { u32x4 w; w.x = pk2(Sf[0], Sf[1]); w.y = pk2(Sf[2], Sf[3]); w.z = pk2(Sf[4], Sf[5]); w.w = pk2(Sf[6], Sf[7]);
          *(LAS u32x4*)(lds + R_SF + tid * 16) = w; *(LAS u32x4*)(lds + R_SB + tid * 16) = psb; }
        RET_AXPY(Sf, gf128, pkv);
        if (jn < 7) RET_PREFETCH(n + 1);
        float cl[3]; u32x4 ca[3];
#define RET_CLOAD(rw_) do { _Pragma("unroll") for (int br_ = 0; br_ < 3; ++br_) { cl[br_] = LSE[((size_t)br_ * M + (rw_)) * NHEAD + (lane >> 3)]; ca[br_] = *(const u32x4*)(OBR + ((size_t)br_ * M + (rw_)) * SEGW + 8 * lane); } } while (0)
#define RET_CFIN(rw_) do { const float mx_ = fmaxf(cl[0], fmaxf(cl[1], cl[2])); float w0_ = __expf(cl[0] - mx_), w1_ = __expf(cl[1] - mx_), w2_ = __expf(cl[2] - mx_); \
            const float inv_ = 1.f / (w0_ + w1_ + w2_); w0_ *= inv_; w1_ *= inv_; w2_ *= inv_; float o_[8]; float ssq_ = 0.f; \
            _Pragma("unroll") for (int e_ = 0; e_ < 4; ++e_) { o_[2 * e_] = w0_ * bflo(ca[0][e_]) + w1_ * bflo(ca[1][e_]) + w2_ * bflo(ca[2][e_]); o_[2 * e_ + 1] = w0_ * bfhi(ca[0][e_]) + w1_ * bfhi(ca[1][e_]) + w2_ * bfhi(ca[2][e_]); ssq_ += o_[2 * e_] * o_[2 * e_] + o_[2 * e_ + 1] * o_[2 * e_ + 1]; } \
            const float rs_ = 1.f / sqrtf(wave_sum(ssq_) * (1.f / 512.f) + NORM_EPS); \
            u32x4 w_; w_.x = pk2(o_[0] * rs_, o_[1] * rs_); w_.y = pk2(o_[2] * rs_, o_[3] * rs_); w_.z = pk2(o_[4] * rs_, o_[5] * rs_); w_.w = pk2(o_[6] * rs_, o_[7] * rs_); \
            *(u32x4*)(MIXED + (rw_) * DM + 8 * lane) = w_; } while (0)
        if (crow0 >= 0) RET_CLOAD((size_t)crow0 + 2 * jn);
        __syncthreads();
        const int i_ = 32 * qb + q;
        bf16x8 qr[4];
#pragma unroll
        for (int ks = 0; ks < 4; ++ks) qr[ks] = *(const LAS bf16x8*)(lds + R_Q + i_ * TP + hi * 16 + 32 * ks);
        f32x16 ot;
#pragma unroll
        for (int r = 0; r < 16; ++r) ot[r] = 0.f;
        const LAS unsigned char* vr = lds + R_V + (4 * hi + ((lane & 15) >> 2)) * TP + (32 * dvh + 16 * ((lane >> 4) & 1) + 4 * (lane & 3)) * 2;
#pragma unroll 1
        for (int kb = 0; kb < 4; ++kb) {
            f32x16 st;
#pragma unroll
            for (int r = 0; r < 16; ++r) st[r] = 0.f;
#pragma unroll
            for (int ks = 0; ks < 4; ++ks) st = MFMA32(*(const LAS bf16x8*)(lds + R_K + (32 * kb + q) * TP + hi * 16 + 32 * ks), qr[ks], st);
#pragma unroll
            for (int r = 0; r < 16; ++r) st[r] *= (kb == qb ? (q >= crow(r, hi) ? pf[r] : pb[r]) : kb < qb ? pf[r] : pb[r]);
            if (kb != qb) { const float sc = kb < qb ? exp2f((float)(32 * (qb - kb)) * lgf) : exp2f((float)(32 * (kb - qb)) * lgb);
#pragma unroll
                for (int r = 0; r < 16; ++r) st[r] *= sc; }
            const bf16x8 pb0 = pack8(st, 0), pb1 = pack8(st, 1);
            const LAS unsigned char* v0 = vr + 32 * kb * TP;
            ot = MFMA32(cat44(vtr(v0), vtr(v0 + 8 * TP)), pb0, ot);
            ot = MFMA32(cat44(vtr(v0 + 16 * TP), vtr(v0 + 24 * TP)), pb1, ot);
        }
        {   const float cf = exp2f((float)(i_ + 1) * lgf), cb = exp2f((float)(CHUNK - i_) * lgb);
            f32x16 t;
#pragma unroll
            for (int r = 0; r < 16; ++r) t[r] = 0.f;
#pragma unroll
            for (int ks = 0; ks < 4; ++ks) t = MFMA32(*(const LAS bf16x8*)(lds + R_SF + ((dvh * 4 + ks) * 64 + lane) * 16), qr[ks], t);
#pragma unroll
            for (int r = 0; r < 16; ++r) ot[r] += cf * t[r];
#pragma unroll
            for (int r = 0; r < 16; ++r) t[r] = 0.f;
#pragma unroll
            for (int ks = 0; ks < 4; ++ks) t = MFMA32(*(const LAS bf16x8*)(lds + R_SB + ((dvh * 4 + ks) * 64 + lane) * 16), qr[ks], t);
#pragma unroll
            for (int r = 0; r < 16; ++r) ot[r] += cb * t[r]; }
        if (crow0 >= 0) { RET_CFIN((size_t)crow0 + 2 * jn); RET_CLOAD((size_t)crow0 + 2 * jn + 1); }
        float s1 = 0.f, s2 = 0.f;
#pragma unroll
        for (int r = 0; r < 16; ++r) { s1 += ot[r]; s2 += ot[r] * ot[r]; }
        s1 += __shfl_xor(s1, 32); s2 += __shfl_xor(s2, 32);
        if (hi == 0) *(LAS f32x2*)(lds + R_X + (wave * 32 + q) * 8) = (f32x2){s1, s2};
        __syncthreads();
        { const f32x2 p = *(const LAS f32x2*)(lds + R_X + ((wave ^ 4) * 32 + q) * 8); s1 += p.x; s2 += p.y; }
        const float mean = s1 * (1.f / 64.f), var = fmaxf(s2 * (1.f / 64.f) - mean * mean, 0.f), rstd = 1.f / sqrtf(var + NORM_EPS);
        const LAS unsigned char* gp = lds + R_G + i_ * TP + (32 * dvh + 4 * hi) * 2; LAS unsigned char* op = lds + R_O + i_ * TP + (32 * dvh + 4 * hi) * 2;
#pragma unroll
        for (int g = 0; g < 4; ++g) { const u32x2 gg = *(const LAS u32x2*)(gp + 16 * g); u32x2 w;
            w.x = pk2((ot[4 * g] - mean) * rstd * bflo(gg.x), (ot[4 * g + 1] - mean) * rstd * bfhi(gg.x)); w.y = pk2((ot[4 * g + 2] - mean) * rstd * bflo(gg.y), (ot[4 * g + 3] - mean) * rstd * bfhi(gg.y));
            *(LAS u32x2*)(op + 16 * g) = w; }
        if (crow0 >= 0) RET_CFIN((size_t)crow0 + 2 * jn + 1);
    }
#undef RET_CLOAD
#undef RET_CFIN
    __syncthreads();
    { const size_t row0 = (size_t)b * SEQ + (n0 + 7) * CHUNK;
#pragma unroll
      for (int i = 0; i < 2; ++i) { const int r = 16 * wave + 8 * i + tr; const u32x4 v = *(const LAS u32x4*)(lds + R_O + r * TP + tc * 2);
          *(u32x4*)(MIXED + (row0 + r) * DM + 512 + h * HD + tc) = v; } }
    __syncthreads();
#undef RET_AXPY
#undef RET_PREFETCH
}

template <int NR>
__device__ __forceinline__ void combine_rows(const size_t (&rows)[NR], const bf16* OBR, const float* LSE, bf16* MIXED, int lane) {
    const int hh = lane >> 3;
    float l[NR][3]; u32x4 a[NR][3];
#pragma unroll
    for (int k = 0; k < NR; ++k)
#pragma unroll
        for (int br = 0; br < 3; ++br) { l[k][br] = LSE[((size_t)br * M + rows[k]) * NHEAD + hh]; a[k][br] = *(const u32x4*)(OBR + ((size_t)br * M + rows[k]) * SEGW + 8 * lane); }
#pragma unroll
    for (int k = 0; k < NR; ++k) {
        const float mx = fmaxf(l[k][0], fmaxf(l[k][1], l[k][2])); float w0 = __expf(l[k][0] - mx), w1 = __expf(l[k][1] - mx), w2 = __expf(l[k][2] - mx);
        const float inv = 1.f / (w0 + w1 + w2); w0 *= inv; w1 *= inv; w2 *= inv;
        float o[8]; float ss = 0.f;
#pragma unroll
        for (int e = 0; e < 4; ++e) { o[2 * e] = w0 * bflo(a[k][0][e]) + w1 * bflo(a[k][1][e]) + w2 * bflo(a[k][2][e]); o[2 * e + 1] = w0 * bfhi(a[k][0][e]) + w1 * bfhi(a[k][1][e]) + w2 * bfhi(a[k][2][e]); ss += o[2 * e] * o[2 * e] + o[2 * e + 1] * o[2 * e + 1]; }
        const float rstd = 1.f / sqrtf(wave_sum(ss) * (1.f / 512.f) + NORM_EPS);
        u32x4 w; w.x = pk2(o[0] * rstd, o[1] * rstd); w.y = pk2(o[2] * rstd, o[3] * rstd); w.z = pk2(o[4] * rstd, o[5] * rstd); w.w = pk2(o[6] * rstd, o[7] * rstd);
        *(u32x4*)(MIXED + rows[k] * DM + 8 * lane) = w;
    }
}
constexpr int RP = 528;
constexpr int R5_W = 0, R5_A = 2 * 48 * RP, R5_SC = R5_A + 8 * 16 * RP, R5_CNT = R5_SC + 8 * 3200;
__device__ __forceinline__ void route_wg(int wgt, const bf16* HB, const bf16* WR, const float* bg, const float* be, gu32* ctl, int* LIST, float* GATEL, float* RSL, LAS unsigned char* lds, int tid, int wave, int lane) {
    const size_t row0 = (size_t)wgt * 128;
    LAS unsigned* cntL = (LAS unsigned*)(lds + R5_CNT); LAS unsigned* baseL = cntL + 32;
    if (tid < 32) cntL[tid] = 0u;
    u32x4 pw[6], pa[8];
#define R5_PREF(kc) do { _Pragma("unroll") for (int i_ = 0; i_ < 6; ++i_) { const int idx = tid + 512 * i_; pw[i_] = *(const u32x4*)(WR + (size_t)(idx >> 5) * DM + 256 * (kc) + 8 * (idx & 31)); } \
        _Pragma("unroll") for (int i_ = 0; i_ < 8; ++i_) pa[i_] = *(const u32x4*)(HB + (row0 + 16 * wave + 2 * i_ + (lane >> 5)) * DM + 256 * (kc) + 8 * (lane & 31)); } while (0)
    R5_PREF(0);
    f32x4 acc[3]; float ss = 0.f;
#pragma unroll
    for (int c = 0; c < 3; ++c) acc[c] = (f32x4){0.f, 0.f, 0.f, 0.f};
    const LAS unsigned char* Aw = lds + R5_A + wave * 16 * RP;
#pragma unroll 1
    for (int kc = 0; kc < 4; ++kc) {
        __syncthreads();
#pragma unroll
        for (int i = 0; i < 6; ++i) { const int idx = tid + 512 * i; *(LAS u32x4*)(lds + R5_W + (idx >> 5) * RP + (idx & 31) * 16) = pw[i]; }
#pragma unroll
        for (int i = 0; i < 8; ++i) *(LAS u32x4*)(lds + R5_A + (wave * 16 + 2 * i + (lane >> 5)) * RP + (lane & 31) * 16) = pa[i];
        if (kc < 3) R5_PREF(kc + 1);
        __syncthreads();
#pragma unroll
        for (int ks = 0; ks < 8; ++ks) {
            const int ko = (32 * ks + 8 * (lane >> 4)) * 2;
            const bf16x8 a = *(const LAS bf16x8*)(Aw + (lane & 15) * RP + ko);
            { const u32x4 au = __builtin_bit_cast(u32x4, a);
#pragma unroll
              for (int e = 0; e < 4; ++e) { const float lo = bflo(au[e]), hi_ = bfhi(au[e]); ss += lo * lo + hi_ * hi_; } }
#pragma unroll
            for (int c = 0; c < 3; ++c)
#pragma unroll
                for (int p = 0; p < 2; ++p) { const bf16x8 bb = *(const LAS bf16x8*)(lds + R5_W + (p * 48 + 16 * c + (lane & 15)) * RP + ko);
                    acc[c] = __builtin_amdgcn_mfma_f32_16x16x32_bf16(a, bb, acc[c], 0, 0, 0); }
        }
    }
#undef R5_PREF
    ss += __shfl_xor(ss, 16); ss += __shfl_xor(ss, 32);
    const float rstd = 1.f / sqrtf(ss * (1.f / DM) + NORM_EPS);
    LAS float* sc = (LAS float*)(lds + R5_SC + wave * 3200);
    { const int r = lane & 15, g = lane >> 4;
#pragma unroll
      for (int e = 0; e < 4; ++e) { sc[(4 * g + e) * 48 + r] = acc[0][e]; sc[(4 * g + e) * 48 + 16 + r] = acc[1][e]; sc[(4 * g + e) * 48 + 32 + r] = acc[2][e]; }
      if (g == 0) sc[768 + r] = rstd; }
    LDS_WAIT(); asm volatile("" ::: "memory");
    int e1 = 0, e2 = 0; unsigned r1 = 0, r2 = 0; float g1 = 0.f, g2 = 0.f, rs = 0.f;
    if (lane < 16) {
        rs = sc[768 + lane]; const LAS float* lg = sc + lane * 48;
        float gmax = lg[32] * rs + bg[0]; int gi = 0; float gl[4]; gl[0] = gmax;
#pragma unroll
        for (int k = 1; k < 4; ++k) { gl[k] = lg[32 + k] * rs + bg[k]; if (gl[k] > gmax) { gmax = gl[k]; gi = k; } }
        float den = 0.f;
#pragma unroll
        for (int k = 0; k < 4; ++k) den += __expf(gl[k] - gmax);
        const float ggate = 1.f / den;
        float b1v = -3.0e38f, b2v = -3.0e38f; int i1 = 0, i2 = 0;
        for (int k = 0; k < 8; ++k) { const float v = lg[gi * 8 + k] * rs + be[gi * 8 + k]; if (v > b1v) { b1v = v; i1 = k; } }
        for (int k = 0; k < 8; ++k) { const float v = lg[gi * 8 + k] * rs + be[gi * 8 + k]; if (k != i1 && v > b2v) { b2v = v; i2 = k; } }
        const float p1 = 1.f / (1.f + __expf(b2v - b1v));
        g1 = ggate * p1; g2 = ggate * (1.f - p1); e1 = gi * 8 + i1; e2 = gi * 8 + i2;
        r1 = __hip_atomic_fetch_add(cntL + e1, 1u, __ATOMIC_RELAXED, __HIP_MEMORY_SCOPE_WORKGROUP); r2 = __hip_atomic_fetch_add(cntL + e2, 1u, __ATOMIC_RELAXED, __HIP_MEMORY_SCOPE_WORKGROUP);
    }
    __syncthreads();
    if (tid < 32) { const unsigned c = cntL[tid]; baseL[tid] = c ? __hip_atomic_fetch_add(ctl + CW_CNT + 64 * tid, c, RLX_AGENT) : 0u; }
    __syncthreads();
    if (lane < 16) {
        const size_t trow = row0 + 16 * wave + lane; const size_t s1 = (size_t)e1 * M + baseL[e1] + r1, s2 = (size_t)e2 * M + baseL[e2] + r2;
        LIST[s1] = (int)(trow * 2); GATEL[s1] = g1; RSL[s1] = rs;
        LIST[s2] = (int)(trow * 2 + 1); GATEL[s2] = g2; RSL[s2] = rs;
    }
    __syncthreads();
}
template <int NR>
__device__ __forceinline__ void final_rows(const size_t (&rows)[NR], const bf16* H, const bf16* Y, const f32x4 (&gv)[4], float* out, int lane) {
    u32x2 hv[NR][4], a[NR][4], b[NR][4];
#pragma unroll
    for (int k = 0; k < NR; ++k) { const u32x2* hp = (const u32x2*)(H + rows[k] * DM) + lane; const u32x2* y0 = (const u32x2*)(Y + (rows[k] * 2) * DM) + lane; const u32x2* y1 = (const u32x2*)(Y + (rows[k] * 2 + 1) * DM) + lane;
#pragma unroll
        for (int j = 0; j < 4; ++j) { hv[k][j] = hp[64 * j]; a[k][j] = y0[64 * j]; b[k][j] = y1[64 * j]; } }
#pragma unroll
    for (int k = 0; k < NR; ++k) { f32x4 z[4]; float ss = 0.f;
#pragma unroll
        for (int j = 0; j < 4; ++j) {
            z[j][0] = bflo(hv[k][j].x) + bflo(a[k][j].x) + bflo(b[k][j].x); z[j][1] = bfhi(hv[k][j].x) + bfhi(a[k][j].x) + bfhi(b[k][j].x); z[j][2] = bflo(hv[k][j].y) + bflo(a[k][j].y) + bflo(b[k][j].y); z[j][3] = bfhi(hv[k][j].y) + bfhi(a[k][j].y) + bfhi(b[k][j].y);
            ss += (z[j][0] * z[j][0] + z[j][1] * z[j][1]) + (z[j][2] * z[j][2] + z[j][3] * z[j][3]); }
        const float rstd = 1.f / sqrtf(wave_sum(ss) * (1.f / DM) + NORM_EPS);
        f32x4* op = (f32x4*)(out + rows[k] * DM) + lane;
#pragma unroll
        for (int j = 0; j < 4; ++j) op[64 * j] = z[j] * rstd * gv[j]; }
}
__device__ __forceinline__ TileTab build_tiles(Frame& F, int& ntiles) {
    LAS int* T = (LAS int*)(F.lds + TILE_OFF); LAS int* TE = T; LAS int* NE = T + MAXTILES; LAS int* T0 = NE + 32; LAS int* NT = T0 + 32;
    __syncthreads();
    if (F.tid == 0) { int t = 0;
        for (int e = 0; e < NEXP; ++e) { int n = (int)__hip_atomic_load(F.ctl + CW_CNT + 64 * e, RLX_AGENT); if (n > M) n = M; NE[e] = n; T0[e] = t; const int k = (n + 255) >> 8;
            for (int j = 0; j < k && t + j < MAXTILES; ++j) TE[t + j] = e; t += k; if (t > MAXTILES) t = MAXTILES; }
        NT[0] = t; }
    __syncthreads();
    ntiles = NT[0];
    TileTab tt; tt.TE = TE; tt.NE = NE; tt.T0 = T0; return tt;
}

__device__ __forceinline__ int fresh_lane() { int t = threadIdx.x; asm volatile("" : "+v"(t)); return t & 63; }
constexpr int N_LAUNCHES = MK_N_LAUNCHES, PER_PHASE = 9;
__global__ void __launch_bounds__(NWAVES * 64, 2) mk_fwd(Args args) {
    extern __shared__ __attribute__((aligned(16))) unsigned char lds_raw[];
    Frame F;
    F.lds = (LAS unsigned char*)lds_raw;
    F.MISC = (volatile LAS unsigned*)(F.lds + MISC_OFF);
    F.tid = threadIdx.x; F.lane = F.tid & 63; F.wave = __builtin_amdgcn_readfirstlane(F.tid >> 6);
    F.G = gridDim.x; { const int bx = blockIdx.x; F.vcu = (F.G % 8 == 0) ? (bx % 8) * (F.G / 8) + bx / 8 : bx; }
    unsigned char* ws = args.ws;
    F.ctl = (gu32*)(ws + WS_CTL);
    for (int u = F.tid; u < (LDS_BYTES - LDSCTL_OFF) / 4; u += NWAVES * 64) ((LAS unsigned*)(F.lds + LDSCTL_OFF))[u] = 0u;
    __syncthreads();
    XcdBarrier bar; bar.bar = (unsigned*)(F.ctl + CW_BAR); bar.x = 0; bar.st = nullptr;
    if (N_LAUNCHES != PER_PHASE) bar = xcd_barrier_post((unsigned*)(F.ctl + CW_BAR) + args.li * XCD_BAR_WORDS, F.MISC + 8);
#define GRID_BAR() do { if (N_LAUNCHES != PER_PHASE) xcd_barrier(bar); } while (0)
    const int lo = args.ph_lo, hi = args.ph_hi;
#define IN(k) (lo <= (k) && (k) < hi)
#define REPS(k) ((MK_REPEAT == (k)) ? MK_NREP : 1)
#define BOTH(k) (IN(k) && IN((k) + 1))
    const int gw = F.vcu * NWAVES + F.wave, NGW = F.G * NWAVES;
#if MK_TIME
    int n_stamp = 0;
#define STAMP() do { if (blockIdx.x == 0 && F.tid == 0) { const unsigned long long t_ = __builtin_amdgcn_s_memrealtime(); __hip_atomic_store(F.ctl + CW_TS + 2 * n_stamp, (unsigned)t_, RLX_AGENT); __hip_atomic_store(F.ctl + CW_TS + 2 * n_stamp + 1, (unsigned)(t_ >> 32), RLX_AGENT); } ++n_stamp; } while (0)
    STAMP();
#else
#define STAMP() do {} while (0)
#endif
    bf16* SEGB = (bf16*)(ws + WS_SEG);
    const bf16 *QA = SEGB, *KA = SEGB + (size_t)1 * M * SEGW, *VA = SEGB + (size_t)2 * M * SEGW, *QR = SEGB + (size_t)3 * M * SEGW, *KR = SEGB + (size_t)4 * M * SEGW, *VR = SEGB + (size_t)5 * M * SEGW, *GR = SEGB + (size_t)6 * M * SEGW;

    for (int rep_ = 0; rep_ < REPS(0); ++rep_) if (IN(0)) { p0_prologue(F, args); if (BOTH(0)) GRID_BAR(); STAMP(); }
    for (int rep_ = 0; rep_ < REPS(1); ++rep_) if (IN(1)) {
        const int bx = (int)blockIdx.x, rowg = bx >> 3; const bool split = (F.G == 256), conv = split && ((rowg & 7) == 7);
        if (conv) {
            expert_items(args, ws, (LAS float*)(F.lds + F.wave * 16384), 0, N_CONV_P1, (((rowg >> 3) << 3) + (bx & 7)) * NWAVES + F.wave, 32 * NWAVES, fresh_lane());
        } else {
            pg8::StaticOrder S; if (split) S.init(M / 256, NIN / 256, 224, (rowg - ((rowg + 1) >> 3)) * 8 + (bx & 7)); else S.init(M / 256, NIN / 256, F.G, bx);
            SrcPlain SRC{(const bf16*)(ws + WS_XN), (const bf16*)(ws + WS_WIN), DM};
            EpiInProj E{SEGB, (const float*)(ws + WS_ROPE), (const float*)(ws + WS_ROPE) + SEQ * 40};
            pg8::gemm_phase<EpiInProj, pg8::StaticOrder, SrcPlain, true, true>(F.lds, DM, S, SRC, E);
        }
        if (BOTH(1)) GRID_BAR(); STAMP();
    }
    for (int rep_ = 0; rep_ < REPS(2); ++rep_) if (IN(2)) {
        bf16* OBR = (bf16*)(ws + WS_OBR); float* LSE = (float*)(ws + WS_LSE); bf16* KVB = (bf16*)(ws + WS_ST);
        for (int cid = gw; cid < NBATCH * NHEAD * NCHUNK; cid += NGW) kv_task(cid, KR, VR, KVB, args.in[4], args.in[5], F.lds + F.wave * 16384, fresh_lane());
        { const int nrt = NBATCH * NHEAD * 48, per = (nrt + F.G - 1) / F.G, r0 = F.vcu * per, nr = r0 + per <= nrt ? per : (nrt > r0 ? nrt - r0 : 0);
          __syncthreads();
          if (F.G == 256) attn_rounds((F.vcu >> 5) * 8, F.vcu & 31, 12, QA, KA, VA, OBR, LSE, F.lds, F.wave, fresh_lane());
          else if (nr > 0) attn_rounds(r0, -1, nr, QA, KA, VA, OBR, LSE, F.lds, F.wave, fresh_lane()); }
        if (BOTH(2)) GRID_BAR(); STAMP();
    }
    for (int rep_ = 0; rep_ < REPS(3); ++rep_) if (IN(3)) {
        bf16* MIXED = (bf16*)(ws + WS_MIXED);
        const bool fold = (F.G == 256);
        for (int wgt = F.vcu; wgt < NBATCH * NHEAD * 4; wgt += F.G) { int t_ = threadIdx.x; asm volatile("" : "+v"(t_));
            ret_wg(wgt, QR, KR, VR, GR, (const bf16*)(ws + WS_ST), (bf16*)(ws + WS_SBW), MIXED, args.in[4], args.in[5], (const bf16*)(ws + WS_OBR), (const float*)(ws + WS_LSE),
                   fold ? (long)wgt * 128 + F.wave * 16 : -1L, F.lds, t_, F.wave, t_ & 63); }
        if (!fold) { const int ln = fresh_lane();
          for (int row = gw; row < M; row += 4 * NGW) { const size_t rows[4] = {(size_t)row, (size_t)(row + NGW), (size_t)(row + 2 * NGW), (size_t)(row + 3 * NGW)};
              combine_rows<4>(rows, (const bf16*)(ws + WS_OBR), (const float*)(ws + WS_LSE), MIXED, ln); } }
        if (BOTH(3)) GRID_BAR(); STAMP();
    }
    for (int rep_ = 0; rep_ < REPS(4); ++rep_) if (IN(4)) {
        pg8::StaticOrder S; S.init(M / 256, DM / 256, F.G, (int)blockIdx.x);
        SrcPlain SRC{(const bf16*)(ws + WS_MIXED), (const bf16*)(ws + WS_WOUT), DM};
        EpiOutProj E{args.in[0], (bf16*)(ws + WS_HG)};
        pg8::gemm_phase<EpiOutProj, pg8::StaticOrder, SrcPlain, true, true>(F.lds, DM, S, SRC, E);
        if (BOTH(4)) GRID_BAR(); STAMP();
    }
    for (int rep_ = 0; rep_ < REPS(5); ++rep_) if (IN(5)) {
        if (rep_ > 0) { if (blockIdx.x == 0 && F.tid < NEXP) __hip_atomic_store(F.ctl + CW_CNT + 64 * F.tid, 0u, RLX_AGENT); GRID_BAR(); }
        for (int wgt = F.vcu; wgt < M / 128; wgt += F.G) { int t_ = threadIdx.x; asm volatile("" : "+v"(t_));
            route_wg(wgt, (const bf16*)(ws + WS_HG), (const bf16*)(ws + WS_WRT), args.in[10], args.in[12], F.ctl, (int*)(ws + WS_LIST), (float*)(ws + WS_GATEL), (float*)(ws + WS_RSL), F.lds, t_, F.wave, t_ & 63); }
        if (BOTH(5)) GRID_BAR(); STAMP();
    }
    for (int rep_ = 0; rep_ < REPS(6); ++rep_) if (IN(6)) {
        int ntiles; const TileTab tt = build_tiles(F, ntiles);
        pg8::StaticOrder S; S.init(ntiles, 4, F.G, (int)blockIdx.x);
        SrcGather SRC{(const bf16*)(ws + WS_HG), (const bf16*)(ws + WS_WGU), (const int*)(ws + WS_LIST), tt};
        EpiGateUp E{(bf16*)(ws + WS_HID), (const float*)(ws + WS_GATEL), (const float*)(ws + WS_RSL), tt};
        pg8::gemm_phase<EpiGateUp, pg8::StaticOrder, SrcGather, true, true>(F.lds, DM, S, SRC, E);
        if (BOTH(6)) GRID_BAR(); STAMP();
    }
    for (int rep_ = 0; rep_ < REPS(7); ++rep_) if (IN(7)) {
        int ntiles; const TileTab tt = build_tiles(F, ntiles);
        pg8::StaticOrder S; S.init(ntiles, 4, F.G, (int)blockIdx.x);
        SrcDown SRC{(const bf16*)(ws + WS_HID), (const bf16*)(ws + WS_WD), tt};
        EpiDown E{(bf16*)(ws + WS_Y), (const int*)(ws + WS_LIST), tt};
        pg8::gemm_phase<EpiDown, pg8::StaticOrder, SrcDown, true, true>(F.lds, FF, S, SRC, E);
        if (BOTH(7)) GRID_BAR(); STAMP();
    }
    for (int rep_ = 0; rep_ < REPS(8); ++rep_) if (IN(8)) {
        f32x4 gv[4];
#pragma unroll
        for (int j = 0; j < 4; ++j) gv[j] = ((const f32x4*)args.in[16])[fresh_lane() + 64 * j];
        { const int ln = fresh_lane();
          for (int row = gw; row < M; row += 2 * NGW) { const size_t rows[2] = {(size_t)row, (size_t)(row + NGW)}; final_rows<2>(rows, (const bf16*)(ws + WS_HG), (const bf16*)(ws + WS_Y), gv, args.out, ln); } }
#if MK_TIME
        STAMP();
        if (blockIdx.x == 0 && F.tid == 0) {
            unsigned long long ts[10];
#pragma unroll
            for (int k = 0; k < 10; ++k) ts[k] = (unsigned long long)__hip_atomic_load(F.ctl + CW_TS + 2 * k, RLX_AGENT) | ((unsigned long long)__hip_atomic_load(F.ctl + CW_TS + 2 * k + 1, RLX_AGENT) << 32);
            const float t = MK_TIME == 10 ? (float)(ts[9] - ts[0]) * 0.01f : (float)(ts[MK_TIME] - ts[MK_TIME - 1]) * 0.01f;
            VM_WAIT(); args.out[0] = t * MK_TSCALE; }
#endif
    }
#undef IN
#undef BOTH
#undef GRID_BAR
}

#if MK_CHECK
__device__ __forceinline__ unsigned hsh(unsigned x) { x ^= x >> 16; x *= 0x7feb352dU; x ^= x >> 15; x *= 0x846ca68bU; x ^= x >> 16; return x; }
__device__ __forceinline__ float ldb(const bf16* p, size_t i) { return __uint_as_float(((unsigned)p[i]) << 16); }
__device__ __forceinline__ float rbf(float x) { return bflo(pk2(x, 0.f) & 0xffffu); }
__device__ __forceinline__ void chk_put(gu32* ctl, int stage, float got, float ref, float atol) {
    float e = fabsf(got - ref) / (0.03f * fabsf(ref) + atol); if (!(e == e)) e = 1e30f; if (e > 1e30f) e = 1e30f;
    __hip_atomic_fetch_max(ctl + CW_CHK + stage, __float_as_uint(e), RLX_AGENT);
}
__global__ void __launch_bounds__(256) chk_kernel(Args A, int stage) {
    unsigned char* ws = A.ws; gu32* ctl = (gu32*)(ws + WS_CTL);
    const int gt = blockIdx.x * 256 + threadIdx.x, NT = gridDim.x * 256;
    const bf16* SEGB = (const bf16*)(ws + WS_SEG);
    const bf16 *QA = SEGB, *KA = SEGB + (size_t)1 * M * SEGW, *VA = SEGB + (size_t)2 * M * SEGW, *QR = SEGB + (size_t)3 * M * SEGW, *KR = SEGB + (size_t)4 * M * SEGW, *VR = SEGB + (size_t)5 * M * SEGW, *GR = SEGB + (size_t)6 * M * SEGW;
    if (stage == 0) {
        const bf16* WIN = (const bf16*)(ws + WS_WIN); const bf16* WOUT = (const bf16*)(ws + WS_WOUT); const bf16* WGU = (const bf16*)(ws + WS_WGU); const bf16* WD = (const bf16*)(ws + WS_WD);
        for (int s = gt; s < 65536; s += NT) { const unsigned r = hsh(s * 7 + 1), r2 = hsh(r);
            { const int n = r % NIN, k = r2 % DM; chk_put(ctl, 0, ldb(WIN, (size_t)winperm(n) * DM + k), A.in[2][(size_t)k * NIN + n], 1e-4f); }
            { const int n = r % DM, k = r2 % DM; chk_put(ctl, 0, ldb(WOUT, (size_t)n * DM + k), A.in[7][(size_t)k * DM + n] * (k < 512 ? A.in[3][k] : A.in[6][k - 512]), 1e-4f); }
            { const int e = (r >> 10) % NEXP, j = r % FF, k = r2 % DM;
              chk_put(ctl, 0, ldb(WGU, ((size_t)e * DM + ((j >> 7) << 8) + (j & 127)) * DM + k), A.in[13][((size_t)e * DM + k) * FF + j] * A.in[8][k], 1e-4f);
              chk_put(ctl, 0, ldb(WGU, ((size_t)e * DM + ((j >> 7) << 8) + 128 + (j & 127)) * DM + k), A.in[14][((size_t)e * DM + k) * FF + j] * A.in[8][k], 1e-4f); }
            { const int e = (r >> 10) % NEXP, n = r % DM, k = r2 % FF; chk_put(ctl, 0, ldb(WD, ((size_t)e * DM + n) * FF + k), A.in[15][((size_t)e * FF + k) * DM + n], 1e-4f); }
            { const int j = r % 36, i = r2 % DM; const float ref = (j < 32 ? A.in[11][i * 32 + j] : A.in[9][i * 4 + j - 32]) * A.in[8][i]; chk_put(ctl, 0, 1000.f * (ldb((const bf16*)(ws + WS_WRT), j * DM + i) + ldb((const bf16*)(ws + WS_WRT), (48 + j) * DM + i)), 1000.f * ref, 1e-3f); }
            { const int pos = r % SEQ, f = r2 % 40; const float fr = f < 8 ? powf(500000.f, -(float)f / 8.f) : powf(10000.f, -(float)(f - 8) / 31.f); const float ang = (float)pos * fr;
              chk_put(ctl, 0, ((const float*)(ws + WS_ROPE))[pos * 40 + f], cosf(ang), 2e-3f); chk_put(ctl, 0, ((const float*)(ws + WS_ROPE))[SEQ * 40 + pos * 40 + f], sinf(ang), 2e-3f); }
        }
        for (int s = gt; s < 2048; s += NT) { const unsigned r = hsh(s * 13 + 5); const int row = r % M, c = hsh(r) % DM; const float* x = A.in[0] + (size_t)row * DM; float ss = 0.f;
            for (int k = 0; k < DM; ++k) ss += x[k] * x[k];
            chk_put(ctl, 0, ldb((const bf16*)(ws + WS_XN), (size_t)row * DM + c), x[c] / sqrtf(ss / DM + NORM_EPS) * A.in[1][c], 1e-3f); }
    }
    if (stage == 1) {
        const bf16* XN = (const bf16*)(ws + WS_XN);
        for (int s = gt; s < 8192; s += NT) { const unsigned r = hsh(s * 3 + 11), r2 = hsh(r); const int row = r % M, seg = r2 % 7, hh = (r2 >> 4) % 8, pos = row & (SEQ - 1);
            const int half = (seg == 0 || seg == 1) ? 8 : 32; const int i = (r2 >> 8) % half; const int d1 = i, d2 = i + half;
            float a1 = 0.f, a2 = 0.f; const float* w = A.in[2] + seg * 512 + hh * 64;
            for (int k = 0; k < DM; ++k) { const float xv = ldb(XN, (size_t)row * DM + k); a1 += xv * rbf(w[(size_t)k * NIN + d1]); a2 += xv * rbf(w[(size_t)k * NIN + d2]); }
            const bf16* O = SEGB + (size_t)seg * M * SEGW + (size_t)row * SEGW + hh * 64;
            if (seg == 0 || seg == 1 || seg == 3 || seg == 4) {
                const float fr = seg < 2 ? powf(500000.f, -(float)i / 8.f) : powf(10000.f, -(float)i / 31.f); const float ang = (float)pos * fr, c = cosf(ang), sn = sinf(ang);
                const float sc = seg == 0 ? 0.125f * LOG2E : (seg == 4 ? 0.125f : 1.f);
                chk_put(ctl, 1, ldb(O, 2 * i), (a1 * c - a2 * sn) * sc, 0.02f); chk_put(ctl, 1, ldb(O, 2 * i + 1), (a2 * c + a1 * sn) * sc, 0.02f);
                if (seg < 2) { const int d3 = 16 + (r2 >> 12) % 48; float a3 = 0.f; for (int k = 0; k < DM; ++k) a3 += ldb(XN, (size_t)row * DM + k) * rbf(w[(size_t)k * NIN + d3]); chk_put(ctl, 1, ldb(O, d3), a3 * sc, 0.02f); }
            } else { chk_put(ctl, 1, ldb(O, d1), seg == 6 ? silu_f(a1) : a1, 0.02f); chk_put(ctl, 1, ldb(O, d2), seg == 6 ? silu_f(a2) : a2, 0.02f); }
        }
    }
    if (stage == 2) {
        const bf16* OBR = (const bf16*)(ws + WS_OBR); const float* LSE = (const float*)(ws + WS_LSE); const bf16* ST = (const bf16*)(ws + WS_ST);
        for (int s = gt; s < 4096; s += NT) { const unsigned r = hsh(s * 5 + 3), r2 = hsh(r); const int b = r % NBATCH, pos = (s < 256) ? (s & 1 ? SEQ - 1 - (s >> 1) % 80 : (s >> 1) % 80) : (r >> 3) % SEQ, h = r2 % NHEAD, br = (r2 >> 3) % 3, dd = (r2 >> 8) % HD;
            const int dil = 1 << (2 * br); const size_t row = (size_t)b * SEQ + pos;
            float mx = -1e30f;
            for (int pass = 0; pass < 2; ++pass) { float l = 0.f, o = 0.f;
                for (int j = -64; j <= 64; ++j) { const int kp = pos + j * dil; if (kp < 0 || kp >= SEQ) continue; const size_t kr = (size_t)b * SEQ + kp; float d = 0.f;
                    for (int k = 0; k < HD; ++k) d += ldb(QA, row * SEGW + h * HD + k) * ldb(KA, kr * SEGW + h * HD + k);
                    if (pass == 0) mx = fmaxf(mx, d); else { const float p = exp2f(d - mx); l += p; o += p * ldb(VA, kr * SEGW + h * HD + dd); } }
                if (pass == 1) { chk_put(ctl, 2, ldb(OBR, ((size_t)br * M + row) * SEGW + h * HD + dd), o / l, 0.02f); chk_put(ctl, 2, LSE[((size_t)br * M + row) * NHEAD + h], (mx + log2f(l)) * LN2, 0.02f); } }
        }
        for (int s = gt; s < 8192; s += NT) { const unsigned r = hsh(s * 9 + 7), r2 = hsh(r); const int bh = r % 64, dir = (r >> 6) & 1, n = (r >> 7) % NCHUNK, dv = r2 % 64, dk = (r2 >> 6) % 64, b = bh >> 3, h = bh & 7;
            const float lg2 = log1pf(-exp2f((dir ? A.in[5] : A.in[4])[h])) * LOG2E; float S = 0.f;
            for (int j = 0; j < CHUNK; ++j) { const size_t row = (size_t)b * SEQ + n * CHUNK + j; const float ex = dir == 0 ? (float)(127 - j) : (float)j;
                S += exp2f(ex * lg2) * ldb(KR, row * SEGW + h * HD + dk) * ldb(VR, row * SEGW + h * HD + dv); }
            chk_put(ctl, 2, ldb(ST, (((size_t)bh * NCHUNK + n) * 2 + dir) * 4096 + ((size_t)((dv >> 5) * 4 + (dk >> 4)) * 64 + (dv & 31) + 32 * ((dk >> 3) & 1)) * 8 + (dk & 7)), S, 0.05f);
        }
    }
    if (stage == 3) {
        const bf16* MIXED = (const bf16*)(ws + WS_MIXED);
        for (int s = gt; s < 512; s += NT) { const unsigned r = hsh(s * 17 + 9), r2 = hsh(r); const int b = r % NBATCH, pos = (s < 64) ? (s & 1 ? SEQ - 1 - (s >> 1) * 5 : (s >> 1) * 5) : (r >> 3) % SEQ, h = r2 % NHEAD; const size_t row = (size_t)b * SEQ + pos;
            const float lgf = log1pf(-exp2f(A.in[4][h])) * LOG2E, lgb = log1pf(-exp2f(A.in[5][h])) * LOG2E;
            float o[HD], qv[HD];
#pragma unroll
            for (int k = 0; k < HD; ++k) { o[k] = 0.f; qv[k] = ldb(QR, row * SEGW + h * HD + k); }
            for (int kp = 0; kp < SEQ; ++kp) { const size_t kr = (size_t)b * SEQ + kp; const int dl = pos - kp; const float w = dl >= 0 ? exp2f((float)dl * lgf) : exp2f((float)(-dl) * lgb); if (w < 1e-12f) continue; float d = 0.f;
#pragma unroll
                for (int k = 0; k < HD; ++k) d += qv[k] * ldb(KR, kr * SEGW + h * HD + k);
                d *= w;
#pragma unroll
                for (int k = 0; k < HD; ++k) o[k] += d * ldb(VR, kr * SEGW + h * HD + k); }
            float mean = 0.f, var = 0.f;
#pragma unroll
            for (int k = 0; k < HD; ++k) mean += o[k];
            mean *= (1.f / HD);
#pragma unroll
            for (int k = 0; k < HD; ++k) var += (o[k] - mean) * (o[k] - mean);
            var *= (1.f / HD); const float rstd = 1.f / sqrtf(var + NORM_EPS);
#pragma unroll
            for (int k = 0; k < HD; ++k) if ((k & 7) == (int)(r2 >> 8) % 8) chk_put(ctl, 3, ldb(MIXED, row * DM + 512 + h * HD + k), (o[k] - mean) * rstd * ldb(GR, row * SEGW + h * HD + k), 0.03f);
        }
        {
            const bf16* OBR = (const bf16*)(ws + WS_OBR); const float* LSE = (const float*)(ws + WS_LSE);
            for (int s = gt; s < 4096; s += NT) { const unsigned r = hsh(s * 19 + 1), r2 = hsh(r); const int row = r % M, csel = r2 % 512; float ss = 0.f, osel = 0.f;
                for (int c = 0; c < 512; ++c) { const int h = c >> 6; const float l0 = LSE[((size_t)0 * M + row) * NHEAD + h], l1 = LSE[((size_t)1 * M + row) * NHEAD + h], l2 = LSE[((size_t)2 * M + row) * NHEAD + h];
                    const float mx = fmaxf(l0, fmaxf(l1, l2)), w0 = expf(l0 - mx), w1 = expf(l1 - mx), w2 = expf(l2 - mx);
                    const float o = (w0 * ldb(OBR, ((size_t)0 * M + row) * SEGW + c) + w1 * ldb(OBR, ((size_t)1 * M + row) * SEGW + c) + w2 * ldb(OBR, ((size_t)2 * M + row) * SEGW + c)) / (w0 + w1 + w2);
                    ss += o * o; if (c == csel) osel = o; }
                chk_put(ctl, 3, ldb(MIXED, (size_t)row * DM + csel), osel / sqrtf(ss / 512.f + NORM_EPS), 0.03f); }
        }
    }
    if (stage == 4) {
        const bf16* MIXED = (const bf16*)(ws + WS_MIXED); const bf16* WOUT = (const bf16*)(ws + WS_WOUT); const float* H = (const float*)(ws + WS_H); const bf16* HG = (const bf16*)(ws + WS_HG);
        for (int s = gt; s < 16384; s += NT) { const unsigned r = hsh(s * 23 + 3); const int row = r % M, c = hsh(r) % DM; float a = 0.f;
            for (int k = 0; k < DM; ++k) a += ldb(MIXED, (size_t)row * DM + k) * ldb(WOUT, (size_t)c * DM + k);
            const float h = a + A.in[0][(size_t)row * DM + c]; chk_put(ctl, 4, ldb(HG, (size_t)row * DM + c), h, 0.02f); (void)H; }
    }
    if (stage == 5) {
        const float* H = (const float*)(ws + WS_H); const int* LIST = (const int*)(ws + WS_LIST); const float* GATEL = (const float*)(ws + WS_GATEL); const float* RSL = (const float*)(ws + WS_RSL);
        if (gt == 0) { unsigned tot = 0; for (int e = 0; e < NEXP; ++e) tot += ctl[CW_CNT + 64 * e]; chk_put(ctl, 5, (float)tot, (float)(2 * M), 0.5f); }
        const bf16* HBc = (const bf16*)(ws + WS_HG); (void)H;
        for (int s = gt; s < 2048; s += NT) { const int t = hsh(s * 29 + 5) % M; const bf16* h_ = HBc + (size_t)t * DM; float ss = 0.f;
#define h_AT(k) ldb(h_, (k))
            for (int k = 0; k < DM; ++k) ss += h_AT(k) * h_AT(k);
            const float rs = 1.f / sqrtf(ss / DM + NORM_EPS); float gl[4]; int gi = 0;
            for (int g = 0; g < 4; ++g) { float a = 0.f; for (int k = 0; k < DM; ++k) a += h_AT(k) * rs * A.in[8][k] * A.in[9][k * 4 + g]; gl[g] = a + A.in[10][g]; if (gl[g] > gl[gi]) gi = g; }
            float den = 0.f; for (int g = 0; g < 4; ++g) den += expf(gl[g] - gl[gi]);
            float b1 = -3e38f, b2 = -3e38f, b3 = -3e38f; int i1 = 0, i2 = 0;
            for (int e = 0; e < 8; ++e) { float a = 0.f; for (int k = 0; k < DM; ++k) a += h_AT(k) * rs * A.in[8][k] * A.in[11][k * 32 + gi * 8 + e]; a += A.in[12][gi * 8 + e];
                if (a > b1) { b3 = b2; b2 = b1; i2 = i1; b1 = a; i1 = e; } else if (a > b2) { b3 = b2; b2 = a; i2 = e; } else if (a > b3) b3 = a; }
            float second = -3e38f; for (int g = 0; g < 4; ++g) if (g != gi) second = fmaxf(second, gl[g]);
            if (gl[gi] - second < 1e-3f || b2 - b3 < 1e-3f || b1 - b2 < 1e-3f) continue;
            const float p1 = 1.f / (1.f + expf(b2 - b1)); const float g1 = p1 / den, g2 = (1.f - p1) / den;
            for (int k = 0; k < 2; ++k) { const int e = gi * 8 + (k ? i2 : i1); const int n = (int)ctl[CW_CNT + 64 * e]; int found = -1;
                for (int p = 0; p < n && p < M; ++p) if (LIST[(size_t)e * M + p] == t * 2 + k) { found = p; break; }
                if (found < 0) chk_put(ctl, 5, 0.f, 100.f, 0.1f); else { chk_put(ctl, 5, GATEL[(size_t)e * M + found], k ? g2 : g1, 1e-3f); chk_put(ctl, 5, RSL[(size_t)e * M + found], rs, 1e-4f); } }
        }
    }
    if (stage == 6 || stage == 7) {
        const int* LIST = (const int*)(ws + WS_LIST); const float* GATEL = (const float*)(ws + WS_GATEL); const float* RSL = (const float*)(ws + WS_RSL);
        const bf16* HG = (const bf16*)(ws + WS_HG); const bf16* WGU = (const bf16*)(ws + WS_WGU); const bf16* HID = (const bf16*)(ws + WS_HID); const bf16* WD = (const bf16*)(ws + WS_WD); const bf16* Y = (const bf16*)(ws + WS_Y);
        for (int s = gt; s < 8192; s += NT) { const unsigned r = hsh(s * 31 + 7), r2 = hsh(r); const int e = r % NEXP; const int ne = (int)ctl[CW_CNT + 64 * e]; if (ne <= 0) continue;
            int t0 = 0; for (int q = 0; q < e; ++q) t0 += ((int)ctl[CW_CNT + 64 * q] + 255) >> 8;
            const int pos = (s & 3) == 0 ? ne - 1 - (int)((r >> 5) % (ne < 300 ? ne : 300)) : (int)((r >> 5) % ne); const size_t slot = (size_t)t0 * 256 + pos; const int tk = LIST[(size_t)e * M + pos], t = tk >> 1;
            if (stage == 6) { const int j = r2 % FF; float g = 0.f, u = 0.f; const bf16* wg = WGU + ((size_t)e * DM + ((j >> 7) << 8) + (j & 127)) * DM; const bf16* wu = wg + (size_t)128 * DM;
                for (int k = 0; k < DM; ++k) { const float xv = ldb(HG, (size_t)t * DM + k); g += xv * ldb(wg, k); u += xv * ldb(wu, k); }
                const float rs = RSL[(size_t)e * M + pos]; chk_put(ctl, 6, ldb(HID, slot * FF + j), silu_f(g * rs) * (u * rs) * GATEL[(size_t)e * M + pos], 0.01f); }
            else { const int c = r2 % DM; float a = 0.f; for (int k = 0; k < FF; ++k) a += ldb(HID, slot * FF + k) * ldb(WD, ((size_t)e * DM + c) * FF + k);
                chk_put(ctl, 7, ldb(Y, (size_t)tk * DM + c), a, 0.01f); }
        }
    }
    if (stage == 8) {
        const float* H = (const float*)(ws + WS_H); const bf16* Y = (const bf16*)(ws + WS_Y);
        for (int s = gt; s < 4096; s += NT) { const unsigned r = hsh(s * 37 + 1); const int row = r % M, c = hsh(r) % DM; float ss = 0.f, zc = 0.f;
            for (int k = 0; k < DM; ++k) { const float z = ldb((const bf16*)(ws + WS_HG), (size_t)row * DM + k) + ldb(Y, (size_t)(2 * row) * DM + k) + ldb(Y, (size_t)(2 * row + 1) * DM + k); (void)H; ss += z * z; if (k == c) zc = z; }
            chk_put(ctl, 8, A.out[(size_t)row * DM + c], zc / sqrtf(ss / DM + NORM_EPS) * A.in[16][c], 0.01f); }
    }
}
__global__ void __launch_bounds__(256) chk_final(Args A) {
    gu32* ctl = (gu32*)(A.ws + WS_CTL); int bad = -1; float err = 0.f;
    for (int s = 0; s < 9; ++s) { const float e = __uint_as_float(ctl[CW_CHK + s]); if (e > 1.f) { bad = s; err = e; break; } }
    if (bad < 0 && ctl[CW_BAR + XB_TMO] != 0u) { bad = 10; err = 1.f; }
    if (bad < 0) return;
    float mant = 1.f + log10f(err); if (mant > 9.9f) mant = 9.9f; if (mant < 1.f) mant = 1.f;
    const float C = sqrtf(mant * powf(10.f, (float)(bad + 3)));
    for (size_t i = blockIdx.x * 256 + threadIdx.x; i < (size_t)M * DM; i += (size_t)gridDim.x * 256) A.out[i] = C;
}
#endif

extern "C" void kernel_launch(void* const* d_in, const int* in_sizes, int n_in, void* d_out, int out_size, void* d_ws, size_t ws_size, hipStream_t stream) {
    static int grid = 0;
    if (grid == 0) {
        if (n_in != 17 || in_sizes[0] != M * DM || out_size != M * DM || ws_size < WS_END) { fprintf(stderr, "kernel_launch: unexpected shapes (n_in %d, in0 %d, out %d, ws %zu); nothing launched\n", n_in, n_in > 0 ? in_sizes[0] : -1, out_size, ws_size); grid = -1; return; }
        int dev = 0, cus = 0, per_cu = 0;
        if (hipGetDevice(&dev) != hipSuccess || hipDeviceGetAttribute(&cus, hipDeviceAttributeMultiprocessorCount, dev) != hipSuccess) { grid = -1; return; }
        if (hipFuncSetAttribute((const void*)mk_fwd, hipFuncAttributeMaxDynamicSharedMemorySize, LDS_BYTES) != hipSuccess) { fprintf(stderr, "kernel_launch: hipFuncSetAttribute failed\n"); grid = -1; return; }
        if (hipOccupancyMaxActiveBlocksPerMultiprocessor(&per_cu, (const void*)mk_fwd, NWAVES * 64, LDS_BYTES) != hipSuccess || per_cu < 1) { fprintf(stderr, "kernel_launch: occupancy query says %d blocks per CU; nothing launched\n", per_cu); (void)hipGetLastError(); grid = -1; return; }
        grid = cus;
    }
    if (grid < 0) return;
    if (hipMemsetAsync((char*)d_ws + WS_CTL, 0, CTL_ZERO_BYTES, stream) != hipSuccess) { fprintf(stderr, "kernel_launch: memset failed\n"); return; }
    Args a{};
    for (int i = 0; i < 17; ++i) a.in[i] = (const float*)d_in[i];
    a.out = (float*)d_out; a.ws = (unsigned char*)d_ws;
    const double TWO_PI = 6.283185307179586476925286766559;
    for (int i = 0; i < 8; ++i) a.frev[i] = std::pow(500000.0, -(double)i / 8.0) / TWO_PI;
    for (int i = 0; i < 32; ++i) a.frev[8 + i] = std::pow(10000.0, -(double)i / 31.0) / TWO_PI;
    if (N_LAUNCHES == 1) {
        a.ph_lo = 0; a.ph_hi = PER_PHASE; a.li = 0;
#if MK_COOP
        void* kargs[] = {&a};
        const hipError_t le = hipLaunchCooperativeKernel((const void*)mk_fwd, dim3(grid), dim3(NWAVES * 64), kargs, LDS_BYTES, stream);
        if (le != hipSuccess) fprintf(stderr, "kernel_launch: cooperative launch failed: %s (grid %d)\n", hipGetErrorName(le), grid);
#else
        hipLaunchKernelGGL(mk_fwd, dim3(grid), dim3(NWAVES * 64), LDS_BYTES, stream, a);
#endif
    } else {
        for (int li = 0; li < PER_PHASE; ++li) {
            a.ph_lo = li; a.ph_hi = li + 1; a.li = 0;
            hipLaunchKernelGGL(mk_fwd, dim3(grid), dim3(NWAVES * 64), LDS_BYTES, stream, a);
#if MK_CHECK
            hipLaunchKernelGGL(chk_kernel, dim3(256), dim3(256), 0, stream, a, li);
#endif
        }
#if MK_CHECK
        hipLaunchKernelGGL(chk_final, dim3(1024), dim3(256), 0, stream, a);
#endif
    }
}
```

```cpp
#include <hip/hip_runtime.h>
#include <cstdio>
#include <cstdint>
#include <cmath>

#ifndef MK_N_LAUNCHES
#define MK_N_LAUNCHES 1
#endif
#ifndef MK_TIME
#define MK_TIME 0
#endif
#ifndef MK_REPEAT
#define MK_REPEAT -1
#endif
#ifndef MK_NREP
#define MK_NREP 2
#endif
#ifndef MK_COOP
#define MK_COOP 1
#endif
#ifndef MK_TSCALE
#define MK_TSCALE 1.0f
#endif
#ifndef MK_CHECK
#define MK_CHECK 0
#endif

#define LAS __attribute__((address_space(3)))
#define GAS __attribute__((address_space(1)))
typedef unsigned short bf16;
typedef short bf16x8 __attribute__((ext_vector_type(8)));
typedef short s16x4 __attribute__((ext_vector_type(4)));
typedef float f32x2 __attribute__((ext_vector_type(2)));
typedef float f32x4 __attribute__((ext_vector_type(4)));
typedef float f32x16 __attribute__((ext_vector_type(16)));
typedef unsigned u32x2 __attribute__((ext_vector_type(2)));
typedef unsigned u32x4 __attribute__((ext_vector_type(4)));
typedef __bf16 bf16x2_t __attribute__((ext_vector_type(2)));
typedef GAS unsigned gu32;

constexpr int NBATCH = 8, SEQ = 4096, DM = 1024, M = NBATCH * SEQ;
constexpr int NIN = 3584, SEGW = 512, NHEAD = 8, HD = 64;
constexpr int NEXP = 32, FF = 512, NGRP = 4, EPG = 8;
constexpr int CHUNK = 128, NCHUNK = SEQ / CHUNK;
constexpr float NORM_EPS = 1e-6f;
constexpr float LOG2E = 1.4426950408889634f, LN2 = 0.6931471805599453f;
constexpr int NWAVES = 8;
constexpr int N_CONV_P1 = 66 * 256;
constexpr int MAXTILES = 288;

constexpr size_t MiB = 1u << 20;
constexpr size_t WS_CTL = 0, CTL_ZERO_BYTES = 128 * 1024;
constexpr size_t WS_WRT = 1 * MiB;
constexpr size_t WS_ROPE = 2 * MiB;
constexpr size_t WS_LSE = 4 * MiB;
constexpr size_t WS_LIST = 8 * MiB;
constexpr size_t WS_GATEL = 12 * MiB;
constexpr size_t WS_RSL = 16 * MiB;
constexpr size_t WS_WIN = 20 * MiB;
constexpr size_t WS_WOUT = 27 * MiB;
constexpr size_t WS_WD = 30 * MiB;
constexpr size_t WS_WGU = 62 * MiB;
constexpr size_t WS_ST = 126 * MiB;
constexpr size_t WS_SBW = 478 * MiB;
constexpr size_t WS_XN = 158 * MiB;
constexpr size_t WS_OBR = 158 * MiB;
constexpr size_t WS_SEG = 254 * MiB;
constexpr size_t SEG_BYTES = (size_t)M * SEGW * 2;
constexpr size_t WS_MIXED = 254 * MiB;
constexpr size_t WS_H = 350 * MiB;
constexpr size_t WS_HG = 350 * MiB;
constexpr size_t WS_HID = 222 * MiB;
constexpr size_t WS_Y = 64 * MiB;
constexpr size_t WS_END = 494 * MiB;
constexpr int CW_CNT = 64;
constexpr int CW_BAR = 4096;
constexpr int CW_CHK = 16384;
constexpr int CW_TS = 20480;

constexpr int RING_BYTES = 147456;
constexpr int LDSCTL_OFF = RING_BYTES, MISC_OFF = LDSCTL_OFF + 320;
constexpr int TILE_OFF = MISC_OFF + 128;
constexpr int LDS_BYTES = 151552;

#define RLX_AGENT __ATOMIC_RELAXED, __HIP_MEMORY_SCOPE_AGENT
#define LDS_WAIT() asm volatile("s_waitcnt lgkmcnt(0)" ::: "memory")
#define VM_WAIT() asm volatile("s_waitcnt vmcnt(0)" ::: "memory")
__device__ __forceinline__ unsigned pk2(float lo, float hi) { f32x2 v = {lo, hi}; bf16x2_t b = __builtin_convertvector(v, bf16x2_t); return __builtin_bit_cast(unsigned, b); }
__device__ __forceinline__ float bflo(unsigned u) { return __uint_as_float(u << 16); }
__device__ __forceinline__ float bfhi(unsigned u) { return __uint_as_float(u & 0xffff0000u); }
__device__ __forceinline__ float bf2f(short s) { return __uint_as_float(((unsigned)(unsigned short)s) << 16); }
__device__ __forceinline__ int crow(int r, int hi) { return (r & 3) + 8 * (r >> 2) + 4 * hi; }
__device__ __forceinline__ float wave_sum(float v) {
#pragma unroll
    for (int o = 1; o < 64; o <<= 1) v += __shfl_xor(v, o);
    return v;
}
__device__ __forceinline__ float silu_f(float v) { return v * __builtin_amdgcn_rcpf(1.f + __builtin_amdgcn_exp2f(-v * LOG2E)); }

namespace pg8 {
constexpr int BM = 256, BK = 64, HALF = 128, HTB = HALF * BK * 2, STAGE_BYTES = 8 * HTB, NXCD = 8, WGM = 8;
__host__ __device__ __forceinline__ int lds_byte(int r, int c) { const int st = (r >> 4) * 2 + (c >> 5), rr = r & 15, cc = c & 31, ob = rr * 64 + cc * 2; return st * 1024 + (ob ^ (((ob >> 9) & 1) << 5)); }
__host__ __device__ __forceinline__ void stage_rc(int b, int& R, int& C) { const int st = b / 1024, sb = b % 1024, swz = sb ^ (((sb >> 9) & 1) << 5); R = (st >> 1) * 16 + swz / 64; C = (st & 1) * 32 + (swz % 64) / 2; }
__host__ __device__ __forceinline__ int perm32(int rho) { const int n = rho >> 4, i = rho & 15; return 8 * (i >> 2) + 4 * n + (i & 3); }

struct Unit { int pm, pn; };
struct StaticOrder {
    int nM, nN, nwg, G, c;
    __device__ void init(int nM_, int nN_, int G_, int c_) { nM = nM_; nN = nN_; nwg = nM * nN; G = G_; c = c_; }
    __device__ bool next(int i, Unit& u) const {
        const long L = (long)i * G + c; if (L >= nwg) return false;
        int wgid = (int)L; { const int q = nwg / NXCD, r = nwg % NXCD, xcd = wgid % NXCD, off = wgid / NXCD; wgid = (xcd < r ? xcd * (q + 1) : r * (q + 1) + (xcd - r) * q) + off; }
        const int nig = WGM * nN, gid = wgid / nig, fm = gid * WGM, gsz = (nM - fm) < WGM ? (nM - fm) : WGM;
        u.pm = fm + ((wgid % nig) % gsz); u.pn = (wgid % nig) / gsz; return true;
    }
};

template <class Epi, class Sched, class Src, bool ALIGN_EPI, bool SP2>
__device__ __forceinline__ void gemm_phase(LAS unsigned char* lds, const int K, const Sched& S, const Src& SRC, const Epi& E) {
    int tid_ = threadIdx.x; asm volatile("" : "+v"(tid_));
    const int tid = tid_, wid = __builtin_amdgcn_readfirstlane(tid >> 6), lane = tid & 63, wr = wid >> 2, wc = wid & 3, fr = lane & 15, fq = lane >> 4;
    const int nt = K / BK;
    unsigned voffB[2]; int RA[2], CA[2];
#pragma unroll
    for (int i = 0; i < 2; ++i) { int R, C; stage_rc(tid * 16 + i * 8192, R, C); const int Rb = Epi::PERM ? ((R & ~31) + perm32(R & 31)) : R;
        RA[i] = R; CA[i] = C; voffB[i] = (unsigned)(Rb * K + C) * 2u; }
    const size_t kstep = (size_t)(BK * 2);
    const size_t hstep = (size_t)HALF * K * 2;
    const unsigned ldsw = (unsigned)wid * 1024u;
    const int aoff = lds_byte(wr * 64 + fr, fq * 8), boff = lds_byte(wc * 32 + fr, fq * 8);
#define PG8_SA(b, h) (((b) * 2 + (h)) * HTB)
#define PG8_SB(b, h) ((4 + (b) * 2 + (h)) * HTB)
#define PG8_STAGE(bufoff, gbase, voff) do { _Pragma("unroll") for (int _i = 0; _i < 2; ++_i) \
        __builtin_amdgcn_global_load_lds((const unsigned*)((const char*)(gbase) + (voff)[_i]), (LAS unsigned*)(lds + (bufoff) + ldsw + _i * 8192), 16, 0, 0); } while (0)
#define PG8_LDA(dst, b, h) do { _Pragma("unroll") for (int m = 0; m < 4; ++m) _Pragma("unroll") for (int k = 0; k < 2; ++k) dst[m][k] = *(const LAS bf16x8*)(lds + PG8_SA(b, h) + aoff + m * 2048 + k * 1024); } while (0)
#define PG8_LDB(dst, b, h) do { _Pragma("unroll") for (int n = 0; n < 2; ++n) _Pragma("unroll") for (int k = 0; k < 2; ++k) dst[n][k] = *(const LAS bf16x8*)(lds + PG8_SB(b, h) + boff + n * 2048 + k * 1024); } while (0)
#define PG8_MMA(ai, bj, At, Bt) do { __builtin_amdgcn_s_setprio(1); _Pragma("unroll") for (int m = 0; m < 4; ++m) _Pragma("unroll") for (int n = 0; n < 2; ++n) _Pragma("unroll") for (int k = 0; k < 2; ++k) \
        acc[ai][bj][m][n] = __builtin_amdgcn_mfma_f32_16x16x32_bf16(Bt[n][k], At[m][k], acc[ai][bj][m][n], 0, 0, 0); __builtin_amdgcn_s_setprio(0); } while (0)
#define PG8_WAIT_V(n) asm volatile("s_waitcnt vmcnt(" #n ")" ::: "memory")
#define PG8_WAIT_L(n) asm volatile("s_waitcnt lgkmcnt(" #n ")" ::: "memory")
#define PG8_BAR __builtin_amdgcn_s_barrier()
#define PG8_SCHED __builtin_amdgcn_sched_barrier(0)
    Unit cur, nxt; int ui = 0;
    if (!S.next(0, cur)) return;
    f32x4 acc[2][2][4][2];
#pragma unroll
    for (int a = 0; a < 2; ++a)
#pragma unroll
        for (int b = 0; b < 2; ++b)
#pragma unroll
            for (int m = 0; m < 4; ++m)
#pragma unroll
                for (int n = 0; n < 2; ++n) acc[a][b][m][n] = (f32x4){0.f, 0.f, 0.f, 0.f};
    bf16x8 At[4][2], B0[2][2], B1[2][2];
    const char *cA, *cB; unsigned vA0[2], vA1[2];
    SRC.setup(cur, RA, CA, cA, cB, vA0, vA1);
    if constexpr (SP2) {
        PG8_STAGE(PG8_SB(0, 0), cB, voffB); PG8_STAGE(PG8_SB(0, 1), cB + hstep, voffB); PG8_STAGE(PG8_SA(0, 0), cA, vA0); PG8_STAGE(PG8_SA(0, 1), cA, vA1);
        if (wr == 1) PG8_BAR;
        PG8_WAIT_V(2); PG8_BAR;
        PG8_STAGE(PG8_SB(1, 0), cB + kstep, voffB); PG8_STAGE(PG8_SA(1, 0), cA + kstep, vA0); PG8_STAGE(PG8_SB(1, 1), cB + hstep + kstep, voffB);
        PG8_WAIT_V(6); PG8_BAR;
    } else {
        PG8_STAGE(PG8_SB(0, 0), cB, voffB); PG8_STAGE(PG8_SA(0, 0), cA, vA0); PG8_STAGE(PG8_SB(0, 1), cB + hstep, voffB); PG8_STAGE(PG8_SA(0, 1), cA, vA1);
        if (wr == 1) PG8_BAR;
        PG8_WAIT_V(4); PG8_BAR;
        PG8_STAGE(PG8_SB(1, 0), cB + kstep, voffB); PG8_STAGE(PG8_SA(1, 0), cA + kstep, vA0); PG8_STAGE(PG8_SB(1, 1), cB + hstep + kstep, voffB);
        PG8_WAIT_V(6); PG8_BAR;
    }
    for (;;) {
        const bool has_next = S.next(ui + 1, nxt);
        const char *nA = cA, *nB = cB; unsigned wA0[2] = {vA0[0], vA0[1]}, wA1[2] = {vA1[0], vA1[1]};
        if (has_next) SRC.setup(nxt, RA, CA, nA, nB, wA0, wA1);
        for (int t = 0; t < nt; t += 2) {
            const bool last = (t == nt - 2);
            const char* a1 = cA + (size_t)(t + 1) * kstep;
            const char* a2 = last ? nA : cA + (size_t)(t + 2) * kstep; const char* b2 = last ? nB : cB + (size_t)(t + 2) * kstep;
            const char* a3 = a2 + kstep; const char* b3 = b2 + kstep;
            unsigned x0[2], x1[2];
            x0[0] = last ? wA0[0] : vA0[0]; x0[1] = last ? wA0[1] : vA0[1]; x1[0] = last ? wA1[0] : vA1[0]; x1[1] = last ? wA1[1] : vA1[1];
            if constexpr (SP2) {
            PG8_LDB(B0, 0, 0); PG8_LDB(B1, 0, 1); PG8_SCHED; PG8_LDA(At, 0, 0); PG8_STAGE(PG8_SA(1, 1), a1, vA1);
            PG8_WAIT_V(8); PG8_WAIT_L(0); PG8_BAR; PG8_MMA(0, 0, At, B0); PG8_MMA(0, 1, At, B1); PG8_BAR; PG8_SCHED;
            PG8_LDA(At, 0, 1); PG8_STAGE(PG8_SB(0, 0), b2, voffB); PG8_STAGE(PG8_SB(0, 1), b2 + hstep, voffB); PG8_STAGE(PG8_SA(0, 0), a2, x0);
            PG8_WAIT_V(8); PG8_WAIT_L(0); PG8_BAR; PG8_MMA(1, 0, At, B0); PG8_MMA(1, 1, At, B1); PG8_BAR; PG8_SCHED;
            PG8_LDB(B0, 1, 0); PG8_LDB(B1, 1, 1); PG8_SCHED; PG8_LDA(At, 1, 0); PG8_STAGE(PG8_SA(0, 1), a2, x1);
            PG8_WAIT_V(8); PG8_WAIT_L(0); PG8_BAR; PG8_MMA(0, 0, At, B0); PG8_MMA(0, 1, At, B1); PG8_BAR; PG8_SCHED;
            PG8_LDA(At, 1, 1); PG8_STAGE(PG8_SB(1, 0), b3, voffB); PG8_STAGE(PG8_SB(1, 1), b3 + hstep, voffB); PG8_STAGE(PG8_SA(1, 0), a3, x0);
            PG8_WAIT_V(8); PG8_WAIT_L(0); PG8_BAR; PG8_MMA(1, 0, At, B0); PG8_MMA(1, 1, At, B1); PG8_BAR; PG8_SCHED;
            } else {
            PG8_LDB(B0, 0, 0); PG8_SCHED; PG8_LDA(At, 0, 0); PG8_STAGE(PG8_SA(1, 1), a1, vA1);
            PG8_WAIT_L(8); PG8_BAR; PG8_WAIT_L(0); PG8_MMA(0, 0, At, B0); PG8_BAR; PG8_SCHED;
            PG8_LDB(B1, 0, 1); PG8_STAGE(PG8_SB(0, 0), b2, voffB);
            PG8_BAR; PG8_WAIT_L(0); PG8_MMA(0, 1, At, B1); PG8_BAR;
            PG8_LDA(At, 0, 1); PG8_STAGE(PG8_SA(0, 0), a2, x0);
            PG8_BAR; PG8_WAIT_L(0); PG8_MMA(1, 0, At, B0); PG8_BAR; PG8_SCHED;
            PG8_STAGE(PG8_SB(0, 1), b2 + hstep, voffB);
            PG8_WAIT_V(6); PG8_BAR; PG8_MMA(1, 1, At, B1); PG8_BAR;
            PG8_LDB(B0, 1, 0); PG8_SCHED; PG8_LDA(At, 1, 0); PG8_STAGE(PG8_SA(0, 1), a2, x1);
            PG8_WAIT_L(8); PG8_BAR; PG8_WAIT_L(0); PG8_MMA(0, 0, At, B0); PG8_BAR; PG8_SCHED;
            PG8_LDB(B1, 1, 1); PG8_STAGE(PG8_SB(1, 0), b3, voffB);
            PG8_BAR; PG8_WAIT_L(0); PG8_MMA(0, 1, At, B1); PG8_BAR;
            PG8_LDA(At, 1, 1); PG8_STAGE(PG8_SA(1, 0), a3, x0);
            PG8_BAR; PG8_WAIT_L(0); PG8_MMA(1, 0, At, B0); PG8_BAR; PG8_SCHED;
            PG8_STAGE(PG8_SB(1, 1), b3 + hstep, voffB);
            PG8_WAIT_V(6); PG8_BAR; PG8_MMA(1, 1, At, B1); PG8_BAR;
            }
        }
        if constexpr (ALIGN_EPI) { if (wr == 0) PG8_BAR; }
        E(acc, cur, wr, wc, fr, fq);
        if (!has_next) break;
#pragma unroll
        for (int a = 0; a < 2; ++a)
#pragma unroll
            for (int b = 0; b < 2; ++b)
#pragma unroll
                for (int m = 0; m < 4; ++m)
#pragma unroll
                    for (int n = 0; n < 2; ++n) acc[a][b][m][n] = (f32x4){0.f, 0.f, 0.f, 0.f};
        cur = nxt; cA = nA; cB = nB; vA0[0] = wA0[0]; vA0[1] = wA0[1]; vA1[0] = wA1[0]; vA1[1] = wA1[1]; ++ui;
        if constexpr (ALIGN_EPI) { if (wr == 1) PG8_BAR; }
    }
    PG8_WAIT_V(0);
    if constexpr (!ALIGN_EPI) { if (wr == 0) PG8_BAR; }
    PG8_BAR;
#undef PG8_SA
#undef PG8_SB
#undef PG8_STAGE
#undef PG8_LDA
#undef PG8_LDB
#undef PG8_MMA
#undef PG8_WAIT_V
#undef PG8_WAIT_L
#undef PG8_BAR
#undef PG8_SCHED
}
}

#define XB_TMO      128
#define XB_XCNT(j)  (256  + 64 * (j))
#define XB_XSUB(j)  (1280 + 64 * (j))
#define XB_XGEN(j)  (2304 + 64 * (j))
#define XB_TOP      3328
#define XB_TOPGEN   3392
#define XCD_BAR_WORDS 3456
#define XB_SPIN_CAP (1u << 18)
__device__ __forceinline__ unsigned xb_ld(unsigned* p)              { return __hip_atomic_load(p, __ATOMIC_RELAXED, __HIP_MEMORY_SCOPE_AGENT); }
__device__ __forceinline__ unsigned xb_add(unsigned* p, unsigned v) { return __hip_atomic_fetch_add(p, v, __ATOMIC_RELAXED, __HIP_MEMORY_SCOPE_AGENT); }
__device__ __forceinline__ unsigned xb_xcc_id() { return (unsigned)__builtin_amdgcn_s_getreg((3 << 11) | 20) & 0xFu; }
#define XB_SPIN(cond, bar) do { unsigned _sp = 0; while (cond) { __builtin_amdgcn_s_sleep(1); \
    if ((++_sp & 255u) == 0u) { if (xb_ld(&(bar)[XB_TMO])) break; if (_sp > XB_SPIN_CAP) { atomicAdd(&(bar)[XB_TMO], 1u); break; } } } } while (0)
struct XcdBarrier { unsigned* bar; unsigned x; volatile LAS unsigned* st; };
__device__ __forceinline__ XcdBarrier xcd_barrier_post(unsigned* bar, volatile LAS unsigned* st) {
    XcdBarrier b; b.bar = bar; b.x = xb_xcc_id(); b.st = st;
    if (threadIdx.x == 0) (void)xb_add(&bar[XB_XCNT(b.x)], 1u);
    return b;
}
__device__ __forceinline__ void xcd_barrier_complete(unsigned* bar, unsigned x, unsigned& nloc, unsigned& nx) {
    const unsigned G = gridDim.x * gridDim.y * gridDim.z;
    unsigned sum, cnt, mine, sp = 0u;
    for (;;) {
        sum = 0u; cnt = 0u; mine = 0u;
#pragma unroll
        for (unsigned j = 0; j < 16; ++j) { const unsigned c = xb_ld(&bar[XB_XCNT(j)]); sum += c; cnt += (c > 0u) ? 1u : 0u; mine = (j == x) ? c : mine; }
        if (sum == G) break;
        __builtin_amdgcn_s_sleep(1);
        if ((++sp & 255u) == 0u) { if (xb_ld(&bar[XB_TMO])) break; if (sp > XB_SPIN_CAP) { atomicAdd(&bar[XB_TMO], 1u); break; } }
    }
    nloc = mine > 0u ? mine : 1u; nx = cnt > 0u ? cnt : 1u;
}
__device__ __forceinline__ void xcd_barrier(const XcdBarrier& b) {
    asm volatile("s_waitcnt vmcnt(0)" ::: "memory");
    __syncthreads();
    if (threadIdx.x == 0) {
        unsigned* bar = b.bar;
        __builtin_amdgcn_s_waitcnt(0);
        unsigned nloc = b.st[0], nx = b.st[1];
        if (nloc == 0u) { xcd_barrier_complete(bar, b.x, nloc, nx); b.st[0] = nloc; b.st[1] = nx; }
        const unsigned old = xb_add(&bar[XB_XSUB(b.x)], 1u);
        const unsigned gen = old / nloc;
        if (old + 1u == (gen + 1u) * nloc) {
            __builtin_amdgcn_fence(__ATOMIC_RELEASE, "agent");
            asm volatile("s_waitcnt vmcnt(0)" ::: "memory");
            const unsigned og = xb_add(&bar[XB_TOP], 1u);
            const unsigned tg = og / nx;
            if (og + 1u == (tg + 1u) * nx) xb_add(&bar[XB_TOPGEN], 1u);
            else XB_SPIN(xb_ld(&bar[XB_TOPGEN]) == tg, bar);
            __builtin_amdgcn_fence(__ATOMIC_ACQUIRE, "agent");
            xb_add(&bar[XB_XGEN(b.x)], 1u);
            asm volatile("s_waitcnt vmcnt(0)" ::: "memory");
        } else {
            XB_SPIN(xb_ld(&bar[XB_XGEN(b.x)]) == gen, bar);
            __builtin_amdgcn_fence(__ATOMIC_ACQUIRE, "agent");
            asm volatile("s_waitcnt vmcnt(0)" ::: "memory");
        }
    }
    __syncthreads();
}

struct Args {
    const float* in[17]; float* out; unsigned char* ws;
    double frev[40];
    int ph_lo, ph_hi, li, pad;
};
struct Frame {
    LAS unsigned char* lds;
    volatile LAS unsigned* MISC;
    gu32* ctl;
    int tid, lane, wave, vcu, G;
};

__device__ __forceinline__ int winperm(int n) {
    const int s = n >> 9, c = n & 511, hh = c >> 6, d = c & 63; int dp = d;
    if (s == 0 || s == 1) { if (d < 16) dp = 2 * (d & 7) + (d >> 3); }
    else if (s == 3 || s == 4) dp = 2 * (d & 31) + (d >> 5);
    return (s << 9) + (hh << 6) + dp;
}
template <int MODE>
__device__ __forceinline__ int tr_row(int ns) { return MODE == 0 ? winperm(ns) : MODE == 1 ? ns : MODE == 2 ? ((ns >> 7) << 8) + (ns & 127) : ((ns >> 7) << 8) + 128 + (ns & 127); }
__device__ __forceinline__ void tr_load(f32x4 (&v)[8], const float* S, int N, int kb, int nb, int lane) {
    const float* p = S + (size_t)(64 * kb + (lane >> 3)) * N + 32 * nb + (lane & 7) * 4;
#pragma unroll
    for (int i = 0; i < 8; ++i) v[i] = __builtin_nontemporal_load((const f32x4*)(p + (size_t)8 * i * N));
}
template <int MODE>
__device__ __forceinline__ void tr_store(const f32x4 (&v)[8], bf16* Dst, int Kd, LAS float* scr, int kb, int nb, int lane, const float* kscale) {
    const int k0 = 64 * kb, n0 = 32 * nb;
#pragma unroll
    for (int i = 0; i < 8; ++i) { const int kk = 8 * i + (lane >> 3); const float sc = kscale ? kscale[k0 + kk] : 1.f; LAS float* d = scr + kk * 33 + (lane & 7) * 4;
        d[0] = v[i][0] * sc; d[1] = v[i][1] * sc; d[2] = v[i][2] * sc; d[3] = v[i][3] * sc; }
    LDS_WAIT(); asm volatile("" ::: "memory");
    const int c = lane & 7;
#pragma unroll
    for (int j = 0; j < 4; ++j) { const int n = (lane >> 3) + 8 * j; const LAS float* s = scr + (8 * c) * 33 + n;
        u32x4 o; o.x = pk2(s[0 * 33], s[1 * 33]); o.y = pk2(s[2 * 33], s[3 * 33]); o.z = pk2(s[4 * 33], s[5 * 33]); o.w = pk2(s[6 * 33], s[7 * 33]);
        *(GAS u32x4*)(Dst + (size_t)tr_row<MODE>(n0 + n) * Kd + k0 + 8 * c) = o; }
    LDS_WAIT(); asm volatile("" ::: "memory");
}
template <int MODE>
__device__ __forceinline__ void p0_transpose_item(const float* S, int N, bf16* Dst, int Kd, LAS float* scr, int kb, int nb, int lane, const float* kscale) {
    f32x4 v[8]; tr_load(v, S, N, kb, nb, lane); tr_store<MODE>(v, Dst, Kd, scr, kb, nb, lane, kscale);
}
__device__ __forceinline__ void expert_src(const Args& A, int it, const float*& S, int& N, int& kb, int& nb) {
    const int e = it / 768, r = it - e * 768;
    if (r < 256) { S = A.in[13] + (size_t)e * DM * FF; N = FF; kb = r >> 4; nb = r & 15; }
    else if (r < 512) { S = A.in[14] + (size_t)e * DM * FF; N = FF; kb = (r - 256) >> 4; nb = (r - 256) & 15; }
    else { S = A.in[15] + (size_t)e * FF * DM; N = DM; kb = (r - 512) >> 5; nb = (r - 512) & 31; }
}
__device__ __forceinline__ void expert_store(const Args& A, unsigned char* ws, int it, const f32x4 (&v)[8], LAS float* scr, int lane) {
    bf16* WGU = (bf16*)(ws + WS_WGU); bf16* WD = (bf16*)(ws + WS_WD);
    const int e = it / 768, r = it - e * 768;
    if (r < 256) tr_store<2>(v, WGU + (size_t)e * DM * DM, DM, scr, r >> 4, r & 15, lane, A.in[8]);
    else if (r < 512) tr_store<3>(v, WGU + (size_t)e * DM * DM, DM, scr, (r - 256) >> 4, (r - 256) & 15, lane, A.in[8]);
    else tr_store<1>(v, WD + (size_t)e * DM * FF, FF, scr, (r - 512) >> 5, (r - 512) & 31, lane, nullptr);
}
__device__ __forceinline__ void expert_items(const Args& A, unsigned char* ws, LAS float* scr, int lo, int NI, int w0, int nw, int lane) {
    for (int it = lo + w0; it < NI; it += 4 * nw) {
        f32x4 v0[8], v1[8], v2[8], v3[8]; const float* S; int N, kb, nb;
        expert_src(A, it, S, N, kb, nb); tr_load(v0, S, N, kb, nb, lane);
        if (it + nw < NI) { expert_src(A, it + nw, S, N, kb, nb); tr_load(v1, S, N, kb, nb, lane); }
        if (it + 2 * nw < NI) { expert_src(A, it + 2 * nw, S, N, kb, nb); tr_load(v2, S, N, kb, nb, lane); }
        if (it + 3 * nw < NI) { expert_src(A, it + 3 * nw, S, N, kb, nb); tr_load(v3, S, N, kb, nb, lane); }
        expert_store(A, ws, it, v0, scr, lane);
        if (it + nw < NI) expert_store(A, ws, it + nw, v1, scr, lane);
        if (it + 2 * nw < NI) expert_store(A, ws, it + 2 * nw, v2, scr, lane);
        if (it + 3 * nw < NI) expert_store(A, ws, it + 3 * nw, v3, scr, lane);
    }
}
__device__ __forceinline__ void p0_prologue(Frame& F, const Args& A) {
    unsigned char* ws = A.ws;
    LAS float* scr = (LAS float*)(F.lds + F.wave * 16384);
    const int gw = F.vcu * NWAVES + F.wave, NGW = F.G * NWAVES;
    constexpr int I_IN = 16 * 112, I_OUT = 16 * 32;
    bf16* WIN = (bf16*)(ws + WS_WIN); bf16* WOUT = (bf16*)(ws + WS_WOUT);
    for (int it = gw; it < I_IN + I_OUT; it += NGW) {
        int r = it;
        if (r < I_IN) { p0_transpose_item<0>(A.in[2], NIN, WIN, DM, scr, r / 112, r % 112, F.lane, nullptr); continue; } r -= I_IN;
        const int kb = r / 32; p0_transpose_item<1>(A.in[7], DM, WOUT, DM, scr, kb, r % 32, F.lane, kb < 8 ? A.in[3] : A.in[6] - 512);
    }
    expert_items(A, ws, scr, F.G == 256 ? N_CONV_P1 : 0, 768 * NEXP, gw, NGW, F.lane);
    { const float* x = A.in[0]; const float* g = A.in[1]; bf16* XN = (bf16*)(ws + WS_XN);
      f32x4 gv[4];
#pragma unroll
      for (int j = 0; j < 4; ++j) gv[j] = ((const f32x4*)g)[F.lane + 64 * j];
      for (int m0 = gw; m0 < M; m0 += 4 * NGW) {
        f32x4 v[4][4];
#pragma unroll
        for (int k = 0; k < 4; ++k) { const GAS f32x4* xr = (const GAS f32x4*)(x + (size_t)(m0 + k * NGW) * DM) + F.lane;
#pragma unroll
            for (int j = 0; j < 4; ++j) v[k][j] = __builtin_nontemporal_load(xr + 64 * j); }
#pragma unroll
        for (int k = 0; k < 4; ++k) { float s = 0.f;
#pragma unroll
            for (int j = 0; j < 4; ++j) s += (v[k][j].x * v[k][j].x + v[k][j].y * v[k][j].y) + (v[k][j].z * v[k][j].z + v[k][j].w * v[k][j].w);
            const float rstd = 1.f / sqrtf(wave_sum(s) * (1.f / DM) + NORM_EPS);
            GAS unsigned long long* o8 = (GAS unsigned long long*)(XN + (size_t)(m0 + k * NGW) * DM) + F.lane;
#pragma unroll
            for (int j = 0; j < 4; ++j) { const f32x4 t = v[k][j] * rstd * gv[j]; o8[64 * j] = (unsigned long long)pk2(t.x, t.y) | ((unsigned long long)pk2(t.z, t.w) << 32); } }
      } }
    { const int gt = (F.vcu * NWAVES + F.wave) * 64 + F.lane, NT = NGW * 64;
      bf16* WRH = (bf16*)(ws + WS_WRT); bf16* WRL = WRH + 48 * DM; const float* gf = A.in[8]; const float* wg = A.in[9]; const float* we = A.in[11];
      for (int idx = gt; idx < 48 * DM; idx += NT) { const int j = idx >> 10, i = idx & 1023;
          const float v = (j < 32 ? we[i * 32 + j] : (j < 36 ? wg[i * 4 + (j - 32)] : 0.f)) * gf[i];
          const unsigned hb = pk2(v, 0.f) & 0xffffu; const float lo = v - bflo(hb); WRH[idx] = (bf16)hb; WRL[idx] = (bf16)(pk2(lo, 0.f) & 0xffffu); }
      float* RC = (float*)(ws + WS_ROPE); float* RS = RC + SEQ * 40;
      for (int idx = gt; idx < SEQ * 40; idx += NT) { const int pos = idx / 40, f = idx % 40;
          double rv = (double)pos * A.frev[f]; rv -= floor(rv); const float r = (float)rv;
          RC[idx] = __builtin_amdgcn_cosf(r); RS[idx] = __builtin_amdgcn_sinf(r); } }
}

struct SrcPlain {
    const bf16* A; const bf16* Bt; int K;
    __device__ __forceinline__ void setup(const pg8::Unit& u, const int (&RA)[2], const int (&CA)[2], const char*& cA, const char*& cB, unsigned (&v0)[2], unsigned (&v1)[2]) const {
        cA = (const char*)A + (size_t)u.pm * 256 * K * 2; cB = (const char*)Bt + (size_t)u.pn * 256 * K * 2;
#pragma unroll
        for (int i = 0; i < 2; ++i) { v0[i] = (unsigned)(RA[i] * K + CA[i]) * 2u; v1[i] = v0[i] + (unsigned)(128 * K * 2); }
    }
};
struct TileTab { const LAS int* TE; const LAS int* NE; const LAS int* T0; };
struct SrcGather {
    const bf16* HG; const bf16* WGU; const int* LIST; TileTab tt;
    __device__ __forceinline__ void setup(const pg8::Unit& u, const int (&RA)[2], const int (&CA)[2], const char*& cA, const char*& cB, unsigned (&v0)[2], unsigned (&v1)[2]) const {
        const int e = tt.TE[u.pm], ne = tt.NE[e], p0 = (u.pm - tt.T0[e]) * 256;
        cA = (const char*)HG; cB = (const char*)WGU + ((size_t)e * DM + (size_t)u.pn * 256) * DM * 2;
#pragma unroll
        for (int i = 0; i < 2; ++i) {
            const int pa = p0 + RA[i], pb = pa + 128;
            const int ta = pa < ne ? (LIST[e * M + pa] >> 1) : 0, tb = pb < ne ? (LIST[e * M + pb] >> 1) : 0;
            v0[i] = (unsigned)(ta * DM + CA[i]) * 2u; v1[i] = (unsigned)(tb * DM + CA[i]) * 2u; }
    }
};
struct SrcDown {
    const bf16* HID; const bf16* WD; TileTab tt;
    __device__ __forceinline__ void setup(const pg8::Unit& u, const int (&RA)[2], const int (&CA)[2], const char*& cA, const char*& cB, unsigned (&v0)[2], unsigned (&v1)[2]) const {
        const int e = tt.TE[u.pm];
        cA = (const char*)HID + (size_t)u.pm * 256 * FF * 2; cB = (const char*)WD + ((size_t)e * DM + (size_t)u.pn * 256) * FF * 2;
#pragma unroll
        for (int i = 0; i < 2; ++i) { v0[i] = (unsigned)(RA[i] * FF + CA[i]) * 2u; v1[i] = v0[i] + (unsigned)(128 * FF * 2); }
    }
};

struct EpiInProj {
    static constexpr bool PERM = true;
    bf16* SEG; const float* RC; const float* RS;
    __device__ __forceinline__ void operator()(const f32x4 (&acc)[2][2][4][2], const pg8::Unit& u, int wr, int wc, int fr, int fq) const {
        const int seg = u.pn >> 1, colt = (u.pn & 1) * 256;
        bf16* base = SEG + (size_t)seg * M * SEGW;
        const int dq = (wc & 1) * 32 + 8 * fq;
        const bool attn = seg < 2, ret = (seg == 3 || seg == 4);
        const bool rot = ret || (attn && dq < 16);
        const int i0 = ret ? 8 + (dq >> 1) : (dq >> 1);
        const float sc = seg == 0 ? 0.125f * LOG2E : (seg == 4 ? 0.125f : 1.f);
#pragma unroll
        for (int ai = 0; ai < 2; ++ai)
#pragma unroll
            for (int m = 0; m < 4; ++m) {
                const int row = u.pm * 256 + ai * 128 + wr * 64 + m * 16 + fr, pos = row & (SEQ - 1);
                f32x4 c4 = {1.f, 1.f, 1.f, 1.f}, s4 = {0.f, 0.f, 0.f, 0.f};
                if (rot) { c4 = *(const f32x4*)(RC + pos * 40 + i0); s4 = *(const f32x4*)(RS + pos * 40 + i0); }
                bf16* rowp = base + (size_t)row * SEGW + colt + wc * 32 + 8 * fq;
#pragma unroll
                for (int bj = 0; bj < 2; ++bj) {
                    f32x4 v0 = acc[ai][bj][m][0], v1 = acc[ai][bj][m][1];
                    if (attn || ret) {
                        f32x4 r0, r1;
                        r0[0] = v0[0] * c4[0] - v0[1] * s4[0]; r0[1] = v0[1] * c4[0] + v0[0] * s4[0];
                        r0[2] = v0[2] * c4[1] - v0[3] * s4[1]; r0[3] = v0[3] * c4[1] + v0[2] * s4[1];
                        r1[0] = v1[0] * c4[2] - v1[1] * s4[2]; r1[1] = v1[1] * c4[2] + v1[0] * s4[2];
                        r1[2] = v1[2] * c4[3] - v1[3] * s4[3]; r1[3] = v1[3] * c4[3] + v1[2] * s4[3];
                        v0 = r0 * sc; v1 = r1 * sc;
                    } else if (seg == 6) {
#pragma unroll
                        for (int e = 0; e < 4; ++e) { v0[e] = silu_f(v0[e]); v1[e] = silu_f(v1[e]); }
                    }
                    u32x4 w; w.x = pk2(v0[0], v0[1]); w.y = pk2(v0[2], v0[3]); w.z = pk2(v1[0], v1[1]); w.w = pk2(v1[2], v1[3]);
                    *(u32x4*)(rowp + bj * 128) = w;
                }
            }
    }
};
struct EpiOutProj {
    static constexpr bool PERM = true;
    const float* X; bf16* HB;
    __device__ __forceinline__ void operator()(const f32x4 (&acc)[2][2][4][2], const pg8::Unit& u, int wr, int wc, int fr, int fq) const {
        const int col0 = u.pn * 256 + wc * 32 + 8 * fq;
#pragma unroll
        for (int ai = 0; ai < 2; ++ai)
#pragma unroll
            for (int m = 0; m < 4; ++m) { const size_t off = (size_t)(u.pm * 256 + ai * 128 + wr * 64 + m * 16 + fr) * DM + col0;
#pragma unroll
                for (int bj = 0; bj < 2; ++bj) { const f32x4 h0 = __builtin_nontemporal_load((const f32x4*)(X + off + bj * 128)) + acc[ai][bj][m][0], h1 = __builtin_nontemporal_load((const f32x4*)(X + off + bj * 128 + 4)) + acc[ai][bj][m][1];
                    u32x4 w; w.x = pk2(h0[0], h0[1]); w.y = pk2(h0[2], h0[3]); w.z = pk2(h1[0], h1[1]); w.w = pk2(h1[2], h1[3]); *(u32x4*)(HB + off + bj * 128) = w; }
                if (m & 1) asm volatile("" ::: "memory"); }
    }
};
struct EpiGateUp {
    static constexpr bool PERM = true;
    bf16* HID; const float* GATEL; const float* RSL; TileTab tt;
    __device__ __forceinline__ void operator()(const f32x4 (&acc)[2][2][4][2], const pg8::Unit& u, int wr, int wc, int fr, int fq) const {
        const int e = tt.TE[u.pm], ne = tt.NE[e], p0 = (u.pm - tt.T0[e]) * 256;
#pragma unroll
        for (int ai = 0; ai < 2; ++ai)
#pragma unroll
            for (int m = 0; m < 4; ++m) {
                const int rr = ai * 128 + wr * 64 + m * 16 + fr, pos = p0 + rr;
                float rs = 0.f, gt = 0.f; if (pos < ne) { rs = RSL[e * M + pos]; gt = GATEL[e * M + pos]; }
                u32x4 w; unsigned* wp = (unsigned*)&w;
#pragma unroll
                for (int n = 0; n < 2; ++n) { const f32x4 g = acc[ai][0][m][n] * rs, up = acc[ai][1][m][n] * rs; float hv[4];
#pragma unroll
                    for (int q = 0; q < 4; ++q) hv[q] = silu_f(g[q]) * up[q] * gt;
                    wp[2 * n] = pk2(hv[0], hv[1]); wp[2 * n + 1] = pk2(hv[2], hv[3]); }
                *(u32x4*)(HID + (size_t)(u.pm * 256 + rr) * FF + u.pn * 128 + wc * 32 + 8 * fq) = w;
            }
    }
};
struct EpiDown {
    static constexpr bool PERM = true;
    bf16* Y; const int* LIST; TileTab tt;
    __device__ __forceinline__ void operator()(const f32x4 (&acc)[2][2][4][2], const pg8::Unit& u, int wr, int wc, int fr, int fq) const {
        const int e = tt.TE[u.pm], ne = tt.NE[e], p0 = (u.pm - tt.T0[e]) * 256;
#pragma unroll
        for (int ai = 0; ai < 2; ++ai)
#pragma unroll
            for (int m = 0; m < 4; ++m) {
                const int pos = p0 + ai * 128 + wr * 64 + m * 16 + fr;
                if (pos < ne) { const int tk = LIST[e * M + pos]; bf16* rowp = Y + (size_t)tk * DM + u.pn * 256 + wc * 32 + 8 * fq;
#pragma unroll
                    for (int bj = 0; bj < 2; ++bj) { const f32x4 v0 = acc[ai][bj][m][0], v1 = acc[ai][bj][m][1];
                        u32x4 w; w.x = pk2(v0[0], v0[1]); w.y = pk2(v0[2], v0[3]); w.z = pk2(v1[0], v1[1]); w.w = pk2(v1[2], v1[3]);
                        *(u32x4*)(rowp + bj * 128) = w; } }
            }
    }
};

typedef short v4i16_t __attribute__((ext_vector_type(4)));
__device__ __forceinline__ s16x4 vtr(const LAS unsigned char* p) { return __builtin_bit_cast(s16x4, __builtin_amdgcn_ds_read_tr16_b64_v4i16((LAS v4i16_t*)p)); }
#define MFMA32(a, b, c) __builtin_amdgcn_mfma_f32_32x32x16_bf16((a), (b), (c), 0, 0, 0)
__device__ __forceinline__ bf16x8 pack8(const f32x16& x, int s) {
    u32x4 p; p.x = pk2(x[8 * s], x[8 * s + 1]); p.y = pk2(x[8 * s + 2], x[8 * s + 3]); p.z = pk2(x[8 * s + 4], x[8 * s + 5]); p.w = pk2(x[8 * s + 6], x[8 * s + 7]);
    return __builtin_bit_cast(bf16x8, p);
}
__device__ __forceinline__ bf16x8 cat44(s16x4 lo, s16x4 hi) { return __builtin_shufflevector(lo, hi, 0, 1, 2, 3, 4, 5, 6, 7); }
__device__ __forceinline__ bf16x8 scale8(bf16x8 v, float s) {
    u32x4 u = __builtin_bit_cast(u32x4, v), o;
    o.x = pk2(bflo(u.x) * s, bfhi(u.x) * s); o.y = pk2(bflo(u.y) * s, bfhi(u.y) * s); o.z = pk2(bflo(u.z) * s, bfhi(u.z) * s); o.w = pk2(bflo(u.w) * s, bfhi(u.w) * s);
    return __builtin_bit_cast(bf16x8, o);
}
constexpr int TP = 144;
__device__ __forceinline__ void pv_tile_p(f32x16& ot0, f32x16& ot1, const f32x16& st, const LAS unsigned char* vl, int lane) {
    const int hi = lane >> 5;
    const LAS unsigned char* vr = vl + (4 * hi + ((lane & 15) >> 2)) * TP + (16 * ((lane >> 4) & 1) + 4 * (lane & 3)) * 2;
    const bf16x8 pb0 = pack8(st, 0), pb1 = pack8(st, 1);
    { const bf16x8 va = cat44(vtr(vr), vtr(vr + 8 * TP)); ot0 = MFMA32(va, pb0, ot0); }
    { const bf16x8 va = cat44(vtr(vr + 16 * TP), vtr(vr + 24 * TP)); ot0 = MFMA32(va, pb1, ot0); }
    { const bf16x8 va = cat44(vtr(vr + 64), vtr(vr + 8 * TP + 64)); ot1 = MFMA32(va, pb0, ot1); }
    { const bf16x8 va = cat44(vtr(vr + 16 * TP + 64), vtr(vr + 24 * TP + 64)); ot1 = MFMA32(va, pb1, ot1); }
}
__device__ __forceinline__ void kv_task(int cid, const bf16* KR, const bf16* VR, bf16* KV, const float* dec_f, const float* dec_b, LAS unsigned char* wl, int lane) {
    const int bh = cid >> 5, n = cid & 31, b = bh >> 3, h = bh & 7, q = lane & 31, hi = lane >> 5, tr = lane >> 3, tc = (lane & 7) * 8;
    const float lgf = __uint_as_float(__builtin_amdgcn_readfirstlane(__float_as_uint(log1pf(-exp2f(dec_f[h])) * LOG2E))), lgb = __uint_as_float(__builtin_amdgcn_readfirstlane(__float_as_uint(log1pf(-exp2f(dec_b[h])) * LOG2E)));
    const size_t row0 = (size_t)b * SEQ + n * CHUNK; const int loff = tr * SEGW + tc;
    const bf16* Kb = KR + row0 * SEGW + h * HD; const bf16* Vb = VR + row0 * SEGW + h * HD;
    LAS unsigned char* Tf = wl; LAS unsigned char* Tb = wl + 32 * TP; LAS unsigned char* Tv = wl + 64 * TP; LAS unsigned char* tw = wl + tr * TP + tc * 2;
    const int tro = (8 * hi + ((lane & 15) >> 2)) * TP + (16 * ((lane >> 4) & 1) + 4 * (lane & 3)) * 2;
    f32x16 acc[2][2][2];
#pragma unroll
    for (int d = 0; d < 2; ++d)
#pragma unroll
        for (int a = 0; a < 2; ++a)
#pragma unroll
            for (int c = 0; c < 2; ++c)
#pragma unroll
                for (int r = 0; r < 16; ++r) acc[d][a][c][r] = 0.f;
    bf16x8 nk[4], nv[4];
#pragma unroll
    for (int i = 0; i < 4; ++i) { nk[i] = *(const bf16x8*)(Kb + loff + 8 * i * SEGW); nv[i] = *(const bf16x8*)(Vb + loff + 8 * i * SEGW); }
#pragma unroll 1
    for (int it = 0; it < 4; ++it) {
#pragma unroll
        for (int i = 0; i < 4; ++i) { const int key = 32 * it + tr + 8 * i;
            *(LAS bf16x8*)(tw + 8 * i * TP) = scale8(nk[i], __builtin_amdgcn_exp2f((float)(CHUNK - 1 - key) * lgf));
            *(LAS bf16x8*)(tw + 32 * TP + 8 * i * TP) = scale8(nk[i], __builtin_amdgcn_exp2f((float)key * lgb));
            *(LAS bf16x8*)(tw + 64 * TP + 8 * i * TP) = nv[i]; }
        if (it < 3) {
#pragma unroll
            for (int i = 0; i < 4; ++i) { nk[i] = *(const bf16x8*)(Kb + 32 * (it + 1) * SEGW + loff + 8 * i * SEGW); nv[i] = *(const bf16x8*)(Vb + 32 * (it + 1) * SEGW + loff + 8 * i * SEGW); } }
        asm volatile("" ::: "memory");
#pragma unroll
        for (int s2 = 0; s2 < 2; ++s2) {
            bf16x8 bv[2];
#pragma unroll
            for (int c = 0; c < 2; ++c) bv[c] = cat44(vtr(Tv + tro + s2 * 16 * TP + c * 64), vtr(Tv + tro + s2 * 16 * TP + 4 * TP + c * 64));
#pragma unroll
            for (int a = 0; a < 2; ++a) {
                const bf16x8 af = cat44(vtr(Tf + tro + s2 * 16 * TP + a * 64), vtr(Tf + tro + s2 * 16 * TP + 4 * TP + a * 64));
                const bf16x8 ab = cat44(vtr(Tb + tro + s2 * 16 * TP + a * 64), vtr(Tb + tro + s2 * 16 * TP + 4 * TP + a * 64));
#pragma unroll
                for (int c = 0; c < 2; ++c) { acc[0][a][c] = MFMA32(af, bv[c], acc[0][a][c]); acc[1][a][c] = MFMA32(ab, bv[c], acc[1][a][c]); }
            }
        }
        asm volatile("" ::: "memory");
    }
#pragma unroll
    for (int d = 0; d < 2; ++d) { bf16* ob = KV + (((size_t)bh * NCHUNK + n) * 2 + d) * 4096;
#pragma unroll
        for (int a = 0; a < 2; ++a)
#pragma unroll
            for (int c = 0; c < 2; ++c)
#pragma unroll
                for (int g = 0; g < 4; ++g) { u32x2 w; w.x = pk2(acc[d][a][c][4 * g], acc[d][a][c][4 * g + 1]); w.y = pk2(acc[d][a][c][4 * g + 2], acc[d][a][c][4 * g + 3]);
                    *(u32x2*)(ob + ((c * 4 + 2 * a + (g >> 1)) * 64 + q + 32 * (g & 1)) * 8 + 4 * hi) = w; } }
}

struct AttnRound { size_t rowbase; int dil, qb0, nblk, h, br; };
__device__ __forceinline__ AttnRound round_decode(int rg) {
    AttnRound a; const int bh = rg / 48, x = rg - bh * 48, br = x >> 4, w16 = x & 15; int cls, qb0;
    if (br == 0) { cls = 0; qb0 = 8 * w16; } else if (br == 1) { cls = w16 >> 2; qb0 = 8 * (w16 & 3); } else { cls = w16; qb0 = 0; }
    a.rowbase = (size_t)(bh >> 3) * SEQ + cls; a.dil = 1 << (2 * br); a.qb0 = qb0; a.nblk = (SEQ >> (2 * br)) >> 5; a.h = bh & 7; a.br = br; return a;
}
__device__ __forceinline__ int round_id(int r0, int xl, int rr) { if (xl < 0) return r0 + rr; const int t = rr / 3, i = rr - 3 * t; return (r0 + 2 * t + (xl >> 4)) * 48 + 3 * (xl & 15) + i; }
__device__ __forceinline__ void attn_rounds(int r0, int xl, int nr, const bf16* QA, const bf16* KA, const bf16* VA, bf16* OBR, float* LSE, LAS unsigned char* lds, int wave, int lane) {
    const int q = lane & 31, hi = lane >> 5, tr = lane >> 3, tc = (lane & 7) * 8;
    LAS unsigned char* Qt = lds + (24 + wave) * (32 * TP);
    const int twoff = tr * TP + tc * 2;
    bf16x8 pt[3][4], pq[4];
    AttnRound nx = round_decode(round_id(r0, xl, 0));
#define ATT_PREFETCH(R) do { \
        _Pragma("unroll") for (int x_ = 0; x_ < 3; ++x_) { const int tile = 3 * wave + x_, slot = tile >= 12 ? tile - 12 : tile, j_ = (R).qb0 - 2 + slot; \
            if (j_ >= 0 && j_ < (R).nblk) { const bf16* src = (tile >= 12 ? VA : KA) + ((R).rowbase + (size_t)(R).dil * (32 * j_ + tr)) * SEGW + (R).h * HD + tc; \
                _Pragma("unroll") for (int i_ = 0; i_ < 4; ++i_) pt[x_][i_] = *(const bf16x8*)(src + (size_t)(R).dil * 8 * i_ * SEGW); } } \
        { const bf16* src = QA + ((R).rowbase + (size_t)(R).dil * (32 * ((R).qb0 + wave) + tr)) * SEGW + (R).h * HD + tc; \
          _Pragma("unroll") for (int i_ = 0; i_ < 4; ++i_) pq[i_] = *(const bf16x8*)(src + (size_t)(R).dil * 8 * i_ * SEGW); } } while (0)
    ATT_PREFETCH(nx);
#pragma unroll 1
    for (int rr = 0; rr < nr; ++rr) {
        const AttnRound cu = nx;
        __syncthreads();
#pragma unroll
        for (int x = 0; x < 3; ++x) { const int tile = 3 * wave + x, slot = tile >= 12 ? tile - 12 : tile, j = cu.qb0 - 2 + slot;
            if (j >= 0 && j < cu.nblk) { LAS unsigned char* tb = lds + tile * (32 * TP) + twoff;
#pragma unroll
                for (int i = 0; i < 4; ++i) *(LAS bf16x8*)(tb + 8 * i * TP) = pt[x][i]; } }
#pragma unroll
        for (int i = 0; i < 4; ++i) *(LAS bf16x8*)(Qt + twoff + 8 * i * TP) = pq[i];
        if (rr + 1 < nr) { nx = round_decode(round_id(r0, xl, rr + 1)); ATT_PREFETCH(nx); }
        __syncthreads();
        bf16x8 qr[4];
#pragma unroll
        for (int ks = 0; ks < 4; ++ks) qr[ks] = *(const LAS bf16x8*)(Qt + q * TP + hi * 16 + 32 * ks);
        float mrun = -1e30f, lsum = 0.f; f32x16 ot0, ot1;
#pragma unroll
        for (int r = 0; r < 16; ++r) { ot0[r] = 0.f; ot1[r] = 0.f; }
        const int jb = cu.qb0 + wave - 2, klo = jb < 0 ? -jb : 0, khi = jb + 4 >= cu.nblk ? cu.nblk - 1 - jb : 4;
        f32x16 stn;
#define ATT_QK(dst, kb_) do { const LAS unsigned char* Kt_ = lds + (wave + (kb_)) * (32 * TP); _Pragma("unroll") for (int r_ = 0; r_ < 16; ++r_) dst[r_] = 0.f; \
            _Pragma("unroll") for (int ks_ = 0; ks_ < 4; ++ks_) dst = MFMA32(*(const LAS bf16x8*)(Kt_ + q * TP + hi * 16 + 32 * ks_), qr[ks_], dst); } while (0)
        ATT_QK(stn, klo);
#pragma unroll 1
        for (int kb = klo; kb <= khi; ++kb) {
            f32x16 st = stn;
            if (kb < khi) ATT_QK(stn, kb + 1);
            const LAS unsigned char* Vt = lds + (12 + wave + kb) * (32 * TP);
            if (kb == 0) {
#pragma unroll
                for (int r = 0; r < 16; ++r) if (crow(r, hi) < q) st[r] = -1e30f;
            }
            if (kb == 4) {
#pragma unroll
                for (int r = 0; r < 16; ++r) if (crow(r, hi) > q) st[r] = -1e30f;
            }
            float mx = st[0];
#pragma unroll
            for (int r = 1; r < 16; ++r) mx = fmaxf(mx, st[r]);
            mx = fmaxf(mx, __shfl_xor(mx, 32));
            if (!__all(mx <= mrun + 8.f)) {
                const float mnew = fmaxf(mrun, mx), alpha = __builtin_amdgcn_exp2f(mrun - mnew); mrun = mnew; lsum *= alpha;
#pragma unroll
                for (int r = 0; r < 16; ++r) { ot0[r] *= alpha; ot1[r] *= alpha; }
            }
            float ps = 0.f;
#pragma unroll
            for (int r = 0; r < 16; ++r) { st[r] = __builtin_amdgcn_exp2f(st[r] - mrun); ps += st[r]; }
            lsum += ps;
            pv_tile_p(ot0, ot1, st, Vt, lane);
        }
#undef ATT_QK
        const float lt = lsum + __shfl_xor(lsum, 32);
        const float inv = 1.f / lt, lse = (mrun + __log2f(lt)) * LN2;
        asm volatile("" ::: "memory");
        LAS unsigned char* ow = Qt + q * TP + 8 * hi;
#pragma unroll
        for (int g = 0; g < 4; ++g) {
            u32x2 w0, w1; w0.x = pk2(ot0[4 * g] * inv, ot0[4 * g + 1] * inv); w0.y = pk2(ot0[4 * g + 2] * inv, ot0[4 * g + 3] * inv);
            w1.x = pk2(ot1[4 * g] * inv, ot1[4 * g + 1] * inv); w1.y = pk2(ot1[4 * g + 2] * inv, ot1[4 * g + 3] * inv);
            *(LAS u32x2*)(ow + 16 * g) = w0; *(LAS u32x2*)(ow + 64 + 16 * g) = w1; }
        asm volatile("" ::: "memory");
        const size_t qbase = cu.rowbase + (size_t)cu.dil * 32 * (cu.qb0 + wave);
#pragma unroll
        for (int i = 0; i < 4; ++i) { const u32x4 v = *(const LAS u32x4*)(Qt + twoff + 8 * i * TP);
            *(u32x4*)(OBR + ((size_t)cu.br * M + qbase + (size_t)cu.dil * (tr + 8 * i)) * SEGW + cu.h * HD + tc) = v; }
        if (hi == 0) LSE[((size_t)cu.br * M + qbase + (size_t)cu.dil * q) * NHEAD + cu.h] = lse;
        asm volatile("" ::: "memory");
    }
#undef ATT_PREFETCH
    __syncthreads();
}

constexpr int R_K = 0, R_V = 128 * TP, R_Q = 2 * 128 * TP, R_G = 3 * 128 * TP, R_O = 4 * 128 * TP, R_SF = 5 * 128 * TP, R_SB = R_SF + 8192, R_X = R_SB + 8192;
__device__ __forceinline__ void ret_wg(int wgt, const bf16* QR, const bf16* KR, const bf16* VR, const bf16* GR, const bf16* KV, bf16* SBW, bf16* MIXED, const float* dec_f, const float* dec_b,
                                       const bf16* OBR, const float* LSE, long crow0, LAS unsigned char* lds, int tid, int wave, int lane) {
    const int bh = wgt >> 2, n0 = (wgt & 3) * 8, b = bh >> 3, h = bh & 7, q = lane & 31, hi = lane >> 5, tr = lane >> 3, tc = (lane & 7) * 8;
    const float lgf = __uint_as_float(__builtin_amdgcn_readfirstlane(__float_as_uint(log1pf(-exp2f(dec_f[h])) * LOG2E))), lgb = __uint_as_float(__builtin_amdgcn_readfirstlane(__float_as_uint(log1pf(-exp2f(dec_b[h])) * LOG2E)));
    const float gf128 = exp2f(128.f * lgf), gb128 = exp2f(128.f * lgb);
    float pf[16], pb[16];
#pragma unroll
    for (int r = 0; r < 16; ++r) { const int dl = q - crow(r, hi); pf[r] = exp2f((float)dl * lgf); pb[r] = exp2f((float)(-dl) * lgb); }
    const bf16* KVt = KV + (size_t)bh * NCHUNK * 2 * 4096 + 8 * tid;
    bf16* SBt = SBW + (size_t)bh * NCHUNK * 4096 + 8 * tid;
    float Sf[8], Sb[8];
#pragma unroll
    for (int e = 0; e < 8; ++e) { Sf[e] = 0.f; Sb[e] = 0.f; }
#define RET_AXPY(S, g, v) do { S[0] = S[0] * (g) + bflo((v).x); S[1] = S[1] * (g) + bfhi((v).x); S[2] = S[2] * (g) + bflo((v).y); S[3] = S[3] * (g) + bfhi((v).y); \
                               S[4] = S[4] * (g) + bflo((v).z); S[5] = S[5] * (g) + bfhi((v).z); S[6] = S[6] * (g) + bflo((v).w); S[7] = S[7] * (g) + bfhi((v).w); } while (0)
    for (int m0 = 0; m0 < n0; m0 += 8) { u32x4 v[8];
#pragma unroll
        for (int k = 0; k < 8; ++k) v[k] = *(const u32x4*)(KVt + (size_t)((m0 + k) * 2) * 4096);
#pragma unroll
        for (int k = 0; k < 8; ++k) RET_AXPY(Sf, gf128, v[k]); }
    for (int m0 = NCHUNK - 8; m0 >= n0 + 8; m0 -= 8) { u32x4 v[8];
#pragma unroll
        for (int k = 0; k < 8; ++k) v[k] = *(const u32x4*)(KVt + (size_t)((m0 + 7 - k) * 2 + 1) * 4096);
#pragma unroll
        for (int k = 0; k < 8; ++k) RET_AXPY(Sb, gb128, v[k]); }
    { u32x4 v[8];
#pragma unroll
      for (int k = 0; k < 8; ++k) v[k] = *(const u32x4*)(KVt + (size_t)((n0 + 7 - k) * 2 + 1) * 4096);
#pragma unroll
      for (int k = 0; k < 8; ++k) { u32x4 w; w.x = pk2(Sb[0], Sb[1]); w.y = pk2(Sb[2], Sb[3]); w.z = pk2(Sb[4], Sb[5]); w.w = pk2(Sb[6], Sb[7]);
          *(u32x4*)(SBt + (size_t)(n0 + 7 - k) * 4096) = w; RET_AXPY(Sb, gb128, v[k]); } }
    VM_WAIT();
    const int tsel = wave >> 1, rbase = 64 * (wave & 1) + tr;
    const bf16* tsrc = (tsel == 0 ? KR : tsel == 1 ? VR : tsel == 2 ? QR : GR) + ((size_t)b * SEQ + rbase) * SEGW + h * HD + tc;
    LAS unsigned char* tdst = lds + tsel * (128 * TP) + rbase * TP + tc * 2;
    const int qb = wave & 3, dvh = wave >> 2;
    bf16x8 pre[8]; u32x4 pkv, psb;
#define RET_PREFETCH(n_) do { _Pragma("unroll") for (int i_ = 0; i_ < 8; ++i_) pre[i_] = __builtin_nontemporal_load((const bf16x8*)(tsrc + (size_t)((n_) * CHUNK + 8 * i_) * SEGW)); \
        pkv = *(const u32x4*)(KVt + (size_t)((n_) * 2) * 4096); psb = *(const u32x4*)(SBt + (size_t)(n_) * 4096); } while (0)
    RET_PREFETCH(n0);
#pragma unroll 1
    for (int jn = 0; jn < 8; ++jn) {
        const int n = n0 + jn; const size_t row0 = (size_t)b * SEQ + n * CHUNK;
        __syncthreads();
        if (jn > 0) {
#pragma unroll
            for (int i = 0; i < 2; ++i) { const int r = 16 * wave + 8 * i + tr; const u32x4 v = *(const LAS u32x4*)(lds + R_O + r * TP + tc * 2);
                *(u32x4*)(MIXED + (row0 - CHUNK + r) * DM + 512 + h * HD + tc) = v; } }
#pragma unroll
        for (int i = 0; i < 8; ++i) *(LAS bf16x8*)(tdst + 8 * i * TP) = pre[i];
        { u32x4 w; w.x = pk2(Sf[0], Sf[1]); w.y = pk2(Sf[2], Sf[3]); w.z = pk2(Sf[4], Sf[5]); w.w = pk2(Sf[6], Sf[7]);
          *(LAS u32x4*)(lds + R_SF + tid * 16) = w; *(LAS u32x4*)(lds + R_SB + tid * 16) = psb; }
        RET_AXPY(Sf, gf128, pkv);
        if (jn < 7) RET_PREFETCH(n + 1);
        float cl[3]; u32x4 ca[3];
#define RET_CLOAD(rw_) do { _Pragma("unroll") for (int br_ = 0; br_ < 3; ++br_) { cl[br_] = LSE[((size_t)br_ * M + (rw_)) * NHEAD + (lane >> 3)]; ca[br_] = __builtin_nontemporal_load((const u32x4*)(OBR + ((size_t)br_ * M + (rw_)) * SEGW + 8 * lane)); } } while (0)
#define RET_CFIN(rw_) do { const float mx_ = fmaxf(cl[0], fmaxf(cl[1], cl[2])); float w0_ = __expf(cl[0] - mx_), w1_ = __expf(cl[1] - mx_), w2_ = __expf(cl[2] - mx_); \
            const float inv_ = 1.f / (w0_ + w1_ + w2_); w0_ *= inv_; w1_ *= inv_; w2_ *= inv_; float o_[8]; float ssq_ = 0.f; \
            _Pragma("unroll") for (int e_ = 0; e_ < 4; ++e_) { o_[2 * e_] = w0_ * bflo(ca[0][e_]) + w1_ * bflo(ca[1][e_]) + w2_ * bflo(ca[2][e_]); o_[2 * e_ + 1] = w0_ * bfhi(ca[0][e_]) + w1_ * bfhi(ca[1][e_]) + w2_ * bfhi(ca[2][e_]); ssq_ += o_[2 * e_] * o_[2 * e_] + o_[2 * e_ + 1] * o_[2 * e_ + 1]; } \
            const float rs_ = 1.f / sqrtf(wave_sum(ssq_) * (1.f / 512.f) + NORM_EPS); \
            u32x4 w_; w_.x = pk2(o_[0] * rs_, o_[1] * rs_); w_.y = pk2(o_[2] * rs_, o_[3] * rs_); w_.z = pk2(o_[4] * rs_, o_[5] * rs_); w_.w = pk2(o_[6] * rs_, o_[7] * rs_); \
            *(u32x4*)(MIXED + (rw_) * DM + 8 * lane) = w_; } while (0)
        if (crow0 >= 0) RET_CLOAD((size_t)crow0 + 2 * jn);
        __syncthreads();
        const int i_ = 32 * qb + q;
        bf16x8 qr[4];
#pragma unroll
        for (int ks = 0; ks < 4; ++ks) qr[ks] = *(const LAS bf16x8*)(lds + R_Q + i_ * TP + hi * 16 + 32 * ks);
        f32x16 ot;
#pragma unroll
        for (int r = 0; r < 16; ++r) ot[r] = 0.f;
        const LAS unsigned char* vr = lds + R_V + (4 * hi + ((lane & 15) >> 2)) * TP + (32 * dvh + 16 * ((lane >> 4) & 1) + 4 * (lane & 3)) * 2;
#pragma unroll 1
        for (int kb = 0; kb < 4; ++kb) {
            f32x16 st;
#pragma unroll
            for (int r = 0; r < 16; ++r) st[r] = 0.f;
#pragma unroll
            for (int ks = 0; ks < 4; ++ks) st = MFMA32(*(const LAS bf16x8*)(lds + R_K + (32 * kb + q) * TP + hi * 16 + 32 * ks), qr[ks], st);
#pragma unroll
            for (int r = 0; r < 16; ++r) st[r] *= (kb == qb ? (q >= crow(r, hi) ? pf[r] : pb[r]) : kb < qb ? pf[r] : pb[r]);
            if (kb != qb) { const float sc = kb < qb ? exp2f((float)(32 * (qb - kb)) * lgf) : exp2f((float)(32 * (kb - qb)) * lgb);
#pragma unroll
                for (int r = 0; r < 16; ++r) st[r] *= sc; }
            const bf16x8 pb0 = pack8(st, 0), pb1 = pack8(st, 1);
            const LAS unsigned char* v0 = vr + 32 * kb * TP;
            ot = MFMA32(cat44(vtr(v0), vtr(v0 + 8 * TP)), pb0, ot);
            ot = MFMA32(cat44(vtr(v0 + 16 * TP), vtr(v0 + 24 * TP)), pb1, ot);
        }
        {   const float cf = exp2f((float)(i_ + 1) * lgf), cb = exp2f((float)(CHUNK - i_) * lgb);
            f32x16 t;
#pragma unroll
            for (int r = 0; r < 16; ++r) t[r] = 0.f;
#pragma unroll
            for (int ks = 0; ks < 4; ++ks) t = MFMA32(*(const LAS bf16x8*)(lds + R_SF + ((dvh * 4 + ks) * 64 + lane) * 16), qr[ks], t);
#pragma unroll
            for (int r = 0; r < 16; ++r) ot[r] += cf * t[r];
#pragma unroll
            for (int r = 0; r < 16; ++r) t[r] = 0.f;
#pragma unroll
            for (int ks = 0; ks < 4; ++ks) t = MFMA32(*(const LAS bf16x8*)(lds + R_SB + ((dvh * 4 + ks) * 64 + lane) * 16), qr[ks], t);
#pragma unroll
            for (int r = 0; r < 16; ++r) ot[r] += cb * t[r]; }
        if (crow0 >= 0) { RET_CFIN((size_t)crow0 + 2 * jn); RET_CLOAD((size_t)crow0 + 2 * jn + 1); }
        float s1 = 0.f, s2 = 0.f;
#pragma unroll
        for (int r = 0; r < 16; ++r) { s1 += ot[r]; s2 += ot[r] * ot[r]; }
        s1 += __shfl_xor(s1, 32); s2 += __shfl_xor(s2, 32);
        if (hi == 0) *(LAS f32x2*)(lds + R_X + (wave * 32 + q) * 8) = (f32x2){s1, s2};
        __syncthreads();
        { const f32x2 p = *(const LAS f32x2*)(lds + R_X + ((wave ^ 4) * 32 + q) * 8); s1 += p.x; s2 += p.y; }
        const float mean = s1 * (1.f / 64.f), var = fmaxf(s2 * (1.f / 64.f) - mean * mean, 0.f), rstd = 1.f / sqrtf(var + NORM_EPS);
        const LAS unsigned char* gp = lds + R_G + i_ * TP + (32 * dvh + 4 * hi) * 2; LAS unsigned char* op = lds + R_O + i_ * TP + (32 * dvh + 4 * hi) * 2;
#pragma unroll
        for (int g = 0; g < 4; ++g) { const u32x2 gg = *(const LAS u32x2*)(gp + 16 * g); u32x2 w;
            w.x = pk2((ot[4 * g] - mean) * rstd * bflo(gg.x), (ot[4 * g + 1] - mean) * rstd * bfhi(gg.x)); w.y = pk2((ot[4 * g + 2] - mean) * rstd * bflo(gg.y), (ot[4 * g + 3] - mean) * rstd * bfhi(gg.y));
            *(LAS u32x2*)(op + 16 * g) = w; }
        if (crow0 >= 0) RET_CFIN((size_t)crow0 + 2 * jn + 1);
    }
#undef RET_CLOAD
#undef RET_CFIN
    __syncthreads();
    { const size_t row0 = (size_t)b * SEQ + (n0 + 7) * CHUNK;
#pragma unroll
      for (int i = 0; i < 2; ++i) { const int r = 16 * wave + 8 * i + tr; const u32x4 v = *(const LAS u32x4*)(lds + R_O + r * TP + tc * 2);
          *(u32x4*)(MIXED + (row0 + r) * DM + 512 + h * HD + tc) = v; } }
    __syncthreads();
#undef RET_AXPY
#undef RET_PREFETCH
}

template <int NR>
__device__ __forceinline__ void combine_rows(const size_t (&rows)[NR], const bf16* OBR, const float* LSE, bf16* MIXED, int lane) {
    const int hh = lane >> 3;
    float l[NR][3]; u32x4 a[NR][3];
#pragma unroll
    for (int k = 0; k < NR; ++k)
#pragma unroll
        for (int br = 0; br < 3; ++br) { l[k][br] = LSE[((size_t)br * M + rows[k]) * NHEAD + hh]; a[k][br] = *(const u32x4*)(OBR + ((size_t)br * M + rows[k]) * SEGW + 8 * lane); }
#pragma unroll
    for (int k = 0; k < NR; ++k) {
        const float mx = fmaxf(l[k][0], fmaxf(l[k][1], l[k][2])); float w0 = __expf(l[k][0] - mx), w1 = __expf(l[k][1] - mx), w2 = __expf(l[k][2] - mx);
        const float inv = 1.f / (w0 + w1 + w2); w0 *= inv; w1 *= inv; w2 *= inv;
        float o[8]; float ss = 0.f;
#pragma unroll
        for (int e = 0; e < 4; ++e) { o[2 * e] = w0 * bflo(a[k][0][e]) + w1 * bflo(a[k][1][e]) + w2 * bflo(a[k][2][e]); o[2 * e + 1] = w0 * bfhi(a[k][0][e]) + w1 * bfhi(a[k][1][e]) + w2 * bfhi(a[k][2][e]); ss += o[2 * e] * o[2 * e] + o[2 * e + 1] * o[2 * e + 1]; }
        const float rstd = 1.f / sqrtf(wave_sum(ss) * (1.f / 512.f) + NORM_EPS);
        u32x4 w; w.x = pk2(o[0] * rstd, o[1] * rstd); w.y = pk2(o[2] * rstd, o[3] * rstd); w.z = pk2(o[4] * rstd, o[5] * rstd); w.w = pk2(o[6] * rstd, o[7] * rstd);
        *(u32x4*)(MIXED + rows[k] * DM + 8 * lane) = w;
    }
}
constexpr int RP = 528;
constexpr int R5_W = 0, R5_A = 2 * 48 * RP, R5_SC = R5_A + 8 * 16 * RP, R5_CNT = R5_SC + 8 * 3200;
__device__ __forceinline__ void route_wg(int wgt, const bf16* HB, const bf16* WR, const float* bg, const float* be, gu32* ctl, int* LIST, float* GATEL, float* RSL, LAS unsigned char* lds, int tid, int wave, int lane) {
    const size_t row0 = (size_t)wgt * 128;
    LAS unsigned* cntL = (LAS unsigned*)(lds + R5_CNT); LAS unsigned* baseL = cntL + 32;
    if (tid < 32) cntL[tid] = 0u;
    u32x4 pw[6], pa[8];
#define R5_PREF(kc) do { _Pragma("unroll") for (int i_ = 0; i_ < 6; ++i_) { const int idx = tid + 512 * i_; pw[i_] = *(const u32x4*)(WR + (size_t)(idx >> 5) * DM + 256 * (kc) + 8 * (idx & 31)); } \
        _Pragma("unroll") for (int i_ = 0; i_ < 8; ++i_) pa[i_] = *(const u32x4*)(HB + (row0 + 16 * wave + 2 * i_ + (lane >> 5)) * DM + 256 * (kc) + 8 * (lane & 31)); } while (0)
    R5_PREF(0);
    f32x4 acc[3]; float ss = 0.f;
#pragma unroll
    for (int c = 0; c < 3; ++c) acc[c] = (f32x4){0.f, 0.f, 0.f, 0.f};
    const LAS unsigned char* Aw = lds + R5_A + wave * 16 * RP;
#pragma unroll 1
    for (int kc = 0; kc < 4; ++kc) {
        __syncthreads();
#pragma unroll
        for (int i = 0; i < 6; ++i) { const int idx = tid + 512 * i; *(LAS u32x4*)(lds + R5_W + (idx >> 5) * RP + (idx & 31) * 16) = pw[i]; }
#pragma unroll
        for (int i = 0; i < 8; ++i) *(LAS u32x4*)(lds + R5_A + (wave * 16 + 2 * i + (lane >> 5)) * RP + (lane & 31) * 16) = pa[i];
        if (kc < 3) R5_PREF(kc + 1);
        __syncthreads();
#pragma unroll
        for (int ks = 0; ks < 8; ++ks) {
            const int ko = (32 * ks + 8 * (lane >> 4)) * 2;
            const bf16x8 a = *(const LAS bf16x8*)(Aw + (lane & 15) * RP + ko);
            { const u32x4 au = __builtin_bit_cast(u32x4, a);
#pragma unroll
              for (int e = 0; e < 4; ++e) { const float lo = bflo(au[e]), hi_ = bfhi(au[e]); ss += lo * lo + hi_ * hi_; } }
#pragma unroll
            for (int c = 0; c < 3; ++c)
#pragma unroll
                for (int p = 0; p < 2; ++p) { const bf16x8 bb = *(const LAS bf16x8*)(lds + R5_W + (p * 48 + 16 * c + (lane & 15)) * RP + ko);
                    acc[c] = __builtin_amdgcn_mfma_f32_16x16x32_bf16(a, bb, acc[c], 0, 0, 0); }
        }
    }
#undef R5_PREF
    ss += __shfl_xor(ss, 16); ss += __shfl_xor(ss, 32);
    const float rstd = 1.f / sqrtf(ss * (1.f / DM) + NORM_EPS);
    LAS float* sc = (LAS float*)(lds + R5_SC + wave * 3200);
    { const int r = lane & 15, g = lane >> 4;
#pragma unroll
      for (int e = 0; e < 4; ++e) { sc[(4 * g + e) * 48 + r] = acc[0][e]; sc[(4 * g + e) * 48 + 16 + r] = acc[1][e]; sc[(4 * g + e) * 48 + 32 + r] = acc[2][e]; }
      if (g == 0) sc[768 + r] = rstd; }
    LDS_WAIT(); asm volatile("" ::: "memory");
    int e1 = 0, e2 = 0; unsigned r1 = 0, r2 = 0; float g1 = 0.f, g2 = 0.f, rs = 0.f;
    if (lane < 16) {
        rs = sc[768 + lane]; const LAS float* lg = sc + lane * 48;
        float gmax = lg[32] * rs + bg[0]; int gi = 0; float gl[4]; gl[0] = gmax;
#pragma unroll
        for (int k = 1; k < 4; ++k) { gl[k] = lg[32 + k] * rs + bg[k]; if (gl[k] > gmax) { gmax = gl[k]; gi = k; } }
        float den = 0.f;
#pragma unroll
        for (int k = 0; k < 4; ++k) den += __expf(gl[k] - gmax);
        const float ggate = 1.f / den;
        float b1v = -3.0e38f, b2v = -3.0e38f; int i1 = 0, i2 = 0;
        for (int k = 0; k < 8; ++k) { const float v = lg[gi * 8 + k] * rs + be[gi * 8 + k]; if (v > b1v) { b1v = v; i1 = k; } }
        for (int k = 0; k < 8; ++k) { const float v = lg[gi * 8 + k] * rs + be[gi * 8 + k]; if (k != i1 && v > b2v) { b2v = v; i2 = k; } }
        const float p1 = 1.f / (1.f + __expf(b2v - b1v));
        g1 = ggate * p1; g2 = ggate * (1.f - p1); e1 = gi * 8 + i1; e2 = gi * 8 + i2;
        r1 = __hip_atomic_fetch_add(cntL + e1, 1u, __ATOMIC_RELAXED, __HIP_MEMORY_SCOPE_WORKGROUP); r2 = __hip_atomic_fetch_add(cntL + e2, 1u, __ATOMIC_RELAXED, __HIP_MEMORY_SCOPE_WORKGROUP);
    }
    __syncthreads();
    if (tid < 32) { const unsigned c = cntL[tid]; baseL[tid] = c ? __hip_atomic_fetch_add(ctl + CW_CNT + 64 * tid, c, RLX_AGENT) : 0u; }
    __syncthreads();
    if (lane < 16) {
        const size_t trow = row0 + 16 * wave + lane; const size_t s1 = (size_t)e1 * M + baseL[e1] + r1, s2 = (size_t)e2 * M + baseL[e2] + r2;
        LIST[s1] = (int)(trow * 2); GATEL[s1] = g1; RSL[s1] = rs;
        LIST[s2] = (int)(trow * 2 + 1); GATEL[s2] = g2; RSL[s2] = rs;
    }
    __syncthreads();
}
template <int NR>
__device__ __forceinline__ void final_rows(const size_t (&rows)[NR], const bf16* H, const bf16* Y, const f32x4 (&gv)[4], float* out, int lane) {
    u32x2 hv[NR][4], a[NR][4], b[NR][4];
#pragma unroll
    for (int k = 0; k < NR; ++k) { const u32x2* hp = (const u32x2*)(H + rows[k] * DM) + lane; const u32x2* y0 = (const u32x2*)(Y + (rows[k] * 2) * DM) + lane; const u32x2* y1 = (const u32x2*)(Y + (rows[k] * 2 + 1) * DM) + lane;
#pragma unroll
        for (int j = 0; j < 4; ++j) { hv[k][j] = __builtin_nontemporal_load(hp + 64 * j); a[k][j] = __builtin_nontemporal_load(y0 + 64 * j); b[k][j] = __builtin_nontemporal_load(y1 + 64 * j); } }
#pragma unroll
    for (int k = 0; k < NR; ++k) { f32x4 z[4]; float ss = 0.f;
#pragma unroll
        for (int j = 0; j < 4; ++j) {
            z[j][0] = bflo(hv[k][j].x) + bflo(a[k][j].x) + bflo(b[k][j].x); z[j][1] = bfhi(hv[k][j].x) + bfhi(a[k][j].x) + bfhi(b[k][j].x); z[j][2] = bflo(hv[k][j].y) + bflo(a[k][j].y) + bflo(b[k][j].y); z[j][3] = bfhi(hv[k][j].y) + bfhi(a[k][j].y) + bfhi(b[k][j].y);
            ss += (z[j][0] * z[j][0] + z[j][1] * z[j][1]) + (z[j][2] * z[j][2] + z[j][3] * z[j][3]); }
        const float rstd = 1.f / sqrtf(wave_sum(ss) * (1.f / DM) + NORM_EPS);
        f32x4* op = (f32x4*)(out + rows[k] * DM) + lane;
#pragma unroll
        for (int j = 0; j < 4; ++j) __builtin_nontemporal_store(z[j] * rstd * gv[j], op + 64 * j); }
}
__device__ __forceinline__ TileTab build_tiles(Frame& F, int& ntiles) {
    LAS int* T = (LAS int*)(F.lds + TILE_OFF); LAS int* TE = T; LAS int* NE = T + MAXTILES; LAS int* T0 = NE + 32; LAS int* NT = T0 + 32;
    __syncthreads();
    if (F.tid == 0) { int t = 0;
        for (int e = 0; e < NEXP; ++e) { int n = (int)__hip_atomic_load(F.ctl + CW_CNT + 64 * e, RLX_AGENT); if (n > M) n = M; NE[e] = n; T0[e] = t; const int k = (n + 255) >> 8;
            for (int j = 0; j < k && t + j < MAXTILES; ++j) TE[t + j] = e; t += k; if (t > MAXTILES) t = MAXTILES; }
        NT[0] = t; }
    __syncthreads();
    ntiles = NT[0];
    TileTab tt; tt.TE = TE; tt.NE = NE; tt.T0 = T0; return tt;
}

__device__ __forceinline__ int fresh_lane() { int t = threadIdx.x; asm volatile("" : "+v"(t)); return t & 63; }
constexpr int N_LAUNCHES = MK_N_LAUNCHES, PER_PHASE = 9;
__global__ void __launch_bounds__(NWAVES * 64, 2) mk_fwd(Args args) {
    extern __shared__ __attribute__((aligned(16))) unsigned char lds_raw[];
    Frame F;
    F.lds = (LAS unsigned char*)lds_raw;
    F.MISC = (volatile LAS unsigned*)(F.lds + MISC_OFF);
    F.tid = threadIdx.x; F.lane = F.tid & 63; F.wave = __builtin_amdgcn_readfirstlane(F.tid >> 6);
    F.G = gridDim.x; { const int bx = blockIdx.x; F.vcu = (F.G % 8 == 0) ? (bx % 8) * (F.G / 8) + bx / 8 : bx; }
    unsigned char* ws = args.ws;
    F.ctl = (gu32*)(ws + WS_CTL);
    for (int u = F.tid; u < (LDS_BYTES - LDSCTL_OFF) / 4; u += NWAVES * 64) ((LAS unsigned*)(F.lds + LDSCTL_OFF))[u] = 0u;
    __syncthreads();
    XcdBarrier bar; bar.bar = (unsigned*)(F.ctl + CW_BAR); bar.x = 0; bar.st = nullptr;
    if (N_LAUNCHES != PER_PHASE) bar = xcd_barrier_post((unsigned*)(F.ctl + CW_BAR) + args.li * XCD_BAR_WORDS, F.MISC + 8);
#define GRID_BAR() do { if (N_LAUNCHES != PER_PHASE) xcd_barrier(bar); } while (0)
    const int lo = args.ph_lo, hi = args.ph_hi;
#define IN(k) (lo <= (k) && (k) < hi)
#define REPS(k) ((MK_REPEAT == (k)) ? MK_NREP : 1)
#define BOTH(k) (IN(k) && IN((k) + 1))
    const int gw = F.vcu * NWAVES + F.wave, NGW = F.G * NWAVES;
#if MK_TIME
    int n_stamp = 0;
#define STAMP() do { if (blockIdx.x == 0 && F.tid == 0) { const unsigned long long t_ = __builtin_amdgcn_s_memrealtime(); __hip_atomic_store(F.ctl + CW_TS + 2 * n_stamp, (unsigned)t_, RLX_AGENT); __hip_atomic_store(F.ctl + CW_TS + 2 * n_stamp + 1, (unsigned)(t_ >> 32), RLX_AGENT); } ++n_stamp; } while (0)
    STAMP();
#else
#define STAMP() do {} while (0)
#endif
    bf16* SEGB = (bf16*)(ws + WS_SEG);
    const bf16 *QA = SEGB, *KA = SEGB + (size_t)1 * M * SEGW, *VA = SEGB + (size_t)2 * M * SEGW, *QR = SEGB + (size_t)3 * M * SEGW, *KR = SEGB + (size_t)4 * M * SEGW, *VR = SEGB + (size_t)5 * M * SEGW, *GR = SEGB + (size_t)6 * M * SEGW;

    for (int rep_ = 0; rep_ < REPS(0); ++rep_) if (IN(0)) { p0_prologue(F, args); if (BOTH(0)) GRID_BAR(); STAMP(); }
    for (int rep_ = 0; rep_ < REPS(1); ++rep_) if (IN(1)) {
        const int bx = (int)blockIdx.x, rowg = bx >> 3; const bool split = (F.G == 256), conv = split && ((rowg & 7) == 7);
        if (conv) {
            expert_items(args, ws, (LAS float*)(F.lds + F.wave * 16384), 0, N_CONV_P1, (((rowg >> 3) << 3) + (bx & 7)) * NWAVES + F.wave, 32 * NWAVES, fresh_lane());
        } else {
            pg8::StaticOrder S; if (split) S.init(M / 256, NIN / 256, 224, (rowg - ((rowg + 1) >> 3)) * 8 + (bx & 7)); else S.init(M / 256, NIN / 256, F.G, bx);
            SrcPlain SRC{(const bf16*)(ws + WS_XN), (const bf16*)(ws + WS_WIN), DM};
            EpiInProj E{SEGB, (const float*)(ws + WS_ROPE), (const float*)(ws + WS_ROPE) + SEQ * 40};
            pg8::gemm_phase<EpiInProj, pg8::StaticOrder, SrcPlain, true, true>(F.lds, DM, S, SRC, E);
        }
        if (BOTH(1)) GRID_BAR(); STAMP();
    }
    for (int rep_ = 0; rep_ < REPS(2); ++rep_) if (IN(2)) {
        bf16* OBR = (bf16*)(ws + WS_OBR); float* LSE = (float*)(ws + WS_LSE); bf16* KVB = (bf16*)(ws + WS_ST);
        for (int cid = gw; cid < NBATCH * NHEAD * NCHUNK; cid += NGW) kv_task(cid, KR, VR, KVB, args.in[4], args.in[5], F.lds + F.wave * 16384, fresh_lane());
        { const int nrt = NBATCH * NHEAD * 48, per = (nrt + F.G - 1) / F.G, r0 = F.vcu * per, nr = r0 + per <= nrt ? per : (nrt > r0 ? nrt - r0 : 0);
          __syncthreads();
          if (F.G == 256) attn_rounds((F.vcu >> 5) * 8, F.vcu & 31, 12, QA, KA, VA, OBR, LSE, F.lds, F.wave, fresh_lane());
          else if (nr > 0) attn_rounds(r0, -1, nr, QA, KA, VA, OBR, LSE, F.lds, F.wave, fresh_lane()); }
        if (BOTH(2)) GRID_BAR(); STAMP();
    }
    for (int rep_ = 0; rep_ < REPS(3); ++rep_) if (IN(3)) {
        bf16* MIXED = (bf16*)(ws + WS_MIXED);
        const bool fold = (F.G == 256);
        for (int wgt = F.vcu; wgt < NBATCH * NHEAD * 4; wgt += F.G) { int t_ = threadIdx.x; asm volatile("" : "+v"(t_));
            ret_wg(wgt, QR, KR, VR, GR, (const bf16*)(ws + WS_ST), (bf16*)(ws + WS_SBW), MIXED, args.in[4], args.in[5], (const bf16*)(ws + WS_OBR), (const float*)(ws + WS_LSE),
                   fold ? (long)wgt * 128 + F.wave * 16 : -1L, F.lds, t_, F.wave, t_ & 63); }
        if (!fold) { const int ln = fresh_lane();
          for (int row = gw; row < M; row += 4 * NGW) { const size_t rows[4] = {(size_t)row, (size_t)(row + NGW), (size_t)(row + 2 * NGW), (size_t)(row + 3 * NGW)};
              combine_rows<4>(rows, (const bf16*)(ws + WS_OBR), (const float*)(ws + WS_LSE), MIXED, ln); } }
        if (BOTH(3)) GRID_BAR(); STAMP();
    }
    for (int rep_ = 0; rep_ < REPS(4); ++rep_) if (IN(4)) {
        pg8::StaticOrder S; S.init(M / 256, DM / 256, F.G, (int)blockIdx.x);
        SrcPlain SRC{(const bf16*)(ws + WS_MIXED), (const bf16*)(ws + WS_WOUT), DM};
        EpiOutProj E{args.in[0], (bf16*)(ws + WS_HG)};
        pg8::gemm_phase<EpiOutProj, pg8::StaticOrder, SrcPlain, true, true>(F.lds, DM, S, SRC, E);
        if (BOTH(4)) GRID_BAR(); STAMP();
    }
    for (int rep_ = 0; rep_ < REPS(5); ++rep_) if (IN(5)) {
        if (rep_ > 0) { if (blockIdx.x == 0 && F.tid < NEXP) __hip_atomic_store(F.ctl + CW_CNT + 64 * F.tid, 0u, RLX_AGENT); GRID_BAR(); }
        for (int wgt = F.vcu; wgt < M / 128; wgt += F.G) { int t_ = threadIdx.x; asm volatile("" : "+v"(t_));
            route_wg(wgt, (const bf16*)(ws + WS_HG), (const bf16*)(ws + WS_WRT), args.in[10], args.in[12], F.ctl, (int*)(ws + WS_LIST), (float*)(ws + WS_GATEL), (float*)(ws + WS_RSL), F.lds, t_, F.wave, t_ & 63); }
        if (BOTH(5)) GRID_BAR(); STAMP();
    }
    for (int rep_ = 0; rep_ < REPS(6); ++rep_) if (IN(6)) {
        int ntiles; const TileTab tt = build_tiles(F, ntiles);
        pg8::StaticOrder S; S.init(ntiles, 4, F.G, (int)blockIdx.x);
        SrcGather SRC{(const bf16*)(ws + WS_HG), (const bf16*)(ws + WS_WGU), (const int*)(ws + WS_LIST), tt};
        EpiGateUp E{(bf16*)(ws + WS_HID), (const float*)(ws + WS_GATEL), (const float*)(ws + WS_RSL), tt};
        pg8::gemm_phase<EpiGateUp, pg8::StaticOrder, SrcGather, true, true>(F.lds, DM, S, SRC, E);
        if (BOTH(6)) GRID_BAR(); STAMP();
    }
    for (int rep_ = 0; rep_ < REPS(7); ++rep_) if (IN(7)) {
        int ntiles; const TileTab tt = build_tiles(F, ntiles);
        pg8::StaticOrder S; S.init(ntiles, 4, F.G, (int)blockIdx.x);
        SrcDown SRC{(const bf16*)(ws + WS_HID), (const bf16*)(ws + WS_WD), tt};
        EpiDown E{(bf16*)(ws + WS_Y), (const int*)(ws + WS_LIST), tt};
        pg8::gemm_phase<EpiDown, pg8::StaticOrder, SrcDown, true, true>(F.lds, FF, S, SRC, E);
        if (BOTH(7)) GRID_BAR(); STAMP();
    }
    for (int rep_ = 0; rep_ < REPS(8); ++rep_) if (IN(8)) {
        f32x4 gv[4];
#pragma unroll
        for (int j = 0; j < 4; ++j) gv[j] = ((const f32x4*)args.in[16])[fresh_lane() + 64 * j];
        { const int ln = fresh_lane();
          for (int row = gw; row < M; row += 2 * NGW) { const size_t rows[2] = {(size_t)row, (size_t)(row + NGW)}; final_rows<2>(rows, (const bf16*)(ws + WS_HG), (const bf16*)(ws + WS_Y), gv, args.out, ln); } }
#if MK_TIME
        STAMP();
        if (blockIdx.x == 0 && F.tid == 0) {
            unsigned long long ts[10];
#pragma unroll
            for (int k = 0; k < 10; ++k) ts[k] = (unsigned long long)__hip_atomic_load(F.ctl + CW_TS + 2 * k, RLX_AGENT) | ((unsigned long long)__hip_atomic_load(F.ctl + CW_TS + 2 * k + 1, RLX_AGENT) << 32);
            const float t = MK_TIME == 10 ? (float)(ts[9] - ts[0]) * 0.01f : (float)(ts[MK_TIME] - ts[MK_TIME - 1]) * 0.01f;
            VM_WAIT(); args.out[0] = t * MK_TSCALE; }
#endif
    }
#undef IN
#undef BOTH
#undef GRID_BAR
}

#if MK_CHECK
__device__ __forceinline__ unsigned hsh(unsigned x) { x ^= x >> 16; x *= 0x7feb352dU; x ^= x >> 15; x *= 0x846ca68bU; x ^= x >> 16; return x; }
__device__ __forceinline__ float ldb(const bf16* p, size_t i) { return __uint_as_float(((unsigned)p[i]) << 16); }
__device__ __forceinline__ float rbf(float x) { return bflo(pk2(x, 0.f) & 0xffffu); }
__device__ __forceinline__ void chk_put(gu32* ctl, int stage, float got, float ref, float atol) {
    float e = fabsf(got - ref) / (0.03f * fabsf(ref) + atol); if (!(e == e)) e = 1e30f; if (e > 1e30f) e = 1e30f;
    __hip_atomic_fetch_max(ctl + CW_CHK + stage, __float_as_uint(e), RLX_AGENT);
}
__global__ void __launch_bounds__(256) chk_kernel(Args A, int stage) {
    unsigned char* ws = A.ws; gu32* ctl = (gu32*)(ws + WS_CTL);
    const int gt = blockIdx.x * 256 + threadIdx.x, NT = gridDim.x * 256;
    const bf16* SEGB = (const bf16*)(ws + WS_SEG);
    const bf16 *QA = SEGB, *KA = SEGB + (size_t)1 * M * SEGW, *VA = SEGB + (size_t)2 * M * SEGW, *QR = SEGB + (size_t)3 * M * SEGW, *KR = SEGB + (size_t)4 * M * SEGW, *VR = SEGB + (size_t)5 * M * SEGW, *GR = SEGB + (size_t)6 * M * SEGW;
    if (stage == 0) {
        const bf16* WIN = (const bf16*)(ws + WS_WIN); const bf16* WOUT = (const bf16*)(ws + WS_WOUT); const bf16* WGU = (const bf16*)(ws + WS_WGU); const bf16* WD = (const bf16*)(ws + WS_WD);
        for (int s = gt; s < 65536; s += NT) { const unsigned r = hsh(s * 7 + 1), r2 = hsh(r);
            { const int n = r % NIN, k = r2 % DM; chk_put(ctl, 0, ldb(WIN, (size_t)winperm(n) * DM + k), A.in[2][(size_t)k * NIN + n], 1e-4f); }
            { const int n = r % DM, k = r2 % DM; chk_put(ctl, 0, ldb(WOUT, (size_t)n * DM + k), A.in[7][(size_t)k * DM + n] * (k < 512 ? A.in[3][k] : A.in[6][k - 512]), 1e-4f); }
            { const int e = (r >> 10) % NEXP, j = r % FF, k = r2 % DM;
              chk_put(ctl, 0, ldb(WGU, ((size_t)e * DM + ((j >> 7) << 8) + (j & 127)) * DM + k), A.in[13][((size_t)e * DM + k) * FF + j] * A.in[8][k], 1e-4f);
              chk_put(ctl, 0, ldb(WGU, ((size_t)e * DM + ((j >> 7) << 8) + 128 + (j & 127)) * DM + k), A.in[14][((size_t)e * DM + k) * FF + j] * A.in[8][k], 1e-4f); }
            { const int e = (r >> 10) % NEXP, n = r % DM, k = r2 % FF; chk_put(ctl, 0, ldb(WD, ((size_t)e * DM + n) * FF + k), A.in[15][((size_t)e * FF + k) * DM + n], 1e-4f); }
            { const int j = r % 36, i = r2 % DM; const float ref = (j < 32 ? A.in[11][i * 32 + j] : A.in[9][i * 4 + j - 32]) * A.in[8][i]; chk_put(ctl, 0, 1000.f * (ldb((const bf16*)(ws + WS_WRT), j * DM + i) + ldb((const bf16*)(ws + WS_WRT), (48 + j) * DM + i)), 1000.f * ref, 1e-3f); }
            { const int pos = r % SEQ, f = r2 % 40; const float fr = f < 8 ? powf(500000.f, -(float)f / 8.f) : powf(10000.f, -(float)(f - 8) / 31.f); const float ang = (float)pos * fr;
              chk_put(ctl, 0, ((const float*)(ws + WS_ROPE))[pos * 40 + f], cosf(ang), 2e-3f); chk_put(ctl, 0, ((const float*)(ws + WS_ROPE))[SEQ * 40 + pos * 40 + f], sinf(ang), 2e-3f); }
        }
        for (int s = gt; s < 2048; s += NT) { const unsigned r = hsh(s * 13 + 5); const int row = r % M, c = hsh(r) % DM; const float* x = A.in[0] + (size_t)row * DM; float ss = 0.f;
            for (int k = 0; k < DM; ++k) ss += x[k] * x[k];
            chk_put(ctl, 0, ldb((const bf16*)(ws + WS_XN), (size_t)row * DM + c), x[c] / sqrtf(ss / DM + NORM_EPS) * A.in[1][c], 1e-3f); }
    }
    if (stage == 1) {
        const bf16* XN = (const bf16*)(ws + WS_XN);
        for (int s = gt; s < 8192; s += NT) { const unsigned r = hsh(s * 3 + 11), r2 = hsh(r); const int row = r % M, seg = r2 % 7, hh = (r2 >> 4) % 8, pos = row & (SEQ - 1);
            const int half = (seg == 0 || seg == 1) ? 8 : 32; const int i = (r2 >> 8) % half; const int d1 = i, d2 = i + half;
            float a1 = 0.f, a2 = 0.f; const float* w = A.in[2] + seg * 512 + hh * 64;
            for (int k = 0; k < DM; ++k) { const float xv = ldb(XN, (size_t)row * DM + k); a1 += xv * rbf(w[(size_t)k * NIN + d1]); a2 += xv * rbf(w[(size_t)k * NIN + d2]); }
            const bf16* O = SEGB + (size_t)seg * M * SEGW + (size_t)row * SEGW + hh * 64;
            if (seg == 0 || seg == 1 || seg == 3 || seg == 4) {
                const float fr = seg < 2 ? powf(500000.f, -(float)i / 8.f) : powf(10000.f, -(float)i / 31.f); const float ang = (float)pos * fr, c = cosf(ang), sn = sinf(ang);
                const float sc = seg == 0 ? 0.125f * LOG2E : (seg == 4 ? 0.125f : 1.f);
                chk_put(ctl, 1, ldb(O, 2 * i), (a1 * c - a2 * sn) * sc, 0.02f); chk_put(ctl, 1, ldb(O, 2 * i + 1), (a2 * c + a1 * sn) * sc, 0.02f);
                if (seg < 2) { const int d3 = 16 + (r2 >> 12) % 48; float a3 = 0.f; for (int k = 0; k < DM; ++k) a3 += ldb(XN, (size_t)row * DM + k) * rbf(w[(size_t)k * NIN + d3]); chk_put(ctl, 1, ldb(O, d3), a3 * sc, 0.02f); }
            } else { chk_put(ctl, 1, ldb(O, d1), seg == 6 ? silu_f(a1) : a1, 0.02f); chk_put(ctl, 1, ldb(O, d2), seg == 6 ? silu_f(a2) : a2, 0.02f); }
        }
    }
    if (stage == 2) {
        const bf16* OBR = (const bf16*)(ws + WS_OBR); const float* LSE = (const float*)(ws + WS_LSE); const bf16* ST = (const bf16*)(ws + WS_ST);
        for (int s = gt; s < 4096; s += NT) { const unsigned r = hsh(s * 5 + 3), r2 = hsh(r); const int b = r % NBATCH, pos = (s < 256) ? (s & 1 ? SEQ - 1 - (s >> 1) % 80 : (s >> 1) % 80) : (r >> 3) % SEQ, h = r2 % NHEAD, br = (r2 >> 3) % 3, dd = (r2 >> 8) % HD;
            const int dil = 1 << (2 * br); const size_t row = (size_t)b * SEQ + pos;
            float mx = -1e30f;
            for (int pass = 0; pass < 2; ++pass) { float l = 0.f, o = 0.f;
                for (int j = -64; j <= 64; ++j) { const int kp = pos + j * dil; if (kp < 0 || kp >= SEQ) continue; const size_t kr = (size_t)b * SEQ + kp; float d = 0.f;
                    for (int k = 0; k < HD; ++k) d += ldb(QA, row * SEGW + h * HD + k) * ldb(KA, kr * SEGW + h * HD + k);
                    if (pass == 0) mx = fmaxf(mx, d); else { const float p = exp2f(d - mx); l += p; o += p * ldb(VA, kr * SEGW + h * HD + dd); } }
                if (pass == 1) { chk_put(ctl, 2, ldb(OBR, ((size_t)br * M + row) * SEGW + h * HD + dd), o / l, 0.02f); chk_put(ctl, 2, LSE[((size_t)br * M + row) * NHEAD + h], (mx + log2f(l)) * LN2, 0.02f); } }
        }
        for (int s = gt; s < 8192; s += NT) { const unsigned r = hsh(s * 9 + 7), r2 = hsh(r); const int bh = r % 64, dir = (r >> 6) & 1, n = (r >> 7) % NCHUNK, dv = r2 % 64, dk = (r2 >> 6) % 64, b = bh >> 3, h = bh & 7;
            const float lg2 = log1pf(-exp2f((dir ? A.in[5] : A.in[4])[h])) * LOG2E; float S = 0.f;
            for (int j = 0; j < CHUNK; ++j) { const size_t row = (size_t)b * SEQ + n * CHUNK + j; const float ex = dir == 0 ? (float)(127 - j) : (float)j;
                S += exp2f(ex * lg2) * ldb(KR, row * SEGW + h * HD + dk) * ldb(VR, row * SEGW + h * HD + dv); }
            chk_put(ctl, 2, ldb(ST, (((size_t)bh * NCHUNK + n) * 2 + dir) * 4096 + ((size_t)((dv >> 5) * 4 + (dk >> 4)) * 64 + (dv & 31) + 32 * ((dk >> 3) & 1)) * 8 + (dk & 7)), S, 0.05f);
        }
    }
    if (stage == 3) {
        const bf16* MIXED = (const bf16*)(ws + WS_MIXED);
        for (int s = gt; s < 512; s += NT) { const unsigned r = hsh(s * 17 + 9), r2 = hsh(r); const int b = r % NBATCH, pos = (s < 64) ? (s & 1 ? SEQ - 1 - (s >> 1) * 5 : (s >> 1) * 5) : (r >> 3) % SEQ, h = r2 % NHEAD; const size_t row = (size_t)b * SEQ + pos;
            const float lgf = log1pf(-exp2f(A.in[4][h])) * LOG2E, lgb = log1pf(-exp2f(A.in[5][h])) * LOG2E;
            float o[HD], qv[HD];
#pragma unroll
            for (int k = 0; k < HD; ++k) { o[k] = 0.f; qv[k] = ldb(QR, row * SEGW + h * HD + k); }
            for (int kp = 0; kp < SEQ; ++kp) { const size_t kr = (size_t)b * SEQ + kp; const int dl = pos - kp; const float w = dl >= 0 ? exp2f((float)dl * lgf) : exp2f((float)(-dl) * lgb); if (w < 1e-12f) continue; float d = 0.f;
#pragma unroll
                for (int k = 0; k < HD; ++k) d += qv[k] * ldb(KR, kr * SEGW + h * HD + k);
                d *= w;
#pragma unroll
                for (int k = 0; k < HD; ++k) o[k] += d * ldb(VR, kr * SEGW + h * HD + k); }
            float mean = 0.f, var = 0.f;
#pragma unroll
            for (int k = 0; k < HD; ++k) mean += o[k];
            mean *= (1.f / HD);
#pragma unroll
            for (int k = 0; k < HD; ++k) var += (o[k] - mean) * (o[k] - mean);
            var *= (1.f / HD); const float rstd = 1.f / sqrtf(var + NORM_EPS);
#pragma unroll
            for (int k = 0; k < HD; ++k) if ((k & 7) == (int)(r2 >> 8) % 8) chk_put(ctl, 3, ldb(MIXED, row * DM + 512 + h * HD + k), (o[k] - mean) * rstd * ldb(GR, row * SEGW + h * HD + k), 0.03f);
        }
        {
            const bf16* OBR = (const bf16*)(ws + WS_OBR); const float* LSE = (const float*)(ws + WS_LSE);
            for (int s = gt; s < 4096; s += NT) { const unsigned r = hsh(s * 19 + 1), r2 = hsh(r); const int row = r % M, csel = r2 % 512; float ss = 0.f, osel = 0.f;
                for (int c = 0; c < 512; ++c) { const int h = c >> 6; const float l0 = LSE[((size_t)0 * M + row) * NHEAD + h], l1 = LSE[((size_t)1 * M + row) * NHEAD + h], l2 = LSE[((size_t)2 * M + row) * NHEAD + h];
                    const float mx = fmaxf(l0, fmaxf(l1, l2)), w0 = expf(l0 - mx), w1 = expf(l1 - mx), w2 = expf(l2 - mx);
                    const float o = (w0 * ldb(OBR, ((size_t)0 * M + row) * SEGW + c) + w1 * ldb(OBR, ((size_t)1 * M + row) * SEGW + c) + w2 * ldb(OBR, ((size_t)2 * M + row) * SEGW + c)) / (w0 + w1 + w2);
                    ss += o * o; if (c == csel) osel = o; }
                chk_put(ctl, 3, ldb(MIXED, (size_t)row * DM + csel), osel / sqrtf(ss / 512.f + NORM_EPS), 0.03f); }
        }
    }
    if (stage == 4) {
        const bf16* MIXED = (const bf16*)(ws + WS_MIXED); const bf16* WOUT = (const bf16*)(ws + WS_WOUT); const float* H = (const float*)(ws + WS_H); const bf16* HG = (const bf16*)(ws + WS_HG);
        for (int s = gt; s < 16384; s += NT) { const unsigned r = hsh(s * 23 + 3); const int row = r % M, c = hsh(r) % DM; float a = 0.f;
            for (int k = 0; k < DM; ++k) a += ldb(MIXED, (size_t)row * DM + k) * ldb(WOUT, (size_t)c * DM + k);
            const float h = a + A.in[0][(size_t)row * DM + c]; chk_put(ctl, 4, ldb(HG, (size_t)row * DM + c), h, 0.02f); (void)H; }
    }
    if (stage == 5) {
        const float* H = (const float*)(ws + WS_H); const int* LIST = (const int*)(ws + WS_LIST); const float* GATEL = (const float*)(ws + WS_GATEL); const float* RSL = (const float*)(ws + WS_RSL);
        if (gt == 0) { unsigned tot = 0; for (int e = 0; e < NEXP; ++e) tot += ctl[CW_CNT + 64 * e]; chk_put(ctl, 5, (float)tot, (float)(2 * M), 0.5f); }
        const bf16* HBc = (const bf16*)(ws + WS_HG); (void)H;
        for (int s = gt; s < 2048; s += NT) { const int t = hsh(s * 29 + 5) % M; const bf16* h_ = HBc + (size_t)t * DM; float ss = 0.f;
#define h_AT(k) ldb(h_, (k))
            for (int k = 0; k < DM; ++k) ss += h_AT(k) * h_AT(k);
            const float rs = 1.f / sqrtf(ss / DM + NORM_EPS); float gl[4]; int gi = 0;
            for (int g = 0; g < 4; ++g) { float a = 0.f; for (int k = 0; k < DM; ++k) a += h_AT(k) * rs * A.in[8][k] * A.in[9][k * 4 + g]; gl[g] = a + A.in[10][g]; if (gl[g] > gl[gi]) gi = g; }
            float den = 0.f; for (int g = 0; g < 4; ++g) den += expf(gl[g] - gl[gi]);
            float b1 = -3e38f, b2 = -3e38f, b3 = -3e38f; int i1 = 0, i2 = 0;
            for (int e = 0; e < 8; ++e) { float a = 0.f; for (int k = 0; k < DM; ++k) a += h_AT(k) * rs * A.in[8][k] * A.in[11][k * 32 + gi * 8 + e]; a += A.in[12][gi * 8 + e];
                if (a > b1) { b3 = b2; b2 = b1; i2 = i1; b1 = a; i1 = e; } else if (a > b2) { b3 = b2; b2 = a; i2 = e; } else if (a > b3) b3 = a; }
            float second = -3e38f; for (int g = 0; g < 4; ++g) if (g != gi) second = fmaxf(second, gl[g]);
            if (gl[gi] - second < 1e-3f || b2 - b3 < 1e-3f || b1 - b2 < 1e-3f) continue;
            const float p1 = 1.f / (1.f + expf(b2 - b1)); const float g1 = p1 / den, g2 = (1.f - p1) / den;
            for (int k = 0; k < 2; ++k) { const int e = gi * 8 + (k ? i2 : i1); const int n = (int)ctl[CW_CNT + 64 * e]; int found = -1;
                for (int p = 0; p < n && p < M; ++p) if (LIST[(size_t)e * M + p] == t * 2 + k) { found = p; break; }
                if (found < 0) chk_put(ctl, 5, 0.f, 100.f, 0.1f); else { chk_put(ctl, 5, GATEL[(size_t)e * M + found], k ? g2 : g1, 1e-3f); chk_put(ctl, 5, RSL[(size_t)e * M + found], rs, 1e-4f); } }
        }
    }
    if (stage == 6 || stage == 7) {
        const int* LIST = (const int*)(ws + WS_LIST); const float* GATEL = (const float*)(ws + WS_GATEL); const float* RSL = (const float*)(ws + WS_RSL);
        const bf16* HG = (const bf16*)(ws + WS_HG); const bf16* WGU = (const bf16*)(ws + WS_WGU); const bf16* HID = (const bf16*)(ws + WS_HID); const bf16* WD = (const bf16*)(ws + WS_WD); const bf16* Y = (const bf16*)(ws + WS_Y);
        for (int s = gt; s < 8192; s += NT) { const unsigned r = hsh(s * 31 + 7), r2 = hsh(r); const int e = r % NEXP; const int ne = (int)ctl[CW_CNT + 64 * e]; if (ne <= 0) continue;
            int t0 = 0; for (int q = 0; q < e; ++q) t0 += ((int)ctl[CW_CNT + 64 * q] + 255) >> 8;
            const int pos = (s & 3) == 0 ? ne - 1 - (int)((r >> 5) % (ne < 300 ? ne : 300)) : (int)((r >> 5) % ne); const size_t slot = (size_t)t0 * 256 + pos; const int tk = LIST[(size_t)e * M + pos], t = tk >> 1;
            if (stage == 6) { const int j = r2 % FF; float g = 0.f, u = 0.f; const bf16* wg = WGU + ((size_t)e * DM + ((j >> 7) << 8) + (j & 127)) * DM; const bf16* wu = wg + (size_t)128 * DM;
                for (int k = 0; k < DM; ++k) { const float xv = ldb(HG, (size_t)t * DM + k); g += xv * ldb(wg, k); u += xv * ldb(wu, k); }
                const float rs = RSL[(size_t)e * M + pos]; chk_put(ctl, 6, ldb(HID, slot * FF + j), silu_f(g * rs) * (u * rs) * GATEL[(size_t)e * M + pos], 0.01f); }
            else { const int c = r2 % DM; float a = 0.f; for (int k = 0; k < FF; ++k) a += ldb(HID, slot * FF + k) * ldb(WD, ((size_t)e * DM + c) * FF + k);
                chk_put(ctl, 7, ldb(Y, (size_t)tk * DM + c), a, 0.01f); }
        }
    }
    if (stage == 8) {
        const float* H = (const float*)(ws + WS_H); const bf16* Y = (const bf16*)(ws + WS_Y);
        for (int s = gt; s < 4096; s += NT) { const unsigned r = hsh(s * 37 + 1); const int row = r % M, c = hsh(r) % DM; float ss = 0.f, zc = 0.f;
            for (int k = 0; k < DM; ++k) { const float z = ldb((const bf16*)(ws + WS_HG), (size_t)row * DM + k) + ldb(Y, (size_t)(2 * row) * DM + k) + ldb(Y, (size_t)(2 * row + 1) * DM + k); (void)H; ss += z * z; if (k == c) zc = z; }
            chk_put(ctl, 8, A.out[(size_t)row * DM + c], zc / sqrtf(ss / DM + NORM_EPS) * A.in[16][c], 0.01f); }
    }
}
__global__ void __launch_bounds__(256) chk_final(Args A) {
    gu32* ctl = (gu32*)(A.ws + WS_CTL); int bad = -1; float err = 0.f;
    for (int s = 0; s < 9; ++s) { const float e = __uint_as_float(ctl[CW_CHK + s]); if (e > 1.f) { bad = s; err = e; break; } }
    if (bad < 0 && ctl[CW_BAR + XB_TMO] != 0u) { bad = 10; err = 1.f; }
    if (bad < 0) return;
    float mant = 1.f + log10f(err); if (mant > 9.9f) mant = 9.9f; if (mant < 1.f) mant = 1.f;
    const float C = sqrtf(mant * powf(10.f, (float)(bad + 3)));
    for (size_t i = blockIdx.x * 256 + threadIdx.x; i < (size_t)M * DM; i += (size_t)gridDim.x * 256) A.out[i] = C;
}
#endif

extern "C" void kernel_launch(void* const* d_in, const int* in_sizes, int n_in, void* d_out, int out_size, void* d_ws, size_t ws_size, hipStream_t stream) {
    static int grid = 0;
    if (grid == 0) {
        if (n_in != 17 || in_sizes[0] != M * DM || out_size != M * DM || ws_size < WS_END) { fprintf(stderr, "kernel_launch: unexpected shapes (n_in %d, in0 %d, out %d, ws %zu); nothing launched\n", n_in, n_in > 0 ? in_sizes[0] : -1, out_size, ws_size); grid = -1; return; }
        int dev = 0, cus = 0, per_cu = 0;
        if (hipGetDevice(&dev) != hipSuccess || hipDeviceGetAttribute(&cus, hipDeviceAttributeMultiprocessorCount, dev) != hipSuccess) { grid = -1; return; }
        if (hipFuncSetAttribute((const void*)mk_fwd, hipFuncAttributeMaxDynamicSharedMemorySize, LDS_BYTES) != hipSuccess) { fprintf(stderr, "kernel_launch: hipFuncSetAttribute failed\n"); grid = -1; return; }
        if (hipOccupancyMaxActiveBlocksPerMultiprocessor(&per_cu, (const void*)mk_fwd, NWAVES * 64, LDS_BYTES) != hipSuccess || per_cu < 1) { fprintf(stderr, "kernel_launch: occupancy query says %d blocks per CU; nothing launched\n", per_cu); (void)hipGetLastError(); grid = -1; return; }
        grid = cus;
    }
    if (grid < 0) return;
    if (hipMemsetAsync((char*)d_ws + WS_CTL, 0, CTL_ZERO_BYTES, stream) != hipSuccess) { fprintf(stderr, "kernel_launch: memset failed\n"); return; }
    Args a{};
    for (int i = 0; i < 17; ++i) a.in[i] = (const float*)d_in[i];
    a.out = (float*)d_out; a.ws = (unsigned char*)d_ws;
    const double TWO_PI = 6.283185307179586476925286766559;
    for (int i = 0; i < 8; ++i) a.frev[i] = std::pow(500000.0, -(double)i / 8.0) / TWO_PI;
    for (int i = 0; i < 32; ++i) a.frev[8 + i] = std::pow(10000.0, -(double)i / 31.0) / TWO_PI;
    if (N_LAUNCHES == 1) {
        a.ph_lo = 0; a.ph_hi = PER_PHASE; a.li = 0;
#if MK_COOP
        void* kargs[] = {&a};
        const hipError_t le = hipLaunchCooperativeKernel((const void*)mk_fwd, dim3(grid), dim3(NWAVES * 64), kargs, LDS_BYTES, stream);
        if (le != hipSuccess) fprintf(stderr, "kernel_launch: cooperative launch failed: %s (grid %d)\n", hipGetErrorName(le), grid);
#else
        hipLaunchKernelGGL(mk_fwd, dim3(grid), dim3(NWAVES * 64), LDS_BYTES, stream, a);
#endif
    } else {
        for (int li = 0; li < PER_PHASE; ++li) {
            a.ph_lo = li; a.ph_hi = li + 1; a.li = 0;
            hipLaunchKernelGGL(mk_fwd, dim3(grid), dim3(NWAVES * 64), LDS_BYTES, stream, a);
#if MK_CHECK
            hipLaunchKernelGGL(chk_kernel, dim3(256), dim3(256), 0, stream, a, li);
#endif
        }
#if MK_CHECK
        hipLaunchKernelGGL(chk_final, dim3(1024), dim3(256), 0, stream, a);
#endif
    }
}
```

```cpp
#include <hip/hip_runtime.h>
#include <cstdio>
#include <cstdint>
#include <cmath>

#ifndef MK_N_LAUNCHES
#define MK_N_LAUNCHES 1
#endif
#ifndef MK_TIME
#define MK_TIME 0
#endif
#ifndef MK_REPEAT
#define MK_REPEAT -1
#endif
#ifndef MK_NREP
#define MK_NREP 2
#endif
#ifndef MK_COOP
#define MK_COOP 1
#endif
#ifndef MK_TSCALE
#define MK_TSCALE 1.0f
#endif
#ifndef MK_CHECK
#define MK_CHECK 0
#endif

#define LAS __attribute__((address_space(3)))
#define GAS __attribute__((address_space(1)))
typedef unsigned short bf16;
typedef short bf16x8 __attribute__((ext_vector_type(8)));
typedef short s16x4 __attribute__((ext_vector_type(4)));
typedef float f32x2 __attribute__((ext_vector_type(2)));
typedef float f32x4 __attribute__((ext_vector_type(4)));
typedef float f32x16 __attribute__((ext_vector_type(16)));
typedef unsigned u32x2 __attribute__((ext_vector_type(2)));
typedef unsigned u32x4 __attribute__((ext_vector_type(4)));
typedef __bf16 bf16x2_t __attribute__((ext_vector_type(2)));
typedef GAS unsigned gu32;

constexpr int NBATCH = 8, SEQ = 4096, DM = 1024, M = NBATCH * SEQ;
constexpr int NIN = 3584, SEGW = 512, NHEAD = 8, HD = 64;
constexpr int NEXP = 32, FF = 512, NGRP = 4, EPG = 8;
constexpr int CHUNK = 128, NCHUNK = SEQ / CHUNK;
constexpr float NORM_EPS = 1e-6f;
constexpr float LOG2E = 1.4426950408889634f, LN2 = 0.6931471805599453f;
constexpr int NWAVES = 8;
constexpr int N_CONV_P1 = 66 * 256;
constexpr int MAXTILES = 288;

constexpr size_t MiB = 1u << 20;
constexpr size_t WS_CTL = 0, CTL_ZERO_BYTES = 128 * 1024;
constexpr size_t WS_WRT = 1 * MiB;
constexpr size_t WS_ROPE = 2 * MiB;
constexpr size_t WS_LSE = 4 * MiB;
constexpr size_t WS_LIST = 8 * MiB;
constexpr size_t WS_GATEL = 12 * MiB;
constexpr size_t WS_RSL = 16 * MiB;
constexpr size_t WS_WIN = 20 * MiB;
constexpr size_t WS_WOUT = 27 * MiB;
constexpr size_t WS_WD = 30 * MiB;
constexpr size_t WS_WGU = 62 * MiB;
constexpr size_t WS_ST = 126 * MiB;
constexpr size_t WS_SBW = 478 * MiB;
constexpr size_t WS_XN = 158 * MiB;
constexpr size_t WS_OBR = 158 * MiB;
constexpr size_t WS_SEG = 254 * MiB;
constexpr size_t SEG_BYTES = (size_t)M * SEGW * 2;
constexpr size_t WS_MIXED = 254 * MiB;
constexpr size_t WS_H = 350 * MiB;
constexpr size_t WS_HG = 350 * MiB;
constexpr size_t WS_HID = 222 * MiB;
constexpr size_t WS_Y = 64 * MiB;
constexpr size_t WS_END = 494 * MiB;
constexpr int CW_CNT = 64;
constexpr int CW_BAR = 4096;
constexpr int CW_CHK = 16384;
constexpr int CW_TS = 20480;

constexpr int RING_BYTES = 147456;
constexpr int LDSCTL_OFF = RING_BYTES, MISC_OFF = LDSCTL_OFF + 320;
constexpr int TILE_OFF = MISC_OFF + 128;
constexpr int LDS_BYTES = 151552;

#define RLX_AGENT __ATOMIC_RELAXED, __HIP_MEMORY_SCOPE_AGENT
#define LDS_WAIT() asm volatile("s_waitcnt lgkmcnt(0)" ::: "memory")
#define VM_WAIT() asm volatile("s_waitcnt vmcnt(0)" ::: "memory")
__device__ __forceinline__ unsigned pk2(float lo, float hi) { f32x2 v = {lo, hi}; bf16x2_t b = __builtin_convertvector(v, bf16x2_t); return __builtin_bit_cast(unsigned, b); }
__device__ __forceinline__ float bflo(unsigned u) { return __uint_as_float(u << 16); }
__device__ __forceinline__ float bfhi(unsigned u) { return __uint_as_float(u & 0xffff0000u); }
__device__ __forceinline__ float bf2f(short s) { return __uint_as_float(((unsigned)(unsigned short)s) << 16); }
__device__ __forceinline__ int crow(int r, int hi) { return (r & 3) + 8 * (r >> 2) + 4 * hi; }
__device__ __forceinline__ float wave_sum(float v) {
#pragma unroll
    for (int o = 1; o < 64; o <<= 1) v += __shfl_xor(v, o);
    return v;
}
__device__ __forceinline__ float silu_f(float v) { return v * __builtin_amdgcn_rcpf(1.f + __builtin_amdgcn_exp2f(-v * LOG2E)); }

namespace pg8 {
constexpr int BM = 256, BK = 64, HALF = 128, HTB = HALF * BK * 2, STAGE_BYTES = 8 * HTB, NXCD = 8, WGM = 8;
__host__ __device__ __forceinline__ int lds_byte(int r, int c) { const int st = (r >> 4) * 2 + (c >> 5), rr = r & 15, cc = c & 31, ob = rr * 64 + cc * 2; return st * 1024 + (ob ^ (((ob >> 9) & 1) << 5)); }
__host__ __device__ __forceinline__ void stage_rc(int b, int& R, int& C) { const int st = b / 1024, sb = b % 1024, swz = sb ^ (((sb >> 9) & 1) << 5); R = (st >> 1) * 16 + swz / 64; C = (st & 1) * 32 + (swz % 64) / 2; }
__host__ __device__ __forceinline__ int perm32(int rho) { const int n = rho >> 4, i = rho & 15; return 8 * (i >> 2) + 4 * n + (i & 3); }

struct Unit { int pm, pn; };
struct StaticOrder {
    int nM, nN, nwg, G, c;
    __device__ void init(int nM_, int nN_, int G_, int c_) { nM = nM_; nN = nN_; nwg = nM * nN; G = G_; c = c_; }
    __device__ bool next(int i, Unit& u) const {
        const long L = (long)i * G + c; if (L >= nwg) return false;
        int wgid = (int)L; { const int q = nwg / NXCD, r = nwg % NXCD, xcd = wgid % NXCD, off = wgid / NXCD; wgid = (xcd < r ? xcd * (q + 1) : r * (q + 1) + (xcd - r) * q) + off; }
        const int nig = WGM * nN, gid = wgid / nig, fm = gid * WGM, gsz = (nM - fm) < WGM ? (nM - fm) : WGM;
        u.pm = fm + ((wgid % nig) % gsz); u.pn = (wgid % nig) / gsz; return true;
    }
};

template <class Epi, class Sched, class Src, bool ALIGN_EPI, bool SP2>
__device__ __forceinline__ void gemm_phase(LAS unsigned char* lds, const int K, const Sched& S, const Src& SRC, const Epi& E) {
    int tid_ = threadIdx.x; asm volatile("" : "+v"(tid_));
    const int tid = tid_, wid = __builtin_amdgcn_readfirstlane(tid >> 6), lane = tid & 63, wr = wid >> 2, wc = wid & 3, fr = lane & 15, fq = lane >> 4;
    const int nt = K / BK;
    unsigned voffB[2]; int RA[2], CA[2];
#pragma unroll
    for (int i = 0; i < 2; ++i) { int R, C; stage_rc(tid * 16 + i * 8192, R, C); const int Rb = Epi::PERM ? ((R & ~31) + perm32(R & 31)) : R;
        RA[i] = R; CA[i] = C; voffB[i] = (unsigned)(Rb * K + C) * 2u; }
    const size_t kstep = (size_t)(BK * 2);
    const size_t hstep = (size_t)HALF * K * 2;
    const unsigned ldsw = (unsigned)wid * 1024u;
    const int aoff = lds_byte(wr * 64 + fr, fq * 8), boff = lds_byte(wc * 32 + fr, fq * 8);
#define PG8_SA(b, h) (((b) * 2 + (h)) * HTB)
#define PG8_SB(b, h) ((4 + (b) * 2 + (h)) * HTB)
#define PG8_STAGE(bufoff, gbase, voff) do { _Pragma("unroll") for (int _i = 0; _i < 2; ++_i) \
        __builtin_amdgcn_global_load_lds((const unsigned*)((const char*)(gbase) + (voff)[_i]), (LAS unsigned*)(lds + (bufoff) + ldsw + _i * 8192), 16, 0, 0); } while (0)
#define PG8_LDA(dst, b, h) do { _Pragma("unroll") for (int m = 0; m < 4; ++m) _Pragma("unroll") for (int k = 0; k < 2; ++k) dst[m][k] = *(const LAS bf16x8*)(lds + PG8_SA(b, h) + aoff + m * 2048 + k * 1024); } while (0)
#define PG8_LDB(dst, b, h) do { _Pragma("unroll") for (int n = 0; n < 2; ++n) _Pragma("unroll") for (int k = 0; k < 2; ++k) dst[n][k] = *(const LAS bf16x8*)(lds + PG8_SB(b, h) + boff + n * 2048 + k * 1024); } while (0)
#define PG8_MMA(ai, bj, At, Bt) do { __builtin_amdgcn_s_setprio(1); _Pragma("unroll") for (int m = 0; m < 4; ++m) _Pragma("unroll") for (int n = 0; n < 2; ++n) _Pragma("unroll") for (int k = 0; k < 2; ++k) \
        acc[ai][bj][m][n] = __builtin_amdgcn_mfma_f32_16x16x32_bf16(Bt[n][k], At[m][k], acc[ai][bj][m][n], 0, 0, 0); __builtin_amdgcn_s_setprio(0); } while (0)
#define PG8_WAIT_V(n) asm volatile("s_waitcnt vmcnt(" #n ")" ::: "memory")
#define PG8_WAIT_L(n) asm volatile("s_waitcnt lgkmcnt(" #n ")" ::: "memory")
#define PG8_BAR __builtin_amdgcn_s_barrier()
#define PG8_SCHED __builtin_amdgcn_sched_barrier(0)
    Unit cur, nxt; int ui = 0;
    if (!S.next(0, cur)) return;
    f32x4 acc[2][2][4][2];
#pragma unroll
    for (int a = 0; a < 2; ++a)
#pragma unroll
        for (int b = 0; b < 2; ++b)
#pragma unroll
            for (int m = 0; m < 4; ++m)
#pragma unroll
                for (int n = 0; n < 2; ++n) acc[a][b][m][n] = (f32x4){0.f, 0.f, 0.f, 0.f};
    bf16x8 At[4][2], B0[2][2], B1[2][2];
    const char *cA, *cB; unsigned vA0[2], vA1[2];
    SRC.setup(cur, RA, CA, cA, cB, vA0, vA1);
    if constexpr (SP2) {
        PG8_STAGE(PG8_SB(0, 0), cB, voffB); PG8_STAGE(PG8_SB(0, 1), cB + hstep, voffB); PG8_STAGE(PG8_SA(0, 0), cA, vA0); PG8_STAGE(PG8_SA(0, 1), cA, vA1);
        if (wr == 1) PG8_BAR;
        PG8_WAIT_V(2); PG8_BAR;
        PG8_STAGE(PG8_SB(1, 0), cB + kstep, voffB); PG8_STAGE(PG8_SA(1, 0), cA + kstep, vA0); PG8_STAGE(PG8_SB(1, 1), cB + hstep + kstep, voffB);
        PG8_WAIT_V(6); PG8_BAR;
    } else {
        PG8_STAGE(PG8_SB(0, 0), cB, voffB); PG8_STAGE(PG8_SA(0, 0), cA, vA0); PG8_STAGE(PG8_SB(0, 1), cB + hstep, voffB); PG8_STAGE(PG8_SA(0, 1), cA, vA1);
        if (wr == 1) PG8_BAR;
        PG8_WAIT_V(4); PG8_BAR;
        PG8_STAGE(PG8_SB(1, 0), cB + kstep, voffB); PG8_STAGE(PG8_SA(1, 0), cA + kstep, vA0); PG8_STAGE(PG8_SB(1, 1), cB + hstep + kstep, voffB);
        PG8_WAIT_V(6); PG8_BAR;
    }
    for (;;) {
        const bool has_next = S.next(ui + 1, nxt);
        const char *nA = cA, *nB = cB; unsigned wA0[2] = {vA0[0], vA0[1]}, wA1[2] = {vA1[0], vA1[1]};
        if (has_next) SRC.setup(nxt, RA, CA, nA, nB, wA0, wA1);
        for (int t = 0; t < nt; t += 2) {
            const bool last = (t == nt - 2);
            const char* a1 = cA + (size_t)(t + 1) * kstep;
            const char* a2 = last ? nA : cA + (size_t)(t + 2) * kstep; const char* b2 = last ? nB : cB + (size_t)(t + 2) * kstep;
            const char* a3 = a2 + kstep; const char* b3 = b2 + kstep;
            unsigned x0[2], x1[2];
            x0[0] = last ? wA0[0] : vA0[0]; x0[1] = last ? wA0[1] : vA0[1]; x1[0] = last ? wA1[0] : vA1[0]; x1[1] = last ? wA1[1] : vA1[1];
            if constexpr (SP2) {
            PG8_LDB(B0, 0, 0); PG8_LDB(B1, 0, 1); PG8_SCHED; PG8_LDA(At, 0, 0); PG8_STAGE(PG8_SA(1, 1), a1, vA1);
            PG8_WAIT_V(8); PG8_WAIT_L(0); PG8_BAR; PG8_MMA(0, 0, At, B0); PG8_MMA(0, 1, At, B1); PG8_BAR; PG8_SCHED;
            PG8_LDA(At, 0, 1); PG8_STAGE(PG8_SB(0, 0), b2, voffB); PG8_STAGE(PG8_SB(0, 1), b2 + hstep, voffB); PG8_STAGE(PG8_SA(0, 0), a2, x0);
            PG8_WAIT_V(8); PG8_WAIT_L(0); PG8_BAR; PG8_MMA(1, 0, At, B0); PG8_MMA(1, 1, At, B1); PG8_BAR; PG8_SCHED;
            PG8_LDB(B0, 1, 0); PG8_LDB(B1, 1, 1); PG8_SCHED; PG8_LDA(At, 1, 0); PG8_STAGE(PG8_SA(0, 1), a2, x1);
            PG8_WAIT_V(8); PG8_WAIT_L(0); PG8_BAR; PG8_MMA(0, 0, At, B0); PG8_MMA(0, 1, At, B1); PG8_BAR; PG8_SCHED;
            PG8_LDA(At, 1, 1); PG8_STAGE(PG8_SB(1, 0), b3, voffB); PG8_STAGE(PG8_SB(1, 1), b3 + hstep, voffB); PG8_STAGE(PG8_SA(1, 0), a3, x0);
            PG8_WAIT_V(8); PG8_WAIT_L(0); PG8_BAR; PG8_MMA(1, 0, At, B0); PG8_MMA(1, 1, At, B1); PG8_BAR; PG8_SCHED;
            } else {
            PG8_LDB(B0, 0, 0); PG8_SCHED; PG8_LDA(At, 0, 0); PG8_STAGE(PG8_SA(1, 1), a1, vA1);
            PG8_WAIT_L(8); PG8_BAR; PG8_WAIT_L(0); PG8_MMA(0, 0, At, B0); PG8_BAR; PG8_SCHED;
            PG8_LDB(B1, 0, 1); PG8_STAGE(PG8_SB(0, 0), b2, voffB);
            PG8_BAR; PG8_WAIT_L(0); PG8_MMA(0, 1, At, B1); PG8_BAR;
            PG8_LDA(At, 0, 1); PG8_STAGE(PG8_SA(0, 0), a2, x0);
            PG8_BAR; PG8_WAIT_L(0); PG8_MMA(1, 0, At, B0); PG8_BAR; PG8_SCHED;
            PG8_STAGE(PG8_SB(0, 1), b2 + hstep, voffB);
            PG8_WAIT_V(6); PG8_BAR; PG8_MMA(1, 1, At, B1); PG8_BAR;
            PG8_LDB(B0, 1, 0); PG8_SCHED; PG8_LDA(At, 1, 0); PG8_STAGE(PG8_SA(0, 1), a2, x1);
            PG8_WAIT_L(8); PG8_BAR; PG8_WAIT_L(0); PG8_MMA(0, 0, At, B0); PG8_BAR; PG8_SCHED;
            PG8_LDB(B1, 1, 1); PG8_STAGE(PG8_SB(1, 0), b3, voffB);
            PG8_BAR; PG8_WAIT_L(0); PG8_MMA(0, 1, At, B1); PG8_BAR;
            PG8_LDA(At, 1, 1); PG8_STAGE(PG8_SA(1, 0), a3, x0);
            PG8_BAR; PG8_WAIT_L(0); PG8_MMA(1, 0, At, B0); PG8_BAR; PG8_SCHED;
            PG8_STAGE(PG8_SB(1, 1), b3 + hstep, voffB);
            PG8_WAIT_V(6); PG8_BAR; PG8_MMA(1, 1, At, B1); PG8_BAR;
            }
        }
        if constexpr (ALIGN_EPI) { if (wr == 0) PG8_BAR; }
        E(acc, cur, wr, wc, fr, fq);
        if (!has_next) break;
#pragma unroll
        for (int a = 0; a < 2; ++a)
#pragma unroll
            for (int b = 0; b < 2; ++b)
#pragma unroll
                for (int m = 0; m < 4; ++m)
#pragma unroll
                    for (int n = 0; n < 2; ++n) acc[a][b][m][n] = (f32x4){0.f, 0.f, 0.f, 0.f};
        cur = nxt; cA = nA; cB = nB; vA0[0] = wA0[0]; vA0[1] = wA0[1]; vA1[0] = wA1[0]; vA1[1] = wA1[1]; ++ui;
        if constexpr (ALIGN_EPI) { if (wr == 1) PG8_BAR; }
    }
    PG8_WAIT_V(0);
    if constexpr (!ALIGN_EPI) { if (wr == 0) PG8_BAR; }
    PG8_BAR;
#undef PG8_SA
#undef PG8_SB
#undef PG8_STAGE
#undef PG8_LDA
#undef PG8_LDB
#undef PG8_MMA
#undef PG8_WAIT_V
#undef PG8_WAIT_L
#undef PG8_BAR
#undef PG8_SCHED
}
}

#define XB_TMO      128
#define XB_XCNT(j)  (256  + 64 * (j))
#define XB_XSUB(j)  (1280 + 64 * (j))
#define XB_XGEN(j)  (2304 + 64 * (j))
#define XB_TOP      3328
#define XB_TOPGEN   3392
#define XCD_BAR_WORDS 3456
#define XB_SPIN_CAP (1u << 18)
__device__ __forceinline__ unsigned xb_ld(unsigned* p)              { return __hip_atomic_load(p, __ATOMIC_RELAXED, __HIP_MEMORY_SCOPE_AGENT); }
__device__ __forceinline__ unsigned xb_add(unsigned* p, unsigned v) { return __hip_atomic_fetch_add(p, v, __ATOMIC_RELAXED, __HIP_MEMORY_SCOPE_AGENT); }
__device__ __forceinline__ unsigned xb_xcc_id() { return (unsigned)__builtin_amdgcn_s_getreg((3 << 11) | 20) & 0xFu; }
#define XB_SPIN(cond, bar) do { unsigned _sp = 0; while (cond) { __builtin_amdgcn_s_sleep(1); \
    if ((++_sp & 255u) == 0u) { if (xb_ld(&(bar)[XB_TMO])) break; if (_sp > XB_SPIN_CAP) { atomicAdd(&(bar)[XB_TMO], 1u); break; } } } } while (0)
struct XcdBarrier { unsigned* bar; unsigned x; volatile LAS unsigned* st; };
__device__ __forceinline__ XcdBarrier xcd_barrier_post(unsigned* bar, volatile LAS unsigned* st) {
    XcdBarrier b; b.bar = bar; b.x = xb_xcc_id(); b.st = st;
    if (threadIdx.x == 0) (void)xb_add(&bar[XB_XCNT(b.x)], 1u);
    return b;
}
__device__ __forceinline__ void xcd_barrier_complete(unsigned* bar, unsigned x, unsigned& nloc, unsigned& nx) {
    const unsigned G = gridDim.x * gridDim.y * gridDim.z;
    unsigned sum, cnt, mine, sp = 0u;
    for (;;) {
        sum = 0u; cnt = 0u; mine = 0u;
#pragma unroll
        for (unsigned j = 0; j < 16; ++j) { const unsigned c = xb_ld(&bar[XB_XCNT(j)]); sum += c; cnt += (c > 0u) ? 1u : 0u; mine = (j == x) ? c : mine; }
        if (sum == G) break;
        __builtin_amdgcn_s_sleep(1);
        if ((++sp & 255u) == 0u) { if (xb_ld(&bar[XB_TMO])) break; if (sp > XB_SPIN_CAP) { atomicAdd(&bar[XB_TMO], 1u); break; } }
    }
    nloc = mine > 0u ? mine : 1u; nx = cnt > 0u ? cnt : 1u;
}
__device__ __forceinline__ void xcd_barrier(const XcdBarrier& b) {
    asm volatile("s_waitcnt vmcnt(0)" ::: "memory");
    __syncthreads();
    if (threadIdx.x == 0) {
        unsigned* bar = b.bar;
        __builtin_amdgcn_s_waitcnt(0);
        unsigned nloc = b.st[0], nx = b.st[1];
        if (nloc == 0u) { xcd_barrier_complete(bar, b.x, nloc, nx); b.st[0] = nloc; b.st[1] = nx; }
        const unsigned old = xb_add(&bar[XB_XSUB(b.x)], 1u);
        const unsigned gen = old / nloc;
        if (old + 1u == (gen + 1u) * nloc) {
            __builtin_amdgcn_fence(__ATOMIC_RELEASE, "agent");
            asm volatile("s_waitcnt vmcnt(0)" ::: "memory");
            const unsigned og = xb_add(&bar[XB_TOP], 1u);
            const unsigned tg = og / nx;
            if (og + 1u == (tg + 1u) * nx) xb_add(&bar[XB_TOPGEN], 1u);
            else XB_SPIN(xb_ld(&bar[XB_TOPGEN]) == tg, bar);
            __builtin_amdgcn_fence(__ATOMIC_ACQUIRE, "agent");
            xb_add(&bar[XB_XGEN(b.x)], 1u);
            asm volatile("s_waitcnt vmcnt(0)" ::: "memory");
        } else {
            XB_SPIN(xb_ld(&bar[XB_XGEN(b.x)]) == gen, bar);
            __builtin_amdgcn_fence(__ATOMIC_ACQUIRE, "agent");
            asm volatile("s_waitcnt vmcnt(0)" ::: "memory");
        }
    }
    __syncthreads();
}

struct Args {
    const float* in[17]; float* out; unsigned char* ws;
    double frev[40];
    int ph_lo, ph_hi, li, pad;
};
struct Frame {
    LAS unsigned char* lds;
    volatile LAS unsigned* MISC;
    gu32* ctl;
    int tid, lane, wave, vcu, G;
};

__device__ __forceinline__ int winperm(int n) {
    const int s = n >> 9, c = n & 511, hh = c >> 6, d = c & 63; int dp = d;
    if (s == 0 || s == 1) { if (d < 16) dp = 2 * (d & 7) + (d >> 3); }
    else if (s == 3 || s == 4) dp = 2 * (d & 31) + (d >> 5);
    return (s << 9) + (hh << 6) + dp;
}
template <int MODE>
__device__ __forceinline__ int tr_row(int ns) { return MODE == 0 ? winperm(ns) : MODE == 1 ? ns : MODE == 2 ? ((ns >> 7) << 8) + (ns & 127) : ((ns >> 7) << 8) + 128 + (ns & 127); }
__device__ __forceinline__ void tr_load(f32x4 (&v)[8], const float* S, int N, int kb, int nb, int lane) {
    const float* p = S + (size_t)(64 * kb + (lane >> 3)) * N + 32 * nb + (lane & 7) * 4;
#pragma unroll
    for (int i = 0; i < 8; ++i) v[i] = __builtin_nontemporal_load((const f32x4*)(p + (size_t)8 * i * N));
}
template <int MODE, bool NT = false>
__device__ __forceinline__ void tr_store(const f32x4 (&v)[8], bf16* Dst, int Kd, LAS float* scr, int kb, int nb, int lane, const float* kscale) {
    const int k0 = 64 * kb, n0 = 32 * nb;
#pragma unroll
    for (int i = 0; i < 8; ++i) { const int kk = 8 * i + (lane >> 3); const float sc = kscale ? kscale[k0 + kk] : 1.f; LAS float* d = scr + kk * 33 + (lane & 7) * 4;
        d[0] = v[i][0] * sc; d[1] = v[i][1] * sc; d[2] = v[i][2] * sc; d[3] = v[i][3] * sc; }
    LDS_WAIT(); asm volatile("" ::: "memory");
    const int c = lane & 7;
#pragma unroll
    for (int j = 0; j < 4; ++j) { const int n = (lane >> 3) + 8 * j; const LAS float* s = scr + (8 * c) * 33 + n;
        u32x4 o; o.x = pk2(s[0 * 33], s[1 * 33]); o.y = pk2(s[2 * 33], s[3 * 33]); o.z = pk2(s[4 * 33], s[5 * 33]); o.w = pk2(s[6 * 33], s[7 * 33]);
        if (NT) __builtin_nontemporal_store(o, (u32x4*)(Dst + (size_t)tr_row<MODE>(n0 + n) * Kd + k0 + 8 * c)); else *(GAS u32x4*)(Dst + (size_t)tr_row<MODE>(n0 + n) * Kd + k0 + 8 * c) = o; }
    LDS_WAIT(); asm volatile("" ::: "memory");
}
template <int MODE>
__device__ __forceinline__ void p0_transpose_item(const float* S, int N, bf16* Dst, int Kd, LAS float* scr, int kb, int nb, int lane, const float* kscale) {
    f32x4 v[8]; tr_load(v, S, N, kb, nb, lane); tr_store<MODE>(v, Dst, Kd, scr, kb, nb, lane, kscale);
}
__device__ __forceinline__ void expert_src(const Args& A, int it, const float*& S, int& N, int& kb, int& nb) {
    const int e = it / 768, r = it - e * 768;
    if (r < 256) { S = A.in[13] + (size_t)e * DM * FF; N = FF; kb = r >> 4; nb = r & 15; }
    else if (r < 512) { S = A.in[14] + (size_t)e * DM * FF; N = FF; kb = (r - 256) >> 4; nb = (r - 256) & 15; }
    else { S = A.in[15] + (size_t)e * FF * DM; N = DM; kb = (r - 512) >> 5; nb = (r - 512) & 31; }
}
__device__ __forceinline__ void expert_store(const Args& A, unsigned char* ws, int it, const f32x4 (&v)[8], LAS float* scr, int lane) {
    bf16* WGU = (bf16*)(ws + WS_WGU); bf16* WD = (bf16*)(ws + WS_WD);
    const int e = it / 768, r = it - e * 768;
    if (r < 256) tr_store<2, true>(v, WGU + (size_t)e * DM * DM, DM, scr, r >> 4, r & 15, lane, A.in[8]);
    else if (r < 512) tr_store<3, true>(v, WGU + (size_t)e * DM * DM, DM, scr, (r - 256) >> 4, (r - 256) & 15, lane, A.in[8]);
    else tr_store<1, true>(v, WD + (size_t)e * DM * FF, FF, scr, (r - 512) >> 5, (r - 512) & 31, lane, nullptr);
}
__device__ __forceinline__ void expert_items(const Args& A, unsigned char* ws, LAS float* scr, int lo, int NI, int w0, int nw, int lane) {
    for (int it = lo + w0; it < NI; it += 4 * nw) {
        f32x4 v0[8], v1[8], v2[8], v3[8]; const float* S; int N, kb, nb;
        expert_src(A, it, S, N, kb, nb); tr_load(v0, S, N, kb, nb, lane);
        if (it + nw < NI) { expert_src(A, it + nw, S, N, kb, nb); tr_load(v1, S, N, kb, nb, lane); }
        if (it + 2 * nw < NI) { expert_src(A, it + 2 * nw, S, N, kb, nb); tr_load(v2, S, N, kb, nb, lane); }
        if (it + 3 * nw < NI) { expert_src(A, it + 3 * nw, S, N, kb, nb); tr_load(v3, S, N, kb, nb, lane); }
        expert_store(A, ws, it, v0, scr, lane);
        if (it + nw < NI) expert_store(A, ws, it + nw, v1, scr, lane);
        if (it + 2 * nw < NI) expert_store(A, ws, it + 2 * nw, v2, scr, lane);
        if (it + 3 * nw < NI) expert_store(A, ws, it + 3 * nw, v3, scr, lane);
    }
}
__device__ __forceinline__ void p0_prologue(Frame& F, const Args& A) {
    unsigned char* ws = A.ws;
    LAS float* scr = (LAS float*)(F.lds + F.wave * 16384);
    const int gw = F.vcu * NWAVES + F.wave, NGW = F.G * NWAVES;
    constexpr int I_IN = 16 * 112, I_OUT = 16 * 32;
    bf16* WIN = (bf16*)(ws + WS_WIN); bf16* WOUT = (bf16*)(ws + WS_WOUT);
    for (int it = gw; it < I_IN + I_OUT; it += NGW) {
        int r = it;
        if (r < I_IN) { p0_transpose_item<0>(A.in[2], NIN, WIN, DM, scr, r / 112, r % 112, F.lane, nullptr); continue; } r -= I_IN;
        const int kb = r / 32; p0_transpose_item<1>(A.in[7], DM, WOUT, DM, scr, kb, r % 32, F.lane, kb < 8 ? A.in[3] : A.in[6] - 512);
    }
    expert_items(A, ws, scr, F.G == 256 ? N_CONV_P1 : 0, 768 * NEXP, gw, NGW, F.lane);
    { const float* x = A.in[0]; const float* g = A.in[1]; bf16* XN = (bf16*)(ws + WS_XN);
      f32x4 gv[4];
#pragma unroll
      for (int j = 0; j < 4; ++j) gv[j] = ((const f32x4*)g)[F.lane + 64 * j];
      for (int m0 = gw; m0 < M; m0 += 4 * NGW) {
        f32x4 v[4][4];
#pragma unroll
        for (int k = 0; k < 4; ++k) { const GAS f32x4* xr = (const GAS f32x4*)(x + (size_t)(m0 + k * NGW) * DM) + F.lane;
#pragma unroll
            for (int j = 0; j < 4; ++j) v[k][j] = __builtin_nontemporal_load(xr + 64 * j); }
#pragma unroll
        for (int k = 0; k < 4; ++k) { float s = 0.f;
#pragma unroll
            for (int j = 0; j < 4; ++j) s += (v[k][j].x * v[k][j].x + v[k][j].y * v[k][j].y) + (v[k][j].z * v[k][j].z + v[k][j].w * v[k][j].w);
            const float rstd = 1.f / sqrtf(wave_sum(s) * (1.f / DM) + NORM_EPS);
            GAS unsigned long long* o8 = (GAS unsigned long long*)(XN + (size_t)(m0 + k * NGW) * DM) + F.lane;
#pragma unroll
            for (int j = 0; j < 4; ++j) { const f32x4 t = v[k][j] * rstd * gv[j]; o8[64 * j] = (unsigned long long)pk2(t.x, t.y) | ((unsigned long long)pk2(t.z, t.w) << 32); } }
      } }
    { const int gt = (F.vcu * NWAVES + F.wave) * 64 + F.lane, NT = NGW * 64;
      bf16* WRH = (bf16*)(ws + WS_WRT); bf16* WRL = WRH + 48 * DM; const float* gf = A.in[8]; const float* wg = A.in[9]; const float* we = A.in[11];
      for (int idx = gt; idx < 48 * DM; idx += NT) { const int j = idx >> 10, i = idx & 1023;
          const float v = (j < 32 ? we[i * 32 + j] : (j < 36 ? wg[i * 4 + (j - 32)] : 0.f)) * gf[i];
          const unsigned hb = pk2(v, 0.f) & 0xffffu; const float lo = v - bflo(hb); WRH[idx] = (bf16)hb; WRL[idx] = (bf16)(pk2(lo, 0.f) & 0xffffu); }
      float* RC = (float*)(ws + WS_ROPE); float* RS = RC + SEQ * 40;
      for (int idx = gt; idx < SEQ * 40; idx += NT) { const int pos = idx / 40, f = idx % 40;
          double rv = (double)pos * A.frev[f]; rv -= floor(rv); const float r = (float)rv;
          RC[idx] = __builtin_amdgcn_cosf(r); RS[idx] = __builtin_amdgcn_sinf(r); } }
}

struct SrcPlain {
    const bf16* A; const bf16* Bt; int K;
    __device__ __forceinline__ void setup(const pg8::Unit& u, const int (&RA)[2], const int (&CA)[2], const char*& cA, const char*& cB, unsigned (&v0)[2], unsigned (&v1)[2]) const {
        cA = (const char*)A + (size_t)u.pm * 256 * K * 2; cB = (const char*)Bt + (size_t)u.pn * 256 * K * 2;
#pragma unroll
        for (int i = 0; i < 2; ++i) { v0[i] = (unsigned)(RA[i] * K + CA[i]) * 2u; v1[i] = v0[i] + (unsigned)(128 * K * 2); }
    }
};
struct TileTab { const LAS int* TE; const LAS int* NE; const LAS int* T0; };
struct SrcGather {
    const bf16* HG; const bf16* WGU; const int* LIST; TileTab tt;
    __device__ __forceinline__ void setup(const pg8::Unit& u, const int (&RA)[2], const int (&CA)[2], const char*& cA, const char*& cB, unsigned (&v0)[2], unsigned (&v1)[2]) const {
        const int e = tt.TE[u.pm], ne = tt.NE[e], p0 = (u.pm - tt.T0[e]) * 256;
        cA = (const char*)HG; cB = (const char*)WGU + ((size_t)e * DM + (size_t)u.pn * 256) * DM * 2;
#pragma unroll
        for (int i = 0; i < 2; ++i) {
            const int pa = p0 + RA[i], pb = pa + 128;
            const int ta = pa < ne ? (LIST[e * M + pa] >> 1) : 0, tb = pb < ne ? (LIST[e * M + pb] >> 1) : 0;
            v0[i] = (unsigned)(ta * DM + CA[i]) * 2u; v1[i] = (unsigned)(tb * DM + CA[i]) * 2u; }
    }
};
struct SrcDown {
    const bf16* HID; const bf16* WD; TileTab tt;
    __device__ __forceinline__ void setup(const pg8::Unit& u, const int (&RA)[2], const int (&CA)[2], const char*& cA, const char*& cB, unsigned (&v0)[2], unsigned (&v1)[2]) const {
        const int e = tt.TE[u.pm];
        cA = (const char*)HID + (size_t)u.pm * 256 * FF * 2; cB = (const char*)WD + ((size_t)e * DM + (size_t)u.pn * 256) * FF * 2;
#pragma unroll
        for (int i = 0; i < 2; ++i) { v0[i] = (unsigned)(RA[i] * FF + CA[i]) * 2u; v1[i] = v0[i] + (unsigned)(128 * FF * 2); }
    }
};

struct EpiInProj {
    static constexpr bool PERM = true;
    bf16* SEG; const float* RC; const float* RS;
    __device__ __forceinline__ void operator()(const f32x4 (&acc)[2][2][4][2], const pg8::Unit& u, int wr, int wc, int fr, int fq) const {
        const int seg = u.pn >> 1, colt = (u.pn & 1) * 256;
        bf16* base = SEG + (size_t)seg * M * SEGW;
        const int dq = (wc & 1) * 32 + 8 * fq;
        const bool attn = seg < 2, ret = (seg == 3 || seg == 4);
        const bool rot = ret || (attn && dq < 16);
        const int i0 = ret ? 8 + (dq >> 1) : (dq >> 1);
        const float sc = seg == 0 ? 0.125f * LOG2E : (seg == 4 ? 0.125f : 1.f);
#pragma unroll
        for (int ai = 0; ai < 2; ++ai)
#pragma unroll
            for (int m = 0; m < 4; ++m) {
                const int row = u.pm * 256 + ai * 128 + wr * 64 + m * 16 + fr, pos = row & (SEQ - 1);
                f32x4 c4 = {1.f, 1.f, 1.f, 1.f}, s4 = {0.f, 0.f, 0.f, 0.f};
                if (rot) { c4 = *(const f32x4*)(RC + pos * 40 + i0); s4 = *(const f32x4*)(RS + pos * 40 + i0); }
                bf16* rowp = base + (size_t)row * SEGW + colt + wc * 32 + 8 * fq;
#pragma unroll
                for (int bj = 0; bj < 2; ++bj) {
                    f32x4 v0 = acc[ai][bj][m][0], v1 = acc[ai][bj][m][1];
                    if (attn || ret) {
                        f32x4 r0, r1;
                        r0[0] = v0[0] * c4[0] - v0[1] * s4[0]; r0[1] = v0[1] * c4[0] + v0[0] * s4[0];
                        r0[2] = v0[2] * c4[1] - v0[3] * s4[1]; r0[3] = v0[3] * c4[1] + v0[2] * s4[1];
                        r1[0] = v1[0] * c4[2] - v1[1] * s4[2]; r1[1] = v1[1] * c4[2] + v1[0] * s4[2];
                        r1[2] = v1[2] * c4[3] - v1[3] * s4[3]; r1[3] = v1[3] * c4[3] + v1[2] * s4[3];
                        v0 = r0 * sc; v1 = r1 * sc;
                    } else if (seg == 6) {
#pragma unroll
                        for (int e = 0; e < 4; ++e) { v0[e] = silu_f(v0[e]); v1[e] = silu_f(v1[e]); }
                    }
                    u32x4 w; w.x = pk2(v0[0], v0[1]); w.y = pk2(v0[2], v0[3]); w.z = pk2(v1[0], v1[1]); w.w = pk2(v1[2], v1[3]);
                    *(u32x4*)(rowp + bj * 128) = w;
                }
            }
    }
};
struct EpiOutProj {
    static constexpr bool PERM = true;
    const float* X; bf16* HB;
    __device__ __forceinline__ void operator()(const f32x4 (&acc)[2][2][4][2], const pg8::Unit& u, int wr, int wc, int fr, int fq) const {
        const int col0 = u.pn * 256 + wc * 32 + 8 * fq;
#pragma unroll
        for (int ai = 0; ai < 2; ++ai)
#pragma unroll
            for (int m = 0; m < 4; ++m) { const size_t off = (size_t)(u.pm * 256 + ai * 128 + wr * 64 + m * 16 + fr) * DM + col0;
#pragma unroll
                for (int bj = 0; bj < 2; ++bj) { const f32x4 h0 = __builtin_nontemporal_load((const f32x4*)(X + off + bj * 128)) + acc[ai][bj][m][0], h1 = __builtin_nontemporal_load((const f32x4*)(X + off + bj * 128 + 4)) + acc[ai][bj][m][1];
                    u32x4 w; w.x = pk2(h0[0], h0[1]); w.y = pk2(h0[2], h0[3]); w.z = pk2(h1[0], h1[1]); w.w = pk2(h1[2], h1[3]); *(u32x4*)(HB + off + bj * 128) = w; }
                if (m & 1) asm volatile("" ::: "memory"); }
    }
};
struct EpiGateUp {
    static constexpr bool PERM = true;
    bf16* HID; const float* GATEL; const float* RSL; TileTab tt;
    __device__ __forceinline__ void operator()(const f32x4 (&acc)[2][2][4][2], const pg8::Unit& u, int wr, int wc, int fr, int fq) const {
        const int e = tt.TE[u.pm], ne = tt.NE[e], p0 = (u.pm - tt.T0[e]) * 256;
#pragma unroll
        for (int ai = 0; ai < 2; ++ai)
#pragma unroll
            for (int m = 0; m < 4; ++m) {
                const int rr = ai * 128 + wr * 64 + m * 16 + fr, pos = p0 + rr;
                float rs = 0.f, gt = 0.f; if (pos < ne) { rs = RSL[e * M + pos]; gt = GATEL[e * M + pos]; }
                u32x4 w; unsigned* wp = (unsigned*)&w;
#pragma unroll
                for (int n = 0; n < 2; ++n) { const f32x4 g = acc[ai][0][m][n] * rs, up = acc[ai][1][m][n] * rs; float hv[4];
#pragma unroll
                    for (int q = 0; q < 4; ++q) hv[q] = silu_f(g[q]) * up[q] * gt;
                    wp[2 * n] = pk2(hv[0], hv[1]); wp[2 * n + 1] = pk2(hv[2], hv[3]); }
                *(u32x4*)(HID + (size_t)(u.pm * 256 + rr) * FF + u.pn * 128 + wc * 32 + 8 * fq) = w;
            }
    }
};
struct EpiDown {
    static constexpr bool PERM = true;
    bf16* Y; const int* LIST; TileTab tt;
    __device__ __forceinline__ void operator()(const f32x4 (&acc)[2][2][4][2], const pg8::Unit& u, int wr, int wc, int fr, int fq) const {
        const int e = tt.TE[u.pm], ne = tt.NE[e], p0 = (u.pm - tt.T0[e]) * 256;
#pragma unroll
        for (int ai = 0; ai < 2; ++ai)
#pragma unroll
            for (int m = 0; m < 4; ++m) {
                const int pos = p0 + ai * 128 + wr * 64 + m * 16 + fr;
                if (pos < ne) { const int tk = LIST[e * M + pos]; bf16* rowp = Y + (size_t)tk * DM + u.pn * 256 + wc * 32 + 8 * fq;
#pragma unroll
                    for (int bj = 0; bj < 2; ++bj) { const f32x4 v0 = acc[ai][bj][m][0], v1 = acc[ai][bj][m][1];
                        u32x4 w; w.x = pk2(v0[0], v0[1]); w.y = pk2(v0[2], v0[3]); w.z = pk2(v1[0], v1[1]); w.w = pk2(v1[2], v1[3]);
                        *(u32x4*)(rowp + bj * 128) = w; } }
            }
    }
};

typedef short v4i16_t __attribute__((ext_vector_type(4)));
__device__ __forceinline__ s16x4 vtr(const LAS unsigned char* p) { return __builtin_bit_cast(s16x4, __builtin_amdgcn_ds_read_tr16_b64_v4i16((LAS v4i16_t*)p)); }
#define MFMA32(a, b, c) __builtin_amdgcn_mfma_f32_32x32x16_bf16((a), (b), (c), 0, 0, 0)
__device__ __forceinline__ bf16x8 pack8(const f32x16& x, int s) {
    u32x4 p; p.x = pk2(x[8 * s], x[8 * s + 1]); p.y = pk2(x[8 * s + 2], x[8 * s + 3]); p.z = pk2(x[8 * s + 4], x[8 * s + 5]); p.w = pk2(x[8 * s + 6], x[8 * s + 7]);
    return __builtin_bit_cast(bf16x8, p);
}
__device__ __forceinline__ bf16x8 cat44(s16x4 lo, s16x4 hi) { return __builtin_shufflevector(lo, hi, 0, 1, 2, 3, 4, 5, 6, 7); }
__device__ __forceinline__ bf16x8 scale8(bf16x8 v, float s) {
    u32x4 u = __builtin_bit_cast(u32x4, v), o;
    o.x = pk2(bflo(u.x) * s, bfhi(u.x) * s); o.y = pk2(bflo(u.y) * s, bfhi(u.y) * s); o.z = pk2(bflo(u.z) * s, bfhi(u.z) * s); o.w = pk2(bflo(u.w) * s, bfhi(u.w) * s);
    return __builtin_bit_cast(bf16x8, o);
}
constexpr int TP = 144;
__device__ __forceinline__ void pv_tile_p(f32x16& ot0, f32x16& ot1, const f32x16& st, const LAS unsigned char* vl, int lane) {
    const int hi = lane >> 5;
    const LAS unsigned char* vr = vl + (4 * hi + ((lane & 15) >> 2)) * TP + (16 * ((lane >> 4) & 1) + 4 * (lane & 3)) * 2;
    const bf16x8 pb0 = pack8(st, 0), pb1 = pack8(st, 1);
    { const bf16x8 va = cat44(vtr(vr), vtr(vr + 8 * TP)); ot0 = MFMA32(va, pb0, ot0); }
    { const bf16x8 va = cat44(vtr(vr + 16 * TP), vtr(vr + 24 * TP)); ot0 = MFMA32(va, pb1, ot0); }
    { const bf16x8 va = cat44(vtr(vr + 64), vtr(vr + 8 * TP + 64)); ot1 = MFMA32(va, pb0, ot1); }
    { const bf16x8 va = cat44(vtr(vr + 16 * TP + 64), vtr(vr + 24 * TP + 64)); ot1 = MFMA32(va, pb1, ot1); }
}
__device__ __forceinline__ void kv_task(int cid, const bf16* KR, const bf16* VR, bf16* KV, const float* dec_f, const float* dec_b, LAS unsigned char* wl, int lane) {
    const int bh = cid >> 5, n = cid & 31, b = bh >> 3, h = bh & 7, q = lane & 31, hi = lane >> 5, tr = lane >> 3, tc = (lane & 7) * 8;
    const float lgf = __uint_as_float(__builtin_amdgcn_readfirstlane(__float_as_uint(log1pf(-exp2f(dec_f[h])) * LOG2E))), lgb = __uint_as_float(__builtin_amdgcn_readfirstlane(__float_as_uint(log1pf(-exp2f(dec_b[h])) * LOG2E)));
    const size_t row0 = (size_t)b * SEQ + n * CHUNK; const int loff = tr * SEGW + tc;
    const bf16* Kb = KR + row0 * SEGW + h * HD; const bf16* Vb = VR + row0 * SEGW + h * HD;
    LAS unsigned char* Tf = wl; LAS unsigned char* Tb = wl + 32 * TP; LAS unsigned char* Tv = wl + 64 * TP; LAS unsigned char* tw = wl + tr * TP + tc * 2;
    const int tro = (8 * hi + ((lane & 15) >> 2)) * TP + (16 * ((lane >> 4) & 1) + 4 * (lane & 3)) * 2;
    f32x16 acc[2][2][2];
#pragma unroll
    for (int d = 0; d < 2; ++d)
#pragma unroll
        for (int a = 0; a < 2; ++a)
#pragma unroll
            for (int c = 0; c < 2; ++c)
#pragma unroll
                for (int r = 0; r < 16; ++r) acc[d][a][c][r] = 0.f;
    bf16x8 nk[4], nv[4];
#pragma unroll
    for (int i = 0; i < 4; ++i) { nk[i] = *(const bf16x8*)(Kb + loff + 8 * i * SEGW); nv[i] = *(const bf16x8*)(Vb + loff + 8 * i * SEGW); }
#pragma unroll 1
    for (int it = 0; it < 4; ++it) {
#pragma unroll
        for (int i = 0; i < 4; ++i) { const int key = 32 * it + tr + 8 * i;
            *(LAS bf16x8*)(tw + 8 * i * TP) = scale8(nk[i], __builtin_amdgcn_exp2f((float)(CHUNK - 1 - key) * lgf));
            *(LAS bf16x8*)(tw + 32 * TP + 8 * i * TP) = scale8(nk[i], __builtin_amdgcn_exp2f((float)key * lgb));
            *(LAS bf16x8*)(tw + 64 * TP + 8 * i * TP) = nv[i]; }
        if (it < 3) {
#pragma unroll
            for (int i = 0; i < 4; ++i) { nk[i] = *(const bf16x8*)(Kb + 32 * (it + 1) * SEGW + loff + 8 * i * SEGW); nv[i] = *(const bf16x8*)(Vb + 32 * (it + 1) * SEGW + loff + 8 * i * SEGW); } }
        asm volatile("" ::: "memory");
#pragma unroll
        for (int s2 = 0; s2 < 2; ++s2) {
            bf16x8 bv[2];
#pragma unroll
            for (int c = 0; c < 2; ++c) bv[c] = cat44(vtr(Tv + tro + s2 * 16 * TP + c * 64), vtr(Tv + tro + s2 * 16 * TP + 4 * TP + c * 64));
#pragma unroll
            for (int a = 0; a < 2; ++a) {
                const bf16x8 af = cat44(vtr(Tf + tro + s2 * 16 * TP + a * 64), vtr(Tf + tro + s2 * 16 * TP + 4 * TP + a * 64));
                const bf16x8 ab = cat44(vtr(Tb + tro + s2 * 16 * TP + a * 64), vtr(Tb + tro + s2 * 16 * TP + 4 * TP + a * 64));
#pragma unroll
                for (int c = 0; c < 2; ++c) { acc[0][a][c] = MFMA32(af, bv[c], acc[0][a][c]); acc[1][a][c] = MFMA32(ab, bv[c], acc[1][a][c]); }
            }
        }
        asm volatile("" ::: "memory");
    }
#pragma unroll
    for (int d = 0; d < 2; ++d) { bf16* ob = KV + (((size_t)bh * NCHUNK + n) * 2 + d) * 4096;
#pragma unroll
        for (int a = 0; a < 2; ++a)
#pragma unroll
            for (int c = 0; c < 2; ++c)
#pragma unroll
                for (int g = 0; g < 4; ++g) { u32x2 w; w.x = pk2(acc[d][a][c][4 * g], acc[d][a][c][4 * g + 1]); w.y = pk2(acc[d][a][c][4 * g + 2], acc[d][a][c][4 * g + 3]);
                    *(u32x2*)(ob + ((c * 4 + 2 * a + (g >> 1)) * 64 + q + 32 * (g & 1)) * 8 + 4 * hi) = w; } }
}

struct AttnRound { size_t rowbase; int dil, qb0, nblk, h, br; };
__device__ __forceinline__ AttnRound round_decode(int rg) {
    AttnRound a; const int bh = rg / 48, x = rg - bh * 48, br = x >> 4, w16 = x & 15; int cls, qb0;
    if (br == 0) { cls = 0; qb0 = 8 * w16; } else if (br == 1) { cls = w16 >> 2; qb0 = 8 * (w16 & 3); } else { cls = w16; qb0 = 0; }
    a.rowbase = (size_t)(bh >> 3) * SEQ + cls; a.dil = 1 << (2 * br); a.qb0 = qb0; a.nblk = (SEQ >> (2 * br)) >> 5; a.h = bh & 7; a.br = br; return a;
}
__device__ __forceinline__ int round_id(int r0, int xl, int rr) { if (xl < 0) return r0 + rr; const int t = rr / 3, i = rr - 3 * t; return (r0 + 2 * t + (xl >> 4)) * 48 + 3 * (xl & 15) + i; }
__device__ __forceinline__ void attn_rounds(int r0, int xl, int nr, const bf16* QA, const bf16* KA, const bf16* VA, bf16* OBR, float* LSE, LAS unsigned char* lds, int wave, int lane) {
    const int q = lane & 31, hi = lane >> 5, tr = lane >> 3, tc = (lane & 7) * 8;
    LAS unsigned char* Qt = lds + (24 + wave) * (32 * TP);
    const int twoff = tr * TP + tc * 2;
    bf16x8 pt[3][4], pq[4];
    AttnRound nx = round_decode(round_id(r0, xl, 0));
#define ATT_PREFETCH(R) do { \
        _Pragma("unroll") for (int x_ = 0; x_ < 3; ++x_) { const int tile = 3 * wave + x_, slot = tile >= 12 ? tile - 12 : tile, j_ = (R).qb0 - 2 + slot; \
            if (j_ >= 0 && j_ < (R).nblk) { const bf16* src = (tile >= 12 ? VA : KA) + ((R).rowbase + (size_t)(R).dil * (32 * j_ + tr)) * SEGW + (R).h * HD + tc; \
                _Pragma("unroll") for (int i_ = 0; i_ < 4; ++i_) pt[x_][i_] = *(const bf16x8*)(src + (size_t)(R).dil * 8 * i_ * SEGW); } } \
        { const bf16* src = QA + ((R).rowbase + (size_t)(R).dil * (32 * ((R).qb0 + wave) + tr)) * SEGW + (R).h * HD + tc; \
          _Pragma("unroll") for (int i_ = 0; i_ < 4; ++i_) pq[i_] = *(const bf16x8*)(src + (size_t)(R).dil * 8 * i_ * SEGW); } } while (0)
    ATT_PREFETCH(nx);
#pragma unroll 1
    for (int rr = 0; rr < nr; ++rr) {
        const AttnRound cu = nx;
        __syncthreads();
#pragma unroll
        for (int x = 0; x < 3; ++x) { const int tile = 3 * wave + x, slot = tile >= 12 ? tile - 12 : tile, j = cu.qb0 - 2 + slot;
            if (j >= 0 && j < cu.nblk) { LAS unsigned char* tb = lds + tile * (32 * TP) + twoff;
#pragma unroll
                for (int i = 0; i < 4; ++i) *(LAS bf16x8*)(tb + 8 * i * TP) = pt[x][i]; } }
#pragma unroll
        for (int i = 0; i < 4; ++i) *(LAS bf16x8*)(Qt + twoff + 8 * i * TP) = pq[i];
        if (rr + 1 < nr) { nx = round_decode(round_id(r0, xl, rr + 1)); ATT_PREFETCH(nx); }
        __syncthreads();
        bf16x8 qr[4];
#pragma unroll
        for (int ks = 0; ks < 4; ++ks) qr[ks] = *(const LAS bf16x8*)(Qt + q * TP + hi * 16 + 32 * ks);
        float mrun = -1e30f, lsum = 0.f; f32x16 ot0, ot1;
#pragma unroll
        for (int r = 0; r < 16; ++r) { ot0[r] = 0.f; ot1[r] = 0.f; }
        const int jb = cu.qb0 + wave - 2, klo = jb < 0 ? -jb : 0, khi = jb + 4 >= cu.nblk ? cu.nblk - 1 - jb : 4;
        f32x16 stn;
#define ATT_QK(dst, kb_) do { const LAS unsigned char* Kt_ = lds + (wave + (kb_)) * (32 * TP); _Pragma("unroll") for (int r_ = 0; r_ < 16; ++r_) dst[r_] = 0.f; \
            _Pragma("unroll") for (int ks_ = 0; ks_ < 4; ++ks_) dst = MFMA32(*(const LAS bf16x8*)(Kt_ + q * TP + hi * 16 + 32 * ks_), qr[ks_], dst); } while (0)
        ATT_QK(stn, klo);
#pragma unroll 1
        for (int kb = klo; kb <= khi; ++kb) {
            f32x16 st = stn;
            if (kb < khi) ATT_QK(stn, kb + 1);
            const LAS unsigned char* Vt = lds + (12 + wave + kb) * (32 * TP);
            if (kb == 0) {
#pragma unroll
                for (int r = 0; r < 16; ++r) if (crow(r, hi) < q) st[r] = -1e30f;
            }
            if (kb == 4) {
#pragma unroll
                for (int r = 0; r < 16; ++r) if (crow(r, hi) > q) st[r] = -1e30f;
            }
            float mx = st[0];
#pragma unroll
            for (int r = 1; r < 16; ++r) mx = fmaxf(mx, st[r]);
            mx = fmaxf(mx, __shfl_xor(mx, 32));
            if (!__all(mx <= mrun + 8.f)) {
                const float mnew = fmaxf(mrun, mx), alpha = __builtin_amdgcn_exp2f(mrun - mnew); mrun = mnew; lsum *= alpha;
#pragma unroll
                for (int r = 0; r < 16; ++r) { ot0[r] *= alpha; ot1[r] *= alpha; }
            }
            float ps = 0.f;
#pragma unroll
            for (int r = 0; r < 16; ++r) { st[r] = __builtin_amdgcn_exp2f(st[r] - mrun); ps += st[r]; }
            lsum += ps;
            pv_tile_p(ot0, ot1, st, Vt, lane);
        }
#undef ATT_QK
        const float lt = lsum + __shfl_xor(lsum, 32);
        const float inv = 1.f / lt, lse = (mrun + __log2f(lt)) * LN2;
        asm volatile("" ::: "memory");
        LAS unsigned char* ow = Qt + q * TP + 8 * hi;
#pragma unroll
        for (int g = 0; g < 4; ++g) {
            u32x2 w0, w1; w0.x = pk2(ot0[4 * g] * inv, ot0[4 * g + 1] * inv); w0.y = pk2(ot0[4 * g + 2] * inv, ot0[4 * g + 3] * inv);
            w1.x = pk2(ot1[4 * g] * inv, ot1[4 * g + 1] * inv); w1.y = pk2(ot1[4 * g + 2] * inv, ot1[4 * g + 3] * inv);
            *(LAS u32x2*)(ow + 16 * g) = w0; *(LAS u32x2*)(ow + 64 + 16 * g) = w1; }
        asm volatile("" ::: "memory");
        const size_t qbase = cu.rowbase + (size_t)cu.dil * 32 * (cu.qb0 + wave);
#pragma unroll
        for (int i = 0; i < 4; ++i) { const u32x4 v = *(const LAS u32x4*)(Qt + twoff + 8 * i * TP);
            *(u32x4*)(OBR + ((size_t)cu.br * M + qbase + (size_t)cu.dil * (tr + 8 * i)) * SEGW + cu.h * HD + tc) = v; }
        if (hi == 0) LSE[((size_t)cu.br * M + qbase + (size_t)cu.dil * q) * NHEAD + cu.h] = lse;
        asm volatile("" ::: "memory");
    }
#undef ATT_PREFETCH
    __syncthreads();
}

constexpr int R_K = 0, R_V = 128 * TP, R_Q = 2 * 128 * TP, R_G = 3 * 128 * TP, R_O = 4 * 128 * TP, R_SF = 5 * 128 * TP, R_SB = R_SF + 8192, R_X = R_SB + 8192;
__device__ __forceinline__ void ret_wg(int wgt, const bf16* QR, const bf16* KR, const bf16* VR, const bf16* GR, const bf16* KV, bf16* SBW, bf16* MIXED, const float* dec_f, const float* dec_b,
                                       const bf16* OBR, const float* LSE, long crow0, LAS unsigned char* lds, int tid, int wave, int lane) {
    const int bh = wgt >> 2, n0 = (wgt & 3) * 8, b = bh >> 3, h = bh & 7, q = lane & 31, hi = lane >> 5, tr = lane >> 3, tc = (lane & 7) * 8;
    const float lgf = __uint_as_float(__builtin_amdgcn_readfirstlane(__float_as_uint(log1pf(-exp2f(dec_f[h])) * LOG2E))), lgb = __uint_as_float(__builtin_amdgcn_readfirstlane(__float_as_uint(log1pf(-exp2f(dec_b[h])) * LOG2E)));
    const float gf128 = exp2f(128.f * lgf), gb128 = exp2f(128.f * lgb);
    float pf[16], pb[16];
#pragma unroll
    for (int r = 0; r < 16; ++r) { const int dl = q - crow(r, hi); pf[r] = exp2f((float)dl * lgf); pb[r] = exp2f((float)(-dl) * lgb); }
    const bf16* KVt = KV + (size_t)bh * NCHUNK * 2 * 4096 + 8 * tid;
    bf16* SBt = SBW + (size_t)bh * NCHUNK * 4096 + 8 * tid;
    float Sf[8], Sb[8];
#pragma unroll
    for (int e = 0; e < 8; ++e) { Sf[e] = 0.f; Sb[e] = 0.f; }
#define RET_AXPY(S, g, v) do { S[0] = S[0] * (g) + bflo((v).x); S[1] = S[1] * (g) + bfhi((v).x); S[2] = S[2] * (g) + bflo((v).y); S[3] = S[3] * (g) + bfhi((v).y); \
                               S[4] = S[4] * (g) + bflo((v).z); S[5] = S[5] * (g) + bfhi((v).z); S[6] = S[6] * (g) + bflo((v).w); S[7] = S[7] * (g) + bfhi((v).w); } while (0)
    for (int m0 = 0; m0 < n0; m0 += 8) { u32x4 v[8];
#pragma unroll
        for (int k = 0; k < 8; ++k) v[k] = *(const u32x4*)(KVt + (size_t)((m0 + k) * 2) * 4096);
#pragma unroll
        for (int k = 0; k < 8; ++k) RET_AXPY(Sf, gf128, v[k]); }
    for (int m0 = NCHUNK - 8; m0 >= n0 + 8; m0 -= 8) { u32x4 v[8];
#pragma unroll
        for (int k = 0; k < 8; ++k) v[k] = *(const u32x4*)(KVt + (size_t)((m0 + 7 - k) * 2 + 1) * 4096);
#pragma unroll
        for (int k = 0; k < 8; ++k) RET_AXPY(Sb, gb128, v[k]); }
    { u32x4 v[8];
#pragma unroll
      for (int k = 0; k < 8; ++k) v[k] = *(const u32x4*)(KVt + (size_t)((n0 + 7 - k) * 2 + 1) * 4096);
#pragma unroll
      for (int k = 0; k < 8; ++k) { u32x4 w; w.x = pk2(Sb[0], Sb[1]); w.y = pk2(Sb[2], Sb[3]); w.z = pk2(Sb[4], Sb[5]); w.w = pk2(Sb[6], Sb[7]);
          *(u32x4*)(SBt + (size_t)(n0 + 7 - k) * 4096) = w; RET_AXPY(Sb, gb128, v[k]); } }
    VM_WAIT();
    const int tsel = wave >> 1, rbase = 64 * (wave & 1) + tr;
    const bf16* tsrc = (tsel == 0 ? KR : tsel == 1 ? VR : tsel == 2 ? QR : GR) + ((size_t)b * SEQ + rbase) * SEGW + h * HD + tc;
    LAS unsigned char* tdst = lds + tsel * (128 * TP) + rbase * TP + tc * 2;
    const int qb = wave & 3, dvh = wave >> 2;
    bf16x8 pre[8]; u32x4 pkv, psb;
#define RET_PREFETCH(n_) do { _Pragma("unroll") for (int i_ = 0; i_ < 8; ++i_) pre[i_] = __builtin_nontemporal_load((const bf16x8*)(tsrc + (size_t)((n_) * CHUNK + 8 * i_) * SEGW)); \
        pkv = *(const u32x4*)(KVt + (size_t)((n_) * 2) * 4096); psb = *(const u32x4*)(SBt + (size_t)(n_) * 4096); } while (0)
    RET_PREFETCH(n0);
#pragma unroll 1
    for (int jn = 0; jn < 8; ++jn) {
        const int n = n0 + jn; const size_t row0 = (size_t)b * SEQ + n * CHUNK;
        __syncthreads();
        if (jn > 0) {
#pragma unroll
            for (int i = 0; i < 2; ++i) { const int r = 16 * wave + 8 * i + tr; const u32x4 v = *(const LAS u32x4*)(lds + R_O + r * TP + tc * 2);
                *(u32x4*)(MIXED + (row0 - CHUNK + r) * DM + 512 + h * HD + tc) = v; } }
#pragma unroll
        for (int i = 0; i < 8; ++i) *(LAS bf16x8*)(tdst + 8 * i * TP) = pre[i];
        { u32x4 w; w.x = pk2(Sf[0], Sf[1]); w.y = pk2(Sf[2], Sf[3]); w.z = pk2(Sf[4], Sf[5]); w.w = pk2(Sf[6], Sf[7]);
          *(LAS u32x4*)(lds + R_SF + tid * 16) = w; *(LAS u32x4*)(lds + R_SB + tid * 16) = psb; }
        RET_AXPY(Sf, gf128, pkv);
        if (jn < 7) RET_PREFETCH(n + 1);
        float cl[3]; u32x4 ca[3];
#define RET_CLOAD(rw_) do { _Pragma("unroll") for (int br_ = 0; br_ < 3; ++br_) { cl[br_] = LSE[((size_t)br_ * M + (rw_)) * NHEAD + (lane >> 3)]; ca[br_] = __builtin_nontemporal_load((const u32x4*)(OBR + ((size_t)br_ * M + (rw_)) * SEGW + 8 * lane)); } } while (0)
#define RET_CFIN(rw_) do { const float mx_ = fmaxf(cl[0], fmaxf(cl[1], cl[2])); float w0_ = __expf(cl[0] - mx_), w1_ = __expf(cl[1] - mx_), w2_ = __expf(cl[2] - mx_); \
            const float inv_ = 1.f / (w0_ + w1_ + w2_); w0_ *= inv_; w1_ *= inv_; w2_ *= inv_; float o_[8]; float ssq_ = 0.f; \
            _Pragma("unroll") for (int e_ = 0; e_ < 4; ++e_) { o_[2 * e_] = w0_ * bflo(ca[0][e_]) + w1_ * bflo(ca[1][e_]) + w2_ * bflo(ca[2][e_]); o_[2 * e_ + 1] = w0_ * bfhi(ca[0][e_]) + w1_ * bfhi(ca[1][e_]) + w2_ * bfhi(ca[2][e_]); ssq_ += o_[2 * e_] * o_[2 * e_] + o_[2 * e_ + 1] * o_[2 * e_ + 1]; } \
            const float rs_ = 1.f / sqrtf(wave_sum(ssq_) * (1.f / 512.f) + NORM_EPS); \
            u32x4 w_; w_.x = pk2(o_[0] * rs_, o_[1] * rs_); w_.y = pk2(o_[2] * rs_, o_[3] * rs_); w_.z = pk2(o_[4] * rs_, o_[5] * rs_); w_.w = pk2(o_[6] * rs_, o_[7] * rs_); \
            *(u32x4*)(MIXED + (rw_) * DM + 8 * lane) = w_; } while (0)
        if (crow0 >= 0) RET_CLOAD((size_t)crow0 + 2 * jn);
        __syncthreads();
        const int i_ = 32 * qb + q;
        bf16x8 qr[4];
#pragma unroll
        for (int ks = 0; ks < 4; ++ks) qr[ks] = *(const LAS bf16x8*)(lds + R_Q + i_ * TP + hi * 16 + 32 * ks);
        f32x16 ot;
#pragma unroll
        for (int r = 0; r < 16; ++r) ot[r] = 0.f;
        const LAS unsigned char* vr = lds + R_V + (4 * hi + ((lane & 15) >> 2)) * TP + (32 * dvh + 16 * ((lane >> 4) & 1) + 4 * (lane & 3)) * 2;
#pragma unroll 1
        for (int kb = 0; kb < 4; ++kb) {
            f32x16 st;
#pragma unroll
            for (int r = 0; r < 16; ++r) st[r] = 0.f;
#pragma unroll
            for (int ks = 0; ks < 4; ++ks) st = MFMA32(*(const LAS bf16x8*)(lds + R_K + (32 * kb + q) * TP + hi * 16 + 32 * ks), qr[ks], st);
#pragma unroll
            for (int r = 0; r < 16; ++r) st[r] *= (kb == qb ? (q >= crow(r, hi) ? pf[r] : pb[r]) : kb < qb ? pf[r] : pb[r]);
            if (kb != qb) { const float sc = kb < qb ? exp2f((float)(32 * (qb - kb)) * lgf) : exp2f((float)(32 * (kb - qb)) * lgb);
#pragma unroll
                for (int r = 0; r < 16; ++r) st[r] *= sc; }
            const bf16x8 pb0 = pack8(st, 0), pb1 = pack8(st, 1);
            const LAS unsigned char* v0 = vr + 32 * kb * TP;
            ot = MFMA32(cat44(vtr(v0), vtr(v0 + 8 * TP)), pb0, ot);
            ot = MFMA32(cat44(vtr(v0 + 16 * TP), vtr(v0 + 24 * TP)), pb1, ot);
        }
        {   const float cf = exp2f((float)(i_ + 1) * lgf), cb = exp2f((float)(CHUNK - i_) * lgb);
            f32x16 t;
#pragma unroll
            for (int r = 0; r < 16; ++r) t[r] = 0.f;
#pragma unroll
            for (int ks = 0; ks < 4; ++ks) t = MFMA32(*(const LAS bf16x8*)(lds + R_SF + ((dvh * 4 + ks) * 64 + lane) * 16), qr[ks], t);
#pragma unroll
            for (int r = 0; r < 16; ++r) ot[r] += cf * t[r];
#pragma unroll
            for (int r = 0; r < 16; ++r) t[r] = 0.f;
#pragma unroll
            for (int ks = 0; ks < 4; ++ks) t = MFMA32(*(const LAS bf16x8*)(lds + R_SB + ((dvh * 4 + ks) * 64 + lane) * 16), qr[ks], t);
#pragma unroll
            for (int r = 0; r < 16; ++r) ot[r] += cb * t[r]; }
        if (crow0 >= 0) { RET_CFIN((size_t)crow0 + 2 * jn); RET_CLOAD((size_t)crow0 + 2 * jn + 1); }
        float s1 = 0.f, s2 = 0.f;
#pragma unroll
        for (int r = 0; r < 16; ++r) { s1 += ot[r]; s2 += ot[r] * ot[r]; }
        s1 += __shfl_xor(s1, 32); s2 += __shfl_xor(s2, 32);
        if (hi == 0) *(LAS f32x2*)(lds + R_X + (wave * 32 + q) * 8) = (f32x2){s1, s2};
        __syncthreads();
        { const f32x2 p = *(const LAS f32x2*)(lds + R_X + ((wave ^ 4) * 32 + q) * 8); s1 += p.x; s2 += p.y; }
        const float mean = s1 * (1.f / 64.f), var = fmaxf(s2 * (1.f / 64.f) - mean * mean, 0.f), rstd = 1.f / sqrtf(var + NORM_EPS);
        const LAS unsigned char* gp = lds + R_G + i_ * TP + (32 * dvh + 4 * hi) * 2; LAS unsigned char* op = lds + R_O + i_ * TP + (32 * dvh + 4 * hi) * 2;
#pragma unroll
        for (int g = 0; g < 4; ++g) { const u32x2 gg = *(const LAS u32x2*)(gp + 16 * g); u32x2 w;
            w.x = pk2((ot[4 * g] - mean) * rstd * bflo(gg.x), (ot[4 * g + 1] - mean) * rstd * bfhi(gg.x)); w.y = pk2((ot[4 * g + 2] - mean) * rstd * bflo(gg.y), (ot[4 * g + 3] - mean) * rstd * bfhi(gg.y));
            *(LAS u32x2*)(op + 16 * g) = w; }
        if (crow0 >= 0) RET_CFIN((size_t)crow0 + 2 * jn + 1);
    }
#undef RET_CLOAD
#undef RET_CFIN
    __syncthreads();
    { const size_t row0 = (size_t)b * SEQ + (n0 + 7) * CHUNK;
#pragma unroll
      for (int i = 0; i < 2; ++i) { const int r = 16 * wave + 8 * i + tr; const u32x4 v = *(const LAS u32x4*)(lds + R_O + r * TP + tc * 2);
          *(u32x4*)(MIXED + (row0 + r) * DM + 512 + h * HD + tc) = v; } }
    __syncthreads();
#undef RET_AXPY
#undef RET_PREFETCH
}

template <int NR>
__device__ __forceinline__ void combine_rows(const size_t (&rows)[NR], const bf16* OBR, const float* LSE, bf16* MIXED, int lane) {
    const int hh = lane >> 3;
    float l[NR][3]; u32x4 a[NR][3];
#pragma unroll
    for (int k = 0; k < NR; ++k)
#pragma unroll
        for (int br = 0; br < 3; ++br) { l[k][br] = LSE[((size_t)br * M + rows[k]) * NHEAD + hh]; a[k][br] = *(const u32x4*)(OBR + ((size_t)br * M + rows[k]) * SEGW + 8 * lane); }
#pragma unroll
    for (int k = 0; k < NR; ++k) {
        const float mx = fmaxf(l[k][0], fmaxf(l[k][1], l[k][2])); float w0 = __expf(l[k][0] - mx), w1 = __expf(l[k][1] - mx), w2 = __expf(l[k][2] - mx);
        const float inv = 1.f / (w0 + w1 + w2); w0 *= inv; w1 *= inv; w2 *= inv;
        float o[8]; float ss = 0.f;
#pragma unroll
        for (int e = 0; e < 4; ++e) { o[2 * e] = w0 * bflo(a[k][0][e]) + w1 * bflo(a[k][1][e]) + w2 * bflo(a[k][2][e]); o[2 * e + 1] = w0 * bfhi(a[k][0][e]) + w1 * bfhi(a[k][1][e]) + w2 * bfhi(a[k][2][e]); ss += o[2 * e] * o[2 * e] + o[2 * e + 1] * o[2 * e + 1]; }
        const float rstd = 1.f / sqrtf(wave_sum(ss) * (1.f / 512.f) + NORM_EPS);
        u32x4 w; w.x = pk2(o[0] * rstd, o[1] * rstd); w.y = pk2(o[2] * rstd, o[3] * rstd); w.z = pk2(o[4] * rstd, o[5] * rstd); w.w = pk2(o[6] * rstd, o[7] * rstd);
        *(u32x4*)(MIXED + rows[k] * DM + 8 * lane) = w;
    }
}
constexpr int RP = 528;
constexpr int R5_W = 0, R5_A = 2 * 48 * RP, R5_SC = R5_A + 8 * 16 * RP, R5_CNT = R5_SC + 8 * 3200;
__device__ __forceinline__ void route_wg(int wgt, const bf16* HB, const bf16* WR, const float* bg, const float* be, gu32* ctl, int* LIST, float* GATEL, float* RSL, LAS unsigned char* lds, int tid, int wave, int lane) {
    const size_t row0 = (size_t)wgt * 128;
    LAS unsigned* cntL = (LAS unsigned*)(lds + R5_CNT); LAS unsigned* baseL = cntL + 32;
    if (tid < 32) cntL[tid] = 0u;
    u32x4 pw[6], pa[8];
#define R5_PREF(kc) do { _Pragma("unroll") for (int i_ = 0; i_ < 6; ++i_) { const int idx = tid + 512 * i_; pw[i_] = *(const u32x4*)(WR + (size_t)(idx >> 5) * DM + 256 * (kc) + 8 * (idx & 31)); } \
        _Pragma("unroll") for (int i_ = 0; i_ < 8; ++i_) pa[i_] = *(const u32x4*)(HB + (row0 + 16 * wave + 2 * i_ + (lane >> 5)) * DM + 256 * (kc) + 8 * (lane & 31)); } while (0)
    R5_PREF(0);
    f32x4 acc[3]; float ss = 0.f;
#pragma unroll
    for (int c = 0; c < 3; ++c) acc[c] = (f32x4){0.f, 0.f, 0.f, 0.f};
    const LAS unsigned char* Aw = lds + R5_A + wave * 16 * RP;
#pragma unroll 1
    for (int kc = 0; kc < 4; ++kc) {
        __syncthreads();
#pragma unroll
        for (int i = 0; i < 6; ++i) { const int idx = tid + 512 * i; *(LAS u32x4*)(lds + R5_W + (idx >> 5) * RP + (idx & 31) * 16) = pw[i]; }
#pragma unroll
        for (int i = 0; i < 8; ++i) *(LAS u32x4*)(lds + R5_A + (wave * 16 + 2 * i + (lane >> 5)) * RP + (lane & 31) * 16) = pa[i];
        if (kc < 3) R5_PREF(kc + 1);
        __syncthreads();
#pragma unroll
        for (int ks = 0; ks < 8; ++ks) {
            const int ko = (32 * ks + 8 * (lane >> 4)) * 2;
            const bf16x8 a = *(const LAS bf16x8*)(Aw + (lane & 15) * RP + ko);
            { const u32x4 au = __builtin_bit_cast(u32x4, a);
#pragma unroll
              for (int e = 0; e < 4; ++e) { const float lo = bflo(au[e]), hi_ = bfhi(au[e]); ss += lo * lo + hi_ * hi_; } }
#pragma unroll
            for (int c = 0; c < 3; ++c)
#pragma unroll
                for (int p = 0; p < 2; ++p) { const bf16x8 bb = *(const LAS bf16x8*)(lds + R5_W + (p * 48 + 16 * c + (lane & 15)) * RP + ko);
                    acc[c] = __builtin_amdgcn_mfma_f32_16x16x32_bf16(a, bb, acc[c], 0, 0, 0); }
        }
    }
#undef R5_PREF
    ss += __shfl_xor(ss, 16); ss += __shfl_xor(ss, 32);
    const float rstd = 1.f / sqrtf(ss * (1.f / DM) + NORM_EPS);
    LAS float* sc = (LAS float*)(lds + R5_SC + wave * 3200);
    { const int r = lane & 15, g = lane >> 4;
#pragma unroll
      for (int e = 0; e < 4; ++e) { sc[(4 * g + e) * 48 + r] = acc[0][e]; sc[(4 * g + e) * 48 + 16 + r] = acc[1][e]; sc[(4 * g + e) * 48 + 32 + r] = acc[2][e]; }
      if (g == 0) sc[768 + r] = rstd; }
    LDS_WAIT(); asm volatile("" ::: "memory");
    int e1 = 0, e2 = 0; unsigned r1 = 0, r2 = 0; float g1 = 0.f, g2 = 0.f, rs = 0.f;
    if (lane < 16) {
        rs = sc[768 + lane]; const LAS float* lg = sc + lane * 48;
        float gmax = lg[32] * rs + bg[0]; int gi = 0; float gl[4]; gl[0] = gmax;
#pragma unroll
        for (int k = 1; k < 4; ++k) { gl[k] = lg[32 + k] * rs + bg[k]; if (gl[k] > gmax) { gmax = gl[k]; gi = k; } }
        float den = 0.f;
#pragma unroll
        for (int k = 0; k < 4; ++k) den += __expf(gl[k] - gmax);
        const float ggate = 1.f / den;
        float b1v = -3.0e38f, b2v = -3.0e38f; int i1 = 0, i2 = 0;
        for (int k = 0; k < 8; ++k) { const float v = lg[gi * 8 + k] * rs + be[gi * 8 + k]; if (v > b1v) { b1v = v; i1 = k; } }
        for (int k = 0; k < 8; ++k) { const float v = lg[gi * 8 + k] * rs + be[gi * 8 + k]; if (k != i1 && v > b2v) { b2v = v; i2 = k; } }
        const float p1 = 1.f / (1.f + __expf(b2v - b1v));
        g1 = ggate * p1; g2 = ggate * (1.f - p1); e1 = gi * 8 + i1; e2 = gi * 8 + i2;
        r1 = __hip_atomic_fetch_add(cntL + e1, 1u, __ATOMIC_RELAXED, __HIP_MEMORY_SCOPE_WORKGROUP); r2 = __hip_atomic_fetch_add(cntL + e2, 1u, __ATOMIC_RELAXED, __HIP_MEMORY_SCOPE_WORKGROUP);
    }
    __syncthreads();
    if (tid < 32) { const unsigned c = cntL[tid]; baseL[tid] = c ? __hip_atomic_fetch_add(ctl + CW_CNT + 64 * tid, c, RLX_AGENT) : 0u; }
    __syncthreads();
    if (lane < 16) {
        const size_t trow = row0 + 16 * wave + lane; const size_t s1 = (size_t)e1 * M + baseL[e1] + r1, s2 = (size_t)e2 * M + baseL[e2] + r2;
        LIST[s1] = (int)(trow * 2); GATEL[s1] = g1; RSL[s1] = rs;
        LIST[s2] = (int)(trow * 2 + 1); GATEL[s2] = g2; RSL[s2] = rs;
    }
    __syncthreads();
}
template <int NR>
__device__ __forceinline__ void final_rows(const size_t (&rows)[NR], const bf16* H, const bf16* Y, const f32x4 (&gv)[4], float* out, int lane) {
    u32x2 hv[NR][4], a[NR][4], b[NR][4];
#pragma unroll
    for (int k = 0; k < NR; ++k) { const u32x2* hp = (const u32x2*)(H + rows[k] * DM) + lane; const u32x2* y0 = (const u32x2*)(Y + (rows[k] * 2) * DM) + lane; const u32x2* y1 = (const u32x2*)(Y + (rows[k] * 2 + 1) * DM) + lane;
#pragma unroll
        for (int j = 0; j < 4; ++j) { hv[k][j] = __builtin_nontemporal_load(hp + 64 * j); a[k][j] = __builtin_nontemporal_load(y0 + 64 * j); b[k][j] = __builtin_nontemporal_load(y1 + 64 * j); } }
#pragma unroll
    for (int k = 0; k < NR; ++k) { f32x4 z[4]; float ss = 0.f;
#pragma unroll
        for (int j = 0; j < 4; ++j) {
            z[j][0] = bflo(hv[k][j].x) + bflo(a[k][j].x) + bflo(b[k][j].x); z[j][1] = bfhi(hv[k][j].x) + bfhi(a[k][j].x) + bfhi(b[k][j].x); z[j][2] = bflo(hv[k][j].y) + bflo(a[k][j].y) + bflo(b[k][j].y); z[j][3] = bfhi(hv[k][j].y) + bfhi(a[k][j].y) + bfhi(b[k][j].y);
            ss += (z[j][0] * z[j][0] + z[j][1] * z[j][1]) + (z[j][2] * z[j][2] + z[j][3] * z[j][3]); }
        const float rstd = 1.f / sqrtf(wave_sum(ss) * (1.f / DM) + NORM_EPS);
        f32x4* op = (f32x4*)(out + rows[k] * DM) + lane;
#pragma unroll
        for (int j = 0; j < 4; ++j) __builtin_nontemporal_store(z[j] * rstd * gv[j], op + 64 * j); }
}
__device__ __forceinline__ TileTab build_tiles(Frame& F, int& ntiles) {
    LAS int* T = (LAS int*)(F.lds + TILE_OFF); LAS int* TE = T; LAS int* NE = T + MAXTILES; LAS int* T0 = NE + 32; LAS int* NT = T0 + 32;
    __syncthreads();
    if (F.tid == 0) { int t = 0;
        for (int e = 0; e < NEXP; ++e) { int n = (int)__hip_atomic_load(F.ctl + CW_CNT + 64 * e, RLX_AGENT); if (n > M) n = M; NE[e] = n; T0[e] = t; const int k = (n + 255) >> 8;
            for (int j = 0; j < k && t + j < MAXTILES; ++j) TE[t + j] = e; t += k; if (t > MAXTILES) t = MAXTILES; }
        NT[0] = t; }
    __syncthreads();
    ntiles = NT[0];
    TileTab tt; tt.TE = TE; tt.NE = NE; tt.T0 = T0; return tt;
}

__device__ __forceinline__ int fresh_lane() { int t = threadIdx.x; asm volatile("" : "+v"(t)); return t & 63; }
constexpr int N_LAUNCHES = MK_N_LAUNCHES, PER_PHASE = 9;
__global__ void __launch_bounds__(NWAVES * 64, 2) mk_fwd(Args args) {
    extern __shared__ __attribute__((aligned(16))) unsigned char lds_raw[];
    Frame F;
    F.lds = (LAS unsigned char*)lds_raw;
    F.MISC = (volatile LAS unsigned*)(F.lds + MISC_OFF);
    F.tid = threadIdx.x; F.lane = F.tid & 63; F.wave = __builtin_amdgcn_readfirstlane(F.tid >> 6);
    F.G = gridDim.x; { const int bx = blockIdx.x; F.vcu = (F.G % 8 == 0) ? (bx % 8) * (F.G / 8) + bx / 8 : bx; }
    unsigned char* ws = args.ws;
    F.ctl = (gu32*)(ws + WS_CTL);
    for (int u = F.tid; u < (LDS_BYTES - LDSCTL_OFF) / 4; u += NWAVES * 64) ((LAS unsigned*)(F.lds + LDSCTL_OFF))[u] = 0u;
    __syncthreads();
    XcdBarrier bar; bar.bar = (unsigned*)(F.ctl + CW_BAR); bar.x = 0; bar.st = nullptr;
    if (N_LAUNCHES != PER_PHASE) bar = xcd_barrier_post((unsigned*)(F.ctl + CW_BAR) + args.li * XCD_BAR_WORDS, F.MISC + 8);
#define GRID_BAR() do { if (N_LAUNCHES != PER_PHASE) xcd_barrier(bar); } while (0)
    const int lo = args.ph_lo, hi = args.ph_hi;
#define IN(k) (lo <= (k) && (k) < hi)
#define REPS(k) ((MK_REPEAT == (k)) ? MK_NREP : 1)
#define BOTH(k) (IN(k) && IN((k) + 1))
    const int gw = F.vcu * NWAVES + F.wave, NGW = F.G * NWAVES;
#if MK_TIME
    int n_stamp = 0;
#define STAMP() do { if (blockIdx.x == 0 && F.tid == 0) { const unsigned long long t_ = __builtin_amdgcn_s_memrealtime(); __hip_atomic_store(F.ctl + CW_TS + 2 * n_stamp, (unsigned)t_, RLX_AGENT); __hip_atomic_store(F.ctl + CW_TS + 2 * n_stamp + 1, (unsigned)(t_ >> 32), RLX_AGENT); } ++n_stamp; } while (0)
    STAMP();
#else
#define STAMP() do {} while (0)
#endif
    bf16* SEGB = (bf16*)(ws + WS_SEG);
    const bf16 *QA = SEGB, *KA = SEGB + (size_t)1 * M * SEGW, *VA = SEGB + (size_t)2 * M * SEGW, *QR = SEGB + (size_t)3 * M * SEGW, *KR = SEGB + (size_t)4 * M * SEGW, *VR = SEGB + (size_t)5 * M * SEGW, *GR = SEGB + (size_t)6 * M * SEGW;

    for (int rep_ = 0; rep_ < REPS(0); ++rep_) if (IN(0)) { p0_prologue(F, args); if (BOTH(0)) GRID_BAR(); STAMP(); }
    for (int rep_ = 0; rep_ < REPS(1); ++rep_) if (IN(1)) {
        const int bx = (int)blockIdx.x, rowg = bx >> 3; const bool split = (F.G == 256), conv = split && ((rowg & 7) == 7);
        if (conv) {
            expert_items(args, ws, (LAS float*)(F.lds + F.wave * 16384), 0, N_CONV_P1, (((rowg >> 3) << 3) + (bx & 7)) * NWAVES + F.wave, 32 * NWAVES, fresh_lane());
        } else {
            pg8::StaticOrder S; if (split) S.init(M / 256, NIN / 256, 224, (rowg - ((rowg + 1) >> 3)) * 8 + (bx & 7)); else S.init(M / 256, NIN / 256, F.G, bx);
            SrcPlain SRC{(const bf16*)(ws + WS_XN), (const bf16*)(ws + WS_WIN), DM};
            EpiInProj E{SEGB, (const float*)(ws + WS_ROPE), (const float*)(ws + WS_ROPE) + SEQ * 40};
            pg8::gemm_phase<EpiInProj, pg8::StaticOrder, SrcPlain, true, true>(F.lds, DM, S, SRC, E);
        }
        if (BOTH(1)) GRID_BAR(); STAMP();
    }
    for (int rep_ = 0; rep_ < REPS(2); ++rep_) if (IN(2)) {
        bf16* OBR = (bf16*)(ws + WS_OBR); float* LSE = (float*)(ws + WS_LSE); bf16* KVB = (bf16*)(ws + WS_ST);
        for (int cid = gw; cid < NBATCH * NHEAD * NCHUNK; cid += NGW) kv_task(cid, KR, VR, KVB, args.in[4], args.in[5], F.lds + F.wave * 16384, fresh_lane());
        { const int nrt = NBATCH * NHEAD * 48, per = (nrt + F.G - 1) / F.G, r0 = F.vcu * per, nr = r0 + per <= nrt ? per : (nrt > r0 ? nrt - r0 : 0);
          __syncthreads();
          if (F.G == 256) attn_rounds((F.vcu >> 5) * 8, F.vcu & 31, 12, QA, KA, VA, OBR, LSE, F.lds, F.wave, fresh_lane());
          else if (nr > 0) attn_rounds(r0, -1, nr, QA, KA, VA, OBR, LSE, F.lds, F.wave, fresh_lane()); }
        if (BOTH(2)) GRID_BAR(); STAMP();
    }
    for (int rep_ = 0; rep_ < REPS(3); ++rep_) if (IN(3)) {
        bf16* MIXED = (bf16*)(ws + WS_MIXED);
        const bool fold = (F.G == 256);
        for (int wgt = F.vcu; wgt < NBATCH * NHEAD * 4; wgt += F.G) { int t_ = threadIdx.x; asm volatile("" : "+v"(t_));
            ret_wg(wgt, QR, KR, VR, GR, (const bf16*)(ws + WS_ST), (bf16*)(ws + WS_SBW), MIXED, args.in[4], args.in[5], (const bf16*)(ws + WS_OBR), (const float*)(ws + WS_LSE),
                   fold ? (long)wgt * 128 + F.wave * 16 : -1L, F.lds, t_, F.wave, t_ & 63); }
        if (!fold) { const int ln = fresh_lane();
          for (int row = gw; row < M; row += 4 * NGW) { const size_t rows[4] = {(size_t)row, (size_t)(row + NGW), (size_t)(row + 2 * NGW), (size_t)(row + 3 * NGW)};
              combine_rows<4>(rows, (const bf16*)(ws + WS_OBR), (const float*)(ws + WS_LSE), MIXED, ln); } }
        if (BOTH(3)) GRID_BAR(); STAMP();
    }
    for (int rep_ = 0; rep_ < REPS(4); ++rep_) if (IN(4)) {
        pg8::StaticOrder S; S.init(M / 256, DM / 256, F.G, (int)blockIdx.x);
        SrcPlain SRC{(const bf16*)(ws + WS_MIXED), (const bf16*)(ws + WS_WOUT), DM};
        EpiOutProj E{args.in[0], (bf16*)(ws + WS_HG)};
        pg8::gemm_phase<EpiOutProj, pg8::StaticOrder, SrcPlain, true, true>(F.lds, DM, S, SRC, E);
        if (BOTH(4)) GRID_BAR(); STAMP();
    }
    for (int rep_ = 0; rep_ < REPS(5); ++rep_) if (IN(5)) {
        if (rep_ > 0) { if (blockIdx.x == 0 && F.tid < NEXP) __hip_atomic_store(F.ctl + CW_CNT + 64 * F.tid, 0u, RLX_AGENT); GRID_BAR(); }
        for (int wgt = F.vcu; wgt < M / 128; wgt += F.G) { int t_ = threadIdx.x; asm volatile("" : "+v"(t_));
            route_wg(wgt, (const bf16*)(ws + WS_HG), (const bf16*)(ws + WS_WRT), args.in[10], args.in[12], F.ctl, (int*)(ws + WS_LIST), (float*)(ws + WS_GATEL), (float*)(ws + WS_RSL), F.lds, t_, F.wave, t_ & 63); }
        if (BOTH(5)) GRID_BAR(); STAMP();
    }
    for (int rep_ = 0; rep_ < REPS(6); ++rep_) if (IN(6)) {
        int ntiles; const TileTab tt = build_tiles(F, ntiles);
        pg8::StaticOrder S; S.init(ntiles, 4, F.G, (int)blockIdx.x);
        SrcGather SRC{(const bf16*)(ws + WS_HG), (const bf16*)(ws + WS_WGU), (const int*)(ws + WS_LIST), tt};
        EpiGateUp E{(bf16*)(ws + WS_HID), (const float*)(ws + WS_GATEL), (const float*)(ws + WS_RSL), tt};
        pg8::gemm_phase<EpiGateUp, pg8::StaticOrder, SrcGather, true, true>(F.lds, DM, S, SRC, E);
        if (BOTH(6)) GRID_BAR(); STAMP();
    }
    for (int rep_ = 0; rep_ < REPS(7); ++rep_) if (IN(7)) {
        int ntiles; const TileTab tt = build_tiles(F, ntiles);
        pg8::StaticOrder S; S.init(ntiles, 4, F.G, (int)blockIdx.x);
        SrcDown SRC{(const bf16*)(ws + WS_HID), (const bf16*)(ws + WS_WD), tt};
        EpiDown E{(bf16*)(ws + WS_Y), (const int*)(ws + WS_LIST), tt};
        pg8::gemm_phase<EpiDown, pg8::StaticOrder, SrcDown, true, true>(F.lds, FF, S, SRC, E);
        if (BOTH(7)) GRID_BAR(); STAMP();
    }
    for (int rep_ = 0; rep_ < REPS(8); ++rep_) if (IN(8)) {
        f32x4 gv[4];
#pragma unroll
        for (int j = 0; j < 4; ++j) gv[j] = ((const f32x4*)args.in[16])[fresh_lane() + 64 * j];
        { const int ln = fresh_lane();
          for (int row = gw; row < M; row += 2 * NGW) { const size_t rows[2] = {(size_t)row, (size_t)(row + NGW)}; final_rows<2>(rows, (const bf16*)(ws + WS_HG), (const bf16*)(ws + WS_Y), gv, args.out, ln); } }
#if MK_TIME
        STAMP();
        if (blockIdx.x == 0 && F.tid == 0) {
            unsigned long long ts[10];
#pragma unroll
            for (int k = 0; k < 10; ++k) ts[k] = (unsigned long long)__hip_atomic_load(F.ctl + CW_TS + 2 * k, RLX_AGENT) | ((unsigned long long)__hip_atomic_load(F.ctl + CW_TS + 2 * k + 1, RLX_AGENT) << 32);
            const float t = MK_TIME == 10 ? (float)(ts[9] - ts[0]) * 0.01f : (float)(ts[MK_TIME] - ts[MK_TIME - 1]) * 0.01f;
            VM_WAIT(); args.out[0] = t * MK_TSCALE; }
#endif
    }
#undef IN
#undef BOTH
#undef GRID_BAR
}

#if MK_CHECK
__device__ __forceinline__ unsigned hsh(unsigned x) { x ^= x >> 16; x *= 0x7feb352dU; x ^= x >> 15; x *= 0x846ca68bU; x ^= x >> 16; return x; }
__device__ __forceinline__ float ldb(const bf16* p, size_t i) { return __uint_as_float(((unsigned)p[i]) << 16); }
__device__ __forceinline__ float rbf(float x) { return bflo(pk2(x, 0.f) & 0xffffu); }
__device__ __forceinline__ void chk_put(gu32* ctl, int stage, float got, float ref, float atol) {
    float e = fabsf(got - ref) / (0.03f * fabsf(ref) + atol); if (!(e == e)) e = 1e30f; if (e > 1e30f) e = 1e30f;
    __hip_atomic_fetch_max(ctl + CW_CHK + stage, __float_as_uint(e), RLX_AGENT);
}
__global__ void __launch_bounds__(256) chk_kernel(Args A, int stage) {
    unsigned char* ws = A.ws; gu32* ctl = (gu32*)(ws + WS_CTL);
    const int gt = blockIdx.x * 256 + threadIdx.x, NT = gridDim.x * 256;
    const bf16* SEGB = (const bf16*)(ws + WS_SEG);
    const bf16 *QA = SEGB, *KA = SEGB + (size_t)1 * M * SEGW, *VA = SEGB + (size_t)2 * M * SEGW, *QR = SEGB + (size_t)3 * M * SEGW, *KR = SEGB + (size_t)4 * M * SEGW, *VR = SEGB + (size_t)5 * M * SEGW, *GR = SEGB + (size_t)6 * M * SEGW;
    if (stage == 0) {
        const bf16* WIN = (const bf16*)(ws + WS_WIN); const bf16* WOUT = (const bf16*)(ws + WS_WOUT); const bf16* WGU = (const bf16*)(ws + WS_WGU); const bf16* WD = (const bf16*)(ws + WS_WD);
        for (int s = gt; s < 65536; s += NT) { const unsigned r = hsh(s * 7 + 1), r2 = hsh(r);
            { const int n = r % NIN, k = r2 % DM; chk_put(ctl, 0, ldb(WIN, (size_t)winperm(n) * DM + k), A.in[2][(size_t)k * NIN + n], 1e-4f); }
            { const int n = r % DM, k = r2 % DM; chk_put(ctl, 0, ldb(WOUT, (size_t)n * DM + k), A.in[7][(size_t)k * DM + n] * (k < 512 ? A.in[3][k] : A.in[6][k - 512]), 1e-4f); }
            { const int e = (r >> 10) % NEXP, j = r % FF, k = r2 % DM;
              chk_put(ctl, 0, ldb(WGU, ((size_t)e * DM + ((j >> 7) << 8) + (j & 127)) * DM + k), A.in[13][((size_t)e * DM + k) * FF + j] * A.in[8][k], 1e-4f);
              chk_put(ctl, 0, ldb(WGU, ((size_t)e * DM + ((j >> 7) << 8) + 128 + (j & 127)) * DM + k), A.in[14][((size_t)e * DM + k) * FF + j] * A.in[8][k], 1e-4f); }
            { const int e = (r >> 10) % NEXP, n = r % DM, k = r2 % FF; chk_put(ctl, 0, ldb(WD, ((size_t)e * DM + n) * FF + k), A.in[15][((size_t)e * FF + k) * DM + n], 1e-4f); }
            { const int j = r % 36, i = r2 % DM; const float ref = (j < 32 ? A.in[11][i * 32 + j] : A.in[9][i * 4 + j - 32]) * A.in[8][i]; chk_put(ctl, 0, 1000.f * (ldb((const bf16*)(ws + WS_WRT), j * DM + i) + ldb((const bf16*)(ws + WS_WRT), (48 + j) * DM + i)), 1000.f * ref, 1e-3f); }
            { const int pos = r % SEQ, f = r2 % 40; const float fr = f < 8 ? powf(500000.f, -(float)f / 8.f) : powf(10000.f, -(float)(f - 8) / 31.f); const float ang = (float)pos * fr;
              chk_put(ctl, 0, ((const float*)(ws + WS_ROPE))[pos * 40 + f], cosf(ang), 2e-3f); chk_put(ctl, 0, ((const float*)(ws + WS_ROPE))[SEQ * 40 + pos * 40 + f], sinf(ang), 2e-3f); }
        }
        for (int s = gt; s < 2048; s += NT) { const unsigned r = hsh(s * 13 + 5); const int row = r % M, c = hsh(r) % DM; const float* x = A.in[0] + (size_t)row * DM; float ss = 0.f;
            for (int k = 0; k < DM; ++k) ss += x[k] * x[k];
            chk_put(ctl, 0, ldb((const bf16*)(ws + WS_XN), (size_t)row * DM + c), x[c] / sqrtf(ss / DM + NORM_EPS) * A.in[1][c], 1e-3f); }
    }
    if (stage == 1) {
        const bf16* XN = (const bf16*)(ws + WS_XN);
        for (int s = gt; s < 8192; s += NT) { const unsigned r = hsh(s * 3 + 11), r2 = hsh(r); const int row = r % M, seg = r2 % 7, hh = (r2 >> 4) % 8, pos = row & (SEQ - 1);
            const int half = (seg == 0 || seg == 1) ? 8 : 32; const int i = (r2 >> 8) % half; const int d1 = i, d2 = i + half;
            float a1 = 0.f, a2 = 0.f; const float* w = A.in[2] + seg * 512 + hh * 64;
            for (int k = 0; k < DM; ++k) { const float xv = ldb(XN, (size_t)row * DM + k); a1 += xv * rbf(w[(size_t)k * NIN + d1]); a2 += xv * rbf(w[(size_t)k * NIN + d2]); }
            const bf16* O = SEGB + (size_t)seg * M * SEGW + (size_t)row * SEGW + hh * 64;
            if (seg == 0 || seg == 1 || seg == 3 || seg == 4) {
                const float fr = seg < 2 ? powf(500000.f, -(float)i / 8.f) : powf(10000.f, -(float)i / 31.f); const float ang = (float)pos * fr, c = cosf(ang), sn = sinf(ang);
                const float sc = seg == 0 ? 0.125f * LOG2E : (seg == 4 ? 0.125f : 1.f);
                chk_put(ctl, 1, ldb(O, 2 * i), (a1 * c - a2 * sn) * sc, 0.02f); chk_put(ctl, 1, ldb(O, 2 * i + 1), (a2 * c + a1 * sn) * sc, 0.02f);
                if (seg < 2) { const int d3 = 16 + (r2 >> 12) % 48; float a3 = 0.f; for (int k = 0; k < DM; ++k) a3 += ldb(XN, (size_t)row * DM + k) * rbf(w[(size_t)k * NIN + d3]); chk_put(ctl, 1, ldb(O, d3), a3 * sc, 0.02f); }
            } else { chk_put(ctl, 1, ldb(O, d1), seg == 6 ? silu_f(a1) : a1, 0.02f); chk_put(ctl, 1, ldb(O, d2), seg == 6 ? silu_f(a2) : a2, 0.02f); }
        }
    }
    if (stage == 2) {
        const bf16* OBR = (const bf16*)(ws + WS_OBR); const float* LSE = (const float*)(ws + WS_LSE); const bf16* ST = (const bf16*)(ws + WS_ST);
        for (int s = gt; s < 4096; s += NT) { const unsigned r = hsh(s * 5 + 3), r2 = hsh(r); const int b = r % NBATCH, pos = (s < 256) ? (s & 1 ? SEQ - 1 - (s >> 1) % 80 : (s >> 1) % 80) : (r >> 3) % SEQ, h = r2 % NHEAD, br = (r2 >> 3) % 3, dd = (r2 >> 8) % HD;
            const int dil = 1 << (2 * br); const size_t row = (size_t)b * SEQ + pos;
            float mx = -1e30f;
            for (int pass = 0; pass < 2; ++pass) { float l = 0.f, o = 0.f;
                for (int j = -64; j <= 64; ++j) { const int kp = pos + j * dil; if (kp < 0 || kp >= SEQ) continue; const size_t kr = (size_t)b * SEQ + kp; float d = 0.f;
                    for (int k = 0; k < HD; ++k) d += ldb(QA, row * SEGW + h * HD + k) * ldb(KA, kr * SEGW + h * HD + k);
                    if (pass == 0) mx = fmaxf(mx, d); else { const float p = exp2f(d - mx); l += p; o += p * ldb(VA, kr * SEGW + h * HD + dd); } }
                if (pass == 1) { chk_put(ctl, 2, ldb(OBR, ((size_t)br * M + row) * SEGW + h * HD + dd), o / l, 0.02f); chk_put(ctl, 2, LSE[((size_t)br * M + row) * NHEAD + h], (mx + log2f(l)) * LN2, 0.02f); } }
        }
        for (int s = gt; s < 8192; s += NT) { const unsigned r = hsh(s * 9 + 7), r2 = hsh(r); const int bh = r % 64, dir = (r >> 6) & 1, n = (r >> 7) % NCHUNK, dv = r2 % 64, dk = (r2 >> 6) % 64, b = bh >> 3, h = bh & 7;
            const float lg2 = log1pf(-exp2f((dir ? A.in[5] : A.in[4])[h])) * LOG2E; float S = 0.f;
            for (int j = 0; j < CHUNK; ++j) { const size_t row = (size_t)b * SEQ + n * CHUNK + j; const float ex = dir == 0 ? (float)(127 - j) : (float)j;
                S += exp2f(ex * lg2) * ldb(KR, row * SEGW + h * HD + dk) * ldb(VR, row * SEGW + h * HD + dv); }
            chk_put(ctl, 2, ldb(ST, (((size_t)bh * NCHUNK + n) * 2 + dir) * 4096 + ((size_t)((dv >> 5) * 4 + (dk >> 4)) * 64 + (dv & 31) + 32 * ((dk >> 3) & 1)) * 8 + (dk & 7)), S, 0.05f);
        }
    }
    if (stage == 3) {
        const bf16* MIXED = (const bf16*)(ws + WS_MIXED);
        for (int s = gt; s < 512; s += NT) { const unsigned r = hsh(s * 17 + 9), r2 = hsh(r); const int b = r % NBATCH, pos = (s < 64) ? (s & 1 ? SEQ - 1 - (s >> 1) * 5 : (s >> 1) * 5) : (r >> 3) % SEQ, h = r2 % NHEAD; const size_t row = (size_t)b * SEQ + pos;
            const float lgf = log1pf(-exp2f(A.in[4][h])) * LOG2E, lgb = log1pf(-exp2f(A.in[5][h])) * LOG2E;
            float o[HD], qv[HD];
#pragma unroll
            for (int k = 0; k < HD; ++k) { o[k] = 0.f; qv[k] = ldb(QR, row * SEGW + h * HD + k); }
            for (int kp = 0; kp < SEQ; ++kp) { const size_t kr = (size_t)b * SEQ + kp; const int dl = pos - kp; const float w = dl >= 0 ? exp2f((float)dl * lgf) : exp2f((float)(-dl) * lgb); if (w < 1e-12f) continue; float d = 0.f;
#pragma unroll
                for (int k = 0; k < HD; ++k) d += qv[k] * ldb(KR, kr * SEGW + h * HD + k);
                d *= w;
#pragma unroll
                for (int k = 0; k < HD; ++k) o[k] += d * ldb(VR, kr * SEGW + h * HD + k); }
            float mean = 0.f, var = 0.f;
#pragma unroll
            for (int k = 0; k < HD; ++k) mean += o[k];
            mean *= (1.f / HD);
#pragma unroll
            for (int k = 0; k < HD; ++k) var += (o[k] - mean) * (o[k] - mean);
            var *= (1.f / HD); const float rstd = 1.f / sqrtf(var + NORM_EPS);
#pragma unroll
            for (int k = 0; k < HD; ++k) if ((k & 7) == (int)(r2 >> 8) % 8) chk_put(ctl, 3, ldb(MIXED, row * DM + 512 + h * HD + k), (o[k] - mean) * rstd * ldb(GR, row * SEGW + h * HD + k), 0.03f);
        }
        {
            const bf16* OBR = (const bf16*)(ws + WS_OBR); const float* LSE = (const float*)(ws + WS_LSE);
            for (int s = gt; s < 4096; s += NT) { const unsigned r = hsh(s * 19 + 1), r2 = hsh(r); const int row = r % M, csel = r2 % 512; float ss = 0.f, osel = 0.f;
                for (int c = 0; c < 512; ++c) { const int h = c >> 6; const float l0 = LSE[((size_t)0 * M + row) * NHEAD + h], l1 = LSE[((size_t)1 * M + row) * NHEAD + h], l2 = LSE[((size_t)2 * M + row) * NHEAD + h];
                    const float mx = fmaxf(l0, fmaxf(l1, l2)), w0 = expf(l0 - mx), w1 = expf(l1 - mx), w2 = expf(l2 - mx);
                    const float o = (w0 * ldb(OBR, ((size_t)0 * M + row) * SEGW + c) + w1 * ldb(OBR, ((size_t)1 * M + row) * SEGW + c) + w2 * ldb(OBR, ((size_t)2 * M + row) * SEGW + c)) / (w0 + w1 + w2);
                    ss += o * o; if (c == csel) osel = o; }
                chk_put(ctl, 3, ldb(MIXED, (size_t)row * DM + csel), osel / sqrtf(ss / 512.f + NORM_EPS), 0.03f); }
        }
    }
    if (stage == 4) {
        const bf16* MIXED = (const bf16*)(ws + WS_MIXED); const bf16* WOUT = (const bf16*)(ws + WS_WOUT); const float* H = (const float*)(ws + WS_H); const bf16* HG = (const bf16*)(ws + WS_HG);
        for (int s = gt; s < 16384; s += NT) { const unsigned r = hsh(s * 23 + 3); const int row = r % M, c = hsh(r) % DM; float a = 0.f;
            for (int k = 0; k < DM; ++k) a += ldb(MIXED, (size_t)row * DM + k) * ldb(WOUT, (size_t)c * DM + k);
            const float h = a + A.in[0][(size_t)row * DM + c]; chk_put(ctl, 4, ldb(HG, (size_t)row * DM + c), h, 0.02f); (void)H; }
    }
    if (stage == 5) {
        const float* H = (const float*)(ws + WS_H); const int* LIST = (const int*)(ws + WS_LIST); const float* GATEL = (const float*)(ws + WS_GATEL); const float* RSL = (const float*)(ws + WS_RSL);
        if (gt == 0) { unsigned tot = 0; for (int e = 0; e < NEXP; ++e) tot += ctl[CW_CNT + 64 * e]; chk_put(ctl, 5, (float)tot, (float)(2 * M), 0.5f); }
        const bf16* HBc = (const bf16*)(ws + WS_HG); (void)H;
        for (int s = gt; s < 2048; s += NT) { const int t = hsh(s * 29 + 5) % M; const bf16* h_ = HBc + (size_t)t * DM; float ss = 0.f;
#define h_AT(k) ldb(h_, (k))
            for (int k = 0; k < DM; ++k) ss += h_AT(k) * h_AT(k);
            const float rs = 1.f / sqrtf(ss / DM + NORM_EPS); float gl[4]; int gi = 0;
            for (int g = 0; g < 4; ++g) { float a = 0.f; for (int k = 0; k < DM; ++k) a += h_AT(k) * rs * A.in[8][k] * A.in[9][k * 4 + g]; gl[g] = a + A.in[10][g]; if (gl[g] > gl[gi]) gi = g; }
            float den = 0.f; for (int g = 0; g < 4; ++g) den += expf(gl[g] - gl[gi]);
            float b1 = -3e38f, b2 = -3e38f, b3 = -3e38f; int i1 = 0, i2 = 0;
            for (int e = 0; e < 8; ++e) { float a = 0.f; for (int k = 0; k < DM; ++k) a += h_AT(k) * rs * A.in[8][k] * A.in[11][k * 32 + gi * 8 + e]; a += A.in[12][gi * 8 + e];
                if (a > b1) { b3 = b2; b2 = b1; i2 = i1; b1 = a; i1 = e; } else if (a > b2) { b3 = b2; b2 = a; i2 = e; } else if (a > b3) b3 = a; }
            float second = -3e38f; for (int g = 0; g < 4; ++g) if (g != gi) second = fmaxf(second, gl[g]);
            if (gl[gi] - second < 1e-3f || b2 - b3 < 1e-3f || b1 - b2 < 1e-3f) continue;
            const float p1 = 1.f / (1.f + expf(b2 - b1)); const float g1 = p1 / den, g2 = (1.f - p1) / den;
            for (int k = 0; k < 2; ++k) { const int e = gi * 8 + (k ? i2 : i1); const int n = (int)ctl[CW_CNT + 64 * e]; int found = -1;
                for (int p = 0; p < n && p < M; ++p) if (LIST[(size_t)e * M + p] == t * 2 + k) { found = p; break; }
                if (found < 0) chk_put(ctl, 5, 0.f, 100.f, 0.1f); else { chk_put(ctl, 5, GATEL[(size_t)e * M + found], k ? g2 : g1, 1e-3f); chk_put(ctl, 5, RSL[(size_t)e * M + found], rs, 1e-4f); } }
        }
    }
    if (stage == 6 || stage == 7) {
        const int* LIST = (const int*)(ws + WS_LIST); const float* GATEL = (const float*)(ws + WS_GATEL); const float* RSL = (const float*)(ws + WS_RSL);
        const bf16* HG = (const bf16*)(ws + WS_HG); const bf16* WGU = (const bf16*)(ws + WS_WGU); const bf16* HID = (const bf16*)(ws + WS_HID); const bf16* WD = (const bf16*)(ws + WS_WD); const bf16* Y = (const bf16*)(ws + WS_Y);
        for (int s = gt; s < 8192; s += NT) { const unsigned r = hsh(s * 31 + 7), r2 = hsh(r); const int e = r % NEXP; const int ne = (int)ctl[CW_CNT + 64 * e]; if (ne <= 0) continue;
            int t0 = 0; for (int q = 0; q < e; ++q) t0 += ((int)ctl[CW_CNT + 64 * q] + 255) >> 8;
            const int pos = (s & 3) == 0 ? ne - 1 - (int)((r >> 5) % (ne < 300 ? ne : 300)) : (int)((r >> 5) % ne); const size_t slot = (size_t)t0 * 256 + pos; const int tk = LIST[(size_t)e * M + pos], t = tk >> 1;
            if (stage == 6) { const int j = r2 % FF; float g = 0.f, u = 0.f; const bf16* wg = WGU + ((size_t)e * DM + ((j >> 7) << 8) + (j & 127)) * DM; const bf16* wu = wg + (size_t)128 * DM;
                for (int k = 0; k < DM; ++k) { const float xv = ldb(HG, (size_t)t * DM + k); g += xv * ldb(wg, k); u += xv * ldb(wu, k); }
                const float rs = RSL[(size_t)e * M + pos]; chk_put(ctl, 6, ldb(HID, slot * FF + j), silu_f(g * rs) * (u * rs) * GATEL[(size_t)e * M + pos], 0.01f); }
            else { const int c = r2 % DM; float a = 0.f; for (int k = 0; k < FF; ++k) a += ldb(HID, slot * FF + k) * ldb(WD, ((size_t)e * DM + c) * FF + k);
                chk_put(ctl, 7, ldb(Y, (size_t)tk * DM + c), a, 0.01f); }
        }
    }
    if (stage == 8) {
        const float* H = (const float*)(ws + WS_H); const bf16* Y = (const bf16*)(ws + WS_Y);
        for (int s = gt; s < 4096; s += NT) { const unsigned r = hsh(s * 37 + 1); const int row = r % M, c = hsh(r) % DM; float ss = 0.f, zc = 0.f;
            for (int k = 0; k < DM; ++k) { const float z = ldb((const bf16*)(ws + WS_HG), (size_t)row * DM + k) + ldb(Y, (size_t)(2 * row) * DM + k) + ldb(Y, (size_t)(2 * row + 1) * DM + k); (void)H; ss += z * z; if (k == c) zc = z; }
            chk_put(ctl, 8, A.out[(size_t)row * DM + c], zc / sqrtf(ss / DM + NORM_EPS) * A.in[16][c], 0.01f); }
    }
}
__global__ void __launch_bounds__(256) chk_final(Args A) {
    gu32* ctl = (gu32*)(A.ws + WS_CTL); int bad = -1; float err = 0.f;
    for (int s = 0; s < 9; ++s) { const float e = __uint_as_float(ctl[CW_CHK + s]); if (e > 1.f) { bad = s; err = e; break; } }
    if (bad < 0 && ctl[CW_BAR + XB_TMO] != 0u) { bad = 10; err = 1.f; }
    if (bad < 0) return;
    float mant = 1.f + log10f(err); if (mant > 9.9f) mant = 9.9f; if (mant < 1.f) mant = 1.f;
    const float C = sqrtf(mant * powf(10.f, (float)(bad + 3)));
    for (size_t i = blockIdx.x * 256 + threadIdx.x; i < (size_t)M * DM; i += (size_t)gridDim.x * 256) A.out[i] = C;
}
#endif

extern "C" void kernel_launch(void* const* d_in, const int* in_sizes, int n_in, void* d_out, int out_size, void* d_ws, size_t ws_size, hipStream_t stream) {
    static int grid = 0;
    if (grid == 0) {
        if (n_in != 17 || in_sizes[0] != M * DM || out_size != M * DM || ws_size < WS_END) { fprintf(stderr, "kernel_launch: unexpected shapes (n_in %d, in0 %d, out %d, ws %zu); nothing launched\n", n_in, n_in > 0 ? in_sizes[0] : -1, out_size, ws_size); grid = -1; return; }
        int dev = 0, cus = 0, per_cu = 0;
        if (hipGetDevice(&dev) != hipSuccess || hipDeviceGetAttribute(&cus, hipDeviceAttributeMultiprocessorCount, dev) != hipSuccess) { grid = -1; return; }
        if (hipFuncSetAttribute((const void*)mk_fwd, hipFuncAttributeMaxDynamicSharedMemorySize, LDS_BYTES) != hipSuccess) { fprintf(stderr, "kernel_launch: hipFuncSetAttribute failed\n"); grid = -1; return; }
        if (hipOccupancyMaxActiveBlocksPerMultiprocessor(&per_cu, (const void*)mk_fwd, NWAVES * 64, LDS_BYTES) != hipSuccess || per_cu < 1) { fprintf(stderr, "kernel_launch: occupancy query says %d blocks per CU; nothing launched\n", per_cu); (void)hipGetLastError(); grid = -1; return; }
        grid = cus;
    }
    if (grid < 0) return;
    if (hipMemsetAsync((char*)d_ws + WS_CTL, 0, CTL_ZERO_BYTES, stream) != hipSuccess) { fprintf(stderr, "kernel_launch: memset failed\n"); return; }
    Args a{};
    for (int i = 0; i < 17; ++i) a.in[i] = (const float*)d_in[i];
    a.out = (float*)d_out; a.ws = (unsigned char*)d_ws;
    const double TWO_PI = 6.283185307179586476925286766559;
    for (int i = 0; i < 8; ++i) a.frev[i] = std::pow(500000.0, -(double)i / 8.0) / TWO_PI;
    for (int i = 0; i < 32; ++i) a.frev[8 + i] = std::pow(10000.0, -(double)i / 31.0) / TWO_PI;
    if (N_LAUNCHES == 1) {
        a.ph_lo = 0; a.ph_hi = PER_PHASE; a.li = 0;
#if MK_COOP
        void* kargs[] = {&a};
        const hipError_t le = hipLaunchCooperativeKernel((const void*)mk_fwd, dim3(grid), dim3(NWAVES * 64), kargs, LDS_BYTES, stream);
        if (le != hipSuccess) fprintf(stderr, "kernel_launch: cooperative launch failed: %s (grid %d)\n", hipGetErrorName(le), grid);
#else
        hipLaunchKernelGGL(mk_fwd, dim3(grid), dim3(NWAVES * 64), LDS_BYTES, stream, a);
#endif
    } else {
        for (int li = 0; li < PER_PHASE; ++li) {
            a.ph_lo = li; a.ph_hi = li + 1; a.li = 0;
            hipLaunchKernelGGL(mk_fwd, dim3(grid), dim3(NWAVES * 64), LDS_BYTES, stream, a);
#if MK_CHECK
            hipLaunchKernelGGL(chk_kernel, dim3(256), dim3(256), 0, stream, a, li);
#endif
        }
#if MK_CHECK
        hipLaunchKernelGGL(chk_final, dim3(1024), dim3(256), 0, stream, a);
#endif
    }
}
```

```cpp
#include <hip/hip_runtime.h>
#include <cstdio>
#include <cstdint>
#include <cmath>

#ifndef MK_N_LAUNCHES
#define MK_N_LAUNCHES 1
#endif
#ifndef MK_TIME
#define MK_TIME 0
#endif
#ifndef MK_REPEAT
#define MK_REPEAT -1
#endif
#ifndef MK_NREP
#define MK_NREP 2
#endif
#ifndef MK_COOP
#define MK_COOP 1
#endif
#ifndef MK_TSCALE
#define MK_TSCALE 1.0f
#endif
#ifndef MK_CHECK
#define MK_CHECK 0
#endif

#define LAS __attribute__((address_space(3)))
#define GAS __attribute__((address_space(1)))
typedef unsigned short bf16;
typedef short bf16x8 __attribute__((ext_vector_type(8)));
typedef short s16x4 __attribute__((ext_vector_type(4)));
typedef float f32x2 __attribute__((ext_vector_type(2)));
typedef float f32x4 __attribute__((ext_vector_type(4)));
typedef float f32x16 __attribute__((ext_vector_type(16)));
typedef unsigned u32x2 __attribute__((ext_vector_type(2)));
typedef unsigned u32x4 __attribute__((ext_vector_type(4)));
typedef __bf16 bf16x2_t __attribute__((ext_vector_type(2)));
typedef GAS unsigned gu32;

constexpr int NBATCH = 8, SEQ = 4096, DM = 1024, M = NBATCH * SEQ;
constexpr int NIN = 3584, SEGW = 512, NHEAD = 8, HD = 64;
constexpr int NEXP = 32, FF = 512, NGRP = 4, EPG = 8;
constexpr int CHUNK = 128, NCHUNK = SEQ / CHUNK;
constexpr float NORM_EPS = 1e-6f;
constexpr float LOG2E = 1.4426950408889634f, LN2 = 0.6931471805599453f;
constexpr int NWAVES = 8;
constexpr int N_CONV_P1 = 64 * 256;
constexpr int MAXTILES = 288;

constexpr size_t MiB = 1u << 20;
constexpr size_t WS_CTL = 0, CTL_ZERO_BYTES = 128 * 1024;
constexpr size_t WS_WRT = 1 * MiB;
constexpr size_t WS_ROPE = 2 * MiB;
constexpr size_t WS_LSE = 4 * MiB;
constexpr size_t WS_LIST = 8 * MiB;
constexpr size_t WS_GATEL = 12 * MiB;
constexpr size_t WS_RSL = 16 * MiB;
constexpr size_t WS_WIN = 20 * MiB;
constexpr size_t WS_WOUT = 27 * MiB;
constexpr size_t WS_WD = 30 * MiB;
constexpr size_t WS_WGU = 62 * MiB;
constexpr size_t WS_ST = 126 * MiB;
constexpr size_t WS_SBW = 478 * MiB;
constexpr size_t WS_XN = 158 * MiB;
constexpr size_t WS_OBR = 158 * MiB;
constexpr size_t WS_SEG = 254 * MiB;
constexpr size_t SEG_BYTES = (size_t)M * SEGW * 2;
constexpr size_t WS_MIXED = 254 * MiB;
constexpr size_t WS_H = 350 * MiB;
constexpr size_t WS_HG = 350 * MiB;
constexpr size_t WS_HID = 222 * MiB;
constexpr size_t WS_Y = 64 * MiB;
constexpr size_t WS_END = 494 * MiB;
constexpr int CW_CNT = 64;
constexpr int CW_BAR = 4096;
constexpr int CW_CHK = 16384;
constexpr int CW_TS = 20480;

constexpr int RING_BYTES = 147456;
constexpr int LDSCTL_OFF = RING_BYTES, MISC_OFF = LDSCTL_OFF + 320;
constexpr int TILE_OFF = MISC_OFF + 128;
constexpr int LDS_BYTES = 151552;

#define RLX_AGENT __ATOMIC_RELAXED, __HIP_MEMORY_SCOPE_AGENT
#define LDS_WAIT() asm volatile("s_waitcnt lgkmcnt(0)" ::: "memory")
#define VM_WAIT() asm volatile("s_waitcnt vmcnt(0)" ::: "memory")
__device__ __forceinline__ unsigned pk2(float lo, float hi) { f32x2 v = {lo, hi}; bf16x2_t b = __builtin_convertvector(v, bf16x2_t); return __builtin_bit_cast(unsigned, b); }
__device__ __forceinline__ float bflo(unsigned u) { return __uint_as_float(u << 16); }
__device__ __forceinline__ float bfhi(unsigned u) { return __uint_as_float(u & 0xffff0000u); }
__device__ __forceinline__ float bf2f(short s) { return __uint_as_float(((unsigned)(unsigned short)s) << 16); }
__device__ __forceinline__ int crow(int r, int hi) { return (r & 3) + 8 * (r >> 2) + 4 * hi; }
__device__ __forceinline__ float wave_sum(float v) {
#pragma unroll
    for (int o = 1; o < 64; o <<= 1) v += __shfl_xor(v, o);
    return v;
}
__device__ __forceinline__ float silu_f(float v) { return v * __builtin_amdgcn_rcpf(1.f + __builtin_amdgcn_exp2f(-v * LOG2E)); }

namespace pg8 {
constexpr int BM = 256, BK = 64, HALF = 128, HTB = HALF * BK * 2, STAGE_BYTES = 8 * HTB, NXCD = 8, WGM = 8;
__host__ __device__ __forceinline__ int lds_byte(int r, int c) { const int st = (r >> 4) * 2 + (c >> 5), rr = r & 15, cc = c & 31, ob = rr * 64 + cc * 2; return st * 1024 + (ob ^ (((ob >> 9) & 1) << 5)); }
__host__ __device__ __forceinline__ void stage_rc(int b, int& R, int& C) { const int st = b / 1024, sb = b % 1024, swz = sb ^ (((sb >> 9) & 1) << 5); R = (st >> 1) * 16 + swz / 64; C = (st & 1) * 32 + (swz % 64) / 2; }
__host__ __device__ __forceinline__ int perm32(int rho) { const int n = rho >> 4, i = rho & 15; return 8 * (i >> 2) + 4 * n + (i & 3); }

struct Unit { int pm, pn; };
struct StaticOrder {
    int nM, nN, nwg, G, c;
    __device__ void init(int nM_, int nN_, int G_, int c_) { nM = nM_; nN = nN_; nwg = nM * nN; G = G_; c = c_; }
    __device__ bool next(int i, Unit& u) const {
        const long L = (long)i * G + c; if (L >= nwg) return false;
        int wgid = (int)L; { const int q = nwg / NXCD, r = nwg % NXCD, xcd = wgid % NXCD, off = wgid / NXCD; wgid = (xcd < r ? xcd * (q + 1) : r * (q + 1) + (xcd - r) * q) + off; }
        const int nig = WGM * nN, gid = wgid / nig, fm = gid * WGM, gsz = (nM - fm) < WGM ? (nM - fm) : WGM;
        u.pm = fm + ((wgid % nig) % gsz); u.pn = (wgid % nig) / gsz; return true;
    }
};

template <class Epi, class Sched, class Src, bool ALIGN_EPI, bool SP2>
__device__ __forceinline__ void gemm_phase(LAS unsigned char* lds, const int K, const Sched& S, const Src& SRC, const Epi& E) {
    int tid_ = threadIdx.x; asm volatile("" : "+v"(tid_));
    const int tid = tid_, wid = __builtin_amdgcn_readfirstlane(tid >> 6), lane = tid & 63, wr = wid >> 2, wc = wid & 3, fr = lane & 15, fq = lane >> 4;
    const int nt = K / BK;
    unsigned voffB[2]; int RA[2], CA[2];
#pragma unroll
    for (int i = 0; i < 2; ++i) { int R, C; stage_rc(tid * 16 + i * 8192, R, C); const int Rb = Epi::PERM ? ((R & ~31) + perm32(R & 31)) : R;
        RA[i] = R; CA[i] = C; voffB[i] = (unsigned)(Rb * K + C) * 2u; }
    const size_t kstep = (size_t)(BK * 2);
    const size_t hstep = (size_t)HALF * K * 2;
    const unsigned ldsw = (unsigned)wid * 1024u;
    const int aoff = lds_byte(wr * 64 + fr, fq * 8), boff = lds_byte(wc * 32 + fr, fq * 8);
#define PG8_SA(b, h) (((b) * 2 + (h)) * HTB)
#define PG8_SB(b, h) ((4 + (b) * 2 + (h)) * HTB)
#define PG8_STAGE(bufoff, gbase, voff) do { _Pragma("unroll") for (int _i = 0; _i < 2; ++_i) \
        __builtin_amdgcn_global_load_lds((const unsigned*)((const char*)(gbase) + (voff)[_i]), (LAS unsigned*)(lds + (bufoff) + ldsw + _i * 8192), 16, 0, 0); } while (0)
#define PG8_LDA(dst, b, h) do { _Pragma("unroll") for (int m = 0; m < 4; ++m) _Pragma("unroll") for (int k = 0; k < 2; ++k) dst[m][k] = *(const LAS bf16x8*)(lds + PG8_SA(b, h) + aoff + m * 2048 + k * 1024); } while (0)
#define PG8_LDB(dst, b, h) do { _Pragma("unroll") for (int n = 0; n < 2; ++n) _Pragma("unroll") for (int k = 0; k < 2; ++k) dst[n][k] = *(const LAS bf16x8*)(lds + PG8_SB(b, h) + boff + n * 2048 + k * 1024); } while (0)
#define PG8_MMA(ai, bj, At, Bt) do { __builtin_amdgcn_s_setprio(1); _Pragma("unroll") for (int m = 0; m < 4; ++m) _Pragma("unroll") for (int n = 0; n < 2; ++n) _Pragma("unroll") for (int k = 0; k < 2; ++k) \
        acc[ai][bj][m][n] = __builtin_amdgcn_mfma_f32_16x16x32_bf16(Bt[n][k], At[m][k], acc[ai][bj][m][n], 0, 0, 0); __builtin_amdgcn_s_setprio(0); } while (0)
#define PG8_WAIT_V(n) asm volatile("s_waitcnt vmcnt(" #n ")" ::: "memory")
#define PG8_WAIT_L(n) asm volatile("s_waitcnt lgkmcnt(" #n ")" ::: "memory")
#define PG8_BAR __builtin_amdgcn_s_barrier()
#define PG8_SCHED __builtin_amdgcn_sched_barrier(0)
    Unit cur, nxt; int ui = 0;
    if (!S.next(0, cur)) return;
    f32x4 acc[2][2][4][2];
#pragma unroll
    for (int a = 0; a < 2; ++a)
#pragma unroll
        for (int b = 0; b < 2; ++b)
#pragma unroll
            for (int m = 0; m < 4; ++m)
#pragma unroll
                for (int n = 0; n < 2; ++n) acc[a][b][m][n] = (f32x4){0.f, 0.f, 0.f, 0.f};
    bf16x8 At[4][2], B0[2][2], B1[2][2];
    const char *cA, *cB; unsigned vA0[2], vA1[2];
    SRC.setup(cur, RA, CA, cA, cB, vA0, vA1);
    if constexpr (SP2) {
        PG8_STAGE(PG8_SB(0, 0), cB, voffB); PG8_STAGE(PG8_SB(0, 1), cB + hstep, voffB); PG8_STAGE(PG8_SA(0, 0), cA, vA0); PG8_STAGE(PG8_SA(0, 1), cA, vA1);
        if (wr == 1) PG8_BAR;
        PG8_WAIT_V(2); PG8_BAR;
        PG8_STAGE(PG8_SB(1, 0), cB + kstep, voffB); PG8_STAGE(PG8_SA(1, 0), cA + kstep, vA0); PG8_STAGE(PG8_SB(1, 1), cB + hstep + kstep, voffB);
        PG8_WAIT_V(6); PG8_BAR;
    } else {
        PG8_STAGE(PG8_SB(0, 0), cB, voffB); PG8_STAGE(PG8_SA(0, 0), cA, vA0); PG8_STAGE(PG8_SB(0, 1), cB + hstep, voffB); PG8_STAGE(PG8_SA(0, 1), cA, vA1);
        if (wr == 1) PG8_BAR;
        PG8_WAIT_V(4); PG8_BAR;
        PG8_STAGE(PG8_SB(1, 0), cB + kstep, voffB); PG8_STAGE(PG8_SA(1, 0), cA + kstep, vA0); PG8_STAGE(PG8_SB(1, 1), cB + hstep + kstep, voffB);
        PG8_WAIT_V(6); PG8_BAR;
    }
    for (;;) {
        const bool has_next = S.next(ui + 1, nxt);
        const char *nA = cA, *nB = cB; unsigned wA0[2] = {vA0[0], vA0[1]}, wA1[2] = {vA1[0], vA1[1]};
        if (has_next) SRC.setup(nxt, RA, CA, nA, nB, wA0, wA1);
        for (int t = 0; t < nt; t += 2) {
            const bool last = (t == nt - 2);
            const char* a1 = cA + (size_t)(t + 1) * kstep;
            const char* a2 = last ? nA : cA + (size_t)(t + 2) * kstep; const char* b2 = last ? nB : cB + (size_t)(t + 2) * kstep;
            const char* a3 = a2 + kstep; const char* b3 = b2 + kstep;
            unsigned x0[2], x1[2];
            x0[0] = last ? wA0[0] : vA0[0]; x0[1] = last ? wA0[1] : vA0[1]; x1[0] = last ? wA1[0] : vA1[0]; x1[1] = last ? wA1[1] : vA1[1];
            if constexpr (SP2) {
            PG8_LDB(B0, 0, 0); PG8_LDB(B1, 0, 1); PG8_SCHED; PG8_LDA(At, 0, 0); PG8_STAGE(PG8_SA(1, 1), a1, vA1);
            PG8_WAIT_V(8); PG8_WAIT_L(0); PG8_BAR; PG8_MMA(0, 0, At, B0); PG8_MMA(0, 1, At, B1); PG8_BAR; PG8_SCHED;
            PG8_LDA(At, 0, 1); PG8_STAGE(PG8_SB(0, 0), b2, voffB); PG8_STAGE(PG8_SB(0, 1), b2 + hstep, voffB); PG8_STAGE(PG8_SA(0, 0), a2, x0);
            PG8_WAIT_V(8); PG8_WAIT_L(0); PG8_BAR; PG8_MMA(1, 0, At, B0); PG8_MMA(1, 1, At, B1); PG8_BAR; PG8_SCHED;
            PG8_LDB(B0, 1, 0); PG8_LDB(B1, 1, 1); PG8_SCHED; PG8_LDA(At, 1, 0); PG8_STAGE(PG8_SA(0, 1), a2, x1);
            PG8_WAIT_V(8); PG8_WAIT_L(0); PG8_BAR; PG8_MMA(0, 0, At, B0); PG8_MMA(0, 1, At, B1); PG8_BAR; PG8_SCHED;
            PG8_LDA(At, 1, 1); PG8_STAGE(PG8_SB(1, 0), b3, voffB); PG8_STAGE(PG8_SB(1, 1), b3 + hstep, voffB); PG8_STAGE(PG8_SA(1, 0), a3, x0);
            PG8_WAIT_V(8); PG8_WAIT_L(0); PG8_BAR; PG8_MMA(1, 0, At, B0); PG8_MMA(1, 1, At, B1); PG8_BAR; PG8_SCHED;
            } else {
            PG8_LDB(B0, 0, 0); PG8_SCHED; PG8_LDA(At, 0, 0); PG8_STAGE(PG8_SA(1, 1), a1, vA1);
            PG8_WAIT_L(8); PG8_BAR; PG8_WAIT_L(0); PG8_MMA(0, 0, At, B0); PG8_BAR; PG8_SCHED;
            PG8_LDB(B1, 0, 1); PG8_STAGE(PG8_SB(0, 0), b2, voffB);
            PG8_BAR; PG8_WAIT_L(0); PG8_MMA(0, 1, At, B1); PG8_BAR;
            PG8_LDA(At, 0, 1); PG8_STAGE(PG8_SA(0, 0), a2, x0);
            PG8_BAR; PG8_WAIT_L(0); PG8_MMA(1, 0, At, B0); PG8_BAR; PG8_SCHED;
            PG8_STAGE(PG8_SB(0, 1), b2 + hstep, voffB);
            PG8_WAIT_V(6); PG8_BAR; PG8_MMA(1, 1, At, B1); PG8_BAR;
            PG8_LDB(B0, 1, 0); PG8_SCHED; PG8_LDA(At, 1, 0); PG8_STAGE(PG8_SA(0, 1), a2, x1);
            PG8_WAIT_L(8); PG8_BAR; PG8_WAIT_L(0); PG8_MMA(0, 0, At, B0); PG8_BAR; PG8_SCHED;
            PG8_LDB(B1, 1, 1); PG8_STAGE(PG8_SB(1, 0), b3, voffB);
            PG8_BAR; PG8_WAIT_L(0); PG8_MMA(0, 1, At, B1); PG8_BAR;
            PG8_LDA(At, 1, 1); PG8_STAGE(PG8_SA(1, 0), a3, x0);
            PG8_BAR; PG8_WAIT_L(0); PG8_MMA(1, 0, At, B0); PG8_BAR; PG8_SCHED;
            PG8_STAGE(PG8_SB(1, 1), b3 + hstep, voffB);
            PG8_WAIT_V(6); PG8_BAR; PG8_MMA(1, 1, At, B1); PG8_BAR;
            }
        }
        if constexpr (ALIGN_EPI) { if (wr == 0) PG8_BAR; }
        E(acc, cur, wr, wc, fr, fq);
        if (!has_next) break;
#pragma unroll
        for (int a = 0; a < 2; ++a)
#pragma unroll
            for (int b = 0; b < 2; ++b)
#pragma unroll
                for (int m = 0; m < 4; ++m)
#pragma unroll
                    for (int n = 0; n < 2; ++n) acc[a][b][m][n] = (f32x4){0.f, 0.f, 0.f, 0.f};
        cur = nxt; cA = nA; cB = nB; vA0[0] = wA0[0]; vA0[1] = wA0[1]; vA1[0] = wA1[0]; vA1[1] = wA1[1]; ++ui;
        if constexpr (ALIGN_EPI) { if (wr == 1) PG8_BAR; }
    }
    PG8_WAIT_V(0);
    if constexpr (!ALIGN_EPI) { if (wr == 0) PG8_BAR; }
    PG8_BAR;
#undef PG8_SA
#undef PG8_SB
#undef PG8_STAGE
#undef PG8_LDA
#undef PG8_LDB
#undef PG8_MMA
#undef PG8_WAIT_V
#undef PG8_WAIT_L
#undef PG8_BAR
#undef PG8_SCHED
}
}

#define XB_TMO      128
#define XB_XCNT(j)  (256  + 64 * (j))
#define XB_XSUB(j)  (1280 + 64 * (j))
#define XB_XGEN(j)  (2304 + 64 * (j))
#define XB_TOP      3328
#define XB_TOPGEN   3392
#define XCD_BAR_WORDS 3456
#define XB_SPIN_CAP (1u << 18)
__device__ __forceinline__ unsigned xb_ld(unsigned* p)              { return __hip_atomic_load(p, __ATOMIC_RELAXED, __HIP_MEMORY_SCOPE_AGENT); }
__device__ __forceinline__ unsigned xb_add(unsigned* p, unsigned v) { return __hip_atomic_fetch_add(p, v, __ATOMIC_RELAXED, __HIP_MEMORY_SCOPE_AGENT); }
__device__ __forceinline__ unsigned xb_xcc_id() { return (unsigned)__builtin_amdgcn_s_getreg((3 << 11) | 20) & 0xFu; }
#define XB_SPIN(cond, bar) do { unsigned _sp = 0; while (cond) { __builtin_amdgcn_s_sleep(1); \
    if ((++_sp & 255u) == 0u) { if (xb_ld(&(bar)[XB_TMO])) break; if (_sp > XB_SPIN_CAP) { atomicAdd(&(bar)[XB_TMO], 1u); break; } } } } while (0)
struct XcdBarrier { unsigned* bar; unsigned x; volatile LAS unsigned* st; };
__device__ __forceinline__ XcdBarrier xcd_barrier_post(unsigned* bar, volatile LAS unsigned* st) {
    XcdBarrier b; b.bar = bar; b.x = xb_xcc_id(); b.st = st;
    if (threadIdx.x == 0) (void)xb_add(&bar[XB_XCNT(b.x)], 1u);
    return b;
}
__device__ __forceinline__ void xcd_barrier_complete(unsigned* bar, unsigned x, unsigned& nloc, unsigned& nx) {
    const unsigned G = gridDim.x * gridDim.y * gridDim.z;
    unsigned sum, cnt, mine, sp = 0u;
    for (;;) {
        sum = 0u; cnt = 0u; mine = 0u;
#pragma unroll
        for (unsigned j = 0; j < 16; ++j) { const unsigned c = xb_ld(&bar[XB_XCNT(j)]); sum += c; cnt += (c > 0u) ? 1u : 0u; mine = (j == x) ? c : mine; }
        if (sum == G) break;
        __builtin_amdgcn_s_sleep(1);
        if ((++sp & 255u) == 0u) { if (xb_ld(&bar[XB_TMO])) break; if (sp > XB_SPIN_CAP) { atomicAdd(&bar[XB_TMO], 1u); break; } }
    }
    nloc = mine > 0u ? mine : 1u; nx = cnt > 0u ? cnt : 1u;
}
__device__ __forceinline__ void xcd_barrier(const XcdBarrier& b) {
    asm volatile("s_waitcnt vmcnt(0)" ::: "memory");
    __syncthreads();
    if (threadIdx.x == 0) {
        unsigned* bar = b.bar;
        __builtin_amdgcn_s_waitcnt(0);
        unsigned nloc = b.st[0], nx = b.st[1];
        if (nloc == 0u) { xcd_barrier_complete(bar, b.x, nloc, nx); b.st[0] = nloc; b.st[1] = nx; }
        const unsigned old = xb_add(&bar[XB_XSUB(b.x)], 1u);
        const unsigned gen = old / nloc;
        if (old + 1u == (gen + 1u) * nloc) {
            __builtin_amdgcn_fence(__ATOMIC_RELEASE, "agent");
            asm volatile("s_waitcnt vmcnt(0)" ::: "memory");
            const unsigned og = xb_add(&bar[XB_TOP], 1u);
            const unsigned tg = og / nx;
            if (og + 1u == (tg + 1u) * nx) xb_add(&bar[XB_TOPGEN], 1u);
            else XB_SPIN(xb_ld(&bar[XB_TOPGEN]) == tg, bar);
            __builtin_amdgcn_fence(__ATOMIC_ACQUIRE, "agent");
            xb_add(&bar[XB_XGEN(b.x)], 1u);
            asm volatile("s_waitcnt vmcnt(0)" ::: "memory");
        } else {
            XB_SPIN(xb_ld(&bar[XB_XGEN(b.x)]) == gen, bar);
            __builtin_amdgcn_fence(__ATOMIC_ACQUIRE, "agent");
            asm volatile("s_waitcnt vmcnt(0)" ::: "memory");
        }
    }
    __syncthreads();
}

struct Args {
    const float* in[17]; float* out; unsigned char* ws;
    double frev[40];
    int ph_lo, ph_hi, li, pad;
};
struct Frame {
    LAS unsigned char* lds;
    volatile LAS unsigned* MISC;
    gu32* ctl;
    int tid, lane, wave, vcu, G;
};

__device__ __forceinline__ int winperm(int n) {
    const int s = n >> 9, c = n & 511, hh = c >> 6, d = c & 63; int dp = d;
    if (s == 0 || s == 1) { if (d < 16) dp = 2 * (d & 7) + (d >> 3); }
    else if (s == 3 || s == 4) dp = 2 * (d & 31) + (d >> 5);
    return (s << 9) + (hh << 6) + dp;
}
template <int MODE>
__device__ __forceinline__ int tr_row(int ns) { return MODE == 0 ? winperm(ns) : MODE == 1 ? ns : MODE == 2 ? ((ns >> 7) << 8) + (ns & 127) : ((ns >> 7) << 8) + 128 + (ns & 127); }
__device__ __forceinline__ void tr_load(f32x4 (&v)[8], const float* S, int N, int kb, int nb, int lane) {
    const float* p = S + (size_t)(64 * kb + (lane >> 3)) * N + 32 * nb + (lane & 7) * 4;
#pragma unroll
    for (int i = 0; i < 8; ++i) v[i] = __builtin_nontemporal_load((const f32x4*)(p + (size_t)8 * i * N));
}
template <int MODE, bool NT = false>
__device__ __forceinline__ void tr_store(const f32x4 (&v)[8], bf16* Dst, int Kd, LAS float* scr, int kb, int nb, int lane, const float* kscale) {
    const int k0 = 64 * kb, n0 = 32 * nb;
#pragma unroll
    for (int i = 0; i < 8; ++i) { const int kk = 8 * i + (lane >> 3); const float sc = kscale ? kscale[k0 + kk] : 1.f; LAS float* d = scr + kk * 33 + (lane & 7) * 4;
        d[0] = v[i][0] * sc; d[1] = v[i][1] * sc; d[2] = v[i][2] * sc; d[3] = v[i][3] * sc; }
    LDS_WAIT(); asm volatile("" ::: "memory");
    const int c = lane & 7;
#pragma unroll
    for (int j = 0; j < 4; ++j) { const int n = (lane >> 3) + 8 * j; const LAS float* s = scr + (8 * c) * 33 + n;
        u32x4 o; o.x = pk2(s[0 * 33], s[1 * 33]); o.y = pk2(s[2 * 33], s[3 * 33]); o.z = pk2(s[4 * 33], s[5 * 33]); o.w = pk2(s[6 * 33], s[7 * 33]);
        if (NT) __builtin_nontemporal_store(o, (u32x4*)(Dst + (size_t)tr_row<MODE>(n0 + n) * Kd + k0 + 8 * c)); else *(GAS u32x4*)(Dst + (size_t)tr_row<MODE>(n0 + n) * Kd + k0 + 8 * c) = o; }
    LDS_WAIT(); asm volatile("" ::: "memory");
}
template <int MODE>
__device__ __forceinline__ void p0_transpose_item(const float* S, int N, bf16* Dst, int Kd, LAS float* scr, int kb, int nb, int lane, const float* kscale) {
    f32x4 v[8]; tr_load(v, S, N, kb, nb, lane); tr_store<MODE>(v, Dst, Kd, scr, kb, nb, lane, kscale);
}
constexpr int N_GU_ITEMS = 512 * NEXP;
__device__ __forceinline__ void expert_it(int it, int& e, int& r) { if (it < N_GU_ITEMS) { e = it >> 9; r = it & 511; } else { const int d = it - N_GU_ITEMS; e = d >> 8; r = 512 + (d & 255); } }
__device__ __forceinline__ void expert_src(const Args& A, int it, const float*& S, int& N, int& kb, int& nb) {
    int e, r; expert_it(it, e, r);
    if (r < 256) { S = A.in[13] + (size_t)e * DM * FF; N = FF; kb = r >> 4; nb = r & 15; }
    else if (r < 512) { S = A.in[14] + (size_t)e * DM * FF; N = FF; kb = (r - 256) >> 4; nb = (r - 256) & 15; }
    else { S = A.in[15] + (size_t)e * FF * DM; N = DM; kb = (r - 512) >> 5; nb = (r - 512) & 31; }
}
__device__ __forceinline__ void expert_store(const Args& A, unsigned char* ws, int it, const f32x4 (&v)[8], LAS float* scr, int lane) {
    bf16* WGU = (bf16*)(ws + WS_WGU); bf16* WD = (bf16*)(ws + WS_WD);
    int e, r; expert_it(it, e, r);
    if (r < 256) tr_store<2, true>(v, WGU + (size_t)e * DM * DM, DM, scr, r >> 4, r & 15, lane, A.in[8]);
    else if (r < 512) tr_store<3, true>(v, WGU + (size_t)e * DM * DM, DM, scr, (r - 256) >> 4, (r - 256) & 15, lane, A.in[8]);
    else tr_store<1, true>(v, WD + (size_t)e * DM * FF, FF, scr, (r - 512) >> 5, (r - 512) & 31, lane, nullptr);
}
__device__ __forceinline__ void expert_items(const Args& A, unsigned char* ws, LAS float* scr, int lo, int NI, int w0, int nw, int lane) {
    for (int it = lo + w0; it < NI; it += 4 * nw) {
        f32x4 v0[8], v1[8], v2[8], v3[8]; const float* S; int N, kb, nb;
        expert_src(A, it, S, N, kb, nb); tr_load(v0, S, N, kb, nb, lane);
        if (it + nw < NI) { expert_src(A, it + nw, S, N, kb, nb); tr_load(v1, S, N, kb, nb, lane); }
        if (it + 2 * nw < NI) { expert_src(A, it + 2 * nw, S, N, kb, nb); tr_load(v2, S, N, kb, nb, lane); }
        if (it + 3 * nw < NI) { expert_src(A, it + 3 * nw, S, N, kb, nb); tr_load(v3, S, N, kb, nb, lane); }
        expert_store(A, ws, it, v0, scr, lane);
        if (it + nw < NI) expert_store(A, ws, it + nw, v1, scr, lane);
        if (it + 2 * nw < NI) expert_store(A, ws, it + 2 * nw, v2, scr, lane);
        if (it + 3 * nw < NI) expert_store(A, ws, it + 3 * nw, v3, scr, lane);
    }
}
__device__ __forceinline__ void p0_prologue(Frame& F, const Args& A) {
    unsigned char* ws = A.ws;
    LAS float* scr = (LAS float*)(F.lds + F.wave * 16384);
    const int gw = F.vcu * NWAVES + F.wave, NGW = F.G * NWAVES;
    constexpr int I_IN = 16 * 112, I_OUT = 16 * 32;
    bf16* WIN = (bf16*)(ws + WS_WIN); bf16* WOUT = (bf16*)(ws + WS_WOUT);
    for (int it = gw; it < I_IN + I_OUT; it += NGW) {
        int r = it;
        if (r < I_IN) { p0_transpose_item<0>(A.in[2], NIN, WIN, DM, scr, r / 112, r % 112, F.lane, nullptr); continue; } r -= I_IN;
        const int kb = r / 32; p0_transpose_item<1>(A.in[7], DM, WOUT, DM, scr, kb, r % 32, F.lane, kb < 8 ? A.in[3] : A.in[6] - 512);
    }
    expert_items(A, ws, scr, F.G == 256 ? N_CONV_P1 : 0, F.G == 256 ? N_GU_ITEMS : 768 * NEXP, gw, NGW, F.lane);
    { const float* x = A.in[0]; const float* g = A.in[1]; bf16* XN = (bf16*)(ws + WS_XN);
      f32x4 gv[4];
#pragma unroll
      for (int j = 0; j < 4; ++j) gv[j] = ((const f32x4*)g)[F.lane + 64 * j];
      for (int m0 = gw; m0 < M; m0 += 4 * NGW) {
        f32x4 v[4][4];
#pragma unroll
        for (int k = 0; k < 4; ++k) { const GAS f32x4* xr = (const GAS f32x4*)(x + (size_t)(m0 + k * NGW) * DM) + F.lane;
#pragma unroll
            for (int j = 0; j < 4; ++j) v[k][j] = __builtin_nontemporal_load(xr + 64 * j); }
#pragma unroll
        for (int k = 0; k < 4; ++k) { float s = 0.f;
#pragma unroll
            for (int j = 0; j < 4; ++j) s += (v[k][j].x * v[k][j].x + v[k][j].y * v[k][j].y) + (v[k][j].z * v[k][j].z + v[k][j].w * v[k][j].w);
            const float rstd = 1.f / sqrtf(wave_sum(s) * (1.f / DM) + NORM_EPS);
            GAS unsigned long long* o8 = (GAS unsigned long long*)(XN + (size_t)(m0 + k * NGW) * DM) + F.lane;
#pragma unroll
            for (int j = 0; j < 4; ++j) { const f32x4 t = v[k][j] * rstd * gv[j]; o8[64 * j] = (unsigned long long)pk2(t.x, t.y) | ((unsigned long long)pk2(t.z, t.w) << 32); } }
      } }
    { const int gt = (F.vcu * NWAVES + F.wave) * 64 + F.lane, NT = NGW * 64;
      bf16* WRH = (bf16*)(ws + WS_WRT); bf16* WRL = WRH + 48 * DM; const float* gf = A.in[8]; const float* wg = A.in[9]; const float* we = A.in[11];
      for (int idx = gt; idx < 48 * DM; idx += NT) { const int j = idx >> 10, i = idx & 1023;
          const float v = (j < 32 ? we[i * 32 + j] : (j < 36 ? wg[i * 4 + (j - 32)] : 0.f)) * gf[i];
          const unsigned hb = pk2(v, 0.f) & 0xffffu; const float lo = v - bflo(hb); WRH[idx] = (bf16)hb; WRL[idx] = (bf16)(pk2(lo, 0.f) & 0xffffu); }
      float* RC = (float*)(ws + WS_ROPE); float* RS = RC + SEQ * 40;
      for (int idx = gt; idx < SEQ * 40; idx += NT) { const int pos = idx / 40, f = idx % 40;
          double rv = (double)pos * A.frev[f]; rv -= floor(rv); const float r = (float)rv;
          RC[idx] = __builtin_amdgcn_cosf(r); RS[idx] = __builtin_amdgcn_sinf(r); } }
}

struct SrcPlain {
    const bf16* A; const bf16* Bt; int K;
    __device__ __forceinline__ void setup(const pg8::Unit& u, const int (&RA)[2], const int (&CA)[2], const char*& cA, const char*& cB, unsigned (&v0)[2], unsigned (&v1)[2]) const {
        cA = (const char*)A + (size_t)u.pm * 256 * K * 2; cB = (const char*)Bt + (size_t)u.pn * 256 * K * 2;
#pragma unroll
        for (int i = 0; i < 2; ++i) { v0[i] = (unsigned)(RA[i] * K + CA[i]) * 2u; v1[i] = v0[i] + (unsigned)(128 * K * 2); }
    }
};
struct TileTab { const LAS int* TE; const LAS int* NE; const LAS int* T0; };
struct SrcGather {
    const bf16* HG; const bf16* WGU; const int* LIST; TileTab tt;
    __device__ __forceinline__ void setup(const pg8::Unit& u, const int (&RA)[2], const int (&CA)[2], const char*& cA, const char*& cB, unsigned (&v0)[2], unsigned (&v1)[2]) const {
        const int e = tt.TE[u.pm], ne = tt.NE[e], p0 = (u.pm - tt.T0[e]) * 256;
        cA = (const char*)HG; cB = (const char*)WGU + ((size_t)e * DM + (size_t)u.pn * 256) * DM * 2;
#pragma unroll
        for (int i = 0; i < 2; ++i) {
            const int pa = p0 + RA[i], pb = pa + 128;
            const int ta = pa < ne ? (LIST[e * M + pa] >> 1) : 0, tb = pb < ne ? (LIST[e * M + pb] >> 1) : 0;
            v0[i] = (unsigned)(ta * DM + CA[i]) * 2u; v1[i] = (unsigned)(tb * DM + CA[i]) * 2u; }
    }
};
struct SrcDown {
    const bf16* HID; const bf16* WD; TileTab tt;
    __device__ __forceinline__ void setup(const pg8::Unit& u, const int (&RA)[2], const int (&CA)[2], const char*& cA, const char*& cB, unsigned (&v0)[2], unsigned (&v1)[2]) const {
        const int e = tt.TE[u.pm];
        cA = (const char*)HID + (size_t)u.pm * 256 * FF * 2; cB = (const char*)WD + ((size_t)e * DM + (size_t)u.pn * 256) * FF * 2;
#pragma unroll
        for (int i = 0; i < 2; ++i) { v0[i] = (unsigned)(RA[i] * FF + CA[i]) * 2u; v1[i] = v0[i] + (unsigned)(128 * FF * 2); }
    }
};

struct EpiInProj {
    static constexpr bool PERM = true;
    bf16* SEG; const float* RC; const float* RS;
    __device__ __forceinline__ void operator()(const f32x4 (&acc)[2][2][4][2], const pg8::Unit& u, int wr, int wc, int fr, int fq) const {
        const int seg = u.pn >> 1, colt = (u.pn & 1) * 256;
        bf16* base = SEG + (size_t)seg * M * SEGW;
        const int dq = (wc & 1) * 32 + 8 * fq;
        const bool attn = seg < 2, ret = (seg == 3 || seg == 4);
        const bool rot = ret || (attn && dq < 16);
        const int i0 = ret ? 8 + (dq >> 1) : (dq >> 1);
        const float sc = seg == 0 ? 0.125f * LOG2E : (seg == 4 ? 0.125f : 1.f);
#pragma unroll
        for (int ai = 0; ai < 2; ++ai)
#pragma unroll
            for (int m = 0; m < 4; ++m) {
                const int row = u.pm * 256 + ai * 128 + wr * 64 + m * 16 + fr, pos = row & (SEQ - 1);
                f32x4 c4 = {1.f, 1.f, 1.f, 1.f}, s4 = {0.f, 0.f, 0.f, 0.f};
                if (rot) { c4 = *(const f32x4*)(RC + pos * 40 + i0); s4 = *(const f32x4*)(RS + pos * 40 + i0); }
                bf16* rowp = base + (size_t)row * SEGW + colt + wc * 32 + 8 * fq;
#pragma unroll
                for (int bj = 0; bj < 2; ++bj) {
                    f32x4 v0 = acc[ai][bj][m][0], v1 = acc[ai][bj][m][1];
                    if (attn || ret) {
                        f32x4 r0, r1;
                        r0[0] = v0[0] * c4[0] - v0[1] * s4[0]; r0[1] = v0[1] * c4[0] + v0[0] * s4[0];
                        r0[2] = v0[2] * c4[1] - v0[3] * s4[1]; r0[3] = v0[3] * c4[1] + v0[2] * s4[1];
                        r1[0] = v1[0] * c4[2] - v1[1] * s4[2]; r1[1] = v1[1] * c4[2] + v1[0] * s4[2];
                        r1[2] = v1[2] * c4[3] - v1[3] * s4[3]; r1[3] = v1[3] * c4[3] + v1[2] * s4[3];
                        v0 = r0 * sc; v1 = r1 * sc;
                    } else if (seg == 6) {
#pragma unroll
                        for (int e = 0; e < 4; ++e) { v0[e] = silu_f(v0[e]); v1[e] = silu_f(v1[e]); }
                    }
                    u32x4 w; w.x = pk2(v0[0], v0[1]); w.y = pk2(v0[2], v0[3]); w.z = pk2(v1[0], v1[1]); w.w = pk2(v1[2], v1[3]);
                    *(u32x4*)(rowp + bj * 128) = w;
                }
            }
    }
};
struct EpiOutProj {
    static constexpr bool PERM = true;
    const float* X; bf16* HB;
    __device__ __forceinline__ void operator()(const f32x4 (&acc)[2][2][4][2], const pg8::Unit& u, int wr, int wc, int fr, int fq) const {
        const int col0 = u.pn * 256 + wc * 32 + 8 * fq;
#pragma unroll
        for (int ai = 0; ai < 2; ++ai)
#pragma unroll
            for (int m = 0; m < 4; ++m) { const size_t off = (size_t)(u.pm * 256 + ai * 128 + wr * 64 + m * 16 + fr) * DM + col0;
#pragma unroll
                for (int bj = 0; bj < 2; ++bj) { const f32x4 h0 = __builtin_nontemporal_load((const f32x4*)(X + off + bj * 128)) + acc[ai][bj][m][0], h1 = __builtin_nontemporal_load((const f32x4*)(X + off + bj * 128 + 4)) + acc[ai][bj][m][1];
                    u32x4 w; w.x = pk2(h0[0], h0[1]); w.y = pk2(h0[2], h0[3]); w.z = pk2(h1[0], h1[1]); w.w = pk2(h1[2], h1[3]); *(u32x4*)(HB + off + bj * 128) = w; }
                if (m & 1) asm volatile("" ::: "memory"); }
    }
};
struct EpiGateUp {
    static constexpr bool PERM = true;
    bf16* HID; const float* GATEL; const float* RSL; TileTab tt;
    __device__ __forceinline__ void operator()(const f32x4 (&acc)[2][2][4][2], const pg8::Unit& u, int wr, int wc, int fr, int fq) const {
        const int e = tt.TE[u.pm], ne = tt.NE[e], p0 = (u.pm - tt.T0[e]) * 256;
#pragma unroll
        for (int ai = 0; ai < 2; ++ai)
#pragma unroll
            for (int m = 0; m < 4; ++m) {
                const int rr = ai * 128 + wr * 64 + m * 16 + fr, pos = p0 + rr;
                float rs = 0.f, gt = 0.f; if (pos < ne) { rs = RSL[e * M + pos]; gt = GATEL[e * M + pos]; }
                u32x4 w; unsigned* wp = (unsigned*)&w;
#pragma unroll
                for (int n = 0; n < 2; ++n) { const f32x4 g = acc[ai][0][m][n] * rs, up = acc[ai][1][m][n] * rs; float hv[4];
#pragma unroll
                    for (int q = 0; q < 4; ++q) hv[q] = silu_f(g[q]) * up[q] * gt;
                    wp[2 * n] = pk2(hv[0], hv[1]); wp[2 * n + 1] = pk2(hv[2], hv[3]); }
                *(u32x4*)(HID + (size_t)(u.pm * 256 + rr) * FF + u.pn * 128 + wc * 32 + 8 * fq) = w;
            }
    }
};
struct EpiDown {
    static constexpr bool PERM = true;
    bf16* Y; const int* LIST; TileTab tt;
    __device__ __forceinline__ void operator()(const f32x4 (&acc)[2][2][4][2], const pg8::Unit& u, int wr, int wc, int fr, int fq) const {
        const int e = tt.TE[u.pm], ne = tt.NE[e], p0 = (u.pm - tt.T0[e]) * 256;
#pragma unroll
        for (int ai = 0; ai < 2; ++ai)
#pragma unroll
            for (int m = 0; m < 4; ++m) {
                const int pos = p0 + ai * 128 + wr * 64 + m * 16 + fr;
                if (pos < ne) { const int tk = LIST[e * M + pos]; bf16* rowp = Y + (size_t)tk * DM + u.pn * 256 + wc * 32 + 8 * fq;
#pragma unroll
                    for (int bj = 0; bj < 2; ++bj) { const f32x4 v0 = acc[ai][bj][m][0], v1 = acc[ai][bj][m][1];
                        u32x4 w; w.x = pk2(v0[0], v0[1]); w.y = pk2(v0[2], v0[3]); w.z = pk2(v1[0], v1[1]); w.w = pk2(v1[2], v1[3]);
                        *(u32x4*)(rowp + bj * 128) = w; } }
            }
    }
};

typedef short v4i16_t __attribute__((ext_vector_type(4)));
__device__ __forceinline__ s16x4 vtr(const LAS unsigned char* p) { return __builtin_bit_cast(s16x4, __builtin_amdgcn_ds_read_tr16_b64_v4i16((LAS v4i16_t*)p)); }
#define MFMA32(a, b, c) __builtin_amdgcn_mfma_f32_32x32x16_bf16((a), (b), (c), 0, 0, 0)
__device__ __forceinline__ bf16x8 pack8(const f32x16& x, int s) {
    u32x4 p; p.x = pk2(x[8 * s], x[8 * s + 1]); p.y = pk2(x[8 * s + 2], x[8 * s + 3]); p.z = pk2(x[8 * s + 4], x[8 * s + 5]); p.w = pk2(x[8 * s + 6], x[8 * s + 7]);
    return __builtin_bit_cast(bf16x8, p);
}
__device__ __forceinline__ bf16x8 cat44(s16x4 lo, s16x4 hi) { return __builtin_shufflevector(lo, hi, 0, 1, 2, 3, 4, 5, 6, 7); }
__device__ __forceinline__ bf16x8 scale8(bf16x8 v, float s) {
    u32x4 u = __builtin_bit_cast(u32x4, v), o;
    o.x = pk2(bflo(u.x) * s, bfhi(u.x) * s); o.y = pk2(bflo(u.y) * s, bfhi(u.y) * s); o.z = pk2(bflo(u.z) * s, bfhi(u.z) * s); o.w = pk2(bflo(u.w) * s, bfhi(u.w) * s);
    return __builtin_bit_cast(bf16x8, o);
}
constexpr int TP = 144;
__device__ __forceinline__ void pv_tile_p(f32x16& ot0, f32x16& ot1, const f32x16& st, const LAS unsigned char* vl, int lane) {
    const int hi = lane >> 5;
    const LAS unsigned char* vr = vl + (4 * hi + ((lane & 15) >> 2)) * TP + (16 * ((lane >> 4) & 1) + 4 * (lane & 3)) * 2;
    const bf16x8 pb0 = pack8(st, 0), pb1 = pack8(st, 1);
    { const bf16x8 va = cat44(vtr(vr), vtr(vr + 8 * TP)); ot0 = MFMA32(va, pb0, ot0); }
    { const bf16x8 va = cat44(vtr(vr + 16 * TP), vtr(vr + 24 * TP)); ot0 = MFMA32(va, pb1, ot0); }
    { const bf16x8 va = cat44(vtr(vr + 64), vtr(vr + 8 * TP + 64)); ot1 = MFMA32(va, pb0, ot1); }
    { const bf16x8 va = cat44(vtr(vr + 16 * TP + 64), vtr(vr + 24 * TP + 64)); ot1 = MFMA32(va, pb1, ot1); }
}
__device__ __forceinline__ void kv_task(int cid, const bf16* KR, const bf16* VR, bf16* KV, const float* dec_f, const float* dec_b, LAS unsigned char* wl, int lane) {
    const int bh = cid >> 5, n = cid & 31, b = bh >> 3, h = bh & 7, q = lane & 31, hi = lane >> 5, tr = lane >> 3, tc = (lane & 7) * 8;
    const float lgf = __uint_as_float(__builtin_amdgcn_readfirstlane(__float_as_uint(log1pf(-exp2f(dec_f[h])) * LOG2E))), lgb = __uint_as_float(__builtin_amdgcn_readfirstlane(__float_as_uint(log1pf(-exp2f(dec_b[h])) * LOG2E)));
    const size_t row0 = (size_t)b * SEQ + n * CHUNK; const int loff = tr * SEGW + tc;
    const bf16* Kb = KR + row0 * SEGW + h * HD; const bf16* Vb = VR + row0 * SEGW + h * HD;
    LAS unsigned char* Tf = wl; LAS unsigned char* Tb = wl + 32 * TP; LAS unsigned char* Tv = wl + 64 * TP; LAS unsigned char* tw = wl + tr * TP + tc * 2;
    const int tro = (8 * hi + ((lane & 15) >> 2)) * TP + (16 * ((lane >> 4) & 1) + 4 * (lane & 3)) * 2;
    f32x16 acc[2][2][2];
#pragma unroll
    for (int d = 0; d < 2; ++d)
#pragma unroll
        for (int a = 0; a < 2; ++a)
#pragma unroll
            for (int c = 0; c < 2; ++c)
#pragma unroll
                for (int r = 0; r < 16; ++r) acc[d][a][c][r] = 0.f;
    bf16x8 nk[4], nv[4];
#pragma unroll
    for (int i = 0; i < 4; ++i) { nk[i] = *(const bf16x8*)(Kb + loff + 8 * i * SEGW); nv[i] = *(const bf16x8*)(Vb + loff + 8 * i * SEGW); }
#pragma unroll 1
    for (int it = 0; it < 4; ++it) {
#pragma unroll
        for (int i = 0; i < 4; ++i) { const int key = 32 * it + tr + 8 * i;
            *(LAS bf16x8*)(tw + 8 * i * TP) = scale8(nk[i], __builtin_amdgcn_exp2f((float)(CHUNK - 1 - key) * lgf));
            *(LAS bf16x8*)(tw + 32 * TP + 8 * i * TP) = scale8(nk[i], __builtin_amdgcn_exp2f((float)key * lgb));
            *(LAS bf16x8*)(tw + 64 * TP + 8 * i * TP) = nv[i]; }
        if (it < 3) {
#pragma unroll
            for (int i = 0; i < 4; ++i) { nk[i] = *(const bf16x8*)(Kb + 32 * (it + 1) * SEGW + loff + 8 * i * SEGW); nv[i] = *(const bf16x8*)(Vb + 32 * (it + 1) * SEGW + loff + 8 * i * SEGW); } }
        asm volatile("" ::: "memory");
#pragma unroll
        for (int s2 = 0; s2 < 2; ++s2) {
            bf16x8 bv[2];
#pragma unroll
            for (int c = 0; c < 2; ++c) bv[c] = cat44(vtr(Tv + tro + s2 * 16 * TP + c * 64), vtr(Tv + tro + s2 * 16 * TP + 4 * TP + c * 64));
#pragma unroll
            for (int a = 0; a < 2; ++a) {
                const bf16x8 af = cat44(vtr(Tf + tro + s2 * 16 * TP + a * 64), vtr(Tf + tro + s2 * 16 * TP + 4 * TP + a * 64));
                const bf16x8 ab = cat44(vtr(Tb + tro + s2 * 16 * TP + a * 64), vtr(Tb + tro + s2 * 16 * TP + 4 * TP + a * 64));
#pragma unroll
                for (int c = 0; c < 2; ++c) { acc[0][a][c] = MFMA32(af, bv[c], acc[0][a][c]); acc[1][a][c] = MFMA32(ab, bv[c], acc[1][a][c]); }
            }
        }
        asm volatile("" ::: "memory");
    }
#pragma unroll
    for (int d = 0; d < 2; ++d) { bf16* ob = KV + (((size_t)bh * NCHUNK + n) * 2 + d) * 4096;
#pragma unroll
        for (int a = 0; a < 2; ++a)
#pragma unroll
            for (int c = 0; c < 2; ++c)
#pragma unroll
                for (int g = 0; g < 4; ++g) { u32x2 w; w.x = pk2(acc[d][a][c][4 * g], acc[d][a][c][4 * g + 1]); w.y = pk2(acc[d][a][c][4 * g + 2], acc[d][a][c][4 * g + 3]);
                    *(u32x2*)(ob + ((c * 4 + 2 * a + (g >> 1)) * 64 + q + 32 * (g & 1)) * 8 + 4 * hi) = w; } }
}

struct AttnRound { size_t rowbase; int dil, qb0, nblk, h, br; };
__device__ __forceinline__ AttnRound round_decode(int rg) {
    AttnRound a; const int bh = rg / 48, x = rg - bh * 48, br = x >> 4, w16 = x & 15; int cls, qb0;
    if (br == 0) { cls = 0; qb0 = 8 * w16; } else if (br == 1) { cls = w16 >> 2; qb0 = 8 * (w16 & 3); } else { cls = w16; qb0 = 0; }
    a.rowbase = (size_t)(bh >> 3) * SEQ + cls; a.dil = 1 << (2 * br); a.qb0 = qb0; a.nblk = (SEQ >> (2 * br)) >> 5; a.h = bh & 7; a.br = br; return a;
}
__device__ __forceinline__ int round_id(int r0, int xl, int rr) { if (xl < 0) return r0 + rr; const int t = rr / 3, i = rr - 3 * t; return (r0 + 2 * t + (xl >> 4)) * 48 + 3 * (xl & 15) + i; }
__device__ __forceinline__ void attn_rounds(int r0, int xl, int nr, const bf16* QA, const bf16* KA, const bf16* VA, bf16* OBR, float* LSE, LAS unsigned char* lds, int wave, int lane) {
    const int q = lane & 31, hi = lane >> 5, tr = lane >> 3, tc = (lane & 7) * 8;
    LAS unsigned char* Qt = lds + (24 + wave) * (32 * TP);
    const int twoff = tr * TP + tc * 2;
    bf16x8 pt[3][4], pq[4];
    AttnRound nx = round_decode(round_id(r0, xl, 0));
#define ATT_PREFETCH(R) do { \
        _Pragma("unroll") for (int x_ = 0; x_ < 3; ++x_) { const int tile = 3 * wave + x_, slot = tile >= 12 ? tile - 12 : tile, j_ = (R).qb0 - 2 + slot; \
            if (j_ >= 0 && j_ < (R).nblk) { const bf16* src = (tile >= 12 ? VA : KA) + ((R).rowbase + (size_t)(R).dil * (32 * j_ + tr)) * SEGW + (R).h * HD + tc; \
                _Pragma("unroll") for (int i_ = 0; i_ < 4; ++i_) pt[x_][i_] = *(const bf16x8*)(src + (size_t)(R).dil * 8 * i_ * SEGW); } } \
        { const bf16* src = QA + ((R).rowbase + (size_t)(R).dil * (32 * ((R).qb0 + wave) + tr)) * SEGW + (R).h * HD + tc; \
          _Pragma("unroll") for (int i_ = 0; i_ < 4; ++i_) pq[i_] = *(const bf16x8*)(src + (size_t)(R).dil * 8 * i_ * SEGW); } } while (0)
    ATT_PREFETCH(nx);
#pragma unroll 1
    for (int rr = 0; rr < nr; ++rr) {
        const AttnRound cu = nx;
        __syncthreads();
#pragma unroll
        for (int x = 0; x < 3; ++x) { const int tile = 3 * wave + x, slot = tile >= 12 ? tile - 12 : tile, j = cu.qb0 - 2 + slot;
            if (j >= 0 && j < cu.nblk) { LAS unsigned char* tb = lds + tile * (32 * TP) + twoff;
#pragma unroll
                for (int i = 0; i < 4; ++i) *(LAS bf16x8*)(tb + 8 * i * TP) = pt[x][i]; } }
#pragma unroll
        for (int i = 0; i < 4; ++i) *(LAS bf16x8*)(Qt + twoff + 8 * i * TP) = pq[i];
        if (rr + 1 < nr) { nx = round_decode(round_id(r0, xl, rr + 1)); ATT_PREFETCH(nx); }
        __syncthreads();
        bf16x8 qr[4];
#pragma unroll
        for (int ks = 0; ks < 4; ++ks) qr[ks] = *(const LAS bf16x8*)(Qt + q * TP + hi * 16 + 32 * ks);
        float mrun = -1e30f, lsum = 0.f; f32x16 ot0, ot1;
#pragma unroll
        for (int r = 0; r < 16; ++r) { ot0[r] = 0.f; ot1[r] = 0.f; }
        const int jb = cu.qb0 + wave - 2, klo = jb < 0 ? -jb : 0, khi = jb + 4 >= cu.nblk ? cu.nblk - 1 - jb : 4;
        f32x16 stn;
#define ATT_QK(dst, kb_) do { const LAS unsigned char* Kt_ = lds + (wave + (kb_)) * (32 * TP); _Pragma("unroll") for (int r_ = 0; r_ < 16; ++r_) dst[r_] = 0.f; \
            _Pragma("unroll") for (int ks_ = 0; ks_ < 4; ++ks_) dst = MFMA32(*(const LAS bf16x8*)(Kt_ + q * TP + hi * 16 + 32 * ks_), qr[ks_], dst); } while (0)
        ATT_QK(stn, klo);
#pragma unroll 1
        for (int kb = klo; kb <= khi; ++kb) {
            f32x16 st = stn;
            if (kb < khi) ATT_QK(stn, kb + 1);
            const LAS unsigned char* Vt = lds + (12 + wave + kb) * (32 * TP);
            if (kb == 0) {
#pragma unroll
                for (int r = 0; r < 16; ++r) if (crow(r, hi) < q) st[r] = -1e30f;
            }
            if (kb == 4) {
#pragma unroll
                for (int r = 0; r < 16; ++r) if (crow(r, hi) > q) st[r] = -1e30f;
            }
            float mx = st[0];
#pragma unroll
            for (int r = 1; r < 16; ++r) mx = fmaxf(mx, st[r]);
            mx = fmaxf(mx, __shfl_xor(mx, 32));
            if (!__all(mx <= mrun + 8.f)) {
                const float mnew = fmaxf(mrun, mx), alpha = __builtin_amdgcn_exp2f(mrun - mnew); mrun = mnew; lsum *= alpha;
#pragma unroll
                for (int r = 0; r < 16; ++r) { ot0[r] *= alpha; ot1[r] *= alpha; }
            }
            float ps = 0.f;
#pragma unroll
            for (int r = 0; r < 16; ++r) { st[r] = __builtin_amdgcn_exp2f(st[r] - mrun); ps += st[r]; }
            lsum += ps;
            pv_tile_p(ot0, ot1, st, Vt, lane);
        }
#undef ATT_QK
        const float lt = lsum + __shfl_xor(lsum, 32);
        const float inv = 1.f / lt, lse = (mrun + __log2f(lt)) * LN2;
        asm volatile("" ::: "memory");
        LAS unsigned char* ow = Qt + q * TP + 8 * hi;
#pragma unroll
        for (int g = 0; g < 4; ++g) {
            u32x2 w0, w1; w0.x = pk2(ot0[4 * g] * inv, ot0[4 * g + 1] * inv); w0.y = pk2(ot0[4 * g + 2] * inv, ot0[4 * g + 3] * inv);
            w1.x = pk2(ot1[4 * g] * inv, ot1[4 * g + 1] * inv); w1.y = pk2(ot1[4 * g + 2] * inv, ot1[4 * g + 3] * inv);
            *(LAS u32x2*)(ow + 16 * g) = w0; *(LAS u32x2*)(ow + 64 + 16 * g) = w1; }
        asm volatile("" ::: "memory");
        const size_t qbase = cu.rowbase + (size_t)cu.dil * 32 * (cu.qb0 + wave);
#pragma unroll
        for (int i = 0; i < 4; ++i) { const u32x4 v = *(const LAS u32x4*)(Qt + twoff + 8 * i * TP);
            *(u32x4*)(OBR + ((size_t)cu.br * M + qbase + (size_t)cu.dil * (tr + 8 * i)) * SEGW + cu.h * HD + tc) = v; }
        if (hi == 0) LSE[((size_t)cu.br * M + qbase + (size_t)cu.dil * q) * NHEAD + cu.h] = lse;
        asm volatile("" ::: "memory");
    }
#undef ATT_PREFETCH
    __syncthreads();
}

constexpr int R_K = 0, R_V = 128 * TP, R_Q = 2 * 128 * TP, R_G = 3 * 128 * TP, R_O = 4 * 128 * TP, R_SF = 5 * 128 * TP, R_SB = R_SF + 8192, R_X = R_SB + 8192;
__device__ __forceinline__ void ret_wg(int wgt, const bf16* QR, const bf16* KR, const bf16* VR, const bf16* GR, const bf16* KV, bf16* SBW, bf16* MIXED, const float* dec_f, const float* dec_b,
                                       const bf16* OBR, const float* LSE, long crow0, LAS unsigned char* lds, int tid, int wave, int lane) {
    const int bh = wgt >> 2, n0 = (wgt & 3) * 8, b = bh >> 3, h = bh & 7, q = lane & 31, hi = lane >> 5, tr = lane >> 3, tc = (lane & 7) * 8;
    const float lgf = __uint_as_float(__builtin_amdgcn_readfirstlane(__float_as_uint(log1pf(-exp2f(dec_f[h])) * LOG2E))), lgb = __uint_as_float(__builtin_amdgcn_readfirstlane(__float_as_uint(log1pf(-exp2f(dec_b[h])) * LOG2E)));
    const float gf128 = exp2f(128.f * lgf), gb128 = exp2f(128.f * lgb);
    float pf[16], pb[16];
#pragma unroll
    for (int r = 0; r < 16; ++r) { const int dl = q - crow(r, hi); pf[r] = exp2f((float)dl * lgf); pb[r] = exp2f((float)(-dl) * lgb); }
    const bf16* KVt = KV + (size_t)bh * NCHUNK * 2 * 4096 + 8 * tid;
    bf16* SBt = SBW + (size_t)bh * NCHUNK * 4096 + 8 * tid;
    float Sf[8], Sb[8];
#pragma unroll
    for (int e = 0; e < 8; ++e) { Sf[e] = 0.f; Sb[e] = 0.f; }
#define RET_AXPY(S, g, v) do { S[0] = S[0] * (g) + bflo((v).x); S[1] = S[1] * (g) + bfhi((v).x); S[2] = S[2] * (g) + bflo((v).y); S[3] = S[3] * (g) + bfhi((v).y); \
                               S[4] = S[4] * (g) + bflo((v).z); S[5] = S[5] * (g) + bfhi((v).z); S[6] = S[6] * (g) + bflo((v).w); S[7] = S[7] * (g) + bfhi((v).w); } while (0)
    for (int m0 = 0; m0 < n0; m0 += 8) { u32x4 v[8];
#pragma unroll
        for (int k = 0; k < 8; ++k) v[k] = *(const u32x4*)(KVt + (size_t)((m0 + k) * 2) * 4096);
#pragma unroll
        for (int k = 0; k < 8; ++k) RET_AXPY(Sf, gf128, v[k]); }
    for (int m0 = NCHUNK - 8; m0 >= n0 + 8; m0 -= 8) { u32x4 v[8];
#pragma unroll
        for (int k = 0; k < 8; ++k) v[k] = *(const u32x4*)(KVt + (size_t)((m0 + 7 - k) * 2 + 1) * 4096);
#pragma unroll
        for (int k = 0; k < 8; ++k) RET_AXPY(Sb, gb128, v[k]); }
    { u32x4 v[8];
#pragma unroll
      for (int k = 0; k < 8; ++k) v[k] = *(const u32x4*)(KVt + (size_t)((n0 + 7 - k) * 2 + 1) * 4096);
#pragma unroll
      for (int k = 0; k < 8; ++k) { u32x4 w; w.x = pk2(Sb[0], Sb[1]); w.y = pk2(Sb[2], Sb[3]); w.z = pk2(Sb[4], Sb[5]); w.w = pk2(Sb[6], Sb[7]);
          *(u32x4*)(SBt + (size_t)(n0 + 7 - k) * 4096) = w; RET_AXPY(Sb, gb128, v[k]); } }
    VM_WAIT();
    const int tsel = wave >> 1, rbase = 64 * (wave & 1) + tr;
    const bf16* tsrc = (tsel == 0 ? KR : tsel == 1 ? VR : tsel == 2 ? QR : GR) + ((size_t)b * SEQ + rbase) * SEGW + h * HD + tc;
    LAS unsigned char* tdst = lds + tsel * (128 * TP) + rbase * TP + tc * 2;
    const int qb = wave & 3, dvh = wave >> 2;
    bf16x8 pre[8]; u32x4 pkv, psb;
#define RET_PREFETCH(n_) do { _Pragma("unroll") for (int i_ = 0; i_ < 8; ++i_) pre[i_] = __builtin_nontemporal_load((const bf16x8*)(tsrc + (size_t)((n_) * CHUNK + 8 * i_) * SEGW)); \
        pkv = *(const u32x4*)(KVt + (size_t)((n_) * 2) * 4096); psb = *(const u32x4*)(SBt + (size_t)(n_) * 4096); } while (0)
    RET_PREFETCH(n0);
#pragma unroll 1
    for (int jn = 0; jn < 8; ++jn) {
        const int n = n0 + jn; const size_t row0 = (size_t)b * SEQ + n * CHUNK;
        __syncthreads();
        if (jn > 0) {
#pragma unroll
            for (int i = 0; i < 2; ++i) { const int r = 16 * wave + 8 * i + tr; const u32x4 v = *(const LAS u32x4*)(lds + R_O + r * TP + tc * 2);
                *(u32x4*)(MIXED + (row0 - CHUNK + r) * DM + 512 + h * HD + tc) = v; } }
#pragma unroll
        for (int i = 0; i < 8; ++i) *(LAS bf16x8*)(tdst + 8 * i * TP) = pre[i];
        { u32x4 w; w.x = pk2(Sf[0], Sf[1]); w.y = pk2(Sf[2], Sf[3]); w.z = pk2(Sf[4], Sf[5]); w.w = pk2(Sf[6], Sf[7]);
          *(LAS u32x4*)(lds + R_SF + tid * 16) = w; *(LAS u32x4*)(lds + R_SB + tid * 16) = psb; }
        RET_AXPY(Sf, gf128, pkv);
        if (jn < 7) RET_PREFETCH(n + 1);
        float cl[3]; u32x4 ca[3];
#define RET_CLOAD(rw_) do { _Pragma("unroll") for (int br_ = 0; br_ < 3; ++br_) { cl[br_] = LSE[((size_t)br_ * M + (rw_)) * NHEAD + (lane >> 3)]; ca[br_] = __builtin_nontemporal_load((const u32x4*)(OBR + ((size_t)br_ * M + (rw_)) * SEGW + 8 * lane)); } } while (0)
#define RET_CFIN(rw_) do { const float mx_ = fmaxf(cl[0], fmaxf(cl[1], cl[2])); float w0_ = __expf(cl[0] - mx_), w1_ = __expf(cl[1] - mx_), w2_ = __expf(cl[2] - mx_); \
            const float inv_ = 1.f / (w0_ + w1_ + w2_); w0_ *= inv_; w1_ *= inv_; w2_ *= inv_; float o_[8]; float ssq_ = 0.f; \
            _Pragma("unroll") for (int e_ = 0; e_ < 4; ++e_) { o_[2 * e_] = w0_ * bflo(ca[0][e_]) + w1_ * bflo(ca[1][e_]) + w2_ * bflo(ca[2][e_]); o_[2 * e_ + 1] = w0_ * bfhi(ca[0][e_]) + w1_ * bfhi(ca[1][e_]) + w2_ * bfhi(ca[2][e_]); ssq_ += o_[2 * e_] * o_[2 * e_] + o_[2 * e_ + 1] * o_[2 * e_ + 1]; } \
            const float rs_ = 1.f / sqrtf(wave_sum(ssq_) * (1.f / 512.f) + NORM_EPS); \
            u32x4 w_; w_.x = pk2(o_[0] * rs_, o_[1] * rs_); w_.y = pk2(o_[2] * rs_, o_[3] * rs_); w_.z = pk2(o_[4] * rs_, o_[5] * rs_); w_.w = pk2(o_[6] * rs_, o_[7] * rs_); \
            *(u32x4*)(MIXED + (rw_) * DM + 8 * lane) = w_; } while (0)
        if (crow0 >= 0) RET_CLOAD((size_t)crow0 + 2 * jn);
        __syncthreads();
        const int i_ = 32 * qb + q;
        bf16x8 qr[4];
#pragma unroll
        for (int ks = 0; ks < 4; ++ks) qr[ks] = *(const LAS bf16x8*)(lds + R_Q + i_ * TP + hi * 16 + 32 * ks);
        f32x16 ot;
#pragma unroll
        for (int r = 0; r < 16; ++r) ot[r] = 0.f;
        const LAS unsigned char* vr = lds + R_V + (4 * hi + ((lane & 15) >> 2)) * TP + (32 * dvh + 16 * ((lane >> 4) & 1) + 4 * (lane & 3)) * 2;
#pragma unroll 1
        for (int kb = 0; kb < 4; ++kb) {
            f32x16 st;
#pragma unroll
            for (int r = 0; r < 16; ++r) st[r] = 0.f;
#pragma unroll
            for (int ks = 0; ks < 4; ++ks) st = MFMA32(*(const LAS bf16x8*)(lds + R_K + (32 * kb + q) * TP + hi * 16 + 32 * ks), qr[ks], st);
#pragma unroll
            for (int r = 0; r < 16; ++r) st[r] *= (kb == qb ? (q >= crow(r, hi) ? pf[r] : pb[r]) : kb < qb ? pf[r] : pb[r]);
            if (kb != qb) { const float sc = kb < qb ? exp2f((float)(32 * (qb - kb)) * lgf) : exp2f((float)(32 * (kb - qb)) * lgb);
#pragma unroll
                for (int r = 0; r < 16; ++r) st[r] *= sc; }
            const bf16x8 pb0 = pack8(st, 0), pb1 = pack8(st, 1);
            const LAS unsigned char* v0 = vr + 32 * kb * TP;
            ot = MFMA32(cat44(vtr(v0), vtr(v0 + 8 * TP)), pb0, ot);
            ot = MFMA32(cat44(vtr(v0 + 16 * TP), vtr(v0 + 24 * TP)), pb1, ot);
        }
        {   const float cf = exp2f((float)(i_ + 1) * lgf), cb = exp2f((float)(CHUNK - i_) * lgb);
            f32x16 t;
#pragma unroll
            for (int r = 0; r < 16; ++r) t[r] = 0.f;
#pragma unroll
            for (int ks = 0; ks < 4; ++ks) t = MFMA32(*(const LAS bf16x8*)(lds + R_SF + ((dvh * 4 + ks) * 64 + lane) * 16), qr[ks], t);
#pragma unroll
            for (int r = 0; r < 16; ++r) ot[r] += cf * t[r];
#pragma unroll
            for (int r = 0; r < 16; ++r) t[r] = 0.f;
#pragma unroll
            for (int ks = 0; ks < 4; ++ks) t = MFMA32(*(const LAS bf16x8*)(lds + R_SB + ((dvh * 4 + ks) * 64 + lane) * 16), qr[ks], t);
#pragma unroll
            for (int r = 0; r < 16; ++r) ot[r] += cb * t[r]; }
        if (crow0 >= 0) { RET_CFIN((size_t)crow0 + 2 * jn); RET_CLOAD((size_t)crow0 + 2 * jn + 1); }
        float s1 = 0.f, s2 = 0.f;
#pragma unroll
        for (int r = 0; r < 16; ++r) { s1 += ot[r]; s2 += ot[r] * ot[r]; }
        s1 += __shfl_xor(s1, 32); s2 += __shfl_xor(s2, 32);
        if (hi == 0) *(LAS f32x2*)(lds + R_X + (wave * 32 + q) * 8) = (f32x2){s1, s2};
        __syncthreads();
        { const f32x2 p = *(const LAS f32x2*)(lds + R_X + ((wave ^ 4) * 32 + q) * 8); s1 += p.x; s2 += p.y; }
        const float mean = s1 * (1.f / 64.f), var = fmaxf(s2 * (1.f / 64.f) - mean * mean, 0.f), rstd = 1.f / sqrtf(var + NORM_EPS);
        const LAS unsigned char* gp = lds + R_G + i_ * TP + (32 * dvh + 4 * hi) * 2; LAS unsigned char* op = lds + R_O + i_ * TP + (32 * dvh + 4 * hi) * 2;
#pragma unroll
        for (int g = 0; g < 4; ++g) { const u32x2 gg = *(const LAS u32x2*)(gp + 16 * g); u32x2 w;
            w.x = pk2((ot[4 * g] - mean) * rstd * bflo(gg.x), (ot[4 * g + 1] - mean) * rstd * bfhi(gg.x)); w.y = pk2((ot[4 * g + 2] - mean) * rstd * bflo(gg.y), (ot[4 * g + 3] - mean) * rstd * bfhi(gg.y));
            *(LAS u32x2*)(op + 16 * g) = w; }
        if (crow0 >= 0) RET_CFIN((size_t)crow0 + 2 * jn + 1);
    }
#undef RET_CLOAD
#undef RET_CFIN
    __syncthreads();
    { const size_t row0 = (size_t)b * SEQ + (n0 + 7) * CHUNK;
#pragma unroll
      for (int i = 0; i < 2; ++i) { const int r = 16 * wave + 8 * i + tr; const u32x4 v = *(const LAS u32x4*)(lds + R_O + r * TP + tc * 2);
          *(u32x4*)(MIXED + (row0 + r) * DM + 512 + h * HD + tc) = v; } }
    __syncthreads();
#undef RET_AXPY
#undef RET_PREFETCH
}

template <int NR>
__device__ __forceinline__ void combine_rows(const size_t (&rows)[NR], const bf16* OBR, const float* LSE, bf16* MIXED, int lane) {
    const int hh = lane >> 3;
    float l[NR][3]; u32x4 a[NR][3];
#pragma unroll
    for (int k = 0; k < NR; ++k)
#pragma unroll
        for (int br = 0; br < 3; ++br) { l[k][br] = LSE[((size_t)br * M + rows[k]) * NHEAD + hh]; a[k][br] = *(const u32x4*)(OBR + ((size_t)br * M + rows[k]) * SEGW + 8 * lane); }
#pragma unroll
    for (int k = 0; k < NR; ++k) {
        const float mx = fmaxf(l[k][0], fmaxf(l[k][1], l[k][2])); float w0 = __expf(l[k][0] - mx), w1 = __expf(l[k][1] - mx), w2 = __expf(l[k][2] - mx);
        const float inv = 1.f / (w0 + w1 + w2); w0 *= inv; w1 *= inv; w2 *= inv;
        float o[8]; float ss = 0.f;
#pragma unroll
        for (int e = 0; e < 4; ++e) { o[2 * e] = w0 * bflo(a[k][0][e]) + w1 * bflo(a[k][1][e]) + w2 * bflo(a[k][2][e]); o[2 * e + 1] = w0 * bfhi(a[k][0][e]) + w1 * bfhi(a[k][1][e]) + w2 * bfhi(a[k][2][e]); ss += o[2 * e] * o[2 * e] + o[2 * e + 1] * o[2 * e + 1]; }
        const float rstd = 1.f / sqrtf(wave_sum(ss) * (1.f / 512.f) + NORM_EPS);
        u32x4 w; w.x = pk2(o[0] * rstd, o[1] * rstd); w.y = pk2(o[2] * rstd, o[3] * rstd); w.z = pk2(o[4] * rstd, o[5] * rstd); w.w = pk2(o[6] * rstd, o[7] * rstd);
        *(u32x4*)(MIXED + rows[k] * DM + 8 * lane) = w;
    }
}
constexpr int RP = 528;
constexpr int R5_W = 0, R5_A = 2 * 48 * RP, R5_SC = R5_A + 8 * 16 * RP, R5_CNT = R5_SC + 8 * 3200;
__device__ __forceinline__ void route_wg(int wgt, const bf16* HB, const bf16* WR, const float* bg, const float* be, gu32* ctl, int* LIST, float* GATEL, float* RSL, LAS unsigned char* lds, int tid, int wave, int lane) {
    const size_t row0 = (size_t)wgt * 128;
    LAS unsigned* cntL = (LAS unsigned*)(lds + R5_CNT); LAS unsigned* baseL = cntL + 32;
    if (tid < 32) cntL[tid] = 0u;
    u32x4 pw[6], pa[8];
#define R5_PREF(kc) do { _Pragma("unroll") for (int i_ = 0; i_ < 6; ++i_) { const int idx = tid + 512 * i_; pw[i_] = *(const u32x4*)(WR + (size_t)(idx >> 5) * DM + 256 * (kc) + 8 * (idx & 31)); } \
        _Pragma("unroll") for (int i_ = 0; i_ < 8; ++i_) pa[i_] = *(const u32x4*)(HB + (row0 + 16 * wave + 2 * i_ + (lane >> 5)) * DM + 256 * (kc) + 8 * (lane & 31)); } while (0)
    R5_PREF(0);
    f32x4 acc[3]; float ss = 0.f;
#pragma unroll
    for (int c = 0; c < 3; ++c) acc[c] = (f32x4){0.f, 0.f, 0.f, 0.f};
    const LAS unsigned char* Aw = lds + R5_A + wave * 16 * RP;
#pragma unroll 1
    for (int kc = 0; kc < 4; ++kc) {
        __syncthreads();
#pragma unroll
        for (int i = 0; i < 6; ++i) { const int idx = tid + 512 * i; *(LAS u32x4*)(lds + R5_W + (idx >> 5) * RP + (idx & 31) * 16) = pw[i]; }
#pragma unroll
        for (int i = 0; i < 8; ++i) *(LAS u32x4*)(lds + R5_A + (wave * 16 + 2 * i + (lane >> 5)) * RP + (lane & 31) * 16) = pa[i];
        if (kc < 3) R5_PREF(kc + 1);
        __syncthreads();
#pragma unroll
        for (int ks = 0; ks < 8; ++ks) {
            const int ko = (32 * ks + 8 * (lane >> 4)) * 2;
            const bf16x8 a = *(const LAS bf16x8*)(Aw + (lane & 15) * RP + ko);
            { const u32x4 au = __builtin_bit_cast(u32x4, a);
#pragma unroll
              for (int e = 0; e < 4; ++e) { const float lo = bflo(au[e]), hi_ = bfhi(au[e]); ss += lo * lo + hi_ * hi_; } }
#pragma unroll
            for (int c = 0; c < 3; ++c)
#pragma unroll
                for (int p = 0; p < 2; ++p) { const bf16x8 bb = *(const LAS bf16x8*)(lds + R5_W + (p * 48 + 16 * c + (lane & 15)) * RP + ko);
                    acc[c] = __builtin_amdgcn_mfma_f32_16x16x32_bf16(a, bb, acc[c], 0, 0, 0); }
        }
    }
#undef R5_PREF
    ss += __shfl_xor(ss, 16); ss += __shfl_xor(ss, 32);
    const float rstd = 1.f / sqrtf(ss * (1.f / DM) + NORM_EPS);
    LAS float* sc = (LAS float*)(lds + R5_SC + wave * 3200);
    { const int r = lane & 15, g = lane >> 4;
#pragma unroll
      for (int e = 0; e < 4; ++e) { sc[(4 * g + e) * 48 + r] = acc[0][e]; sc[(4 * g + e) * 48 + 16 + r] = acc[1][e]; sc[(4 * g + e) * 48 + 32 + r] = acc[2][e]; }
      if (g == 0) sc[768 + r] = rstd; }
    LDS_WAIT(); asm volatile("" ::: "memory");
    int e1 = 0, e2 = 0; unsigned r1 = 0, r2 = 0; float g1 = 0.f, g2 = 0.f, rs = 0.f;
    if (lane < 16) {
        rs = sc[768 + lane]; const LAS float* lg = sc + lane * 48;
        float gmax = lg[32] * rs + bg[0]; int gi = 0; float gl[4]; gl[0] = gmax;
#pragma unroll
        for (int k = 1; k < 4; ++k) { gl[k] = lg[32 + k] * rs + bg[k]; if (gl[k] > gmax) { gmax = gl[k]; gi = k; } }
        float den = 0.f;
#pragma unroll
        for (int k = 0; k < 4; ++k) den += __expf(gl[k] - gmax);
        const float ggate = 1.f / den;
        float b1v = -3.0e38f, b2v = -3.0e38f; int i1 = 0, i2 = 0;
        for (int k = 0; k < 8; ++k) { const float v = lg[gi * 8 + k] * rs + be[gi * 8 + k]; if (v > b1v) { b1v = v; i1 = k; } }
        for (int k = 0; k < 8; ++k) { const float v = lg[gi * 8 + k] * rs + be[gi * 8 + k]; if (k != i1 && v > b2v) { b2v = v; i2 = k; } }
        const float p1 = 1.f / (1.f + __expf(b2v - b1v));
        g1 = ggate * p1; g2 = ggate * (1.f - p1); e1 = gi * 8 + i1; e2 = gi * 8 + i2;
        r1 = __hip_atomic_fetch_add(cntL + e1, 1u, __ATOMIC_RELAXED, __HIP_MEMORY_SCOPE_WORKGROUP); r2 = __hip_atomic_fetch_add(cntL + e2, 1u, __ATOMIC_RELAXED, __HIP_MEMORY_SCOPE_WORKGROUP);
    }
    __syncthreads();
    if (tid < 32) { const unsigned c = cntL[tid]; baseL[tid] = c ? __hip_atomic_fetch_add(ctl + CW_CNT + 64 * tid, c, RLX_AGENT) : 0u; }
    __syncthreads();
    if (lane < 16) {
        const size_t trow = row0 + 16 * wave + lane; const size_t s1 = (size_t)e1 * M + baseL[e1] + r1, s2 = (size_t)e2 * M + baseL[e2] + r2;
        LIST[s1] = (int)(trow * 2); GATEL[s1] = g1; RSL[s1] = rs;
        LIST[s2] = (int)(trow * 2 + 1); GATEL[s2] = g2; RSL[s2] = rs;
    }
    __syncthreads();
}
template <int NR>
__device__ __forceinline__ void final_rows(const size_t (&rows)[NR], const bf16* H, const bf16* Y, const f32x4 (&gv)[4], float* out, int lane) {
    u32x2 hv[NR][4], a[NR][4], b[NR][4];
#pragma unroll
    for (int k = 0; k < NR; ++k) { const u32x2* hp = (const u32x2*)(H + rows[k] * DM) + lane; const u32x2* y0 = (const u32x2*)(Y + (rows[k] * 2) * DM) + lane; const u32x2* y1 = (const u32x2*)(Y + (rows[k] * 2 + 1) * DM) + lane;
#pragma unroll
        for (int j = 0; j < 4; ++j) { hv[k][j] = __builtin_nontemporal_load(hp + 64 * j); a[k][j] = __builtin_nontemporal_load(y0 + 64 * j); b[k][j] = __builtin_nontemporal_load(y1 + 64 * j); } }
#pragma unroll
    for (int k = 0; k < NR; ++k) { f32x4 z[4]; float ss = 0.f;
#pragma unroll
        for (int j = 0; j < 4; ++j) {
            z[j][0] = bflo(hv[k][j].x) + bflo(a[k][j].x) + bflo(b[k][j].x); z[j][1] = bfhi(hv[k][j].x) + bfhi(a[k][j].x) + bfhi(b[k][j].x); z[j][2] = bflo(hv[k][j].y) + bflo(a[k][j].y) + bflo(b[k][j].y); z[j][3] = bfhi(hv[k][j].y) + bfhi(a[k][j].y) + bfhi(b[k][j].y);
            ss += (z[j][0] * z[j][0] + z[j][1] * z[j][1]) + (z[j][2] * z[j][2] + z[j][3] * z[j][3]); }
        const float rstd = 1.f / sqrtf(wave_sum(ss) * (1.f / DM) + NORM_EPS);
        f32x4* op = (f32x4*)(out + rows[k] * DM) + lane;
#pragma unroll
        for (int j = 0; j < 4; ++j) __builtin_nontemporal_store(z[j] * rstd * gv[j], op + 64 * j); }
}
__device__ __forceinline__ TileTab build_tiles(Frame& F, int& ntiles) {
    LAS int* T = (LAS int*)(F.lds + TILE_OFF); LAS int* TE = T; LAS int* NE = T + MAXTILES; LAS int* T0 = NE + 32; LAS int* NT = T0 + 32;
    __syncthreads();
    if (F.tid == 0) { int t = 0;
        for (int e = 0; e < NEXP; ++e) { int n = (int)__hip_atomic_load(F.ctl + CW_CNT + 64 * e, RLX_AGENT); if (n > M) n = M; NE[e] = n; T0[e] = t; const int k = (n + 255) >> 8;
            for (int j = 0; j < k && t + j < MAXTILES; ++j) TE[t + j] = e; t += k; if (t > MAXTILES) t = MAXTILES; }
        NT[0] = t; }
    __syncthreads();
    ntiles = NT[0];
    TileTab tt; tt.TE = TE; tt.NE = NE; tt.T0 = T0; return tt;
}

__device__ __forceinline__ int fresh_lane() { int t = threadIdx.x; asm volatile("" : "+v"(t)); return t & 63; }
constexpr int N_LAUNCHES = MK_N_LAUNCHES, PER_PHASE = 9;
__global__ void __launch_bounds__(NWAVES * 64, 2) mk_fwd(Args args) {
    extern __shared__ __attribute__((aligned(16))) unsigned char lds_raw[];
    Frame F;
    F.lds = (LAS unsigned char*)lds_raw;
    F.MISC = (volatile LAS unsigned*)(F.lds + MISC_OFF);
    F.tid = threadIdx.x; F.lane = F.tid & 63; F.wave = __builtin_amdgcn_readfirstlane(F.tid >> 6);
    F.G = gridDim.x; { const int bx = blockIdx.x; F.vcu = (F.G % 8 == 0) ? (bx % 8) * (F.G / 8) + bx / 8 : bx; }
    unsigned char* ws = args.ws;
    F.ctl = (gu32*)(ws + WS_CTL);
    for (int u = F.tid; u < (LDS_BYTES - LDSCTL_OFF) / 4; u += NWAVES * 64) ((LAS unsigned*)(F.lds + LDSCTL_OFF))[u] = 0u;
    __syncthreads();
    XcdBarrier bar; bar.bar = (unsigned*)(F.ctl + CW_BAR); bar.x = 0; bar.st = nullptr;
    if (N_LAUNCHES != PER_PHASE) bar = xcd_barrier_post((unsigned*)(F.ctl + CW_BAR) + args.li * XCD_BAR_WORDS, F.MISC + 8);
#define GRID_BAR() do { if (N_LAUNCHES != PER_PHASE) xcd_barrier(bar); } while (0)
    const int lo = args.ph_lo, hi = args.ph_hi;
#define IN(k) (lo <= (k) && (k) < hi)
#define REPS(k) ((MK_REPEAT == (k)) ? MK_NREP : 1)
#define BOTH(k) (IN(k) && IN((k) + 1))
    const int gw = F.vcu * NWAVES + F.wave, NGW = F.G * NWAVES;
#if MK_TIME
    int n_stamp = 0;
#define STAMP() do { if (blockIdx.x == 0 && F.tid == 0) { const unsigned long long t_ = __builtin_amdgcn_s_memrealtime(); __hip_atomic_store(F.ctl + CW_TS + 2 * n_stamp, (unsigned)t_, RLX_AGENT); __hip_atomic_store(F.ctl + CW_TS + 2 * n_stamp + 1, (unsigned)(t_ >> 32), RLX_AGENT); } ++n_stamp; } while (0)
    STAMP();
#else
#define STAMP() do {} while (0)
#endif
    bf16* SEGB = (bf16*)(ws + WS_SEG);
    const bf16 *QA = SEGB, *KA = SEGB + (size_t)1 * M * SEGW, *VA = SEGB + (size_t)2 * M * SEGW, *QR = SEGB + (size_t)3 * M * SEGW, *KR = SEGB + (size_t)4 * M * SEGW, *VR = SEGB + (size_t)5 * M * SEGW, *GR = SEGB + (size_t)6 * M * SEGW;

    for (int rep_ = 0; rep_ < REPS(0); ++rep_) if (IN(0)) { p0_prologue(F, args); if (BOTH(0)) GRID_BAR(); STAMP(); }
    for (int rep_ = 0; rep_ < REPS(1); ++rep_) if (IN(1)) {
        const int bx = (int)blockIdx.x, rowg = bx >> 3; const bool split = (F.G == 256), conv = split && ((rowg & 7) == 7);
        if (conv) {
            expert_items(args, ws, (LAS float*)(F.lds + F.wave * 16384), 0, N_CONV_P1, (((rowg >> 3) << 3) + (bx & 7)) * NWAVES + F.wave, 32 * NWAVES, fresh_lane());
        } else {
            pg8::StaticOrder S; if (split) S.init(M / 256, NIN / 256, 224, (rowg - ((rowg + 1) >> 3)) * 8 + (bx & 7)); else S.init(M / 256, NIN / 256, F.G, bx);
            SrcPlain SRC{(const bf16*)(ws + WS_XN), (const bf16*)(ws + WS_WIN), DM};
            EpiInProj E{SEGB, (const float*)(ws + WS_ROPE), (const float*)(ws + WS_ROPE) + SEQ * 40};
            pg8::gemm_phase<EpiInProj, pg8::StaticOrder, SrcPlain, true, true>(F.lds, DM, S, SRC, E);
        }
        if (BOTH(1)) GRID_BAR(); STAMP();
    }
    for (int rep_ = 0; rep_ < REPS(2); ++rep_) if (IN(2)) {
        bf16* OBR = (bf16*)(ws + WS_OBR); float* LSE = (float*)(ws + WS_LSE); bf16* KVB = (bf16*)(ws + WS_ST);
        for (int cid = gw; cid < NBATCH * NHEAD * NCHUNK; cid += NGW) kv_task(cid, KR, VR, KVB, args.in[4], args.in[5], F.lds + F.wave * 16384, fresh_lane());
        { const int nrt = NBATCH * NHEAD * 48, per = (nrt + F.G - 1) / F.G, r0 = F.vcu * per, nr = r0 + per <= nrt ? per : (nrt > r0 ? nrt - r0 : 0);
          __syncthreads();
          if (F.G == 256) attn_rounds((F.vcu >> 5) * 8, F.vcu & 31, 12, QA, KA, VA, OBR, LSE, F.lds, F.wave, fresh_lane());
          else if (nr > 0) attn_rounds(r0, -1, nr, QA, KA, VA, OBR, LSE, F.lds, F.wave, fresh_lane()); }
        if (BOTH(2)) GRID_BAR(); STAMP();
    }
    for (int rep_ = 0; rep_ < REPS(3); ++rep_) if (IN(3)) {
        bf16* MIXED = (bf16*)(ws + WS_MIXED);
        const bool fold = (F.G == 256);
        for (int wgt = F.vcu; wgt < NBATCH * NHEAD * 4; wgt += F.G) { int t_ = threadIdx.x; asm volatile("" : "+v"(t_));
            ret_wg(wgt, QR, KR, VR, GR, (const bf16*)(ws + WS_ST), (bf16*)(ws + WS_SBW), MIXED, args.in[4], args.in[5], (const bf16*)(ws + WS_OBR), (const float*)(ws + WS_LSE),
                   fold ? (long)wgt * 128 + F.wave * 16 : -1L, F.lds, t_, F.wave, t_ & 63); }
        if (!fold) { const int ln = fresh_lane();
          for (int row = gw; row < M; row += 4 * NGW) { const size_t rows[4] = {(size_t)row, (size_t)(row + NGW), (size_t)(row + 2 * NGW), (size_t)(row + 3 * NGW)};
              combine_rows<4>(rows, (const bf16*)(ws + WS_OBR), (const float*)(ws + WS_LSE), MIXED, ln); } }
        if (BOTH(3)) GRID_BAR(); STAMP();
    }
    for (int rep_ = 0; rep_ < REPS(4); ++rep_) if (IN(4)) {
        pg8::StaticOrder S; S.init(M / 256, DM / 256, F.G, (int)blockIdx.x);
        SrcPlain SRC{(const bf16*)(ws + WS_MIXED), (const bf16*)(ws + WS_WOUT), DM};
        EpiOutProj E{args.in[0], (bf16*)(ws + WS_HG)};
        pg8::gemm_phase<EpiOutProj, pg8::StaticOrder, SrcPlain, true, true>(F.lds, DM, S, SRC, E);
        if (BOTH(4)) GRID_BAR(); STAMP();
    }
    for (int rep_ = 0; rep_ < REPS(5); ++rep_) if (IN(5)) {
        if (rep_ > 0) { if (blockIdx.x == 0 && F.tid < NEXP) __hip_atomic_store(F.ctl + CW_CNT + 64 * F.tid, 0u, RLX_AGENT); GRID_BAR(); }
        for (int wgt = F.vcu; wgt < M / 128; wgt += F.G) { int t_ = threadIdx.x; asm volatile("" : "+v"(t_));
            route_wg(wgt, (const bf16*)(ws + WS_HG), (const bf16*)(ws + WS_WRT), args.in[10], args.in[12], F.ctl, (int*)(ws + WS_LIST), (float*)(ws + WS_GATEL), (float*)(ws + WS_RSL), F.lds, t_, F.wave, t_ & 63); }
        if (BOTH(5)) GRID_BAR(); STAMP();
    }
    for (int rep_ = 0; rep_ < REPS(6); ++rep_) if (IN(6)) {
        int ntiles; const TileTab tt = build_tiles(F, ntiles);
        pg8::StaticOrder S; S.init(ntiles, 4, F.G, (int)blockIdx.x);
        SrcGather SRC{(const bf16*)(ws + WS_HG), (const bf16*)(ws + WS_WGU), (const int*)(ws + WS_LIST), tt};
        EpiGateUp E{(bf16*)(ws + WS_HID), (const float*)(ws + WS_GATEL), (const float*)(ws + WS_RSL), tt};
        pg8::gemm_phase<EpiGateUp, pg8::StaticOrder, SrcGather, true, true>(F.lds, DM, S, SRC, E);
        if (F.G == 256) {
            const int nu = ntiles * 4, rounds = (nu + 255) >> 8, last = nu - (rounds - 1) * 256, nidle = 256 - last, bx = (int)blockIdx.x;
            if (nidle >= 32) { if (bx >= last) expert_items(args, ws, (LAS float*)(F.lds + F.wave * 16384), N_GU_ITEMS, 768 * NEXP, (bx - last) * NWAVES + F.wave, nidle * NWAVES, fresh_lane()); }
            else expert_items(args, ws, (LAS float*)(F.lds + F.wave * 16384), N_GU_ITEMS, 768 * NEXP, gw, NGW, fresh_lane());
        }
        if (BOTH(6)) GRID_BAR(); STAMP();
    }
    for (int rep_ = 0; rep_ < REPS(7); ++rep_) if (IN(7)) {
        int ntiles; const TileTab tt = build_tiles(F, ntiles);
        pg8::StaticOrder S; S.init(ntiles, 4, F.G, (int)blockIdx.x);
        SrcDown SRC{(const bf16*)(ws + WS_HID), (const bf16*)(ws + WS_WD), tt};
        EpiDown E{(bf16*)(ws + WS_Y), (const int*)(ws + WS_LIST), tt};
        pg8::gemm_phase<EpiDown, pg8::StaticOrder, SrcDown, true, true>(F.lds, FF, S, SRC, E);
        if (BOTH(7)) GRID_BAR(); STAMP();
    }
    for (int rep_ = 0; rep_ < REPS(8); ++rep_) if (IN(8)) {
        f32x4 gv[4];
#pragma unroll
        for (int j = 0; j < 4; ++j) gv[j] = ((const f32x4*)args.in[16])[fresh_lane() + 64 * j];
        { const int ln = fresh_lane();
          for (int row = gw; row < M; row += 2 * NGW) { const size_t rows[2] = {(size_t)row, (size_t)(row + NGW)}; final_rows<2>(rows, (const bf16*)(ws + WS_HG), (const bf16*)(ws + WS_Y), gv, args.out, ln); } }
#if MK_TIME
        STAMP();
        if (blockIdx.x == 0 && F.tid == 0) {
            unsigned long long ts[10];
#pragma unroll
            for (int k = 0; k < 10; ++k) ts[k] = (unsigned long long)__hip_atomic_load(F.ctl + CW_TS + 2 * k, RLX_AGENT) | ((unsigned long long)__hip_atomic_load(F.ctl + CW_TS + 2 * k + 1, RLX_AGENT) << 32);
            const float t = MK_TIME == 10 ? (float)(ts[9] - ts[0]) * 0.01f : (float)(ts[MK_TIME] - ts[MK_TIME - 1]) * 0.01f;
            VM_WAIT(); args.out[0] = t * MK_TSCALE; }
#endif
    }
#undef IN
#undef BOTH
#undef GRID_BAR
}

#if MK_CHECK
__device__ __forceinline__ unsigned hsh(unsigned x) { x ^= x >> 16; x *= 0x7feb352dU; x ^= x >> 15; x *= 0x846ca68bU; x ^= x >> 16; return x; }
__device__ __forceinline__ float ldb(const bf16* p, size_t i) { return __uint_as_float(((unsigned)p[i]) << 16); }
__device__ __forceinline__ float rbf(float x) { return bflo(pk2(x, 0.f) & 0xffffu); }
__device__ __forceinline__ void chk_put(gu32* ctl, int stage, float got, float ref, float atol) {
    float e = fabsf(got - ref) / (0.03f * fabsf(ref) + atol); if (!(e == e)) e = 1e30f; if (e > 1e30f) e = 1e30f;
    __hip_atomic_fetch_max(ctl + CW_CHK + stage, __float_as_uint(e), RLX_AGENT);
}
__global__ void __launch_bounds__(256) chk_kernel(Args A, int stage) {
    unsigned char* ws = A.ws; gu32* ctl = (gu32*)(ws + WS_CTL);
    const int gt = blockIdx.x * 256 + threadIdx.x, NT = gridDim.x * 256;
    const bf16* SEGB = (const bf16*)(ws + WS_SEG);
    const bf16 *QA = SEGB, *KA = SEGB + (size_t)1 * M * SEGW, *VA = SEGB + (size_t)2 * M * SEGW, *QR = SEGB + (size_t)3 * M * SEGW, *KR = SEGB + (size_t)4 * M * SEGW, *VR = SEGB + (size_t)5 * M * SEGW, *GR = SEGB + (size_t)6 * M * SEGW;
    if (stage == 0) {
        const bf16* WIN = (const bf16*)(ws + WS_WIN); const bf16* WOUT = (const bf16*)(ws + WS_WOUT); const bf16* WGU = (const bf16*)(ws + WS_WGU); const bf16* WD = (const bf16*)(ws + WS_WD);
        for (int s = gt; s < 65536; s += NT) { const unsigned r = hsh(s * 7 + 1), r2 = hsh(r);
            { const int n = r % NIN, k = r2 % DM; chk_put(ctl, 0, ldb(WIN, (size_t)winperm(n) * DM + k), A.in[2][(size_t)k * NIN + n], 1e-4f); }
            { const int n = r % DM, k = r2 % DM; chk_put(ctl, 0, ldb(WOUT, (size_t)n * DM + k), A.in[7][(size_t)k * DM + n] * (k < 512 ? A.in[3][k] : A.in[6][k - 512]), 1e-4f); }
            { const int e = (r >> 10) % NEXP, j = r % FF, k = r2 % DM;
              chk_put(ctl, 0, ldb(WGU, ((size_t)e * DM + ((j >> 7) << 8) + (j & 127)) * DM + k), A.in[13][((size_t)e * DM + k) * FF + j] * A.in[8][k], 1e-4f);
              chk_put(ctl, 0, ldb(WGU, ((size_t)e * DM + ((j >> 7) << 8) + 128 + (j & 127)) * DM + k), A.in[14][((size_t)e * DM + k) * FF + j] * A.in[8][k], 1e-4f); }
            { const int e = (r >> 10) % NEXP, n = r % DM, k = r2 % FF; chk_put(ctl, 0, ldb(WD, ((size_t)e * DM + n) * FF + k), A.in[15][((size_t)e * FF + k) * DM + n], 1e-4f); }
            { const int j = r % 36, i = r2 % DM; const float ref = (j < 32 ? A.in[11][i * 32 + j] : A.in[9][i * 4 + j - 32]) * A.in[8][i]; chk_put(ctl, 0, 1000.f * (ldb((const bf16*)(ws + WS_WRT), j * DM + i) + ldb((const bf16*)(ws + WS_WRT), (48 + j) * DM + i)), 1000.f * ref, 1e-3f); }
            { const int pos = r % SEQ, f = r2 % 40; const float fr = f < 8 ? powf(500000.f, -(float)f / 8.f) : powf(10000.f, -(float)(f - 8) / 31.f); const float ang = (float)pos * fr;
              chk_put(ctl, 0, ((const float*)(ws + WS_ROPE))[pos * 40 + f], cosf(ang), 2e-3f); chk_put(ctl, 0, ((const float*)(ws + WS_ROPE))[SEQ * 40 + pos * 40 + f], sinf(ang), 2e-3f); }
        }
        for (int s = gt; s < 2048; s += NT) { const unsigned r = hsh(s * 13 + 5); const int row = r % M, c = hsh(r) % DM; const float* x = A.in[0] + (size_t)row * DM; float ss = 0.f;
            for (int k = 0; k < DM; ++k) ss += x[k] * x[k];
            chk_put(ctl, 0, ldb((const bf16*)(ws + WS_XN), (size_t)row * DM + c), x[c] / sqrtf(ss / DM + NORM_EPS) * A.in[1][c], 1e-3f); }
    }
    if (stage == 1) {
        const bf16* XN = (const bf16*)(ws + WS_XN);
        for (int s = gt; s < 8192; s += NT) { const unsigned r = hsh(s * 3 + 11), r2 = hsh(r); const int row = r % M, seg = r2 % 7, hh = (r2 >> 4) % 8, pos = row & (SEQ - 1);
            const int half = (seg == 0 || seg == 1) ? 8 : 32; const int i = (r2 >> 8) % half; const int d1 = i, d2 = i + half;
            float a1 = 0.f, a2 = 0.f; const float* w = A.in[2] + seg * 512 + hh * 64;
            for (int k = 0; k < DM; ++k) { const float xv = ldb(XN, (size_t)row * DM + k); a1 += xv * rbf(w[(size_t)k * NIN + d1]); a2 += xv * rbf(w[(size_t)k * NIN + d2]); }
            const bf16* O = SEGB + (size_t)seg * M * SEGW + (size_t)row * SEGW + hh * 64;
            if (seg == 0 || seg == 1 || seg == 3 || seg == 4) {
                const float fr = seg < 2 ? powf(500000.f, -(float)i / 8.f) : powf(10000.f, -(float)i / 31.f); const float ang = (float)pos * fr, c = cosf(ang), sn = sinf(ang);
                const float sc = seg == 0 ? 0.125f * LOG2E : (seg == 4 ? 0.125f : 1.f);
                chk_put(ctl, 1, ldb(O, 2 * i), (a1 * c - a2 * sn) * sc, 0.02f); chk_put(ctl, 1, ldb(O, 2 * i + 1), (a2 * c + a1 * sn) * sc, 0.02f);
                if (seg < 2) { const int d3 = 16 + (r2 >> 12) % 48; float a3 = 0.f; for (int k = 0; k < DM; ++k) a3 += ldb(XN, (size_t)row * DM + k) * rbf(w[(size_t)k * NIN + d3]); chk_put(ctl, 1, ldb(O, d3), a3 * sc, 0.02f); }
            } else { chk_put(ctl, 1, ldb(O, d1), seg == 6 ? silu_f(a1) : a1, 0.02f); chk_put(ctl, 1, ldb(O, d2), seg == 6 ? silu_f(a2) : a2, 0.02f); }
        }
    }
    if (stage == 2) {
        const bf16* OBR = (const bf16*)(ws + WS_OBR); const float* LSE = (const float*)(ws + WS_LSE); const bf16* ST = (const bf16*)(ws + WS_ST);
        for (int s = gt; s < 4096; s += NT) { const unsigned r = hsh(s * 5 + 3), r2 = hsh(r); const int b = r % NBATCH, pos = (s < 256) ? (s & 1 ? SEQ - 1 - (s >> 1) % 80 : (s >> 1) % 80) : (r >> 3) % SEQ, h = r2 % NHEAD, br = (r2 >> 3) % 3, dd = (r2 >> 8) % HD;
            const int dil = 1 << (2 * br); const size_t row = (size_t)b * SEQ + pos;
            float mx = -1e30f;
            for (int pass = 0; pass < 2; ++pass) { float l = 0.f, o = 0.f;
                for (int j = -64; j <= 64; ++j) { const int kp = pos + j * dil; if (kp < 0 || kp >= SEQ) continue; const size_t kr = (size_t)b * SEQ + kp; float d = 0.f;
                    for (int k = 0; k < HD; ++k) d += ldb(QA, row * SEGW + h * HD + k) * ldb(KA, kr * SEGW + h * HD + k);
                    if (pass == 0) mx = fmaxf(mx, d); else { const float p = exp2f(d - mx); l += p; o += p * ldb(VA, kr * SEGW + h * HD + dd); } }
                if (pass == 1) { chk_put(ctl, 2, ldb(OBR, ((size_t)br * M + row) * SEGW + h * HD + dd), o / l, 0.02f); chk_put(ctl, 2, LSE[((size_t)br * M + row) * NHEAD + h], (mx + log2f(l)) * LN2, 0.02f); } }
        }
        for (int s = gt; s < 8192; s += NT) { const unsigned r = hsh(s * 9 + 7), r2 = hsh(r); const int bh = r % 64, dir = (r >> 6) & 1, n = (r >> 7) % NCHUNK, dv = r2 % 64, dk = (r2 >> 6) % 64, b = bh >> 3, h = bh & 7;
            const float lg2 = log1pf(-exp2f((dir ? A.in[5] : A.in[4])[h])) * LOG2E; float S = 0.f;
            for (int j = 0; j < CHUNK; ++j) { const size_t row = (size_t)b * SEQ + n * CHUNK + j; const float ex = dir == 0 ? (float)(127 - j) : (float)j;
                S += exp2f(ex * lg2) * ldb(KR, row * SEGW + h * HD + dk) * ldb(VR, row * SEGW + h * HD + dv); }
            chk_put(ctl, 2, ldb(ST, (((size_t)bh * NCHUNK + n) * 2 + dir) * 4096 + ((size_t)((dv >> 5) * 4 + (dk >> 4)) * 64 + (dv & 31) + 32 * ((dk >> 3) & 1)) * 8 + (dk & 7)), S, 0.05f);
        }
    }
    if (stage == 3) {
        const bf16* MIXED = (const bf16*)(ws + WS_MIXED);
        for (int s = gt; s < 512; s += NT) { const unsigned r = hsh(s * 17 + 9), r2 = hsh(r); const int b = r % NBATCH, pos = (s < 64) ? (s & 1 ? SEQ - 1 - (s >> 1) * 5 : (s >> 1) * 5) : (r >> 3) % SEQ, h = r2 % NHEAD; const size_t row = (size_t)b * SEQ + pos;
            const float lgf = log1pf(-exp2f(A.in[4][h])) * LOG2E, lgb = log1pf(-exp2f(A.in[5][h])) * LOG2E;
            float o[HD], qv[HD];
#pragma unroll
            for (int k = 0; k < HD; ++k) { o[k] = 0.f; qv[k] = ldb(QR, row * SEGW + h * HD + k); }
            for (int kp = 0; kp < SEQ; ++kp) { const size_t kr = (size_t)b * SEQ + kp; const int dl = pos - kp; const float w = dl >= 0 ? exp2f((float)dl * lgf) : exp2f((float)(-dl) * lgb); if (w < 1e-12f) continue; float d = 0.f;
#pragma unroll
                for (int k = 0; k < HD; ++k) d += qv[k] * ldb(KR, kr * SEGW + h * HD + k);
                d *= w;
#pragma unroll
                for (int k = 0; k < HD; ++k) o[k] += d * ldb(VR, kr * SEGW + h * HD + k); }
            float mean = 0.f, var = 0.f;
#pragma unroll
            for (int k = 0; k < HD; ++k) mean += o[k];
            mean *= (1.f / HD);
#pragma unroll
            for (int k = 0; k < HD; ++k) var += (o[k] - mean) * (o[k] - mean);
            var *= (1.f / HD); const float rstd = 1.f / sqrtf(var + NORM_EPS);
#pragma unroll
            for (int k = 0; k < HD; ++k) if ((k & 7) == (int)(r2 >> 8) % 8) chk_put(ctl, 3, ldb(MIXED, row * DM + 512 + h * HD + k), (o[k] - mean) * rstd * ldb(GR, row * SEGW + h * HD + k), 0.03f);
        }
        {
            const bf16* OBR = (const bf16*)(ws + WS_OBR); const float* LSE = (const float*)(ws + WS_LSE);
            for (int s = gt; s < 4096; s += NT) { const unsigned r = hsh(s * 19 + 1), r2 = hsh(r); const int row = r % M, csel = r2 % 512; float ss = 0.f, osel = 0.f;
                for (int c = 0; c < 512; ++c) { const int h = c >> 6; const float l0 = LSE[((size_t)0 * M + row) * NHEAD + h], l1 = LSE[((size_t)1 * M + row) * NHEAD + h], l2 = LSE[((size_t)2 * M + row) * NHEAD + h];
                    const float mx = fmaxf(l0, fmaxf(l1, l2)), w0 = expf(l0 - mx), w1 = expf(l1 - mx), w2 = expf(l2 - mx);
                    const float o = (w0 * ldb(OBR, ((size_t)0 * M + row) * SEGW + c) + w1 * ldb(OBR, ((size_t)1 * M + row) * SEGW + c) + w2 * ldb(OBR, ((size_t)2 * M + row) * SEGW + c)) / (w0 + w1 + w2);
                    ss += o * o; if (c == csel) osel = o; }
                chk_put(ctl, 3, ldb(MIXED, (size_t)row * DM + csel), osel / sqrtf(ss / 512.f + NORM_EPS), 0.03f); }
        }
    }
    if (stage == 4) {
        const bf16* MIXED = (const bf16*)(ws + WS_MIXED); const bf16* WOUT = (const bf16*)(ws + WS_WOUT); const float* H = (const float*)(ws + WS_H); const bf16* HG = (const bf16*)(ws + WS_HG);
        for (int s = gt; s < 16384; s += NT) { const unsigned r = hsh(s * 23 + 3); const int row = r % M, c = hsh(r) % DM; float a = 0.f;
            for (int k = 0; k < DM; ++k) a += ldb(MIXED, (size_t)row * DM + k) * ldb(WOUT, (size_t)c * DM + k);
            const float h = a + A.in[0][(size_t)row * DM + c]; chk_put(ctl, 4, ldb(HG, (size_t)row * DM + c), h, 0.02f); (void)H; }
    }
    if (stage == 5) {
        const float* H = (const float*)(ws + WS_H); const int* LIST = (const int*)(ws + WS_LIST); const float* GATEL = (const float*)(ws + WS_GATEL); const float* RSL = (const float*)(ws + WS_RSL);
        if (gt == 0) { unsigned tot = 0; for (int e = 0; e < NEXP; ++e) tot += ctl[CW_CNT + 64 * e]; chk_put(ctl, 5, (float)tot, (float)(2 * M), 0.5f); }
        const bf16* HBc = (const bf16*)(ws + WS_HG); (void)H;
        for (int s = gt; s < 2048; s += NT) { const int t = hsh(s * 29 + 5) % M; const bf16* h_ = HBc + (size_t)t * DM; float ss = 0.f;
#define h_AT(k) ldb(h_, (k))
            for (int k = 0; k < DM; ++k) ss += h_AT(k) * h_AT(k);
            const float rs = 1.f / sqrtf(ss / DM + NORM_EPS); float gl[4]; int gi = 0;
            for (int g = 0; g < 4; ++g) { float a = 0.f; for (int k = 0; k < DM; ++k) a += h_AT(k) * rs * A.in[8][k] * A.in[9][k * 4 + g]; gl[g] = a + A.in[10][g]; if (gl[g] > gl[gi]) gi = g; }
            float den = 0.f; for (int g = 0; g < 4; ++g) den += expf(gl[g] - gl[gi]);
            float b1 = -3e38f, b2 = -3e38f, b3 = -3e38f; int i1 = 0, i2 = 0;
            for (int e = 0; e < 8; ++e) { float a = 0.f; for (int k = 0; k < DM; ++k) a += h_AT(k) * rs * A.in[8][k] * A.in[11][k * 32 + gi * 8 + e]; a += A.in[12][gi * 8 + e];
                if (a > b1) { b3 = b2; b2 = b1; i2 = i1; b1 = a; i1 = e; } else if (a > b2) { b3 = b2; b2 = a; i2 = e; } else if (a > b3) b3 = a; }
            float second = -3e38f; for (int g = 0; g < 4; ++g) if (g != gi) second = fmaxf(second, gl[g]);
            if (gl[gi] - second < 1e-3f || b2 - b3 < 1e-3f || b1 - b2 < 1e-3f) continue;
            const float p1 = 1.f / (1.f + expf(b2 - b1)); const float g1 = p1 / den, g2 = (1.f - p1) / den;
            for (int k = 0; k < 2; ++k) { const int e = gi * 8 + (k ? i2 : i1); const int n = (int)ctl[CW_CNT + 64 * e]; int found = -1;
                for (int p = 0; p < n && p < M; ++p) if (LIST[(size_t)e * M + p] == t * 2 + k) { found = p; break; }
                if (found < 0) chk_put(ctl, 5, 0.f, 100.f, 0.1f); else { chk_put(ctl, 5, GATEL[(size_t)e * M + found], k ? g2 : g1, 1e-3f); chk_put(ctl, 5, RSL[(size_t)e * M + found], rs, 1e-4f); } }
        }
    }
    if (stage == 6 || stage == 7) {
        const int* LIST = (const int*)(ws + WS_LIST); const float* GATEL = (const float*)(ws + WS_GATEL); const float* RSL = (const float*)(ws + WS_RSL);
        const bf16* HG = (const bf16*)(ws + WS_HG); const bf16* WGU = (const bf16*)(ws + WS_WGU); const bf16* HID = (const bf16*)(ws + WS_HID); const bf16* WD = (const bf16*)(ws + WS_WD); const bf16* Y = (const bf16*)(ws + WS_Y);
        for (int s = gt; s < 8192; s += NT) { const unsigned r = hsh(s * 31 + 7), r2 = hsh(r); const int e = r % NEXP; const int ne = (int)ctl[CW_CNT + 64 * e]; if (ne <= 0) continue;
            int t0 = 0; for (int q = 0; q < e; ++q) t0 += ((int)ctl[CW_CNT + 64 * q] + 255) >> 8;
            const int pos = (s & 3) == 0 ? ne - 1 - (int)((r >> 5) % (ne < 300 ? ne : 300)) : (int)((r >> 5) % ne); const size_t slot = (size_t)t0 * 256 + pos; const int tk = LIST[(size_t)e * M + pos], t = tk >> 1;
            if (stage == 6) { const int j = r2 % FF; float g = 0.f, u = 0.f; const bf16* wg = WGU + ((size_t)e * DM + ((j >> 7) << 8) + (j & 127)) * DM; const bf16* wu = wg + (size_t)128 * DM;
                for (int k = 0; k < DM; ++k) { const float xv = ldb(HG, (size_t)t * DM + k); g += xv * ldb(wg, k); u += xv * ldb(wu, k); }
                const float rs = RSL[(size_t)e * M + pos]; chk_put(ctl, 6, ldb(HID, slot * FF + j), silu_f(g * rs) * (u * rs) * GATEL[(size_t)e * M + pos], 0.01f); }
            else { const int c = r2 % DM; float a = 0.f; for (int k = 0; k < FF; ++k) a += ldb(HID, slot * FF + k) * ldb(WD, ((size_t)e * DM + c) * FF + k);
                chk_put(ctl, 7, ldb(Y, (size_t)tk * DM + c), a, 0.01f); }
        }
    }
    if (stage == 8) {
        const float* H = (const float*)(ws + WS_H); const bf16* Y = (const bf16*)(ws + WS_Y);
        for (int s = gt; s < 4096; s += NT) { const unsigned r = hsh(s * 37 + 1); const int row = r % M, c = hsh(r) % DM; float ss = 0.f, zc = 0.f;
            for (int k = 0; k < DM; ++k) { const float z = ldb((const bf16*)(ws + WS_HG), (size_t)row * DM + k) + ldb(Y, (size_t)(2 * row) * DM + k) + ldb(Y, (size_t)(2 * row + 1) * DM + k); (void)H; ss += z * z; if (k == c) zc = z; }
            chk_put(ctl, 8, A.out[(size_t)row * DM + c], zc / sqrtf(ss / DM + NORM_EPS) * A.in[16][c], 0.01f); }
    }
}
__global__ void __launch_bounds__(256) chk_final(Args A) {
    gu32* ctl = (gu32*)(A.ws + WS_CTL); int bad = -1; float err = 0.f;
    for (int s = 0; s < 9; ++s) { const float e = __uint_as_float(ctl[CW_CHK + s]); if (e > 1.f) { bad = s; err = e; break; } }
    if (bad < 0 && ctl[CW_BAR + XB_TMO] != 0u) { bad = 10; err = 1.f; }
    if (bad < 0) return;
    float mant = 1.f + log10f(err); if (mant > 9.9f) mant = 9.9f; if (mant < 1.f) mant = 1.f;
    const float C = sqrtf(mant * powf(10.f, (float)(bad + 3)));
    for (size_t i = blockIdx.x * 256 + threadIdx.x; i < (size_t)M * DM; i += (size_t)gridDim.x * 256) A.out[i] = C;
}
#endif

extern "C" void kernel_launch(void* const* d_in, const int* in_sizes, int n_in, void* d_out, int out_size, void* d_ws, size_t ws_size, hipStream_t stream) {
    static int grid = 0;
    if (grid == 0) {
        if (n_in != 17 || in_sizes[0] != M * DM || out_size != M * DM || ws_size < WS_END) { fprintf(stderr, "kernel_launch: unexpected shapes (n_in %d, in0 %d, out %d, ws %zu); nothing launched\n", n_in, n_in > 0 ? in_sizes[0] : -1, out_size, ws_size); grid = -1; return; }
        int dev = 0, cus = 0, per_cu = 0;
        if (hipGetDevice(&dev) != hipSuccess || hipDeviceGetAttribute(&cus, hipDeviceAttributeMultiprocessorCount, dev) != hipSuccess) { grid = -1; return; }
        if (hipFuncSetAttribute((const void*)mk_fwd, hipFuncAttributeMaxDynamicSharedMemorySize, LDS_BYTES) != hipSuccess) { fprintf(stderr, "kernel_launch: hipFuncSetAttribute failed\n"); grid = -1; return; }
        if (hipOccupancyMaxActiveBlocksPerMultiprocessor(&per_cu, (const void*)mk_fwd, NWAVES * 64, LDS_BYTES) != hipSuccess || per_cu < 1) { fprintf(stderr, "kernel_launch: occupancy query says %d blocks per CU; nothing launched\n", per_cu); (void)hipGetLastError(); grid = -1; return; }
        grid = cus;
    }
    if (grid < 0) return;
    if (hipMemsetAsync((char*)d_ws + WS_CTL, 0, CTL_ZERO_BYTES, stream) != hipSuccess) { fprintf(stderr, "kernel_launch: memset failed\n"); return; }
    Args a{};
    for (int i = 0; i < 17; ++i) a.in[i] = (const float*)d_in[i];
    a.out = (float*)d_out; a.ws = (unsigned char*)d_ws;
    const double TWO_PI = 6.283185307179586476925286766559;
    for (int i = 0; i < 8; ++i) a.frev[i] = std::pow(500000.0, -(double)i / 8.0) / TWO_PI;
    for (int i = 0; i < 32; ++i) a.frev[8 + i] = std::pow(10000.0, -(double)i / 31.0) / TWO_PI;
    if (N_LAUNCHES == 1) {
        a.ph_lo = 0; a.ph_hi = PER_PHASE; a.li = 0;
#if MK_COOP
        void* kargs[] = {&a};
        const hipError_t le = hipLaunchCooperativeKernel((const void*)mk_fwd, dim3(grid), dim3(NWAVES * 64), kargs, LDS_BYTES, stream);
        if (le != hipSuccess) fprintf(stderr, "kernel_launch: cooperative launch failed: %s (grid %d)\n", hipGetErrorName(le), grid);
#else
        hipLaunchKernelGGL(mk_fwd, dim3(grid), dim3(NWAVES * 64), LDS_BYTES, stream, a);
#endif
    } else {
        for (int li = 0; li < PER_PHASE; ++li) {
            a.ph_lo = li; a.ph_hi = li + 1; a.li = 0;
            hipLaunchKernelGGL(mk_fwd, dim3(grid), dim3(NWAVES * 64), LDS_BYTES, stream, a);
#if MK_CHECK
            hipLaunchKernelGGL(chk_kernel, dim3(256), dim3(256), 0, stream, a, li);
#endif
        }
#if MK_CHECK
        hipLaunchKernelGGL(chk_final, dim3(1024), dim3(256), 0, stream, a);
#endif
    }
}
```

```cpp
#include <hip/hip_runtime.h>
#include <cstdio>
#include <cstdint>
#include <cmath>

#ifndef MK_N_LAUNCHES
#define MK_N_LAUNCHES 1
#endif
#ifndef MK_TIME
#define MK_TIME 0
#endif
#ifndef MK_REPEAT
#define MK_REPEAT -1
#endif
#ifndef MK_NREP
#define MK_NREP 2
#endif
#ifndef MK_COOP
#define MK_COOP 1
#endif
#ifndef MK_TSCALE
#define MK_TSCALE 1.0f
#endif
#ifndef MK_CHECK
#define MK_CHECK 0
#endif

#define LAS __attribute__((address_space(3)))
#define GAS __attribute__((address_space(1)))
typedef unsigned short bf16;
typedef short bf16x8 __attribute__((ext_vector_type(8)));
typedef short s16x4 __attribute__((ext_vector_type(4)));
typedef float f32x2 __attribute__((ext_vector_type(2)));
typedef float f32x4 __attribute__((ext_vector_type(4)));
typedef float f32x16 __attribute__((ext_vector_type(16)));
typedef unsigned u32x2 __attribute__((ext_vector_type(2)));
typedef unsigned u32x4 __attribute__((ext_vector_type(4)));
typedef __bf16 bf16x2_t __attribute__((ext_vector_type(2)));
typedef GAS unsigned gu32;

constexpr int NBATCH = 8, SEQ = 4096, DM = 1024, M = NBATCH * SEQ;
constexpr int NIN = 3584, SEGW = 512, NHEAD = 8, HD = 64;
constexpr int NEXP = 32, FF = 512, NGRP = 4, EPG = 8;
constexpr int CHUNK = 128, NCHUNK = SEQ / CHUNK;
constexpr float NORM_EPS = 1e-6f;
constexpr float LOG2E = 1.4426950408889634f, LN2 = 0.6931471805599453f;
constexpr int NWAVES = 8;
constexpr int N_CONV_P1 = 64 * 256;
constexpr int MAXTILES = 288;

constexpr size_t MiB = 1u << 20;
constexpr size_t WS_CTL = 0, CTL_ZERO_BYTES = 128 * 1024;
constexpr size_t WS_WRT = 1 * MiB;
constexpr size_t WS_ROPE = 2 * MiB;
constexpr size_t WS_LSE = 4 * MiB;
constexpr size_t WS_LIST = 8 * MiB;
constexpr size_t WS_GATEL = 12 * MiB;
constexpr size_t WS_RSL = 16 * MiB;
constexpr size_t WS_WIN = 20 * MiB;
constexpr size_t WS_WOUT = 27 * MiB;
constexpr size_t WS_WD = 30 * MiB;
constexpr size_t WS_WGU = 62 * MiB;
constexpr size_t WS_ST = 126 * MiB;
constexpr size_t WS_SBW = 478 * MiB;
constexpr size_t WS_XN = 158 * MiB;
constexpr size_t WS_OBR = 158 * MiB;
constexpr size_t WS_SEG = 254 * MiB;
constexpr size_t SEG_BYTES = (size_t)M * SEGW * 2;
constexpr size_t WS_MIXED = 254 * MiB;
constexpr size_t WS_H = 350 * MiB;
constexpr size_t WS_HG = 350 * MiB;
constexpr size_t WS_HID = 222 * MiB;
constexpr size_t WS_Y = 64 * MiB;
constexpr size_t WS_END = 494 * MiB;
constexpr int CW_CNT = 64;
constexpr int CW_BAR = 4096;
constexpr int CW_CHK = 16384;
constexpr int CW_TS = 20480;

constexpr int RING_BYTES = 147456;
constexpr int LDSCTL_OFF = RING_BYTES, MISC_OFF = LDSCTL_OFF + 320;
constexpr int TILE_OFF = MISC_OFF + 128;
constexpr int LDS_BYTES = 151552;

#define RLX_AGENT __ATOMIC_RELAXED, __HIP_MEMORY_SCOPE_AGENT
#define LDS_WAIT() asm volatile("s_waitcnt lgkmcnt(0)" ::: "memory")
#define VM_WAIT() asm volatile("s_waitcnt vmcnt(0)" ::: "memory")
__device__ __forceinline__ unsigned pk2(float lo, float hi) { f32x2 v = {lo, hi}; bf16x2_t b = __builtin_convertvector(v, bf16x2_t); return __builtin_bit_cast(unsigned, b); }
__device__ __forceinline__ float bflo(unsigned u) { return __uint_as_float(u << 16); }
__device__ __forceinline__ float bfhi(unsigned u) { return __uint_as_float(u & 0xffff0000u); }
__device__ __forceinline__ float bf2f(short s) { return __uint_as_float(((unsigned)(unsigned short)s) << 16); }
__device__ __forceinline__ int crow(int r, int hi) { return (r & 3) + 8 * (r >> 2) + 4 * hi; }
__device__ __forceinline__ float wave_sum(float v) {
#pragma unroll
    for (int o = 1; o < 64; o <<= 1) v += __shfl_xor(v, o);
    return v;
}
__device__ __forceinline__ float silu_f(float v) { return v * __builtin_amdgcn_rcpf(1.f + __builtin_amdgcn_exp2f(-v * LOG2E)); }

namespace pg8 {
constexpr int BM = 256, BK = 64, HALF = 128, HTB = HALF * BK * 2, STAGE_BYTES = 8 * HTB, NXCD = 8, WGM = 8;
__host__ __device__ __forceinline__ int lds_byte(int r, int c) { const int st = (r >> 4) * 2 + (c >> 5), rr = r & 15, cc = c & 31, ob = rr * 64 + cc * 2; return st * 1024 + (ob ^ (((ob >> 9) & 1) << 5)); }
__host__ __device__ __forceinline__ void stage_rc(int b, int& R, int& C) { const int st = b / 1024, sb = b % 1024, swz = sb ^ (((sb >> 9) & 1) << 5); R = (st >> 1) * 16 + swz / 64; C = (st & 1) * 32 + (swz % 64) / 2; }
__host__ __device__ __forceinline__ int perm32(int rho) { const int n = rho >> 4, i = rho & 15; return 8 * (i >> 2) + 4 * n + (i & 3); }

struct Unit { int pm, pn; };
struct StaticOrder {
    int nM, nN, nwg, G, c;
    __device__ void init(int nM_, int nN_, int G_, int c_) { nM = nM_; nN = nN_; nwg = nM * nN; G = G_; c = c_; }
    __device__ bool next(int i, Unit& u) const {
        const long L = (long)i * G + c; if (L >= nwg) return false;
        int wgid = (int)L; { const int q = nwg / NXCD, r = nwg % NXCD, xcd = wgid % NXCD, off = wgid / NXCD; wgid = (xcd < r ? xcd * (q + 1) : r * (q + 1) + (xcd - r) * q) + off; }
        const int nig = WGM * nN, gid = wgid / nig, fm = gid * WGM, gsz = (nM - fm) < WGM ? (nM - fm) : WGM;
        u.pm = fm + ((wgid % nig) % gsz); u.pn = (wgid % nig) / gsz; return true;
    }
};

template <class Epi, class Sched, class Src, bool ALIGN_EPI, bool SP2>
__device__ __forceinline__ void gemm_phase(LAS unsigned char* lds, const int K, const Sched& S, const Src& SRC, const Epi& E) {
    int tid_ = threadIdx.x; asm volatile("" : "+v"(tid_));
    const int tid = tid_, wid = __builtin_amdgcn_readfirstlane(tid >> 6), lane = tid & 63, wr = wid >> 2, wc = wid & 3, fr = lane & 15, fq = lane >> 4;
    const int nt = K / BK;
    unsigned voffB[2]; int RA[2], CA[2];
#pragma unroll
    for (int i = 0; i < 2; ++i) { int R, C; stage_rc(tid * 16 + i * 8192, R, C); const int Rb = Epi::PERM ? ((R & ~31) + perm32(R & 31)) : R;
        RA[i] = R; CA[i] = C; voffB[i] = (unsigned)(Rb * K + C) * 2u; }
    const size_t kstep = (size_t)(BK * 2);
    const size_t hstep = (size_t)HALF * K * 2;
    const unsigned ldsw = (unsigned)wid * 1024u;
    const int aoff = lds_byte(wr * 64 + fr, fq * 8), boff = lds_byte(wc * 32 + fr, fq * 8);
#define PG8_SA(b, h) (((b) * 2 + (h)) * HTB)
#define PG8_SB(b, h) ((4 + (b) * 2 + (h)) * HTB)
#define PG8_STAGE(bufoff, gbase, voff) do { _Pragma("unroll") for (int _i = 0; _i < 2; ++_i) \
        __builtin_amdgcn_global_load_lds((const unsigned*)((const char*)(gbase) + (voff)[_i]), (LAS unsigned*)(lds + (bufoff) + ldsw + _i * 8192), 16, 0, 0); } while (0)
#define PG8_LDA(dst, b, h) do { _Pragma("unroll") for (int m = 0; m < 4; ++m) _Pragma("unroll") for (int k = 0; k < 2; ++k) dst[m][k] = *(const LAS bf16x8*)(lds + PG8_SA(b, h) + aoff + m * 2048 + k * 1024); } while (0)
#define PG8_LDB(dst, b, h) do { _Pragma("unroll") for (int n = 0; n < 2; ++n) _Pragma("unroll") for (int k = 0; k < 2; ++k) dst[n][k] = *(const LAS bf16x8*)(lds + PG8_SB(b, h) + boff + n * 2048 + k * 1024); } while (0)
#define PG8_MMA(ai, bj, At, Bt) do { __builtin_amdgcn_s_setprio(1); _Pragma("unroll") for (int m = 0; m < 4; ++m) _Pragma("unroll") for (int n = 0; n < 2; ++n) _Pragma("unroll") for (int k = 0; k < 2; ++k) \
        acc[ai][bj][m][n] = __builtin_amdgcn_mfma_f32_16x16x32_bf16(Bt[n][k], At[m][k], acc[ai][bj][m][n], 0, 0, 0); __builtin_amdgcn_s_setprio(0); } while (0)
#define PG8_WAIT_V(n) asm volatile("s_waitcnt vmcnt(" #n ")" ::: "memory")
#define PG8_WAIT_L(n) asm volatile("s_waitcnt lgkmcnt(" #n ")" ::: "memory")
#define PG8_BAR __builtin_amdgcn_s_barrier()
#define PG8_SCHED __builtin_amdgcn_sched_barrier(0)
    Unit cur, nxt; int ui = 0;
    if (!S.next(0, cur)) return;
    f32x4 acc[2][2][4][2];
#pragma unroll
    for (int a = 0; a < 2; ++a)
#pragma unroll
        for (int b = 0; b < 2; ++b)
#pragma unroll
            for (int m = 0; m < 4; ++m)
#pragma unroll
                for (int n = 0; n < 2; ++n) acc[a][b][m][n] = (f32x4){0.f, 0.f, 0.f, 0.f};
    bf16x8 At[4][2], B0[2][2], B1[2][2];
    const char *cA, *cB; unsigned vA0[2], vA1[2];
    SRC.setup(cur, RA, CA, cA, cB, vA0, vA1);
    if constexpr (SP2) {
        PG8_STAGE(PG8_SB(0, 0), cB, voffB); PG8_STAGE(PG8_SB(0, 1), cB + hstep, voffB); PG8_STAGE(PG8_SA(0, 0), cA, vA0); PG8_STAGE(PG8_SA(0, 1), cA, vA1);
        if (wr == 1) PG8_BAR;
        PG8_WAIT_V(2); PG8_BAR;
        PG8_STAGE(PG8_SB(1, 0), cB + kstep, voffB); PG8_STAGE(PG8_SA(1, 0), cA + kstep, vA0); PG8_STAGE(PG8_SB(1, 1), cB + hstep + kstep, voffB);
        PG8_WAIT_V(6); PG8_BAR;
    } else {
        PG8_STAGE(PG8_SB(0, 0), cB, voffB); PG8_STAGE(PG8_SA(0, 0), cA, vA0); PG8_STAGE(PG8_SB(0, 1), cB + hstep, voffB); PG8_STAGE(PG8_SA(0, 1), cA, vA1);
        if (wr == 1) PG8_BAR;
        PG8_WAIT_V(4); PG8_BAR;
        PG8_STAGE(PG8_SB(1, 0), cB + kstep, voffB); PG8_STAGE(PG8_SA(1, 0), cA + kstep, vA0); PG8_STAGE(PG8_SB(1, 1), cB + hstep + kstep, voffB);
        PG8_WAIT_V(6); PG8_BAR;
    }
    for (;;) {
        const bool has_next = S.next(ui + 1, nxt);
        const char *nA = cA, *nB = cB; unsigned wA0[2] = {vA0[0], vA0[1]}, wA1[2] = {vA1[0], vA1[1]};
        if (has_next) SRC.setup(nxt, RA, CA, nA, nB, wA0, wA1);
        for (int t = 0; t < nt; t += 2) {
            const bool last = (t == nt - 2);
            const char* a1 = cA + (size_t)(t + 1) * kstep;
            const char* a2 = last ? nA : cA + (size_t)(t + 2) * kstep; const char* b2 = last ? nB : cB + (size_t)(t + 2) * kstep;
            const char* a3 = a2 + kstep; const char* b3 = b2 + kstep;
            unsigned x0[2], x1[2];
            x0[0] = last ? wA0[0] : vA0[0]; x0[1] = last ? wA0[1] : vA0[1]; x1[0] = last ? wA1[0] : vA1[0]; x1[1] = last ? wA1[1] : vA1[1];
            if constexpr (SP2) {
            PG8_LDB(B0, 0, 0); PG8_LDB(B1, 0, 1); PG8_SCHED; PG8_LDA(At, 0, 0); PG8_STAGE(PG8_SA(1, 1), a1, vA1);
            PG8_WAIT_V(8); PG8_WAIT_L(0); PG8_BAR; PG8_MMA(0, 0, At, B0); PG8_MMA(0, 1, At, B1); PG8_BAR; PG8_SCHED;
            PG8_LDA(At, 0, 1); PG8_STAGE(PG8_SB(0, 0), b2, voffB); PG8_STAGE(PG8_SB(0, 1), b2 + hstep, voffB); PG8_STAGE(PG8_SA(0, 0), a2, x0);
            PG8_WAIT_V(8); PG8_WAIT_L(0); PG8_BAR; PG8_MMA(1, 0, At, B0); PG8_MMA(1, 1, At, B1); PG8_BAR; PG8_SCHED;
            PG8_LDB(B0, 1, 0); PG8_LDB(B1, 1, 1); PG8_SCHED; PG8_LDA(At, 1, 0); PG8_STAGE(PG8_SA(0, 1), a2, x1);
            PG8_WAIT_V(8); PG8_WAIT_L(0); PG8_BAR; PG8_MMA(0, 0, At, B0); PG8_MMA(0, 1, At, B1); PG8_BAR; PG8_SCHED;
            PG8_LDA(At, 1, 1); PG8_STAGE(PG8_SB(1, 0), b3, voffB); PG8_STAGE(PG8_SB(1, 1), b3 + hstep, voffB); PG8_STAGE(PG8_SA(1, 0), a3, x0);
            PG8_WAIT_V(8); PG8_WAIT_L(0); PG8_BAR; PG8_MMA(1, 0, At, B0); PG8_MMA(1, 1, At, B1); PG8_BAR; PG8_SCHED;
            } else {
            PG8_LDB(B0, 0, 0); PG8_SCHED; PG8_LDA(At, 0, 0); PG8_STAGE(PG8_SA(1, 1), a1, vA1);
            PG8_WAIT_L(8); PG8_BAR; PG8_WAIT_L(0); PG8_MMA(0, 0, At, B0); PG8_BAR; PG8_SCHED;
            PG8_LDB(B1, 0, 1); PG8_STAGE(PG8_SB(0, 0), b2, voffB);
            PG8_BAR; PG8_WAIT_L(0); PG8_MMA(0, 1, At, B1); PG8_BAR;
            PG8_LDA(At, 0, 1); PG8_STAGE(PG8_SA(0, 0), a2, x0);
            PG8_BAR; PG8_WAIT_L(0); PG8_MMA(1, 0, At, B0); PG8_BAR; PG8_SCHED;
            PG8_STAGE(PG8_SB(0, 1), b2 + hstep, voffB);
            PG8_WAIT_V(6); PG8_BAR; PG8_MMA(1, 1, At, B1); PG8_BAR;
            PG8_LDB(B0, 1, 0); PG8_SCHED; PG8_LDA(At, 1, 0); PG8_STAGE(PG8_SA(0, 1), a2, x1);
            PG8_WAIT_L(8); PG8_BAR; PG8_WAIT_L(0); PG8_MMA(0, 0, At, B0); PG8_BAR; PG8_SCHED;
            PG8_LDB(B1, 1, 1); PG8_STAGE(PG8_SB(1, 0), b3, voffB);
            PG8_BAR; PG8_WAIT_L(0); PG8_MMA(0, 1, At, B1); PG8_BAR;
            PG8_LDA(At, 1, 1); PG8_STAGE(PG8_SA(1, 0), a3, x0);
            PG8_BAR; PG8_WAIT_L(0); PG8_MMA(1, 0, At, B0); PG8_BAR; PG8_SCHED;
            PG8_STAGE(PG8_SB(1, 1), b3 + hstep, voffB);
            PG8_WAIT_V(6); PG8_BAR; PG8_MMA(1, 1, At, B1); PG8_BAR;
            }
        }
        if constexpr (ALIGN_EPI) { if (wr == 0) PG8_BAR; }
        E(acc, cur, wr, wc, fr, fq);
        if (!has_next) break;
#pragma unroll
        for (int a = 0; a < 2; ++a)
#pragma unroll
            for (int b = 0; b < 2; ++b)
#pragma unroll
                for (int m = 0; m < 4; ++m)
#pragma unroll
                    for (int n = 0; n < 2; ++n) acc[a][b][m][n] = (f32x4){0.f, 0.f, 0.f, 0.f};
        cur = nxt; cA = nA; cB = nB; vA0[0] = wA0[0]; vA0[1] = wA0[1]; vA1[0] = wA1[0]; vA1[1] = wA1[1]; ++ui;
        if constexpr (ALIGN_EPI) { if (wr == 1) PG8_BAR; }
    }
    PG8_WAIT_V(0);
    if constexpr (!ALIGN_EPI) { if (wr == 0) PG8_BAR; }
    PG8_BAR;
#undef PG8_SA
#undef PG8_SB
#undef PG8_STAGE
#undef PG8_LDA
#undef PG8_LDB
#undef PG8_MMA
#undef PG8_WAIT_V
#undef PG8_WAIT_L
#undef PG8_BAR
#undef PG8_SCHED
}
}

#define XB_TMO      128
#define XB_XCNT(j)  (256  + 64 * (j))
#define XB_XSUB(j)  (1280 + 64 * (j))
#define XB_XGEN(j)  (2304 + 64 * (j))
#define XB_TOP      3328
#define XB_TOPGEN   3392
#define XCD_BAR_WORDS 3456
#define XB_SPIN_CAP (1u << 18)
__device__ __forceinline__ unsigned xb_ld(unsigned* p)              { return __hip_atomic_load(p, __ATOMIC_RELAXED, __HIP_MEMORY_SCOPE_AGENT); }
__device__ __forceinline__ unsigned xb_add(unsigned* p, unsigned v) { return __hip_atomic_fetch_add(p, v, __ATOMIC_RELAXED, __HIP_MEMORY_SCOPE_AGENT); }
__device__ __forceinline__ unsigned xb_xcc_id() { return (unsigned)__builtin_amdgcn_s_getreg((3 << 11) | 20) & 0xFu; }
#define XB_SPIN(cond, bar) do { unsigned _sp = 0; while (cond) { __builtin_amdgcn_s_sleep(1); \
    if ((++_sp & 255u) == 0u) { if (xb_ld(&(bar)[XB_TMO])) break; if (_sp > XB_SPIN_CAP) { atomicAdd(&(bar)[XB_TMO], 1u); break; } } } } while (0)
struct XcdBarrier { unsigned* bar; unsigned x; volatile LAS unsigned* st; };
__device__ __forceinline__ XcdBarrier xcd_barrier_post(unsigned* bar, volatile LAS unsigned* st) {
    XcdBarrier b; b.bar = bar; b.x = xb_xcc_id(); b.st = st;
    if (threadIdx.x == 0) (void)xb_add(&bar[XB_XCNT(b.x)], 1u);
    return b;
}
__device__ __forceinline__ void xcd_barrier_complete(unsigned* bar, unsigned x, unsigned& nloc, unsigned& nx) {
    const unsigned G = gridDim.x * gridDim.y * gridDim.z;
    unsigned sum, cnt, mine, sp = 0u;
    for (;;) {
        sum = 0u; cnt = 0u; mine = 0u;
#pragma unroll
        for (unsigned j = 0; j < 16; ++j) { const unsigned c = xb_ld(&bar[XB_XCNT(j)]); sum += c; cnt += (c > 0u) ? 1u : 0u; mine = (j == x) ? c : mine; }
        if (sum == G) break;
        __builtin_amdgcn_s_sleep(1);
        if ((++sp & 255u) == 0u) { if (xb_ld(&bar[XB_TMO])) break; if (sp > XB_SPIN_CAP) { atomicAdd(&bar[XB_TMO], 1u); break; } }
    }
    nloc = mine > 0u ? mine : 1u; nx = cnt > 0u ? cnt : 1u;
}
__device__ __forceinline__ void xcd_barrier(const XcdBarrier& b) {
    asm volatile("s_waitcnt vmcnt(0)" ::: "memory");
    __syncthreads();
    if (threadIdx.x == 0) {
        unsigned* bar = b.bar;
        __builtin_amdgcn_s_waitcnt(0);
        unsigned nloc = b.st[0], nx = b.st[1];
        if (nloc == 0u) { xcd_barrier_complete(bar, b.x, nloc, nx); b.st[0] = nloc; b.st[1] = nx; }
        const unsigned old = xb_add(&bar[XB_XSUB(b.x)], 1u);
        const unsigned gen = old / nloc;
        if (old + 1u == (gen + 1u) * nloc) {
            __builtin_amdgcn_fence(__ATOMIC_RELEASE, "agent");
            asm volatile("s_waitcnt vmcnt(0)" ::: "memory");
            const unsigned og = xb_add(&bar[XB_TOP], 1u);
            const unsigned tg = og / nx;
            if (og + 1u == (tg + 1u) * nx) xb_add(&bar[XB_TOPGEN], 1u);
            else XB_SPIN(xb_ld(&bar[XB_TOPGEN]) == tg, bar);
            __builtin_amdgcn_fence(__ATOMIC_ACQUIRE, "agent");
            xb_add(&bar[XB_XGEN(b.x)], 1u);
            asm volatile("s_waitcnt vmcnt(0)" ::: "memory");
        } else {
            XB_SPIN(xb_ld(&bar[XB_XGEN(b.x)]) == gen, bar);
            __builtin_amdgcn_fence(__ATOMIC_ACQUIRE, "agent");
            asm volatile("s_waitcnt vmcnt(0)" ::: "memory");
        }
    }
    __syncthreads();
}

struct Args {
    const float* in[17]; float* out; unsigned char* ws;
    double frev[40];
    int ph_lo, ph_hi, li, pad;
};
struct Frame {
    LAS unsigned char* lds;
    volatile LAS unsigned* MISC;
    gu32* ctl;
    int tid, lane, wave, vcu, G;
};

__device__ __forceinline__ int winperm(int n) {
    const int s = n >> 9, c = n & 511, hh = c >> 6, d = c & 63; int dp = d;
    if (s == 0 || s == 1) { if (d < 16) dp = 2 * (d & 7) + (d >> 3); }
    else if (s == 3 || s == 4) dp = 2 * (d & 31) + (d >> 5);
    return (s << 9) + (hh << 6) + dp;
}
template <int MODE>
__device__ __forceinline__ int tr_row(int ns) { return MODE == 0 ? winperm(ns) : MODE == 1 ? ns : MODE == 2 ? ((ns >> 7) << 8) + (ns & 127) : ((ns >> 7) << 8) + 128 + (ns & 127); }
__device__ __forceinline__ void tr_load(f32x4 (&v)[8], const float* S, int N, int kb, int nb, int lane) {
    const float* p = S + (size_t)(64 * kb + (lane >> 3)) * N + 32 * nb + (lane & 7) * 4;
#pragma unroll
    for (int i = 0; i < 8; ++i) v[i] = __builtin_nontemporal_load((const f32x4*)(p + (size_t)8 * i * N));
}
template <int MODE, bool NT = false>
__device__ __forceinline__ void tr_store(const f32x4 (&v)[8], bf16* Dst, int Kd, LAS float* scr, int kb, int nb, int lane, const float* kscale) {
    const int k0 = 64 * kb, n0 = 32 * nb;
#pragma unroll
    for (int i = 0; i < 8; ++i) { const int kk = 8 * i + (lane >> 3); const float sc = kscale ? kscale[k0 + kk] : 1.f; LAS float* d = scr + kk * 33 + (lane & 7) * 4;
        d[0] = v[i][0] * sc; d[1] = v[i][1] * sc; d[2] = v[i][2] * sc; d[3] = v[i][3] * sc; }
    LDS_WAIT(); asm volatile("" ::: "memory");
    const int c = lane & 7;
#pragma unroll
    for (int j = 0; j < 4; ++j) { const int n = (lane >> 3) + 8 * j; const LAS float* s = scr + (8 * c) * 33 + n;
        u32x4 o; o.x = pk2(s[0 * 33], s[1 * 33]); o.y = pk2(s[2 * 33], s[3 * 33]); o.z = pk2(s[4 * 33], s[5 * 33]); o.w = pk2(s[6 * 33], s[7 * 33]);
        if (NT) __builtin_nontemporal_store(o, (u32x4*)(Dst + (size_t)tr_row<MODE>(n0 + n) * Kd + k0 + 8 * c)); else *(GAS u32x4*)(Dst + (size_t)tr_row<MODE>(n0 + n) * Kd + k0 + 8 * c) = o; }
    LDS_WAIT(); asm volatile("" ::: "memory");
}
template <int MODE>
__device__ __forceinline__ void p0_transpose_item(const float* S, int N, bf16* Dst, int Kd, LAS float* scr, int kb, int nb, int lane, const float* kscale) {
    f32x4 v[8]; tr_load(v, S, N, kb, nb, lane); tr_store<MODE>(v, Dst, Kd, scr, kb, nb, lane, kscale);
}
constexpr int N_GU_ITEMS = 512 * NEXP;
__device__ __forceinline__ void expert_it(int it, int& e, int& r) { if (it < N_GU_ITEMS) { e = it >> 9; r = it & 511; } else { const int d = it - N_GU_ITEMS; e = d >> 8; r = 512 + (d & 255); } }
__device__ __forceinline__ void expert_src(const Args& A, int it, const float*& S, int& N, int& kb, int& nb) {
    int e, r; expert_it(it, e, r);
    if (r < 256) { S = A.in[13] + (size_t)e * DM * FF; N = FF; kb = r >> 4; nb = r & 15; }
    else if (r < 512) { S = A.in[14] + (size_t)e * DM * FF; N = FF; kb = (r - 256) >> 4; nb = (r - 256) & 15; }
    else { S = A.in[15] + (size_t)e * FF * DM; N = DM; kb = (r - 512) >> 5; nb = (r - 512) & 31; }
}
__device__ __forceinline__ void expert_store(const Args& A, unsigned char* ws, int it, const f32x4 (&v)[8], LAS float* scr, int lane) {
    bf16* WGU = (bf16*)(ws + WS_WGU); bf16* WD = (bf16*)(ws + WS_WD);
    int e, r; expert_it(it, e, r);
    if (r < 256) tr_store<2, true>(v, WGU + (size_t)e * DM * DM, DM, scr, r >> 4, r & 15, lane, A.in[8]);
    else if (r < 512) tr_store<3, true>(v, WGU + (size_t)e * DM * DM, DM, scr, (r - 256) >> 4, (r - 256) & 15, lane, A.in[8]);
    else tr_store<1, true>(v, WD + (size_t)e * DM * FF, FF, scr, (r - 512) >> 5, (r - 512) & 31, lane, nullptr);
}
__device__ __forceinline__ void expert_items(const Args& A, unsigned char* ws, LAS float* scr, int lo, int NI, int w0, int nw, int lane) {
    for (int it = lo + w0; it < NI; it += 4 * nw) {
        f32x4 v0[8], v1[8], v2[8], v3[8]; const float* S; int N, kb, nb;
        expert_src(A, it, S, N, kb, nb); tr_load(v0, S, N, kb, nb, lane);
        if (it + nw < NI) { expert_src(A, it + nw, S, N, kb, nb); tr_load(v1, S, N, kb, nb, lane); }
        if (it + 2 * nw < NI) { expert_src(A, it + 2 * nw, S, N, kb, nb); tr_load(v2, S, N, kb, nb, lane); }
        if (it + 3 * nw < NI) { expert_src(A, it + 3 * nw, S, N, kb, nb); tr_load(v3, S, N, kb, nb, lane); }
        expert_store(A, ws, it, v0, scr, lane);
        if (it + nw < NI) expert_store(A, ws, it + nw, v1, scr, lane);
        if (it + 2 * nw < NI) expert_store(A, ws, it + 2 * nw, v2, scr, lane);
        if (it + 3 * nw < NI) expert_store(A, ws, it + 3 * nw, v3, scr, lane);
    }
}
__device__ __forceinline__ void p0_prologue(Frame& F, const Args& A) {
    unsigned char* ws = A.ws;
    LAS float* scr = (LAS float*)(F.lds + F.wave * 16384);
    const int gw = F.vcu * NWAVES + F.wave, NGW = F.G * NWAVES;
    constexpr int I_IN = 16 * 112, I_OUT = 16 * 32;
    bf16* WIN = (bf16*)(ws + WS_WIN); bf16* WOUT = (bf16*)(ws + WS_WOUT);
    for (int it = gw; it < I_IN + I_OUT; it += NGW) {
        int r = it;
        if (r < I_IN) { p0_transpose_item<0>(A.in[2], NIN, WIN, DM, scr, r / 112, r % 112, F.lane, nullptr); continue; } r -= I_IN;
        const int kb = r / 32; p0_transpose_item<1>(A.in[7], DM, WOUT, DM, scr, kb, r % 32, F.lane, kb < 8 ? A.in[3] : A.in[6] - 512);
    }
    expert_items(A, ws, scr, F.G == 256 ? N_CONV_P1 : 0, F.G == 256 ? N_GU_ITEMS : 768 * NEXP, gw, NGW, F.lane);
    { const float* x = A.in[0]; const float* g = A.in[1]; bf16* XN = (bf16*)(ws + WS_XN);
      f32x4 gv[4];
#pragma unroll
      for (int j = 0; j < 4; ++j) gv[j] = ((const f32x4*)g)[F.lane + 64 * j];
      for (int m0 = gw; m0 < M; m0 += 4 * NGW) {
        f32x4 v[4][4];
#pragma unroll
        for (int k = 0; k < 4; ++k) { const GAS f32x4* xr = (const GAS f32x4*)(x + (size_t)(m0 + k * NGW) * DM) + F.lane;
#pragma unroll
            for (int j = 0; j < 4; ++j) v[k][j] = __builtin_nontemporal_load(xr + 64 * j); }
#pragma unroll
        for (int k = 0; k < 4; ++k) { float s = 0.f;
#pragma unroll
            for (int j = 0; j < 4; ++j) s += (v[k][j].x * v[k][j].x + v[k][j].y * v[k][j].y) + (v[k][j].z * v[k][j].z + v[k][j].w * v[k][j].w);
            const float rstd = 1.f / sqrtf(wave_sum(s) * (1.f / DM) + NORM_EPS);
            GAS unsigned long long* o8 = (GAS unsigned long long*)(XN + (size_t)(m0 + k * NGW) * DM) + F.lane;
#pragma unroll
            for (int j = 0; j < 4; ++j) { const f32x4 t = v[k][j] * rstd * gv[j]; o8[64 * j] = (unsigned long long)pk2(t.x, t.y) | ((unsigned long long)pk2(t.z, t.w) << 32); } }
      } }
    { const int gt = (F.vcu * NWAVES + F.wave) * 64 + F.lane, NT = NGW * 64;
      bf16* WRH = (bf16*)(ws + WS_WRT); bf16* WRL = WRH + 48 * DM; const float* gf = A.in[8]; const float* wg = A.in[9]; const float* we = A.in[11];
      for (int idx = gt; idx < 48 * DM; idx += NT) { const int j = idx >> 10, i = idx & 1023;
          const float v = (j < 32 ? we[i * 32 + j] : (j < 36 ? wg[i * 4 + (j - 32)] : 0.f)) * gf[i];
          const unsigned hb = pk2(v, 0.f) & 0xffffu; const float lo = v - bflo(hb); WRH[idx] = (bf16)hb; WRL[idx] = (bf16)(pk2(lo, 0.f) & 0xffffu); }
      float* RC = (float*)(ws + WS_ROPE); float* RS = RC + SEQ * 40;
      for (int idx = gt; idx < SEQ * 40; idx += NT) { const int pos = idx / 40, f = idx % 40;
          double rv = (double)pos * A.frev[f]; rv -= floor(rv); const float r = (float)rv;
          RC[idx] = __builtin_amdgcn_cosf(r); RS[idx] = __builtin_amdgcn_sinf(r); } }
}

struct SrcPlain {
    const bf16* A; const bf16* Bt; int K;
    __device__ __forceinline__ void setup(const pg8::Unit& u, const int (&RA)[2], const int (&CA)[2], const char*& cA, const char*& cB, unsigned (&v0)[2], unsigned (&v1)[2]) const {
        cA = (const char*)A + (size_t)u.pm * 256 * K * 2; cB = (const char*)Bt + (size_t)u.pn * 256 * K * 2;
#pragma unroll
        for (int i = 0; i < 2; ++i) { v0[i] = (unsigned)(RA[i] * K + CA[i]) * 2u; v1[i] = v0[i] + (unsigned)(128 * K * 2); }
    }
};
struct TileTab { const LAS int* TE; const LAS int* NE; const LAS int* T0; };
struct SrcGather {
    const bf16* HG; const bf16* WGU; const int* LIST; TileTab tt;
    __device__ __forceinline__ void setup(const pg8::Unit& u, const int (&RA)[2], const int (&CA)[2], const char*& cA, const char*& cB, unsigned (&v0)[2], unsigned (&v1)[2]) const {
        const int e = tt.TE[u.pm], ne = tt.NE[e], p0 = (u.pm - tt.T0[e]) * 256;
        cA = (const char*)HG; cB = (const char*)WGU + ((size_t)e * DM + (size_t)u.pn * 256) * DM * 2;
#pragma unroll
        for (int i = 0; i < 2; ++i) {
            const int pa = p0 + RA[i], pb = pa + 128;
            const int ta = pa < ne ? (LIST[e * M + pa] >> 1) : 0, tb = pb < ne ? (LIST[e * M + pb] >> 1) : 0;
            v0[i] = (unsigned)(ta * DM + CA[i]) * 2u; v1[i] = (unsigned)(tb * DM + CA[i]) * 2u; }
    }
};
struct SrcDown {
    const bf16* HID; const bf16* WD; TileTab tt;
    __device__ __forceinline__ void setup(const pg8::Unit& u, const int (&RA)[2], const int (&CA)[2], const char*& cA, const char*& cB, unsigned (&v0)[2], unsigned (&v1)[2]) const {
        const int e = tt.TE[u.pm];
        cA = (const char*)HID + (size_t)u.pm * 256 * FF * 2; cB = (const char*)WD + ((size_t)e * DM + (size_t)u.pn * 256) * FF * 2;
#pragma unroll
        for (int i = 0; i < 2; ++i) { v0[i] = (unsigned)(RA[i] * FF + CA[i]) * 2u; v1[i] = v0[i] + (unsigned)(128 * FF * 2); }
    }
};

struct EpiInProj {
    static constexpr bool PERM = true;
    bf16* SEG; const float* RC; const float* RS;
    __device__ __forceinline__ void operator()(const f32x4 (&acc)[2][2][4][2], const pg8::Unit& u, int wr, int wc, int fr, int fq) const {
        const int seg = u.pn >> 1, colt = (u.pn & 1) * 256;
        bf16* base = SEG + (size_t)seg * M * SEGW;
        const int dq = (wc & 1) * 32 + 8 * fq;
        const bool attn = seg < 2, ret = (seg == 3 || seg == 4);
        const bool rot = ret || (attn && dq < 16);
        const int i0 = ret ? 8 + (dq >> 1) : (dq >> 1);
        const float sc = seg == 0 ? 0.125f * LOG2E : (seg == 4 ? 0.125f : 1.f);
#pragma unroll
        for (int ai = 0; ai < 2; ++ai)
#pragma unroll
            for (int m = 0; m < 4; ++m) {
                const int row = u.pm * 256 + ai * 128 + wr * 64 + m * 16 + fr, pos = row & (SEQ - 1);
                f32x4 c4 = {1.f, 1.f, 1.f, 1.f}, s4 = {0.f, 0.f, 0.f, 0.f};
                if (rot) { c4 = *(const f32x4*)(RC + pos * 40 + i0); s4 = *(const f32x4*)(RS + pos * 40 + i0); }
                bf16* rowp = base + (size_t)row * SEGW + colt + wc * 32 + 8 * fq;
#pragma unroll
                for (int bj = 0; bj < 2; ++bj) {
                    f32x4 v0 = acc[ai][bj][m][0], v1 = acc[ai][bj][m][1];
                    if (attn || ret) {
                        f32x4 r0, r1;
                        r0[0] = v0[0] * c4[0] - v0[1] * s4[0]; r0[1] = v0[1] * c4[0] + v0[0] * s4[0];
                        r0[2] = v0[2] * c4[1] - v0[3] * s4[1]; r0[3] = v0[3] * c4[1] + v0[2] * s4[1];
                        r1[0] = v1[0] * c4[2] - v1[1] * s4[2]; r1[1] = v1[1] * c4[2] + v1[0] * s4[2];
                        r1[2] = v1[2] * c4[3] - v1[3] * s4[3]; r1[3] = v1[3] * c4[3] + v1[2] * s4[3];
                        v0 = r0 * sc; v1 = r1 * sc;
                    } else if (seg == 6) {
#pragma unroll
                        for (int e = 0; e < 4; ++e) { v0[e] = silu_f(v0[e]); v1[e] = silu_f(v1[e]); }
                    }
                    u32x4 w; w.x = pk2(v0[0], v0[1]); w.y = pk2(v0[2], v0[3]); w.z = pk2(v1[0], v1[1]); w.w = pk2(v1[2], v1[3]);
                    *(u32x4*)(rowp + bj * 128) = w;
                }
            }
    }
};
struct EpiOutProj {
    static constexpr bool PERM = true;
    const float* X; bf16* HB;
    __device__ __forceinline__ void operator()(const f32x4 (&acc)[2][2][4][2], const pg8::Unit& u, int wr, int wc, int fr, int fq) const {
        const int col0 = u.pn * 256 + wc * 32 + 8 * fq;
#pragma unroll
        for (int ai = 0; ai < 2; ++ai)
#pragma unroll
            for (int m = 0; m < 4; ++m) { const size_t off = (size_t)(u.pm * 256 + ai * 128 + wr * 64 + m * 16 + fr) * DM + col0;
#pragma unroll
                for (int bj = 0; bj < 2; ++bj) { const f32x4 h0 = __builtin_nontemporal_load((const f32x4*)(X + off + bj * 128)) + acc[ai][bj][m][0], h1 = __builtin_nontemporal_load((const f32x4*)(X + off + bj * 128 + 4)) + acc[ai][bj][m][1];
                    u32x4 w; w.x = pk2(h0[0], h0[1]); w.y = pk2(h0[2], h0[3]); w.z = pk2(h1[0], h1[1]); w.w = pk2(h1[2], h1[3]); *(u32x4*)(HB + off + bj * 128) = w; }
                if (m & 1) asm volatile("" ::: "memory"); }
    }
};
struct EpiGateUp {
    static constexpr bool PERM = true;
    bf16* HID; const float* GATEL; const float* RSL; TileTab tt;
    __device__ __forceinline__ void operator()(const f32x4 (&acc)[2][2][4][2], const pg8::Unit& u, int wr, int wc, int fr, int fq) const {
        const int e = tt.TE[u.pm], ne = tt.NE[e], p0 = (u.pm - tt.T0[e]) * 256;
#pragma unroll
        for (int ai = 0; ai < 2; ++ai)
#pragma unroll
            for (int m = 0; m < 4; ++m) {
                const int rr = ai * 128 + wr * 64 + m * 16 + fr, pos = p0 + rr;
                float rs = 0.f, gt = 0.f; if (pos < ne) { rs = RSL[e * M + pos]; gt = GATEL[e * M + pos]; }
                u32x4 w; unsigned* wp = (unsigned*)&w;
#pragma unroll
                for (int n = 0; n < 2; ++n) { const f32x4 g = acc[ai][0][m][n] * rs, up = acc[ai][1][m][n] * rs; float hv[4];
#pragma unroll
                    for (int q = 0; q < 4; ++q) hv[q] = silu_f(g[q]) * up[q] * gt;
                    wp[2 * n] = pk2(hv[0], hv[1]); wp[2 * n + 1] = pk2(hv[2], hv[3]); }
                *(u32x4*)(HID + (size_t)(u.pm * 256 + rr) * FF + u.pn * 128 + wc * 32 + 8 * fq) = w;
            }
    }
};
struct EpiDown {
    static constexpr bool PERM = true;
    bf16* Y; const int* LIST; TileTab tt;
    __device__ __forceinline__ void operator()(const f32x4 (&acc)[2][2][4][2], const pg8::Unit& u, int wr, int wc, int fr, int fq) const {
        const int e = tt.TE[u.pm], ne = tt.NE[e], p0 = (u.pm - tt.T0[e]) * 256;
#pragma unroll
        for (int ai = 0; ai < 2; ++ai)
#pragma unroll
            for (int m = 0; m < 4; ++m) {
                const int pos = p0 + ai * 128 + wr * 64 + m * 16 + fr;
                if (pos < ne) { const int tk = LIST[e * M + pos]; bf16* rowp = Y + (size_t)tk * DM + u.pn * 256 + wc * 32 + 8 * fq;
#pragma unroll
                    for (int bj = 0; bj < 2; ++bj) { const f32x4 v0 = acc[ai][bj][m][0], v1 = acc[ai][bj][m][1];
                        u32x4 w; w.x = pk2(v0[0], v0[1]); w.y = pk2(v0[2], v0[3]); w.z = pk2(v1[0], v1[1]); w.w = pk2(v1[2], v1[3]);
                        *(u32x4*)(rowp + bj * 128) = w; } }
            }
    }
};

typedef short v4i16_t __attribute__((ext_vector_type(4)));
__device__ __forceinline__ s16x4 vtr(const LAS unsigned char* p) { return __builtin_bit_cast(s16x4, __builtin_amdgcn_ds_read_tr16_b64_v4i16((LAS v4i16_t*)p)); }
#define MFMA32(a, b, c) __builtin_amdgcn_mfma_f32_32x32x16_bf16((a), (b), (c), 0, 0, 0)
__device__ __forceinline__ bf16x8 pack8(const f32x16& x, int s) {
    u32x4 p; p.x = pk2(x[8 * s], x[8 * s + 1]); p.y = pk2(x[8 * s + 2], x[8 * s + 3]); p.z = pk2(x[8 * s + 4], x[8 * s + 5]); p.w = pk2(x[8 * s + 6], x[8 * s + 7]);
    return __builtin_bit_cast(bf16x8, p);
}
__device__ __forceinline__ bf16x8 cat44(s16x4 lo, s16x4 hi) { return __builtin_shufflevector(lo, hi, 0, 1, 2, 3, 4, 5, 6, 7); }
__device__ __forceinline__ bf16x8 scale8(bf16x8 v, float s) {
    u32x4 u = __builtin_bit_cast(u32x4, v), o;
    o.x = pk2(bflo(u.x) * s, bfhi(u.x) * s); o.y = pk2(bflo(u.y) * s, bfhi(u.y) * s); o.z = pk2(bflo(u.z) * s, bfhi(u.z) * s); o.w = pk2(bflo(u.w) * s, bfhi(u.w) * s);
    return __builtin_bit_cast(bf16x8, o);
}
constexpr int TP = 144;
__device__ __forceinline__ void pv_tile_p(f32x16& ot0, f32x16& ot1, const f32x16& st, const LAS unsigned char* vl, int lane) {
    const int hi = lane >> 5;
    const LAS unsigned char* vr = vl + (4 * hi + ((lane & 15) >> 2)) * TP + (16 * ((lane >> 4) & 1) + 4 * (lane & 3)) * 2;
    const bf16x8 pb0 = pack8(st, 0), pb1 = pack8(st, 1);
    { const bf16x8 va = cat44(vtr(vr), vtr(vr + 8 * TP)); ot0 = MFMA32(va, pb0, ot0); }
    { const bf16x8 va = cat44(vtr(vr + 16 * TP), vtr(vr + 24 * TP)); ot0 = MFMA32(va, pb1, ot0); }
    { const bf16x8 va = cat44(vtr(vr + 64), vtr(vr + 8 * TP + 64)); ot1 = MFMA32(va, pb0, ot1); }
    { const bf16x8 va = cat44(vtr(vr + 16 * TP + 64), vtr(vr + 24 * TP + 64)); ot1 = MFMA32(va, pb1, ot1); }
}
__device__ __forceinline__ void kv_task(int cid, const bf16* KR, const bf16* VR, bf16* KV, const float* dec_f, const float* dec_b, LAS unsigned char* wl, int lane) {
    const int bh = cid >> 5, n = cid & 31, b = bh >> 3, h = bh & 7, q = lane & 31, hi = lane >> 5, tr = lane >> 3, tc = (lane & 7) * 8;
    const float lgf = __uint_as_float(__builtin_amdgcn_readfirstlane(__float_as_uint(log1pf(-exp2f(dec_f[h])) * LOG2E))), lgb = __uint_as_float(__builtin_amdgcn_readfirstlane(__float_as_uint(log1pf(-exp2f(dec_b[h])) * LOG2E)));
    const size_t row0 = (size_t)b * SEQ + n * CHUNK; const int loff = tr * SEGW + tc;
    const bf16* Kb = KR + row0 * SEGW + h * HD; const bf16* Vb = VR + row0 * SEGW + h * HD;
    LAS unsigned char* Tf = wl; LAS unsigned char* Tb = wl + 32 * TP; LAS unsigned char* Tv = wl + 64 * TP; LAS unsigned char* tw = wl + tr * TP + tc * 2;
    const int tro = (8 * hi + ((lane & 15) >> 2)) * TP + (16 * ((lane >> 4) & 1) + 4 * (lane & 3)) * 2;
    f32x16 acc[2][2][2];
#pragma unroll
    for (int d = 0; d < 2; ++d)
#pragma unroll
        for (int a = 0; a < 2; ++a)
#pragma unroll
            for (int c = 0; c < 2; ++c)
#pragma unroll
                for (int r = 0; r < 16; ++r) acc[d][a][c][r] = 0.f;
    bf16x8 nk[4], nv[4];
#pragma unroll
    for (int i = 0; i < 4; ++i) { nk[i] = *(const bf16x8*)(Kb + loff + 8 * i * SEGW); nv[i] = *(const bf16x8*)(Vb + loff + 8 * i * SEGW); }
#pragma unroll 1
    for (int it = 0; it < 4; ++it) {
#pragma unroll
        for (int i = 0; i < 4; ++i) { const int key = 32 * it + tr + 8 * i;
            *(LAS bf16x8*)(tw + 8 * i * TP) = scale8(nk[i], __builtin_amdgcn_exp2f((float)(CHUNK - 1 - key) * lgf));
            *(LAS bf16x8*)(tw + 32 * TP + 8 * i * TP) = scale8(nk[i], __builtin_amdgcn_exp2f((float)key * lgb));
            *(LAS bf16x8*)(tw + 64 * TP + 8 * i * TP) = nv[i]; }
        if (it < 3) {
#pragma unroll
            for (int i = 0; i < 4; ++i) { nk[i] = *(const bf16x8*)(Kb + 32 * (it + 1) * SEGW + loff + 8 * i * SEGW); nv[i] = *(const bf16x8*)(Vb + 32 * (it + 1) * SEGW + loff + 8 * i * SEGW); } }
        asm volatile("" ::: "memory");
#pragma unroll
        for (int s2 = 0; s2 < 2; ++s2) {
            bf16x8 bv[2];
#pragma unroll
            for (int c = 0; c < 2; ++c) bv[c] = cat44(vtr(Tv + tro + s2 * 16 * TP + c * 64), vtr(Tv + tro + s2 * 16 * TP + 4 * TP + c * 64));
#pragma unroll
            for (int a = 0; a < 2; ++a) {
                const bf16x8 af = cat44(vtr(Tf + tro + s2 * 16 * TP + a * 64), vtr(Tf + tro + s2 * 16 * TP + 4 * TP + a * 64));
                const bf16x8 ab = cat44(vtr(Tb + tro + s2 * 16 * TP + a * 64), vtr(Tb + tro + s2 * 16 * TP + 4 * TP + a * 64));
#pragma unroll
                for (int c = 0; c < 2; ++c) { acc[0][a][c] = MFMA32(af, bv[c], acc[0][a][c]); acc[1][a][c] = MFMA32(ab, bv[c], acc[1][a][c]); }
            }
        }
        asm volatile("" ::: "memory");
    }
#pragma unroll
    for (int d = 0; d < 2; ++d) { bf16* ob = KV + (((size_t)bh * NCHUNK + n) * 2 + d) * 4096;
#pragma unroll
        for (int a = 0; a < 2; ++a)
#pragma unroll
            for (int c = 0; c < 2; ++c)
#pragma unroll
                for (int g = 0; g < 4; ++g) { u32x2 w; w.x = pk2(acc[d][a][c][4 * g], acc[d][a][c][4 * g + 1]); w.y = pk2(acc[d][a][c][4 * g + 2], acc[d][a][c][4 * g + 3]);
                    *(u32x2*)(ob + ((c * 4 + 2 * a + (g >> 1)) * 64 + q + 32 * (g & 1)) * 8 + 4 * hi) = w; } }
}

struct AttnRound { size_t rowbase; int dil, qb0, nblk, h, br; };
__device__ __forceinline__ AttnRound round_decode(int rg) {
    AttnRound a; const int bh = rg / 48, x = rg - bh * 48, br = x >> 4, w16 = x & 15; int cls, qb0;
    if (br == 0) { cls = 0; qb0 = 8 * w16; } else if (br == 1) { cls = w16 >> 2; qb0 = 8 * (w16 & 3); } else { cls = w16; qb0 = 0; }
    a.rowbase = (size_t)(bh >> 3) * SEQ + cls; a.dil = 1 << (2 * br); a.qb0 = qb0; a.nblk = (SEQ >> (2 * br)) >> 5; a.h = bh & 7; a.br = br; return a;
}
__device__ __forceinline__ int round_id(int r0, int xl, int rr) { if (xl < 0) return r0 + rr; const int t = rr / 3, i = rr - 3 * t; return (r0 + 2 * t + (xl >> 4)) * 48 + 3 * (xl & 15) + i; }
__device__ __forceinline__ void attn_rounds(int r0, int xl, int nr, const bf16* QA, const bf16* KA, const bf16* VA, bf16* OBR, float* LSE, LAS unsigned char* lds, int wave, int lane) {
    const int q = lane & 31, hi = lane >> 5, tr = lane >> 3, tc = (lane & 7) * 8;
    LAS unsigned char* Qt = lds + (24 + wave) * (32 * TP);
    const int twoff = tr * TP + tc * 2;
    bf16x8 pt[3][4], pq[4];
    AttnRound nx = round_decode(round_id(r0, xl, 0));
#define ATT_PREFETCH(R) do { \
        _Pragma("unroll") for (int x_ = 0; x_ < 3; ++x_) { const int tile = 3 * wave + x_, slot = tile >= 12 ? tile - 12 : tile, j_ = (R).qb0 - 2 + slot; \
            if (j_ >= 0 && j_ < (R).nblk) { const bf16* src = (tile >= 12 ? VA : KA) + ((R).rowbase + (size_t)(R).dil * (32 * j_ + tr)) * SEGW + (R).h * HD + tc; \
                _Pragma("unroll") for (int i_ = 0; i_ < 4; ++i_) pt[x_][i_] = *(const bf16x8*)(src + (size_t)(R).dil * 8 * i_ * SEGW); } } \
        { const bf16* src = QA + ((R).rowbase + (size_t)(R).dil * (32 * ((R).qb0 + wave) + tr)) * SEGW + (R).h * HD + tc; \
          _Pragma("unroll") for (int i_ = 0; i_ < 4; ++i_) pq[i_] = *(const bf16x8*)(src + (size_t)(R).dil * 8 * i_ * SEGW); } } while (0)
    ATT_PREFETCH(nx);
#pragma unroll 1
    for (int rr = 0; rr < nr; ++rr) {
        const AttnRound cu = nx;
        __syncthreads();
#pragma unroll
        for (int x = 0; x < 3; ++x) { const int tile = 3 * wave + x, slot = tile >= 12 ? tile - 12 : tile, j = cu.qb0 - 2 + slot;
            if (j >= 0 && j < cu.nblk) { LAS unsigned char* tb = lds + tile * (32 * TP) + twoff;
#pragma unroll
                for (int i = 0; i < 4; ++i) *(LAS bf16x8*)(tb + 8 * i * TP) = pt[x][i]; } }
#pragma unroll
        for (int i = 0; i < 4; ++i) *(LAS bf16x8*)(Qt + twoff + 8 * i * TP) = pq[i];
        if (rr + 1 < nr) { nx = round_decode(round_id(r0, xl, rr + 1)); ATT_PREFETCH(nx); }
        __syncthreads();
        bf16x8 qr[4];
#pragma unroll
        for (int ks = 0; ks < 4; ++ks) qr[ks] = *(const LAS bf16x8*)(Qt + q * TP + hi * 16 + 32 * ks);
        float mrun = -1e30f, lsum = 0.f; f32x16 ot0, ot1;
#pragma unroll
        for (int r = 0; r < 16; ++r) { ot0[r] = 0.f; ot1[r] = 0.f; }
        const int jb = cu.qb0 + wave - 2, klo = jb < 0 ? -jb : 0, khi = jb + 4 >= cu.nblk ? cu.nblk - 1 - jb : 4;
        f32x16 stn;
#define ATT_QK(dst, kb_) do { const LAS unsigned char* Kt_ = lds + (wave + (kb_)) * (32 * TP); _Pragma("unroll") for (int r_ = 0; r_ < 16; ++r_) dst[r_] = 0.f; \
            _Pragma("unroll") for (int ks_ = 0; ks_ < 4; ++ks_) dst = MFMA32(*(const LAS bf16x8*)(Kt_ + q * TP + hi * 16 + 32 * ks_), qr[ks_], dst); } while (0)
        ATT_QK(stn, klo);
#pragma unroll 1
        for (int kb = klo; kb <= khi; ++kb) {
            f32x16 st = stn;
            if (kb < khi) ATT_QK(stn, kb + 1);
            const LAS unsigned char* Vt = lds + (12 + wave + kb) * (32 * TP);
            if (kb == 0) {
#pragma unroll
                for (int r = 0; r < 16; ++r) if (crow(r, hi) < q) st[r] = -1e30f;
            }
            if (kb == 4) {
#pragma unroll
                for (int r = 0; r < 16; ++r) if (crow(r, hi) > q) st[r] = -1e30f;
            }
            float mx = st[0];
#pragma unroll
            for (int r = 1; r < 16; ++r) mx = fmaxf(mx, st[r]);
            mx = fmaxf(mx, __shfl_xor(mx, 32));
            if (!__all(mx <= mrun + 8.f)) {
                const float mnew = fmaxf(mrun, mx), alpha = __builtin_amdgcn_exp2f(mrun - mnew); mrun = mnew; lsum *= alpha;
#pragma unroll
                for (int r = 0; r < 16; ++r) { ot0[r] *= alpha; ot1[r] *= alpha; }
            }
            float ps = 0.f;
#pragma unroll
            for (int r = 0; r < 16; ++r) { st[r] = __builtin_amdgcn_exp2f(st[r] - mrun); ps += st[r]; }
            lsum += ps;
            pv_tile_p(ot0, ot1, st, Vt, lane);
        }
#undef ATT_QK
        const float lt = lsum + __shfl_xor(lsum, 32);
        const float inv = 1.f / lt, lse = (mrun + __log2f(lt)) * LN2;
        asm volatile("" ::: "memory");
        LAS unsigned char* ow = Qt + q * TP + 8 * hi;
#pragma unroll
        for (int g = 0; g < 4; ++g) {
            u32x2 w0, w1; w0.x = pk2(ot0[4 * g] * inv, ot0[4 * g + 1] * inv); w0.y = pk2(ot0[4 * g + 2] * inv, ot0[4 * g + 3] * inv);
            w1.x = pk2(ot1[4 * g] * inv, ot1[4 * g + 1] * inv); w1.y = pk2(ot1[4 * g + 2] * inv, ot1[4 * g + 3] * inv);
            *(LAS u32x2*)(ow + 16 * g) = w0; *(LAS u32x2*)(ow + 64 + 16 * g) = w1; }
        asm volatile("" ::: "memory");
        const size_t qbase = cu.rowbase + (size_t)cu.dil * 32 * (cu.qb0 + wave);
#pragma unroll
        for (int i = 0; i < 4; ++i) { const u32x4 v = *(const LAS u32x4*)(Qt + twoff + 8 * i * TP);
            *(u32x4*)(OBR + ((size_t)cu.br * M + qbase + (size_t)cu.dil * (tr + 8 * i)) * SEGW + cu.h * HD + tc) = v; }
        if (hi == 0) LSE[((size_t)cu.br * M + qbase + (size_t)cu.dil * q) * NHEAD + cu.h] = lse;
        asm volatile("" ::: "memory");
    }
#undef ATT_PREFETCH
    __syncthreads();
}

constexpr int R_K = 0, R_V = 128 * TP, R_Q = 2 * 128 * TP, R_G = 3 * 128 * TP, R_O = 4 * 128 * TP, R_SF = 5 * 128 * TP, R_SB = R_SF + 8192, R_X = R_SB + 8192;
__device__ __forceinline__ void ret_wg(int wgt, const bf16* QR, const bf16* KR, const bf16* VR, const bf16* GR, const bf16* KV, bf16* SBW, bf16* MIXED, const float* dec_f, const float* dec_b,
                                       const bf16* OBR, const float* LSE, long crow0, LAS unsigned char* lds, int tid, int wave, int lane) {
    const int bh = wgt >> 2, n0 = (wgt & 3) * 8, b = bh >> 3, h = bh & 7, q = lane & 31, hi = lane >> 5, tr = lane >> 3, tc = (lane & 7) * 8;
    const float lgf = __uint_as_float(__builtin_amdgcn_readfirstlane(__float_as_uint(log1pf(-exp2f(dec_f[h])) * LOG2E))), lgb = __uint_as_float(__builtin_amdgcn_readfirstlane(__float_as_uint(log1pf(-exp2f(dec_b[h])) * LOG2E)));
    const float gf128 = exp2f(128.f * lgf), gb128 = exp2f(128.f * lgb);
    float pf[16], pb[16];
#pragma unroll
    for (int r = 0; r < 16; ++r) { const int dl = q - crow(r, hi); pf[r] = exp2f((float)dl * lgf); pb[r] = exp2f((float)(-dl) * lgb); }
    const bf16* KVt = KV + (size_t)bh * NCHUNK * 2 * 4096 + 8 * tid;
    bf16* SBt = SBW + (size_t)bh * NCHUNK * 4096 + 8 * tid;
    float Sf[8], Sb[8];
#pragma unroll
    for (int e = 0; e < 8; ++e) { Sf[e] = 0.f; Sb[e] = 0.f; }
#define RET_AXPY(S, g, v) do { S[0] = S[0] * (g) + bflo((v).x); S[1] = S[1] * (g) + bfhi((v).x); S[2] = S[2] * (g) + bflo((v).y); S[3] = S[3] * (g) + bfhi((v).y); \
                               S[4] = S[4] * (g) + bflo((v).z); S[5] = S[5] * (g) + bfhi((v).z); S[6] = S[6] * (g) + bflo((v).w); S[7] = S[7] * (g) + bfhi((v).w); } while (0)
    for (int m0 = 0; m0 < n0; m0 += 8) { u32x4 v[8];
#pragma unroll
        for (int k = 0; k < 8; ++k) v[k] = *(const u32x4*)(KVt + (size_t)((m0 + k) * 2) * 4096);
#pragma unroll
        for (int k = 0; k < 8; ++k) RET_AXPY(Sf, gf128, v[k]); }
    for (int m0 = NCHUNK - 8; m0 >= n0 + 8; m0 -= 8) { u32x4 v[8];
#pragma unroll
        for (int k = 0; k < 8; ++k) v[k] = *(const u32x4*)(KVt + (size_t)((m0 + 7 - k) * 2 + 1) * 4096);
#pragma unroll
        for (int k = 0; k < 8; ++k) RET_AXPY(Sb, gb128, v[k]); }
    { u32x4 v[8];
#pragma unroll
      for (int k = 0; k < 8; ++k) v[k] = *(const u32x4*)(KVt + (size_t)((n0 + 7 - k) * 2 + 1) * 4096);
#pragma unroll
      for (int k = 0; k < 8; ++k) { u32x4 w; w.x = pk2(Sb[0], Sb[1]); w.y = pk2(Sb[2], Sb[3]); w.z = pk2(Sb[4], Sb[5]); w.w = pk2(Sb[6], Sb[7]);
          *(u32x4*)(SBt + (size_t)(n0 + 7 - k) * 4096) = w; RET_AXPY(Sb, gb128, v[k]); } }
    VM_WAIT();
    const int tsel = wave >> 1, rbase = 64 * (wave & 1) + tr;
    const bf16* tsrc = (tsel == 0 ? KR : tsel == 1 ? VR : tsel == 2 ? QR : GR) + ((size_t)b * SEQ + rbase) * SEGW + h * HD + tc;
    LAS unsigned char* tdst = lds + tsel * (128 * TP) + rbase * TP + tc * 2;
    const int qb = wave & 3, dvh = wave >> 2;
    bf16x8 pre[8]; u32x4 pkv, psb;
#define RET_PREFETCH(n_) do { _Pragma("unroll") for (int i_ = 0; i_ < 8; ++i_) pre[i_] = __builtin_nontemporal_load((const bf16x8*)(tsrc + (size_t)((n_) * CHUNK + 8 * i_) * SEGW)); \
        pkv = *(const u32x4*)(KVt + (size_t)((n_) * 2) * 4096); psb = *(const u32x4*)(SBt + (size_t)(n_) * 4096); } while (0)
    RET_PREFETCH(n0);
#pragma unroll 1
    for (int jn = 0; jn < 8; ++jn) {
        const int n = n0 + jn; const size_t row0 = (size_t)b * SEQ + n * CHUNK;
        __syncthreads();
        if (jn > 0) {
#pragma unroll
            for (int i = 0; i < 2; ++i) { const int r = 16 * wave + 8 * i + tr; const u32x4 v = *(const LAS u32x4*)(lds + R_O + r * TP + tc * 2);
                *(u32x4*)(MIXED + (row0 - CHUNK + r) * DM + 512 + h * HD + tc) = v; } }
#pragma unroll
        for (int i = 0; i < 8; ++i) *(LAS bf16x8*)(tdst + 8 * i * TP) = pre[i];
        { u32x4 w; w.x = pk2(Sf[0], Sf[1]); w.y = pk2(Sf[2], Sf[3]); w.z = pk2(Sf[4], Sf[5]); w.w = pk2(Sf[6], Sf[7]);
          *(LAS u32x4*)(lds + R_SF + tid * 16) = w; *(LAS u32x4*)(lds + R_SB + tid * 16) = psb; }
        RET_AXPY(Sf, gf128, pkv);
        if (jn < 7) RET_PREFETCH(n + 1);
        float cl[3]; u32x4 ca[3];
#define RET_CLOAD(rw_) do { _Pragma("unroll") for (int br_ = 0; br_ < 3; ++br_) { cl[br_] = LSE[((size_t)br_ * M + (rw_)) * NHEAD + (lane >> 3)]; ca[br_] = __builtin_nontemporal_load((const u32x4*)(OBR + ((size_t)br_ * M + (rw_)) * SEGW + 8 * lane)); } } while (0)
#define RET_CFIN(rw_) do { const float mx_ = fmaxf(cl[0], fmaxf(cl[1], cl[2])); float w0_ = __expf(cl[0] - mx_), w1_ = __expf(cl[1] - mx_), w2_ = __expf(cl[2] - mx_); \
            const float inv_ = 1.f / (w0_ + w1_ + w2_); w0_ *= inv_; w1_ *= inv_; w2_ *= inv_; float o_[8]; float ssq_ = 0.f; \
            _Pragma("unroll") for (int e_ = 0; e_ < 4; ++e_) { o_[2 * e_] = w0_ * bflo(ca[0][e_]) + w1_ * bflo(ca[1][e_]) + w2_ * bflo(ca[2][e_]); o_[2 * e_ + 1] = w0_ * bfhi(ca[0][e_]) + w1_ * bfhi(ca[1][e_]) + w2_ * bfhi(ca[2][e_]); ssq_ += o_[2 * e_] * o_[2 * e_] + o_[2 * e_ + 1] * o_[2 * e_ + 1]; } \
            const float rs_ = 1.f / sqrtf(wave_sum(ssq_) * (1.f / 512.f) + NORM_EPS); \
            u32x4 w_; w_.x = pk2(o_[0] * rs_, o_[1] * rs_); w_.y = pk2(o_[2] * rs_, o_[3] * rs_); w_.z = pk2(o_[4] * rs_, o_[5] * rs_); w_.w = pk2(o_[6] * rs_, o_[7] * rs_); \
            *(u32x4*)(MIXED + (rw_) * DM + 8 * lane) = w_; } while (0)
        if (crow0 >= 0) RET_CLOAD((size_t)crow0 + 2 * jn);
        __syncthreads();
        const int i_ = 32 * qb + q;
        bf16x8 qr[4];
#pragma unroll
        for (int ks = 0; ks < 4; ++ks) qr[ks] = *(const LAS bf16x8*)(lds + R_Q + i_ * TP + hi * 16 + 32 * ks);
        f32x16 ot;
#pragma unroll
        for (int r = 0; r < 16; ++r) ot[r] = 0.f;
        const LAS unsigned char* vr = lds + R_V + (4 * hi + ((lane & 15) >> 2)) * TP + (32 * dvh + 16 * ((lane >> 4) & 1) + 4 * (lane & 3)) * 2;
#pragma unroll 1
        for (int kb = 0; kb < 4; ++kb) {
            f32x16 st;
#pragma unroll
            for (int r = 0; r < 16; ++r) st[r] = 0.f;
#pragma unroll
            for (int ks = 0; ks < 4; ++ks) st = MFMA32(*(const LAS bf16x8*)(lds + R_K + (32 * kb + q) * TP + hi * 16 + 32 * ks), qr[ks], st);
#pragma unroll
            for (int r = 0; r < 16; ++r) st[r] *= (kb == qb ? (q >= crow(r, hi) ? pf[r] : pb[r]) : kb < qb ? pf[r] : pb[r]);
            if (kb != qb) { const float sc = kb < qb ? exp2f((float)(32 * (qb - kb)) * lgf) : exp2f((float)(32 * (kb - qb)) * lgb);
#pragma unroll
                for (int r = 0; r < 16; ++r) st[r] *= sc; }
            const bf16x8 pb0 = pack8(st, 0), pb1 = pack8(st, 1);
            const LAS unsigned char* v0 = vr + 32 * kb * TP;
            ot = MFMA32(cat44(vtr(v0), vtr(v0 + 8 * TP)), pb0, ot);
            ot = MFMA32(cat44(vtr(v0 + 16 * TP), vtr(v0 + 24 * TP)), pb1, ot);
        }
        {   const float cf = exp2f((float)(i_ + 1) * lgf), cb = exp2f((float)(CHUNK - i_) * lgb);
            f32x16 t;
#pragma unroll
            for (int r = 0; r < 16; ++r) t[r] = 0.f;
#pragma unroll
            for (int ks = 0; ks < 4; ++ks) t = MFMA32(*(const LAS bf16x8*)(lds + R_SF + ((dvh * 4 + ks) * 64 + lane) * 16), qr[ks], t);
#pragma unroll
            for (int r = 0; r < 16; ++r) ot[r] += cf * t[r];
#pragma unroll
            for (int r = 0; r < 16; ++r) t[r] = 0.f;
#pragma unroll
            for (int ks = 0; ks < 4; ++ks) t = MFMA32(*(const LAS bf16x8*)(lds + R_SB + ((dvh * 4 + ks) * 64 + lane) * 16), qr[ks], t);
#pragma unroll
            for (int r = 0; r < 16; ++r) ot[r] += cb * t[r]; }
        if (crow0 >= 0) { RET_CFIN((size_t)crow0 + 2 * jn); RET_CLOAD((size_t)crow0 + 2 * jn + 1); }
        float s1 = 0.f, s2 = 0.f;
#pragma unroll
        for (int r = 0; r < 16; ++r) { s1 += ot[r]; s2 += ot[r] * ot[r]; }
        s1 += __shfl_xor(s1, 32); s2 += __shfl_xor(s2, 32);
        if (hi == 0) *(LAS f32x2*)(lds + R_X + (wave * 32 + q) * 8) = (f32x2){s1, s2};
        __syncthreads();
        { const f32x2 p = *(const LAS f32x2*)(lds + R_X + ((wave ^ 4) * 32 + q) * 8); s1 += p.x; s2 += p.y; }
        const float mean = s1 * (1.f / 64.f), var = fmaxf(s2 * (1.f / 64.f) - mean * mean, 0.f), rstd = 1.f / sqrtf(var + NORM_EPS);
        const LAS unsigned char* gp = lds + R_G + i_ * TP + (32 * dvh + 4 * hi) * 2; LAS unsigned char* op = lds + R_O + i_ * TP + (32 * dvh + 4 * hi) * 2;
#pragma unroll
        for (int g = 0; g < 4; ++g) { const u32x2 gg = *(const LAS u32x2*)(gp + 16 * g); u32x2 w;
            w.x = pk2((ot[4 * g] - mean) * rstd * bflo(gg.x), (ot[4 * g + 1] - mean) * rstd * bfhi(gg.x)); w.y = pk2((ot[4 * g + 2] - mean) * rstd * bflo(gg.y), (ot[4 * g + 3] - mean) * rstd * bfhi(gg.y));
            *(LAS u32x2*)(op + 16 * g) = w; }
        if (crow0 >= 0) RET_CFIN((size_t)crow0 + 2 * jn + 1);
    }
#undef RET_CLOAD
#undef RET_CFIN
    __syncthreads();
    { const size_t row0 = (size_t)b * SEQ + (n0 + 7) * CHUNK;
#pragma unroll
      for (int i = 0; i < 2; ++i) { const int r = 16 * wave + 8 * i + tr; const u32x4 v = *(const LAS u32x4*)(lds + R_O + r * TP + tc * 2);
          *(u32x4*)(MIXED + (row0 + r) * DM + 512 + h * HD + tc) = v; } }
    __syncthreads();
#undef RET_AXPY
#undef RET_PREFETCH
}

template <int NR>
__device__ __forceinline__ void combine_rows(const size_t (&rows)[NR], const bf16* OBR, const float* LSE, bf16* MIXED, int lane) {
    const int hh = lane >> 3;
    float l[NR][3]; u32x4 a[NR][3];
#pragma unroll
    for (int k = 0; k < NR; ++k)
#pragma unroll
        for (int br = 0; br < 3; ++br) { l[k][br] = LSE[((size_t)br * M + rows[k]) * NHEAD + hh]; a[k][br] = *(const u32x4*)(OBR + ((size_t)br * M + rows[k]) * SEGW + 8 * lane); }
#pragma unroll
    for (int k = 0; k < NR; ++k) {
        const float mx = fmaxf(l[k][0], fmaxf(l[k][1], l[k][2])); float w0 = __expf(l[k][0] - mx), w1 = __expf(l[k][1] - mx), w2 = __expf(l[k][2] - mx);
        const float inv = 1.f / (w0 + w1 + w2); w0 *= inv; w1 *= inv; w2 *= inv;
        float o[8]; float ss = 0.f;
#pragma unroll
        for (int e = 0; e < 4; ++e) { o[2 * e] = w0 * bflo(a[k][0][e]) + w1 * bflo(a[k][1][e]) + w2 * bflo(a[k][2][e]); o[2 * e + 1] = w0 * bfhi(a[k][0][e]) + w1 * bfhi(a[k][1][e]) + w2 * bfhi(a[k][2][e]); ss += o[2 * e] * o[2 * e] + o[2 * e + 1] * o[2 * e + 1]; }
        const float rstd = 1.f / sqrtf(wave_sum(ss) * (1.f / 512.f) + NORM_EPS);
        u32x4 w; w.x = pk2(o[0] * rstd, o[1] * rstd); w.y = pk2(o[2] * rstd, o[3] * rstd); w.z = pk2(o[4] * rstd, o[5] * rstd); w.w = pk2(o[6] * rstd, o[7] * rstd);
        *(u32x4*)(MIXED + rows[k] * DM + 8 * lane) = w;
    }
}
constexpr int RP = 528;
constexpr int R5_W = 0, R5_A = 2 * 48 * RP, R5_SC = R5_A + 8 * 16 * RP, R5_CNT = R5_SC + 8 * 3200;
__device__ __forceinline__ void route_wg(int wgt, const bf16* HB, const bf16* WR, const float* bg, const float* be, gu32* ctl, int* LIST, float* GATEL, float* RSL, LAS unsigned char* lds, int tid, int wave, int lane) {
    const size_t row0 = (size_t)wgt * 128;
    LAS unsigned* cntL = (LAS unsigned*)(lds + R5_CNT); LAS unsigned* baseL = cntL + 32;
    if (tid < 32) cntL[tid] = 0u;
    u32x4 pw[6], pa[8];
#define R5_PREF(kc) do { _Pragma("unroll") for (int i_ = 0; i_ < 6; ++i_) { const int idx = tid + 512 * i_; pw[i_] = *(const u32x4*)(WR + (size_t)(idx >> 5) * DM + 256 * (kc) + 8 * (idx & 31)); } \
        _Pragma("unroll") for (int i_ = 0; i_ < 8; ++i_) pa[i_] = *(const u32x4*)(HB + (row0 + 16 * wave + 2 * i_ + (lane >> 5)) * DM + 256 * (kc) + 8 * (lane & 31)); } while (0)
    R5_PREF(0);
    f32x4 acc[3]; float ss = 0.f;
#pragma unroll
    for (int c = 0; c < 3; ++c) acc[c] = (f32x4){0.f, 0.f, 0.f, 0.f};
    const LAS unsigned char* Aw = lds + R5_A + wave * 16 * RP;
#pragma unroll 1
    for (int kc = 0; kc < 4; ++kc) {
        __syncthreads();
#pragma unroll
        for (int i = 0; i < 6; ++i) { const int idx = tid + 512 * i; *(LAS u32x4*)(lds + R5_W + (idx >> 5) * RP + (idx & 31) * 16) = pw[i]; }
#pragma unroll
        for (int i = 0; i < 8; ++i) *(LAS u32x4*)(lds + R5_A + (wave * 16 + 2 * i + (lane >> 5)) * RP + (lane & 31) * 16) = pa[i];
        if (kc < 3) R5_PREF(kc + 1);
        __syncthreads();
#pragma unroll
        for (int ks = 0; ks < 8; ++ks) {
            const int ko = (32 * ks + 8 * (lane >> 4)) * 2;
            const bf16x8 a = *(const LAS bf16x8*)(Aw + (lane & 15) * RP + ko);
            { const u32x4 au = __builtin_bit_cast(u32x4, a);
#pragma unroll
              for (int e = 0; e < 4; ++e) { const float lo = bflo(au[e]), hi_ = bfhi(au[e]); ss += lo * lo + hi_ * hi_; } }
#pragma unroll
            for (int c = 0; c < 3; ++c)
#pragma unroll
                for (int p = 0; p < 2; ++p) { const bf16x8 bb = *(const LAS bf16x8*)(lds + R5_W + (p * 48 + 16 * c + (lane & 15)) * RP + ko);
                    acc[c] = __builtin_amdgcn_mfma_f32_16x16x32_bf16(a, bb, acc[c], 0, 0, 0); }
        }
    }
#undef R5_PREF
    ss += __shfl_xor(ss, 16); ss += __shfl_xor(ss, 32);
    const float rstd = 1.f / sqrtf(ss * (1.f / DM) + NORM_EPS);
    LAS float* sc = (LAS float*)(lds + R5_SC + wave * 3200);
    { const int r = lane & 15, g = lane >> 4;
#pragma unroll
      for (int e = 0; e < 4; ++e) { sc[(4 * g + e) * 48 + r] = acc[0][e]; sc[(4 * g + e) * 48 + 16 + r] = acc[1][e]; sc[(4 * g + e) * 48 + 32 + r] = acc[2][e]; }
      if (g == 0) sc[768 + r] = rstd; }
    LDS_WAIT(); asm volatile("" ::: "memory");
    int e1 = 0, e2 = 0; unsigned r1 = 0, r2 = 0; float g1 = 0.f, g2 = 0.f, rs = 0.f;
    if (lane < 16) {
        rs = sc[768 + lane]; const LAS float* lg = sc + lane * 48;
        float gmax = lg[32] * rs + bg[0]; int gi = 0; float gl[4]; gl[0] = gmax;
#pragma unroll
        for (int k = 1; k < 4; ++k) { gl[k] = lg[32 + k] * rs + bg[k]; if (gl[k] > gmax) { gmax = gl[k]; gi = k; } }
        float den = 0.f;
#pragma unroll
        for (int k = 0; k < 4; ++k) den += __expf(gl[k] - gmax);
        const float ggate = 1.f / den;
        float b1v = -3.0e38f, b2v = -3.0e38f; int i1 = 0, i2 = 0;
        for (int k = 0; k < 8; ++k) { const float v = lg[gi * 8 + k] * rs + be[gi * 8 + k]; if (v > b1v) { b1v = v; i1 = k; } }
        for (int k = 0; k < 8; ++k) { const float v = lg[gi * 8 + k] * rs + be[gi * 8 + k]; if (k != i1 && v > b2v) { b2v = v; i2 = k; } }
        const float p1 = 1.f / (1.f + __expf(b2v - b1v));
        g1 = ggate * p1; g2 = ggate * (1.f - p1); e1 = gi * 8 + i1; e2 = gi * 8 + i2;
        r1 = __hip_atomic_fetch_add(cntL + e1, 1u, __ATOMIC_RELAXED, __HIP_MEMORY_SCOPE_WORKGROUP); r2 = __hip_atomic_fetch_add(cntL + e2, 1u, __ATOMIC_RELAXED, __HIP_MEMORY_SCOPE_WORKGROUP);
    }
    __syncthreads();
    if (tid < 32) { const unsigned c = cntL[tid]; baseL[tid] = c ? __hip_atomic_fetch_add(ctl + CW_CNT + 64 * tid, c, RLX_AGENT) : 0u; }
    __syncthreads();
    if (lane < 16) {
        const size_t trow = row0 + 16 * wave + lane; const size_t s1 = (size_t)e1 * M + baseL[e1] + r1, s2 = (size_t)e2 * M + baseL[e2] + r2;
        LIST[s1] = (int)(trow * 2); GATEL[s1] = g1; RSL[s1] = rs;
        LIST[s2] = (int)(trow * 2 + 1); GATEL[s2] = g2; RSL[s2] = rs;
    }
    __syncthreads();
}
template <int NR>
__device__ __forceinline__ void final_rows(const size_t (&rows)[NR], const bf16* H, const bf16* Y, const f32x4 (&gv)[4], float* out, int lane) {
    u32x2 hv[NR][4], a[NR][4], b[NR][4];
#pragma unroll
    for (int k = 0; k < NR; ++k) { const u32x2* hp = (const u32x2*)(H + rows[k] * DM) + lane; const u32x2* y0 = (const u32x2*)(Y + (rows[k] * 2) * DM) + lane; const u32x2* y1 = (const u32x2*)(Y + (rows[k] * 2 + 1) * DM) + lane;
#pragma unroll
        for (int j = 0; j < 4; ++j) { hv[k][j] = __builtin_nontemporal_load(hp + 64 * j); a[k][j] = __builtin_nontemporal_load(y0 + 64 * j); b[k][j] = __builtin_nontemporal_load(y1 + 64 * j); } }
#pragma unroll
    for (int k = 0; k < NR; ++k) { f32x4 z[4]; float ss = 0.f;
#pragma unroll
        for (int j = 0; j < 4; ++j) {
            z[j][0] = bflo(hv[k][j].x) + bflo(a[k][j].x) + bflo(b[k][j].x); z[j][1] = bfhi(hv[k][j].x) + bfhi(a[k][j].x) + bfhi(b[k][j].x); z[j][2] = bflo(hv[k][j].y) + bflo(a[k][j].y) + bflo(b[k][j].y); z[j][3] = bfhi(hv[k][j].y) + bfhi(a[k][j].y) + bfhi(b[k][j].y);
            ss += (z[j][0] * z[j][0] + z[j][1] * z[j][1]) + (z[j][2] * z[j][2] + z[j][3] * z[j][3]); }
        const float rstd = 1.f / sqrtf(wave_sum(ss) * (1.f / DM) + NORM_EPS);
        f32x4* op = (f32x4*)(out + rows[k] * DM) + lane;
#pragma unroll
        for (int j = 0; j < 4; ++j) __builtin_nontemporal_store(z[j] * rstd * gv[j], op + 64 * j); }
}
__device__ __forceinline__ TileTab build_tiles(Frame& F, int& ntiles) {
    LAS int* T = (LAS int*)(F.lds + TILE_OFF); LAS int* TE = T; LAS int* NE = T + MAXTILES; LAS int* T0 = NE + 32; LAS int* NT = T0 + 32;
    __syncthreads();
    if (F.tid == 0) { int t = 0;
        for (int e = 0; e < NEXP; ++e) { int n = (int)__hip_atomic_load(F.ctl + CW_CNT + 64 * e, RLX_AGENT); if (n > M) n = M; NE[e] = n; T0[e] = t; const int k = (n + 255) >> 8;
            for (int j = 0; j < k && t + j < MAXTILES; ++j) TE[t + j] = e; t += k; if (t > MAXTILES) t = MAXTILES; }
        NT[0] = t; }
    __syncthreads();
    ntiles = NT[0];
    TileTab tt; tt.TE = TE; tt.NE = NE; tt.T0 = T0; return tt;
}

__device__ __forceinline__ int fresh_lane() { int t = threadIdx.x; asm volatile("" : "+v"(t)); return t & 63; }
constexpr int N_LAUNCHES = MK_N_LAUNCHES, PER_PHASE = 9;
__global__ void __launch_bounds__(NWAVES * 64, 2) mk_fwd(Args args) {
    extern __shared__ __attribute__((aligned(16))) unsigned char lds_raw[];
    Frame F;
    F.lds = (LAS unsigned char*)lds_raw;
    F.MISC = (volatile LAS unsigned*)(F.lds + MISC_OFF);
    F.tid = threadIdx.x; F.lane = F.tid & 63; F.wave = __builtin_amdgcn_readfirstlane(F.tid >> 6);
    F.G = gridDim.x; { const int bx = blockIdx.x; F.vcu = (F.G % 8 == 0) ? (bx % 8) * (F.G / 8) + bx / 8 : bx; }
    unsigned char* ws = args.ws;
    F.ctl = (gu32*)(ws + WS_CTL);
    for (int u = F.tid; u < (LDS_BYTES - LDSCTL_OFF) / 4; u += NWAVES * 64) ((LAS unsigned*)(F.lds + LDSCTL_OFF))[u] = 0u;
    __syncthreads();
    XcdBarrier bar; bar.bar = (unsigned*)(F.ctl + CW_BAR); bar.x = 0; bar.st = nullptr;
    if (N_LAUNCHES != PER_PHASE) bar = xcd_barrier_post((unsigned*)(F.ctl + CW_BAR) + args.li * XCD_BAR_WORDS, F.MISC + 8);
#define GRID_BAR() do { if (N_LAUNCHES != PER_PHASE) xcd_barrier(bar); } while (0)
    const int lo = args.ph_lo, hi = args.ph_hi;
#define IN(k) (lo <= (k) && (k) < hi)
#define REPS(k) ((MK_REPEAT == (k)) ? MK_NREP : 1)
#define BOTH(k) (IN(k) && IN((k) + 1))
    const int gw = F.vcu * NWAVES + F.wave, NGW = F.G * NWAVES;
#if MK_TIME
    int n_stamp = 0;
#define STAMP() do { if (blockIdx.x == 0 && F.tid == 0) { const unsigned long long t_ = __builtin_amdgcn_s_memrealtime(); __hip_atomic_store(F.ctl + CW_TS + 2 * n_stamp, (unsigned)t_, RLX_AGENT); __hip_atomic_store(F.ctl + CW_TS + 2 * n_stamp + 1, (unsigned)(t_ >> 32), RLX_AGENT); } ++n_stamp; } while (0)
    STAMP();
#else
#define STAMP() do {} while (0)
#endif
    bf16* SEGB = (bf16*)(ws + WS_SEG);
    const bf16 *QA = SEGB, *KA = SEGB + (size_t)1 * M * SEGW, *VA = SEGB + (size_t)2 * M * SEGW, *QR = SEGB + (size_t)3 * M * SEGW, *KR = SEGB + (size_t)4 * M * SEGW, *VR = SEGB + (size_t)5 * M * SEGW, *GR = SEGB + (size_t)6 * M * SEGW;

    for (int rep_ = 0; rep_ < REPS(0); ++rep_) if (IN(0)) { p0_prologue(F, args); if (BOTH(0)) GRID_BAR(); STAMP(); }
    for (int rep_ = 0; rep_ < REPS(1); ++rep_) if (IN(1)) {
        const int bx = (int)blockIdx.x, rowg = bx >> 3; const bool split = (F.G == 256), conv = split && ((rowg & 7) == 7);
        if (conv) {
            expert_items(args, ws, (LAS float*)(F.lds + F.wave * 16384), 0, N_CONV_P1, (((rowg >> 3) << 3) + (bx & 7)) * NWAVES + F.wave, 32 * NWAVES, fresh_lane());
        } else {
            pg8::StaticOrder S; if (split) S.init(M / 256, NIN / 256, 224, (rowg - ((rowg + 1) >> 3)) * 8 + (bx & 7)); else S.init(M / 256, NIN / 256, F.G, bx);
            SrcPlain SRC{(const bf16*)(ws + WS_XN), (const bf16*)(ws + WS_WIN), DM};
            EpiInProj E{SEGB, (const float*)(ws + WS_ROPE), (const float*)(ws + WS_ROPE) + SEQ * 40};
            pg8::gemm_phase<EpiInProj, pg8::StaticOrder, SrcPlain, true, true>(F.lds, DM, S, SRC, E);
        }
        if (BOTH(1)) GRID_BAR(); STAMP();
    }
    for (int rep_ = 0; rep_ < REPS(2); ++rep_) if (IN(2)) {
        bf16* OBR = (bf16*)(ws + WS_OBR); float* LSE = (float*)(ws + WS_LSE); bf16* KVB = (bf16*)(ws + WS_ST);
        for (int cid = gw; cid < NBATCH * NHEAD * NCHUNK; cid += NGW) kv_task(cid, KR, VR, KVB, args.in[4], args.in[5], F.lds + F.wave * 16384, fresh_lane());
        { const int nrt = NBATCH * NHEAD * 48, per = (nrt + F.G - 1) / F.G, r0 = F.vcu * per, nr = r0 + per <= nrt ? per : (nrt > r0 ? nrt - r0 : 0);
          __syncthreads();
          if (F.G == 256) attn_rounds((F.vcu >> 5) * 8, F.vcu & 31, 12, QA, KA, VA, OBR, LSE, F.lds, F.wave, fresh_lane());
          else if (nr > 0) attn_rounds(r0, -1, nr, QA, KA, VA, OBR, LSE, F.lds, F.wave, fresh_lane()); }
        if (BOTH(2)) GRID_BAR(); STAMP();
    }
    for (int rep_ = 0; rep_ < REPS(3); ++rep_) if (IN(3)) {
        bf16* MIXED = (bf16*)(ws + WS_MIXED);
        const bool fold = (F.G == 256);
        for (int wgt = F.vcu; wgt < NBATCH * NHEAD * 4; wgt += F.G) { int t_ = threadIdx.x; asm volatile("" : "+v"(t_));
            ret_wg(wgt, QR, KR, VR, GR, (const bf16*)(ws + WS_ST), (bf16*)(ws + WS_SBW), MIXED, args.in[4], args.in[5], (const bf16*)(ws + WS_OBR), (const float*)(ws + WS_LSE),
                   fold ? (long)wgt * 128 + F.wave * 16 : -1L, F.lds, t_, F.wave, t_ & 63); }
        if (!fold) { const int ln = fresh_lane();
          for (int row = gw; row < M; row += 4 * NGW) { const size_t rows[4] = {(size_t)row, (size_t)(row + NGW), (size_t)(row + 2 * NGW), (size_t)(row + 3 * NGW)};
              combine_rows<4>(rows, (const bf16*)(ws + WS_OBR), (const float*)(ws + WS_LSE), MIXED, ln); } }
        if (BOTH(3)) GRID_BAR(); STAMP();
    }
    for (int rep_ = 0; rep_ < REPS(4); ++rep_) if (IN(4)) {
        pg8::StaticOrder S; S.init(M / 256, DM / 256, F.G, (int)blockIdx.x);
        SrcPlain SRC{(const bf16*)(ws + WS_MIXED), (const bf16*)(ws + WS_WOUT), DM};
        EpiOutProj E{args.in[0], (bf16*)(ws + WS_HG)};
        pg8::gemm_phase<EpiOutProj, pg8::StaticOrder, SrcPlain, true, true>(F.lds, DM, S, SRC, E);
        if (BOTH(4)) GRID_BAR(); STAMP();
    }
    for (int rep_ = 0; rep_ < REPS(5); ++rep_) if (IN(5)) {
        if (rep_ > 0) { if (blockIdx.x == 0 && F.tid < NEXP) __hip_atomic_store(F.ctl + CW_CNT + 64 * F.tid, 0u, RLX_AGENT); GRID_BAR(); }
        for (int wgt = F.vcu; wgt < M / 128; wgt += F.G) { int t_ = threadIdx.x; asm volatile("" : "+v"(t_));
            route_wg(wgt, (const bf16*)(ws + WS_HG), (const bf16*)(ws + WS_WRT), args.in[10], args.in[12], F.ctl, (int*)(ws + WS_LIST), (float*)(ws + WS_GATEL), (float*)(ws + WS_RSL), F.lds, t_, F.wave, t_ & 63); }
        if (BOTH(5)) GRID_BAR(); STAMP();
    }
    for (int rep_ = 0; rep_ < REPS(6); ++rep_) if (IN(6)) {
        int ntiles; const TileTab tt = build_tiles(F, ntiles);
        pg8::StaticOrder S; S.init(ntiles, 4, F.G, (int)blockIdx.x);
        SrcGather SRC{(const bf16*)(ws + WS_HG), (const bf16*)(ws + WS_WGU), (const int*)(ws + WS_LIST), tt};
        EpiGateUp E{(bf16*)(ws + WS_HID), (const float*)(ws + WS_GATEL), (const float*)(ws + WS_RSL), tt};
        pg8::gemm_phase<EpiGateUp, pg8::StaticOrder, SrcGather, true, true>(F.lds, DM, S, SRC, E);
        if (F.G == 256) {
            const int nu = ntiles * 4, rounds = (nu + 255) >> 8, last = nu - (rounds - 1) * 256, nidle = 256 - last, bx = (int)blockIdx.x;
            if (nidle >= 32) { if (bx >= last) expert_items(args, ws, (LAS float*)(F.lds + F.wave * 16384), N_GU_ITEMS, 768 * NEXP, (bx - last) * NWAVES + F.wave, nidle * NWAVES, fresh_lane()); }
            else expert_items(args, ws, (LAS float*)(F.lds + F.wave * 16384), N_GU_ITEMS, 768 * NEXP, gw, NGW, fresh_lane());
        }
        if (BOTH(6)) GRID_BAR(); STAMP();
    }
    for (int rep_ = 0; rep_ < REPS(7); ++rep_) if (IN(7)) {
        int ntiles; const TileTab tt = build_tiles(F, ntiles);
        pg8::StaticOrder S; S.init(ntiles, 4, F.G, (int)blockIdx.x);
        SrcDown SRC{(const bf16*)(ws + WS_HID), (const bf16*)(ws + WS_WD), tt};
        EpiDown E{(bf16*)(ws + WS_Y), (const int*)(ws + WS_LIST), tt};
        pg8::gemm_phase<EpiDown, pg8::StaticOrder, SrcDown, true, true>(F.lds, FF, S, SRC, E);
        if (BOTH(7)) GRID_BAR(); STAMP();
    }
    for (int rep_ = 0; rep_ < REPS(8); ++rep_) if (IN(8)) {
        f32x4 gv[4];
#pragma unroll
        for (int j = 0; j < 4; ++j) gv[j] = ((const f32x4*)args.in[16])[fresh_lane() + 64 * j];
        { const int ln = fresh_lane();
          for (int row = gw; row < M; row += 2 * NGW) { const size_t rows[2] = {(size_t)row, (size_t)(row + NGW)}; final_rows<2>(rows, (const bf16*)(ws + WS_HG), (const bf16*)(ws + WS_Y), gv, args.out, ln); } }
#if MK_TIME
        STAMP();
        if (blockIdx.x == 0 && F.tid == 0) {
            unsigned long long ts[10];
#pragma unroll
            for (int k = 0; k < 10; ++k) ts[k] = (unsigned long long)__hip_atomic_load(F.ctl + CW_TS + 2 * k, RLX_AGENT) | ((unsigned long long)__hip_atomic_load(F.ctl + CW_TS + 2 * k + 1, RLX_AGENT) << 32);
            const float t = MK_TIME == 10 ? (float)(ts[9] - ts[0]) * 0.01f : (float)(ts[MK_TIME] - ts[MK_TIME - 1]) * 0.01f;
            VM_WAIT(); args.out[0] = t * MK_TSCALE; }
#endif
    }
#undef IN
#undef BOTH
#undef GRID_BAR
}

#if MK_CHECK
__device__ __forceinline__ unsigned hsh(unsigned x) { x ^= x >> 16; x *= 0x7feb352dU; x ^= x >> 15; x *= 0x846ca68bU; x ^= x >> 16; return x; }
__device__ __forceinline__ float ldb(const bf16* p, size_t i) { return __uint_as_float(((unsigned)p[i]) << 16); }
__device__ __forceinline__ float rbf(float x) { return bflo(pk2(x, 0.f) & 0xffffu); }
__device__ __forceinline__ void chk_put(gu32* ctl, int stage, float got, float ref, float atol) {
    float e = fabsf(got - ref) / (0.03f * fabsf(ref) + atol); if (!(e == e)) e = 1e30f; if (e > 1e30f) e = 1e30f;
    __hip_atomic_fetch_max(ctl + CW_CHK + stage, __float_as_uint(e), RLX_AGENT);
}
__global__ void __launch_bounds__(256) chk_kernel(Args A, int stage) {
    unsigned char* ws = A.ws; gu32* ctl = (gu32*)(ws + WS_CTL);
    const int gt = blockIdx.x * 256 + threadIdx.x, NT = gridDim.x * 256;
    const bf16* SEGB = (const bf16*)(ws + WS_SEG);
    const bf16 *QA = SEGB, *KA = SEGB + (size_t)1 * M * SEGW, *VA = SEGB + (size_t)2 * M * SEGW, *QR = SEGB + (size_t)3 * M * SEGW, *KR = SEGB + (size_t)4 * M * SEGW, *VR = SEGB + (size_t)5 * M * SEGW, *GR = SEGB + (size_t)6 * M * SEGW;
    if (stage == 0) {
        const bf16* WIN = (const bf16*)(ws + WS_WIN); const bf16* WOUT = (const bf16*)(ws + WS_WOUT); const bf16* WGU = (const bf16*)(ws + WS_WGU); const bf16* WD = (const bf16*)(ws + WS_WD);
        for (int s = gt; s < 65536; s += NT) { const unsigned r = hsh(s * 7 + 1), r2 = hsh(r);
            { const int n = r % NIN, k = r2 % DM; chk_put(ctl, 0, ldb(WIN, (size_t)winperm(n) * DM + k), A.in[2][(size_t)k * NIN + n], 1e-4f); }
            { const int n = r % DM, k = r2 % DM; chk_put(ctl, 0, ldb(WOUT, (size_t)n * DM + k), A.in[7][(size_t)k * DM + n] * (k < 512 ? A.in[3][k] : A.in[6][k - 512]), 1e-4f); }
            { const int j = r % 36, i = r2 % DM; const float ref = (j < 32 ? A.in[11][i * 32 + j] : A.in[9][i * 4 + j - 32]) * A.in[8][i]; chk_put(ctl, 0, 1000.f * (ldb((const bf16*)(ws + WS_WRT), j * DM + i) + ldb((const bf16*)(ws + WS_WRT), (48 + j) * DM + i)), 1000.f * ref, 1e-3f); }
            { const int pos = r % SEQ, f = r2 % 40; const float fr = f < 8 ? powf(500000.f, -(float)f / 8.f) : powf(10000.f, -(float)(f - 8) / 31.f); const float ang = (float)pos * fr;
              chk_put(ctl, 0, ((const float*)(ws + WS_ROPE))[pos * 40 + f], cosf(ang), 2e-3f); chk_put(ctl, 0, ((const float*)(ws + WS_ROPE))[SEQ * 40 + pos * 40 + f], sinf(ang), 2e-3f); }
        }
        for (int s = gt; s < 2048; s += NT) { const unsigned r = hsh(s * 13 + 5); const int row = r % M, c = hsh(r) % DM; const float* x = A.in[0] + (size_t)row * DM; float ss = 0.f;
            for (int k = 0; k < DM; ++k) ss += x[k] * x[k];
            chk_put(ctl, 0, ldb((const bf16*)(ws + WS_XN), (size_t)row * DM + c), x[c] / sqrtf(ss / DM + NORM_EPS) * A.in[1][c], 1e-3f); }
    }
    if (stage == 1) {
        const bf16* XN = (const bf16*)(ws + WS_XN);
        for (int s = gt; s < 8192; s += NT) { const unsigned r = hsh(s * 3 + 11), r2 = hsh(r); const int row = r % M, seg = r2 % 7, hh = (r2 >> 4) % 8, pos = row & (SEQ - 1);
            const int half = (seg == 0 || seg == 1) ? 8 : 32; const int i = (r2 >> 8) % half; const int d1 = i, d2 = i + half;
            float a1 = 0.f, a2 = 0.f; const float* w = A.in[2] + seg * 512 + hh * 64;
            for (int k = 0; k < DM; ++k) { const float xv = ldb(XN, (size_t)row * DM + k); a1 += xv * rbf(w[(size_t)k * NIN + d1]); a2 += xv * rbf(w[(size_t)k * NIN + d2]); }
            const bf16* O = SEGB + (size_t)seg * M * SEGW + (size_t)row * SEGW + hh * 64;
            if (seg == 0 || seg == 1 || seg == 3 || seg == 4) {
                const float fr = seg < 2 ? powf(500000.f, -(float)i / 8.f) : powf(10000.f, -(float)i / 31.f); const float ang = (float)pos * fr, c = cosf(ang), sn = sinf(ang);
                const float sc = seg == 0 ? 0.125f * LOG2E : (seg == 4 ? 0.125f : 1.f);
                chk_put(ctl, 1, ldb(O, 2 * i), (a1 * c - a2 * sn) * sc, 0.02f); chk_put(ctl, 1, ldb(O, 2 * i + 1), (a2 * c + a1 * sn) * sc, 0.02f);
                if (seg < 2) { const int d3 = 16 + (r2 >> 12) % 48; float a3 = 0.f; for (int k = 0; k < DM; ++k) a3 += ldb(XN, (size_t)row * DM + k) * rbf(w[(size_t)k * NIN + d3]); chk_put(ctl, 1, ldb(O, d3), a3 * sc, 0.02f); }
            } else { chk_put(ctl, 1, ldb(O, d1), seg == 6 ? silu_f(a1) : a1, 0.02f); chk_put(ctl, 1, ldb(O, d2), seg == 6 ? silu_f(a2) : a2, 0.02f); }
        }
    }
    if (stage == 2) {
        const bf16* OBR = (const bf16*)(ws + WS_OBR); const float* LSE = (const float*)(ws + WS_LSE); const bf16* ST = (const bf16*)(ws + WS_ST);
        for (int s = gt; s < 4096; s += NT) { const unsigned r = hsh(s * 5 + 3), r2 = hsh(r); const int b = r % NBATCH, pos = (s < 256) ? (s & 1 ? SEQ - 1 - (s >> 1) % 80 : (s >> 1) % 80) : (r >> 3) % SEQ, h = r2 % NHEAD, br = (r2 >> 3) % 3, dd = (r2 >> 8) % HD;
            const int dil = 1 << (2 * br); const size_t row = (size_t)b * SEQ + pos;
            float mx = -1e30f;
            for (int pass = 0; pass < 2; ++pass) { float l = 0.f, o = 0.f;
                for (int j = -64; j <= 64; ++j) { const int kp = pos + j * dil; if (kp < 0 || kp >= SEQ) continue; const size_t kr = (size_t)b * SEQ + kp; float d = 0.f;
                    for (int k = 0; k < HD; ++k) d += ldb(QA, row * SEGW + h * HD + k) * ldb(KA, kr * SEGW + h * HD + k);
                    if (pass == 0) mx = fmaxf(mx, d); else { const float p = exp2f(d - mx); l += p; o += p * ldb(VA, kr * SEGW + h * HD + dd); } }
                if (pass == 1) { chk_put(ctl, 2, ldb(OBR, ((size_t)br * M + row) * SEGW + h * HD + dd), o / l, 0.02f); chk_put(ctl, 2, LSE[((size_t)br * M + row) * NHEAD + h], (mx + log2f(l)) * LN2, 0.02f); } }
        }
        for (int s = gt; s < 8192; s += NT) { const unsigned r = hsh(s * 9 + 7), r2 = hsh(r); const int bh = r % 64, dir = (r >> 6) & 1, n = (r >> 7) % NCHUNK, dv = r2 % 64, dk = (r2 >> 6) % 64, b = bh >> 3, h = bh & 7;
            const float lg2 = log1pf(-exp2f((dir ? A.in[5] : A.in[4])[h])) * LOG2E; float S = 0.f;
            for (int j = 0; j < CHUNK; ++j) { const size_t row = (size_t)b * SEQ + n * CHUNK + j; const float ex = dir == 0 ? (float)(127 - j) : (float)j;
                S += exp2f(ex * lg2) * ldb(KR, row * SEGW + h * HD + dk) * ldb(VR, row * SEGW + h * HD + dv); }
            chk_put(ctl, 2, ldb(ST, (((size_t)bh * NCHUNK + n) * 2 + dir) * 4096 + ((size_t)((dv >> 5) * 4 + (dk >> 4)) * 64 + (dv & 31) + 32 * ((dk >> 3) & 1)) * 8 + (dk & 7)), S, 0.05f);
        }
    }
    if (stage == 3) {
        const bf16* MIXED = (const bf16*)(ws + WS_MIXED);
        for (int s = gt; s < 512; s += NT) { const unsigned r = hsh(s * 17 + 9), r2 = hsh(r); const int b = r % NBATCH, pos = (s < 64) ? (s & 1 ? SEQ - 1 - (s >> 1) * 5 : (s >> 1) * 5) : (r >> 3) % SEQ, h = r2 % NHEAD; const size_t row = (size_t)b * SEQ + pos;
            const float lgf = log1pf(-exp2f(A.in[4][h])) * LOG2E, lgb = log1pf(-exp2f(A.in[5][h])) * LOG2E;
            float o[HD], qv[HD];
#pragma unroll
            for (int k = 0; k < HD; ++k) { o[k] = 0.f; qv[k] = ldb(QR, row * SEGW + h * HD + k); }
            for (int kp = 0; kp < SEQ; ++kp) { const size_t kr = (size_t)b * SEQ + kp; const int dl = pos - kp; const float w = dl >= 0 ? exp2f((float)dl * lgf) : exp2f((float)(-dl) * lgb); if (w < 1e-12f) continue; float d = 0.f;
#pragma unroll
                for (int k = 0; k < HD; ++k) d += qv[k] * ldb(KR, kr * SEGW + h * HD + k);
                d *= w;
#pragma unroll
                for (int k = 0; k < HD; ++k) o[k] += d * ldb(VR, kr * SEGW + h * HD + k); }
            float mean = 0.f, var = 0.f;
#pragma unroll
            for (int k = 0; k < HD; ++k) mean += o[k];
            mean *= (1.f / HD);
#pragma unroll
            for (int k = 0; k < HD; ++k) var += (o[k] - mean) * (o[k] - mean);
            var *= (1.f / HD); const float rstd = 1.f / sqrtf(var + NORM_EPS);
#pragma unroll
            for (int k = 0; k < HD; ++k) if ((k & 7) == (int)(r2 >> 8) % 8) chk_put(ctl, 3, ldb(MIXED, row * DM + 512 + h * HD + k), (o[k] - mean) * rstd * ldb(GR, row * SEGW + h * HD + k), 0.03f);
        }
        {
            const bf16* OBR = (const bf16*)(ws + WS_OBR); const float* LSE = (const float*)(ws + WS_LSE);
            for (int s = gt; s < 4096; s += NT) { const unsigned r = hsh(s * 19 + 1), r2 = hsh(r); const int row = r % M, csel = r2 % 512; float ss = 0.f, osel = 0.f;
                for (int c = 0; c < 512; ++c) { const int h = c >> 6; const float l0 = LSE[((size_t)0 * M + row) * NHEAD + h], l1 = LSE[((size_t)1 * M + row) * NHEAD + h], l2 = LSE[((size_t)2 * M + row) * NHEAD + h];
                    const float mx = fmaxf(l0, fmaxf(l1, l2)), w0 = expf(l0 - mx), w1 = expf(l1 - mx), w2 = expf(l2 - mx);
                    const float o = (w0 * ldb(OBR, ((size_t)0 * M + row) * SEGW + c) + w1 * ldb(OBR, ((size_t)1 * M + row) * SEGW + c) + w2 * ldb(OBR, ((size_t)2 * M + row) * SEGW + c)) / (w0 + w1 + w2);
                    ss += o * o; if (c == csel) osel = o; }
                chk_put(ctl, 3, ldb(MIXED, (size_t)row * DM + csel), osel / sqrtf(ss / 512.f + NORM_EPS), 0.03f); }
        }
    }
    if (stage == 4) {
        const bf16* MIXED = (const bf16*)(ws + WS_MIXED); const bf16* WOUT = (const bf16*)(ws + WS_WOUT); const float* H = (const float*)(ws + WS_H); const bf16* HG = (const bf16*)(ws + WS_HG);
        for (int s = gt; s < 16384; s += NT) { const unsigned r = hsh(s * 23 + 3); const int row = r % M, c = hsh(r) % DM; float a = 0.f;
            for (int k = 0; k < DM; ++k) a += ldb(MIXED, (size_t)row * DM + k) * ldb(WOUT, (size_t)c * DM + k);
            const float h = a + A.in[0][(size_t)row * DM + c]; chk_put(ctl, 4, ldb(HG, (size_t)row * DM + c), h, 0.02f); (void)H; }
    }
    if (stage == 5) { const bf16* WGU = (const bf16*)(ws + WS_WGU);
        for (int s = gt; s < 65536; s += NT) { const unsigned r = hsh(s * 7 + 1), r2 = hsh(r);
            { const int e = (r >> 10) % NEXP, j = r % FF, k = r2 % DM;
              chk_put(ctl, 5, ldb(WGU, ((size_t)e * DM + ((j >> 7) << 8) + (j & 127)) * DM + k), A.in[13][((size_t)e * DM + k) * FF + j] * A.in[8][k], 1e-4f);
              chk_put(ctl, 5, ldb(WGU, ((size_t)e * DM + ((j >> 7) << 8) + 128 + (j & 127)) * DM + k), A.in[14][((size_t)e * DM + k) * FF + j] * A.in[8][k], 1e-4f); }
        } }
    if (stage == 5) {
        const float* H = (const float*)(ws + WS_H); const int* LIST = (const int*)(ws + WS_LIST); const float* GATEL = (const float*)(ws + WS_GATEL); const float* RSL = (const float*)(ws + WS_RSL);
        if (gt == 0) { unsigned tot = 0; for (int e = 0; e < NEXP; ++e) tot += ctl[CW_CNT + 64 * e]; chk_put(ctl, 5, (float)tot, (float)(2 * M), 0.5f); }
        const bf16* HBc = (const bf16*)(ws + WS_HG); (void)H;
        for (int s = gt; s < 2048; s += NT) { const int t = hsh(s * 29 + 5) % M; const bf16* h_ = HBc + (size_t)t * DM; float ss = 0.f;
#define h_AT(k) ldb(h_, (k))
            for (int k = 0; k < DM; ++k) ss += h_AT(k) * h_AT(k);
            const float rs = 1.f / sqrtf(ss / DM + NORM_EPS); float gl[4]; int gi = 0;
            for (int g = 0; g < 4; ++g) { float a = 0.f; for (int k = 0; k < DM; ++k) a += h_AT(k) * rs * A.in[8][k] * A.in[9][k * 4 + g]; gl[g] = a + A.in[10][g]; if (gl[g] > gl[gi]) gi = g; }
            float den = 0.f; for (int g = 0; g < 4; ++g) den += expf(gl[g] - gl[gi]);
            float b1 = -3e38f, b2 = -3e38f, b3 = -3e38f; int i1 = 0, i2 = 0;
            for (int e = 0; e < 8; ++e) { float a = 0.f; for (int k = 0; k < DM; ++k) a += h_AT(k) * rs * A.in[8][k] * A.in[11][k * 32 + gi * 8 + e]; a += A.in[12][gi * 8 + e];
                if (a > b1) { b3 = b2; b2 = b1; i2 = i1; b1 = a; i1 = e; } else if (a > b2) { b3 = b2; b2 = a; i2 = e; } else if (a > b3) b3 = a; }
            float second = -3e38f; for (int g = 0; g < 4; ++g) if (g != gi) second = fmaxf(second, gl[g]);
            if (gl[gi] - second < 1e-3f || b2 - b3 < 1e-3f || b1 - b2 < 1e-3f) continue;
            const float p1 = 1.f / (1.f + expf(b2 - b1)); const float g1 = p1 / den, g2 = (1.f - p1) / den;
            for (int k = 0; k < 2; ++k) { const int e = gi * 8 + (k ? i2 : i1); const int n = (int)ctl[CW_CNT + 64 * e]; int found = -1;
                for (int p = 0; p < n && p < M; ++p) if (LIST[(size_t)e * M + p] == t * 2 + k) { found = p; break; }
                if (found < 0) chk_put(ctl, 5, 0.f, 100.f, 0.1f); else { chk_put(ctl, 5, GATEL[(size_t)e * M + found], k ? g2 : g1, 1e-3f); chk_put(ctl, 5, RSL[(size_t)e * M + found], rs, 1e-4f); } }
        }
    }
    if (stage == 6) { const bf16* WD = (const bf16*)(ws + WS_WD);
        for (int s = gt; s < 65536; s += NT) { const unsigned r = hsh(s * 7 + 1), r2 = hsh(r);
            { const int e = (r >> 10) % NEXP, n = r % DM, k = r2 % FF; chk_put(ctl, 6, ldb(WD, ((size_t)e * DM + n) * FF + k), A.in[15][((size_t)e * FF + k) * DM + n], 1e-4f); }
        } }
    if (stage == 6 || stage == 7) {
        const int* LIST = (const int*)(ws + WS_LIST); const float* GATEL = (const float*)(ws + WS_GATEL); const float* RSL = (const float*)(ws + WS_RSL);
        const bf16* HG = (const bf16*)(ws + WS_HG); const bf16* WGU = (const bf16*)(ws + WS_WGU); const bf16* HID = (const bf16*)(ws + WS_HID); const bf16* WD = (const bf16*)(ws + WS_WD); const bf16* Y = (const bf16*)(ws + WS_Y);
        for (int s = gt; s < 8192; s += NT) { const unsigned r = hsh(s * 31 + 7), r2 = hsh(r); const int e = r % NEXP; const int ne = (int)ctl[CW_CNT + 64 * e]; if (ne <= 0) continue;
            int t0 = 0; for (int q = 0; q < e; ++q) t0 += ((int)ctl[CW_CNT + 64 * q] + 255) >> 8;
            const int pos = (s & 3) == 0 ? ne - 1 - (int)((r >> 5) % (ne < 300 ? ne : 300)) : (int)((r >> 5) % ne); const size_t slot = (size_t)t0 * 256 + pos; const int tk = LIST[(size_t)e * M + pos], t = tk >> 1;
            if (stage == 6) { const int j = r2 % FF; float g = 0.f, u = 0.f; const bf16* wg = WGU + ((size_t)e * DM + ((j >> 7) << 8) + (j & 127)) * DM; const bf16* wu = wg + (size_t)128 * DM;
                for (int k = 0; k < DM; ++k) { const float xv = ldb(HG, (size_t)t * DM + k); g += xv * ldb(wg, k); u += xv * ldb(wu, k); }
                const float rs = RSL[(size_t)e * M + pos]; chk_put(ctl, 6, ldb(HID, slot * FF + j), silu_f(g * rs) * (u * rs) * GATEL[(size_t)e * M + pos], 0.01f); }
            else { const int c = r2 % DM; float a = 0.f; for (int k = 0; k < FF; ++k) a += ldb(HID, slot * FF + k) * ldb(WD, ((size_t)e * DM + c) * FF + k);
                chk_put(ctl, 7, ldb(Y, (size_t)tk * DM + c), a, 0.01f); }
        }
    }
    if (stage == 8) {
        const float* H = (const float*)(ws + WS_H); const bf16* Y = (const bf16*)(ws + WS_Y);
        for (int s = gt; s < 4096; s += NT) { const unsigned r = hsh(s * 37 + 1); const int row = r % M, c = hsh(r) % DM; float ss = 0.f, zc = 0.f;
            for (int k = 0; k < DM; ++k) { const float z = ldb((const bf16*)(ws + WS_HG), (size_t)row * DM + k) + ldb(Y, (size_t)(2 * row) * DM + k) + ldb(Y, (size_t)(2 * row + 1) * DM + k); (void)H; ss += z * z; if (k == c) zc = z; }
            chk_put(ctl, 8, A.out[(size_t)row * DM + c], zc / sqrtf(ss / DM + NORM_EPS) * A.in[16][c], 0.01f); }
    }
}
__global__ void __launch_bounds__(256) chk_final(Args A) {
    gu32* ctl = (gu32*)(A.ws + WS_CTL); int bad = -1; float err = 0.f;
    for (int s = 0; s < 9; ++s) { const float e = __uint_as_float(ctl[CW_CHK + s]); if (e > 1.f) { bad = s; err = e; break; } }
    if (bad < 0 && ctl[CW_BAR + XB_TMO] != 0u) { bad = 10; err = 1.f; }
    if (bad < 0) return;
    float mant = 1.f + log10f(err); if (mant > 9.9f) mant = 9.9f; if (mant < 1.f) mant = 1.f;
    const float C = sqrtf(mant * powf(10.f, (float)(bad + 3)));
    for (size_t i = blockIdx.x * 256 + threadIdx.x; i < (size_t)M * DM; i += (size_t)gridDim.x * 256) A.out[i] = C;
}
#endif

extern "C" void kernel_launch(void* const* d_in, const int* in_sizes, int n_in, void* d_out, int out_size, void* d_ws, size_t ws_size, hipStream_t stream) {
    static int grid = 0;
    if (grid == 0) {
        if (n_in != 17 || in_sizes[0] != M * DM || out_size != M * DM || ws_size < WS_END) { fprintf(stderr, "kernel_launch: unexpected shapes (n_in %d, in0 %d, out %d, ws %zu); nothing launched\n", n_in, n_in > 0 ? in_sizes[0] : -1, out_size, ws_size); grid = -1; return; }
        int dev = 0, cus = 0, per_cu = 0;
        if (hipGetDevice(&dev) != hipSuccess || hipDeviceGetAttribute(&cus, hipDeviceAttributeMultiprocessorCount, dev) != hipSuccess) { grid = -1; return; }
        if (hipFuncSetAttribute((const void*)mk_fwd, hipFuncAttributeMaxDynamicSharedMemorySize, LDS_BYTES) != hipSuccess) { fprintf(stderr, "kernel_launch: hipFuncSetAttribute failed\n"); grid = -1; return; }
        if (hipOccupancyMaxActiveBlocksPerMultiprocessor(&per_cu, (const void*)mk_fwd, NWAVES * 64, LDS_BYTES) != hipSuccess || per_cu < 1) { fprintf(stderr, "kernel_launch: occupancy query says %d blocks per CU; nothing launched\n", per_cu); (void)hipGetLastError(); grid = -1; return; }
        grid = cus;
    }
    if (grid < 0) return;
    if (hipMemsetAsync((char*)d_ws + WS_CTL, 0, CTL_ZERO_BYTES, stream) != hipSuccess) { fprintf(stderr, "kernel_launch: memset failed\n"); return; }
    Args a{};
    for (int i = 0; i < 17; ++i) a.in[i] = (const float*)d_in[i];
    a.out = (float*)d_out; a.ws = (unsigned char*)d_ws;
    const double TWO_PI = 6.283185307179586476925286766559;
    for (int i = 0; i < 8; ++i) a.frev[i] = std::pow(500000.0, -(double)i / 8.0) / TWO_PI;
    for (int i = 0; i < 32; ++i) a.frev[8 + i] = std::pow(10000.0, -(double)i / 31.0) / TWO_PI;
    if (N_LAUNCHES == 1) {
        a.ph_lo = 0; a.ph_hi = PER_PHASE; a.li = 0;
#if MK_COOP
        void* kargs[] = {&a};
        const hipError_t le = hipLaunchCooperativeKernel((const void*)mk_fwd, dim3(grid), dim3(NWAVES * 64), kargs, LDS_BYTES, stream);
        if (le != hipSuccess) fprintf(stderr, "kernel_launch: cooperative launch failed: %s (grid %d)\n", hipGetErrorName(le), grid);
#else
        hipLaunchKernelGGL(mk_fwd, dim3(grid), dim3(NWAVES * 64), LDS_BYTES, stream, a);
#endif
    } else {
        for (int li = 0; li < PER_PHASE; ++li) {
            a.ph_lo = li; a.ph_hi = li + 1; a.li = 0;
            hipLaunchKernelGGL(mk_fwd, dim3(grid), dim3(NWAVES * 64), LDS_BYTES, stream, a);
#if MK_CHECK
            hipLaunchKernelGGL(chk_kernel, dim3(256), dim3(256), 0, stream, a, li);
#endif
        }
#if MK_CHECK
        hipLaunchKernelGGL(chk_final, dim3(1024), dim3(256), 0, stream, a);
#endif
    }
}
```

```cpp
#include <hip/hip_runtime.h>
#include <cstdio>
#include <cstdint>
#include <cmath>

#ifndef MK_N_LAUNCHES
#define MK_N_LAUNCHES 1
#endif
#ifndef MK_TIME
#define MK_TIME 0
#endif
#ifndef MK_REPEAT
#define MK_REPEAT -1
#endif
#ifndef MK_NREP
#define MK_NREP 2
#endif
#ifndef MK_COOP
#define MK_COOP 1
#endif
#ifndef MK_TSCALE
#define MK_TSCALE 1.0f
#endif
#ifndef MK_CHECK
#define MK_CHECK 0
#endif

#define LAS __attribute__((address_space(3)))
#define GAS __attribute__((address_space(1)))
typedef unsigned short bf16;
typedef short bf16x8 __attribute__((ext_vector_type(8)));
typedef short s16x4 __attribute__((ext_vector_type(4)));
typedef float f32x2 __attribute__((ext_vector_type(2)));
typedef float f32x4 __attribute__((ext_vector_type(4)));
typedef float f32x16 __attribute__((ext_vector_type(16)));
typedef unsigned u32x2 __attribute__((ext_vector_type(2)));
typedef unsigned u32x4 __attribute__((ext_vector_type(4)));
typedef __bf16 bf16x2_t __attribute__((ext_vector_type(2)));
typedef GAS unsigned gu32;

constexpr int NBATCH = 8, SEQ = 4096, DM = 1024, M = NBATCH * SEQ;
constexpr int NIN = 3584, SEGW = 512, NHEAD = 8, HD = 64;
constexpr int NEXP = 32, FF = 512, NGRP = 4, EPG = 8;
constexpr int CHUNK = 128, NCHUNK = SEQ / CHUNK;
constexpr float NORM_EPS = 1e-6f;
constexpr float LOG2E = 1.4426950408889634f, LN2 = 0.6931471805599453f;
constexpr int NWAVES = 8;
constexpr int N_CONV_P1 = 64 * 256;
constexpr int MAXTILES = 288;

constexpr size_t MiB = 1u << 20;
constexpr size_t WS_CTL = 0, CTL_ZERO_BYTES = 128 * 1024;
constexpr size_t WS_WRT = 1 * MiB;
constexpr size_t WS_ROPE = 2 * MiB;
constexpr size_t WS_LSE = 4 * MiB;
constexpr size_t WS_LIST = 8 * MiB;
constexpr size_t WS_GATEL = 12 * MiB;
constexpr size_t WS_RSL = 16 * MiB;
constexpr size_t WS_WIN = 20 * MiB;
constexpr size_t WS_WOUT = 27 * MiB;
constexpr size_t WS_WD = 30 * MiB;
constexpr size_t WS_WGU = 62 * MiB;
constexpr size_t WS_ST = 126 * MiB;
constexpr size_t WS_SBW = 478 * MiB;
constexpr size_t WS_XN = 158 * MiB;
constexpr size_t WS_OBR = 158 * MiB;
constexpr size_t WS_SEG = 254 * MiB;
constexpr size_t SEG_BYTES = (size_t)M * SEGW * 2;
constexpr size_t WS_MIXED = 254 * MiB;
constexpr size_t WS_H = 350 * MiB;
constexpr size_t WS_HG = 350 * MiB;
constexpr size_t WS_HID = 222 * MiB;
constexpr size_t WS_Y = 64 * MiB;
constexpr size_t WS_END = 494 * MiB;
constexpr int CW_CNT = 64;
constexpr int CW_BAR = 4096;
constexpr int CW_CHK = 16384;
constexpr int CW_TS = 20480;

constexpr int RING_BYTES = 147456;
constexpr int LDSCTL_OFF = RING_BYTES, MISC_OFF = LDSCTL_OFF + 320;
constexpr int TILE_OFF = MISC_OFF + 128;
constexpr int LDS_BYTES = 151552;

#define RLX_AGENT __ATOMIC_RELAXED, __HIP_MEMORY_SCOPE_AGENT
#define LDS_WAIT() asm volatile("s_waitcnt lgkmcnt(0)" ::: "memory")
#define VM_WAIT() asm volatile("s_waitcnt vmcnt(0)" ::: "memory")
__device__ __forceinline__ unsigned pk2(float lo, float hi) { f32x2 v = {lo, hi}; bf16x2_t b = __builtin_convertvector(v, bf16x2_t); return __builtin_bit_cast(unsigned, b); }
__device__ __forceinline__ float bflo(unsigned u) { return __uint_as_float(u << 16); }
__device__ __forceinline__ float bfhi(unsigned u) { return __uint_as_float(u & 0xffff0000u); }
__device__ __forceinline__ float bf2f(short s) { return __uint_as_float(((unsigned)(unsigned short)s) << 16); }
__device__ __forceinline__ int crow(int r, int hi) { return (r & 3) + 8 * (r >> 2) + 4 * hi; }
__device__ __forceinline__ float wave_sum(float v) {
#pragma unroll
    for (int o = 1; o < 64; o <<= 1) v += __shfl_xor(v, o);
    return v;
}
__device__ __forceinline__ float silu_f(float v) { return v * __builtin_amdgcn_rcpf(1.f + __builtin_amdgcn_exp2f(-v * LOG2E)); }

namespace pg8 {
constexpr int BM = 256, BK = 64, HALF = 128, HTB = HALF * BK * 2, STAGE_BYTES = 8 * HTB, NXCD = 8, WGM = 8;
__host__ __device__ __forceinline__ int lds_byte(int r, int c) { const int st = (r >> 4) * 2 + (c >> 5), rr = r & 15, cc = c & 31, ob = rr * 64 + cc * 2; return st * 1024 + (ob ^ (((ob >> 9) & 1) << 5)); }
__host__ __device__ __forceinline__ void stage_rc(int b, int& R, int& C) { const int st = b / 1024, sb = b % 1024, swz = sb ^ (((sb >> 9) & 1) << 5); R = (st >> 1) * 16 + swz / 64; C = (st & 1) * 32 + (swz % 64) / 2; }
__host__ __device__ __forceinline__ int perm32(int rho) { const int n = rho >> 4, i = rho & 15; return 8 * (i >> 2) + 4 * n + (i & 3); }

struct Unit { int pm, pn; };
struct StaticOrder {
    int nM, nN, nwg, G, c;
    __device__ void init(int nM_, int nN_, int G_, int c_) { nM = nM_; nN = nN_; nwg = nM * nN; G = G_; c = c_; }
    __device__ bool next(int i, Unit& u) const {
        const long L = (long)i * G + c; if (L >= nwg) return false;
        int wgid = (int)L; { const int q = nwg / NXCD, r = nwg % NXCD, xcd = wgid % NXCD, off = wgid / NXCD; wgid = (xcd < r ? xcd * (q + 1) : r * (q + 1) + (xcd - r) * q) + off; }
        const int nig = WGM * nN, gid = wgid / nig, fm = gid * WGM, gsz = (nM - fm) < WGM ? (nM - fm) : WGM;
        u.pm = fm + ((wgid % nig) % gsz); u.pn = (wgid % nig) / gsz; return true;
    }
};

template <class Epi, class Sched, class Src, bool ALIGN_EPI, bool SP2>
__device__ __forceinline__ void gemm_phase(LAS unsigned char* lds, const int K, const Sched& S, const Src& SRC, const Epi& E) {
    int tid_ = threadIdx.x; asm volatile("" : "+v"(tid_));
    const int tid = tid_, wid = __builtin_amdgcn_readfirstlane(tid >> 6), lane = tid & 63, wr = wid >> 2, wc = wid & 3, fr = lane & 15, fq = lane >> 4;
    const int nt = K / BK;
    unsigned voffB[2]; int RA[2], CA[2];
#pragma unroll
    for (int i = 0; i < 2; ++i) { int R, C; stage_rc(tid * 16 + i * 8192, R, C); const int Rb = Epi::PERM ? ((R & ~31) + perm32(R & 31)) : R;
        RA[i] = R; CA[i] = C; voffB[i] = (unsigned)(Rb * K + C) * 2u; }
    const size_t kstep = (size_t)(BK * 2);
    const size_t hstep = (size_t)HALF * K * 2;
    const unsigned ldsw = (unsigned)wid * 1024u;
    const int aoff = lds_byte(wr * 64 + fr, fq * 8), boff = lds_byte(wc * 32 + fr, fq * 8);
#define PG8_SA(b, h) (((b) * 2 + (h)) * HTB)
#define PG8_SB(b, h) ((4 + (b) * 2 + (h)) * HTB)
#define PG8_STAGE(bufoff, gbase, voff) do { _Pragma("unroll") for (int _i = 0; _i < 2; ++_i) \
        __builtin_amdgcn_global_load_lds((const unsigned*)((const char*)(gbase) + (voff)[_i]), (LAS unsigned*)(lds + (bufoff) + ldsw + _i * 8192), 16, 0, 0); } while (0)
#define PG8_LDA(dst, b, h) do { _Pragma("unroll") for (int m = 0; m < 4; ++m) _Pragma("unroll") for (int k = 0; k < 2; ++k) dst[m][k] = *(const LAS bf16x8*)(lds + PG8_SA(b, h) + aoff + m * 2048 + k * 1024); } while (0)
#define PG8_LDB(dst, b, h) do { _Pragma("unroll") for (int n = 0; n < 2; ++n) _Pragma("unroll") for (int k = 0; k < 2; ++k) dst[n][k] = *(const LAS bf16x8*)(lds + PG8_SB(b, h) + boff + n * 2048 + k * 1024); } while (0)
#define PG8_MMA(ai, bj, At, Bt) do { __builtin_amdgcn_s_setprio(1); _Pragma("unroll") for (int m = 0; m < 4; ++m) _Pragma("unroll") for (int n = 0; n < 2; ++n) _Pragma("unroll") for (int k = 0; k < 2; ++k) \
        acc[ai][bj][m][n] = __builtin_amdgcn_mfma_f32_16x16x32_bf16(Bt[n][k], At[m][k], acc[ai][bj][m][n], 0, 0, 0); __builtin_amdgcn_s_setprio(0); } while (0)
#define PG8_WAIT_V(n) asm volatile("s_waitcnt vmcnt(" #n ")" ::: "memory")
#define PG8_WAIT_L(n) asm volatile("s_waitcnt lgkmcnt(" #n ")" ::: "memory")
#define PG8_BAR __builtin_amdgcn_s_barrier()
#define PG8_SCHED __builtin_amdgcn_sched_barrier(0)
    Unit cur, nxt; int ui = 0;
    if (!S.next(0, cur)) return;
    f32x4 acc[2][2][4][2];
#pragma unroll
    for (int a = 0; a < 2; ++a)
#pragma unroll
        for (int b = 0; b < 2; ++b)
#pragma unroll
            for (int m = 0; m < 4; ++m)
#pragma unroll
                for (int n = 0; n < 2; ++n) acc[a][b][m][n] = (f32x4){0.f, 0.f, 0.f, 0.f};
    bf16x8 At[4][2], B0[2][2], B1[2][2];
    const char *cA, *cB; unsigned vA0[2], vA1[2];
    SRC.setup(cur, RA, CA, cA, cB, vA0, vA1);
    if constexpr (SP2) {
        PG8_STAGE(PG8_SB(0, 0), cB, voffB); PG8_STAGE(PG8_SB(0, 1), cB + hstep, voffB); PG8_STAGE(PG8_SA(0, 0), cA, vA0); PG8_STAGE(PG8_SA(0, 1), cA, vA1);
        if (wr == 1) PG8_BAR;
        PG8_WAIT_V(2); PG8_BAR;
        PG8_STAGE(PG8_SB(1, 0), cB + kstep, voffB); PG8_STAGE(PG8_SA(1, 0), cA + kstep, vA0); PG8_STAGE(PG8_SB(1, 1), cB + hstep + kstep, voffB);
        PG8_WAIT_V(6); PG8_BAR;
    } else {
        PG8_STAGE(PG8_SB(0, 0), cB, voffB); PG8_STAGE(PG8_SA(0, 0), cA, vA0); PG8_STAGE(PG8_SB(0, 1), cB + hstep, voffB); PG8_STAGE(PG8_SA(0, 1), cA, vA1);
        if (wr == 1) PG8_BAR;
        PG8_WAIT_V(4); PG8_BAR;
        PG8_STAGE(PG8_SB(1, 0), cB + kstep, voffB); PG8_STAGE(PG8_SA(1, 0), cA + kstep, vA0); PG8_STAGE(PG8_SB(1, 1), cB + hstep + kstep, voffB);
        PG8_WAIT_V(6); PG8_BAR;
    }
    for (;;) {
        const bool has_next = S.next(ui + 1, nxt);
        const char *nA = cA, *nB = cB; unsigned wA0[2] = {vA0[0], vA0[1]}, wA1[2] = {vA1[0], vA1[1]};
        if (has_next) SRC.setup(nxt, RA, CA, nA, nB, wA0, wA1);
        for (int t = 0; t < nt; t += 2) {
            const bool last = (t == nt - 2);
            const char* a1 = cA + (size_t)(t + 1) * kstep;
            const char* a2 = last ? nA : cA + (size_t)(t + 2) * kstep; const char* b2 = last ? nB : cB + (size_t)(t + 2) * kstep;
            const char* a3 = a2 + kstep; const char* b3 = b2 + kstep;
            unsigned x0[2], x1[2];
            x0[0] = last ? wA0[0] : vA0[0]; x0[1] = last ? wA0[1] : vA0[1]; x1[0] = last ? wA1[0] : vA1[0]; x1[1] = last ? wA1[1] : vA1[1];
            if constexpr (SP2) {
            PG8_LDB(B0, 0, 0); PG8_LDB(B1, 0, 1); PG8_SCHED; PG8_LDA(At, 0, 0); PG8_STAGE(PG8_SA(1, 1), a1, vA1);
            PG8_WAIT_V(8); PG8_WAIT_L(0); PG8_BAR; PG8_MMA(0, 0, At, B0); PG8_MMA(0, 1, At, B1); PG8_BAR; PG8_SCHED;
            PG8_LDA(At, 0, 1); PG8_STAGE(PG8_SB(0, 0), b2, voffB); PG8_STAGE(PG8_SB(0, 1), b2 + hstep, voffB); PG8_STAGE(PG8_SA(0, 0), a2, x0);
            PG8_WAIT_V(8); PG8_WAIT_L(0); PG8_BAR; PG8_MMA(1, 0, At, B0); PG8_MMA(1, 1, At, B1); PG8_BAR; PG8_SCHED;
            PG8_LDB(B0, 1, 0); PG8_LDB(B1, 1, 1); PG8_SCHED; PG8_LDA(At, 1, 0); PG8_STAGE(PG8_SA(0, 1), a2, x1);
            PG8_WAIT_V(8); PG8_WAIT_L(0); PG8_BAR; PG8_MMA(0, 0, At, B0); PG8_MMA(0, 1, At, B1); PG8_BAR; PG8_SCHED;
            PG8_LDA(At, 1, 1); PG8_STAGE(PG8_SB(1, 0), b3, voffB); PG8_STAGE(PG8_SB(1, 1), b3 + hstep, voffB); PG8_STAGE(PG8_SA(1, 0), a3, x0);
            PG8_WAIT_V(8); PG8_WAIT_L(0); PG8_BAR; PG8_MMA(1, 0, At, B0); PG8_MMA(1, 1, At, B1); PG8_BAR; PG8_SCHED;
            } else {
            PG8_LDB(B0, 0, 0); PG8_SCHED; PG8_LDA(At, 0, 0); PG8_STAGE(PG8_SA(1, 1), a1, vA1);
            PG8_WAIT_L(8); PG8_BAR; PG8_WAIT_L(0); PG8_MMA(0, 0, At, B0); PG8_BAR; PG8_SCHED;
            PG8_LDB(B1, 0, 1); PG8_STAGE(PG8_SB(0, 0), b2, voffB);
            PG8_BAR; PG8_WAIT_L(0); PG8_MMA(0, 1, At, B1); PG8_BAR;
            PG8_LDA(At, 0, 1); PG8_STAGE(PG8_SA(0, 0), a2, x0);
            PG8_BAR; PG8_WAIT_L(0); PG8_MMA(1, 0, At, B0); PG8_BAR; PG8_SCHED;
            PG8_STAGE(PG8_SB(0, 1), b2 + hstep, voffB);
            PG8_WAIT_V(6); PG8_BAR; PG8_MMA(1, 1, At, B1); PG8_BAR;
            PG8_LDB(B0, 1, 0); PG8_SCHED; PG8_LDA(At, 1, 0); PG8_STAGE(PG8_SA(0, 1), a2, x1);
            PG8_WAIT_L(8); PG8_BAR; PG8_WAIT_L(0); PG8_MMA(0, 0, At, B0); PG8_BAR; PG8_SCHED;
            PG8_LDB(B1, 1, 1); PG8_STAGE(PG8_SB(1, 0), b3, voffB);
            PG8_BAR; PG8_WAIT_L(0); PG8_MMA(0, 1, At, B1); PG8_BAR;
            PG8_LDA(At, 1, 1); PG8_STAGE(PG8_SA(1, 0), a3, x0);
            PG8_BAR; PG8_WAIT_L(0); PG8_MMA(1, 0, At, B0); PG8_BAR; PG8_SCHED;
            PG8_STAGE(PG8_SB(1, 1), b3 + hstep, voffB);
            PG8_WAIT_V(6); PG8_BAR; PG8_MMA(1, 1, At, B1); PG8_BAR;
            }
        }
        if constexpr (ALIGN_EPI) { if (wr == 0) PG8_BAR; }
        E(acc, cur, wr, wc, fr, fq);
        if (!has_next) break;
#pragma unroll
        for (int a = 0; a < 2; ++a)
#pragma unroll
            for (int b = 0; b < 2; ++b)
#pragma unroll
                for (int m = 0; m < 4; ++m)
#pragma unroll
                    for (int n = 0; n < 2; ++n) acc[a][b][m][n] = (f32x4){0.f, 0.f, 0.f, 0.f};
        cur = nxt; cA = nA; cB = nB; vA0[0] = wA0[0]; vA0[1] = wA0[1]; vA1[0] = wA1[0]; vA1[1] = wA1[1]; ++ui;
        if constexpr (ALIGN_EPI) { if (wr == 1) PG8_BAR; }
    }
    PG8_WAIT_V(0);
    if constexpr (!ALIGN_EPI) { if (wr == 0) PG8_BAR; }
    PG8_BAR;
#undef PG8_SA
#undef PG8_SB
#undef PG8_STAGE
#undef PG8_LDA
#undef PG8_LDB
#undef PG8_MMA
#undef PG8_WAIT_V
#undef PG8_WAIT_L
#undef PG8_BAR
#undef PG8_SCHED
}
}

#define XB_TMO      128
#define XB_XCNT(j)  (256  + 64 * (j))
#define XB_XSUB(j)  (1280 + 64 * (j))
#define XB_XGEN(j)  (2304 + 64 * (j))
#define XB_TOP      3328
#define XB_TOPGEN   3392
#define XCD_BAR_WORDS 3456
#define XB_SPIN_CAP (1u << 18)
__device__ __forceinline__ unsigned xb_ld(unsigned* p)              { return __hip_atomic_load(p, __ATOMIC_RELAXED, __HIP_MEMORY_SCOPE_AGENT); }
__device__ __forceinline__ unsigned xb_add(unsigned* p, unsigned v) { return __hip_atomic_fetch_add(p, v, __ATOMIC_RELAXED, __HIP_MEMORY_SCOPE_AGENT); }
__device__ __forceinline__ unsigned xb_xcc_id() { return (unsigned)__builtin_amdgcn_s_getreg((3 << 11) | 20) & 0xFu; }
#define XB_SPIN(cond, bar) do { unsigned _sp = 0; while (cond) { __builtin_amdgcn_s_sleep(1); \
    if ((++_sp & 255u) == 0u) { if (xb_ld(&(bar)[XB_TMO])) break; if (_sp > XB_SPIN_CAP) { atomicAdd(&(bar)[XB_TMO], 1u); break; } } } } while (0)
struct XcdBarrier { unsigned* bar; unsigned x; volatile LAS unsigned* st; };
__device__ __forceinline__ XcdBarrier xcd_barrier_post(unsigned* bar, volatile LAS unsigned* st) {
    XcdBarrier b; b.bar = bar; b.x = xb_xcc_id(); b.st = st;
    if (threadIdx.x == 0) (void)xb_add(&bar[XB_XCNT(b.x)], 1u);
    return b;
}
__device__ __forceinline__ void xcd_barrier_complete(unsigned* bar, unsigned x, unsigned& nloc, unsigned& nx) {
    const unsigned G = gridDim.x * gridDim.y * gridDim.z;
    unsigned sum, cnt, mine, sp = 0u;
    for (;;) {
        sum = 0u; cnt = 0u; mine = 0u;
#pragma unroll
        for (unsigned j = 0; j < 16; ++j) { const unsigned c = xb_ld(&bar[XB_XCNT(j)]); sum += c; cnt += (c > 0u) ? 1u : 0u; mine = (j == x) ? c : mine; }
        if (sum == G) break;
        __builtin_amdgcn_s_sleep(1);
        if ((++sp & 255u) == 0u) { if (xb_ld(&bar[XB_TMO])) break; if (sp > XB_SPIN_CAP) { atomicAdd(&bar[XB_TMO], 1u); break; } }
    }
    nloc = mine > 0u ? mine : 1u; nx = cnt > 0u ? cnt : 1u;
}
__device__ __forceinline__ void xcd_barrier(const XcdBarrier& b) {
    asm volatile("s_waitcnt vmcnt(0)" ::: "memory");
    __syncthreads();
    if (threadIdx.x == 0) {
        unsigned* bar = b.bar;
        __builtin_amdgcn_s_waitcnt(0);
        unsigned nloc = b.st[0], nx = b.st[1];
        if (nloc == 0u) { xcd_barrier_complete(bar, b.x, nloc, nx); b.st[0] = nloc; b.st[1] = nx; }
        const unsigned old = xb_add(&bar[XB_XSUB(b.x)], 1u);
        const unsigned gen = old / nloc;
        if (old + 1u == (gen + 1u) * nloc) {
            __builtin_amdgcn_fence(__ATOMIC_RELEASE, "agent");
            asm volatile("s_waitcnt vmcnt(0)" ::: "memory");
            const unsigned og = xb_add(&bar[XB_TOP], 1u);
            const unsigned tg = og / nx;
            if (og + 1u == (tg + 1u) * nx) xb_add(&bar[XB_TOPGEN], 1u);
            else XB_SPIN(xb_ld(&bar[XB_TOPGEN]) == tg, bar);
            __builtin_amdgcn_fence(__ATOMIC_ACQUIRE, "agent");
            xb_add(&bar[XB_XGEN(b.x)], 1u);
            asm volatile("s_waitcnt vmcnt(0)" ::: "memory");
        } else {
            XB_SPIN(xb_ld(&bar[XB_XGEN(b.x)]) == gen, bar);
            __builtin_amdgcn_fence(__ATOMIC_ACQUIRE, "agent");
            asm volatile("s_waitcnt vmcnt(0)" ::: "memory");
        }
    }
    __syncthreads();
}

struct Args {
    const float* in[17]; float* out; unsigned char* ws;
    double frev[40];
    int ph_lo, ph_hi, li, pad;
};
struct Frame {
    LAS unsigned char* lds;
    volatile LAS unsigned* MISC;
    gu32* ctl;
    int tid, lane, wave, vcu, G;
};

__device__ __forceinline__ int winperm(int n) {
    const int s = n >> 9, c = n & 511, hh = c >> 6, d = c & 63; int dp = d;
    if (s == 0 || s == 1) { if (d < 16) dp = 2 * (d & 7) + (d >> 3); }
    else if (s == 3 || s == 4) dp = 2 * (d & 31) + (d >> 5);
    return (s << 9) + (hh << 6) + dp;
}
template <int MODE>
__device__ __forceinline__ int tr_row(int ns) { return MODE == 0 ? winperm(ns) : MODE == 1 ? ns : MODE == 2 ? ((ns >> 7) << 8) + (ns & 127) : ((ns >> 7) << 8) + 128 + (ns & 127); }
__device__ __forceinline__ void tr_load(f32x4 (&v)[8], const float* S, int N, int kb, int nb, int lane) {
    const float* p = S + (size_t)(64 * kb + (lane >> 3)) * N + 32 * nb + (lane & 7) * 4;
#pragma unroll
    for (int i = 0; i < 8; ++i) v[i] = __builtin_nontemporal_load((const f32x4*)(p + (size_t)8 * i * N));
}
template <int MODE, bool NT = false>
__device__ __forceinline__ void tr_store(const f32x4 (&v)[8], bf16* Dst, int Kd, LAS float* scr, int kb, int nb, int lane, const float* kscale) {
    const int k0 = 64 * kb, n0 = 32 * nb;
#pragma unroll
    for (int i = 0; i < 8; ++i) { const int kk = 8 * i + (lane >> 3); const float sc = kscale ? kscale[k0 + kk] : 1.f; LAS float* d = scr + kk * 33 + (lane & 7) * 4;
        d[0] = v[i][0] * sc; d[1] = v[i][1] * sc; d[2] = v[i][2] * sc; d[3] = v[i][3] * sc; }
    LDS_WAIT(); asm volatile("" ::: "memory");
    const int c = lane & 7;
#pragma unroll
    for (int j = 0; j < 4; ++j) { const int n = (lane >> 3) + 8 * j; const LAS float* s = scr + (8 * c) * 33 + n;
        u32x4 o; o.x = pk2(s[0 * 33], s[1 * 33]); o.y = pk2(s[2 * 33], s[3 * 33]); o.z = pk2(s[4 * 33], s[5 * 33]); o.w = pk2(s[6 * 33], s[7 * 33]);
        if (NT) __builtin_nontemporal_store(o, (u32x4*)(Dst + (size_t)tr_row<MODE>(n0 + n) * Kd + k0 + 8 * c)); else *(GAS u32x4*)(Dst + (size_t)tr_row<MODE>(n0 + n) * Kd + k0 + 8 * c) = o; }
    LDS_WAIT(); asm volatile("" ::: "memory");
}
template <int MODE>
__device__ __forceinline__ void p0_transpose_item(const float* S, int N, bf16* Dst, int Kd, LAS float* scr, int kb, int nb, int lane, const float* kscale) {
    f32x4 v[8]; tr_load(v, S, N, kb, nb, lane); tr_store<MODE>(v, Dst, Kd, scr, kb, nb, lane, kscale);
}
constexpr int N_GU_ITEMS = 512 * NEXP;
__device__ __forceinline__ void expert_it(int it, int& e, int& r) { if (it < N_GU_ITEMS) { e = it >> 9; r = it & 511; } else { const int d = it - N_GU_ITEMS; e = d >> 8; r = 512 + (d & 255); } }
__device__ __forceinline__ void expert_src(const Args& A, int it, const float*& S, int& N, int& kb, int& nb) {
    int e, r; expert_it(it, e, r);
    if (r < 256) { S = A.in[13] + (size_t)e * DM * FF; N = FF; kb = r >> 4; nb = r & 15; }
    else if (r < 512) { S = A.in[14] + (size_t)e * DM * FF; N = FF; kb = (r - 256) >> 4; nb = (r - 256) & 15; }
    else { S = A.in[15] + (size_t)e * FF * DM; N = DM; kb = (r - 512) >> 5; nb = (r - 512) & 31; }
}
__device__ __forceinline__ void expert_store(const Args& A, unsigned char* ws, int it, const f32x4 (&v)[8], LAS float* scr, int lane) {
    bf16* WGU = (bf16*)(ws + WS_WGU); bf16* WD = (bf16*)(ws + WS_WD);
    int e, r; expert_it(it, e, r);
    if (r < 256) tr_store<2, true>(v, WGU + (size_t)e * DM * DM, DM, scr, r >> 4, r & 15, lane, A.in[8]);
    else if (r < 512) tr_store<3, true>(v, WGU + (size_t)e * DM * DM, DM, scr, (r - 256) >> 4, (r - 256) & 15, lane, A.in[8]);
    else tr_store<1, true>(v, WD + (size_t)e * DM * FF, FF, scr, (r - 512) >> 5, (r - 512) & 31, lane, nullptr);
}
__device__ __forceinline__ void expert_items(const Args& A, unsigned char* ws, LAS float* scr, int lo, int NI, int w0, int nw, int lane) {
    for (int it = lo + w0; it < NI; it += 4 * nw) {
        f32x4 v0[8], v1[8], v2[8], v3[8]; const float* S; int N, kb, nb;
        expert_src(A, it, S, N, kb, nb); tr_load(v0, S, N, kb, nb, lane);
        if (it + nw < NI) { expert_src(A, it + nw, S, N, kb, nb); tr_load(v1, S, N, kb, nb, lane); }
        if (it + 2 * nw < NI) { expert_src(A, it + 2 * nw, S, N, kb, nb); tr_load(v2, S, N, kb, nb, lane); }
        if (it + 3 * nw < NI) { expert_src(A, it + 3 * nw, S, N, kb, nb); tr_load(v3, S, N, kb, nb, lane); }
        expert_store(A, ws, it, v0, scr, lane);
        if (it + nw < NI) expert_store(A, ws, it + nw, v1, scr, lane);
        if (it + 2 * nw < NI) expert_store(A, ws, it + 2 * nw, v2, scr, lane);
        if (it + 3 * nw < NI) expert_store(A, ws, it + 3 * nw, v3, scr, lane);
    }
}
__device__ __forceinline__ void p0_prologue(Frame& F, const Args& A) {
    unsigned char* ws = A.ws;
    LAS float* scr = (LAS float*)(F.lds + F.wave * 16384);
    const int gw = F.vcu * NWAVES + F.wave, NGW = F.G * NWAVES;
    constexpr int I_IN = 16 * 112, I_OUT = 16 * 32;
    bf16* WIN = (bf16*)(ws + WS_WIN); bf16* WOUT = (bf16*)(ws + WS_WOUT);
    for (int it = gw; it < I_IN + I_OUT; it += NGW) {
        int r = it;
        if (r < I_IN) { p0_transpose_item<0>(A.in[2], NIN, WIN, DM, scr, r / 112, r % 112, F.lane, nullptr); continue; } r -= I_IN;
        const int kb = r / 32; p0_transpose_item<1>(A.in[7], DM, WOUT, DM, scr, kb, r % 32, F.lane, kb < 8 ? A.in[3] : A.in[6] - 512);
    }
    expert_items(A, ws, scr, F.G == 256 ? N_CONV_P1 : 0, F.G == 256 ? N_GU_ITEMS : 768 * NEXP, gw, NGW, F.lane);
    { const float* x = A.in[0]; const float* g = A.in[1]; bf16* XN = (bf16*)(ws + WS_XN);
      f32x4 gv[4];
#pragma unroll
      for (int j = 0; j < 4; ++j) gv[j] = ((const f32x4*)g)[F.lane + 64 * j];
      for (int m0 = gw; m0 < M; m0 += 4 * NGW) {
        f32x4 v[4][4];
#pragma unroll
        for (int k = 0; k < 4; ++k) { const GAS f32x4* xr = (const GAS f32x4*)(x + (size_t)(m0 + k * NGW) * DM) + F.lane;
#pragma unroll
            for (int j = 0; j < 4; ++j) v[k][j] = __builtin_nontemporal_load(xr + 64 * j); }
#pragma unroll
        for (int k = 0; k < 4; ++k) { float s = 0.f;
#pragma unroll
            for (int j = 0; j < 4; ++j) s += (v[k][j].x * v[k][j].x + v[k][j].y * v[k][j].y) + (v[k][j].z * v[k][j].z + v[k][j].w * v[k][j].w);
            const float rstd = 1.f / sqrtf(wave_sum(s) * (1.f / DM) + NORM_EPS);
            GAS unsigned long long* o8 = (GAS unsigned long long*)(XN + (size_t)(m0 + k * NGW) * DM) + F.lane;
#pragma unroll
            for (int j = 0; j < 4; ++j) { const f32x4 t = v[k][j] * rstd * gv[j]; o8[64 * j] = (unsigned long long)pk2(t.x, t.y) | ((unsigned long long)pk2(t.z, t.w) << 32); } }
      } }
    { const int gt = (F.vcu * NWAVES + F.wave) * 64 + F.lane, NT = NGW * 64;
      bf16* WRH = (bf16*)(ws + WS_WRT); bf16* WRL = WRH + 48 * DM; const float* gf = A.in[8]; const float* wg = A.in[9]; const float* we = A.in[11];
      for (int idx = gt; idx < 48 * DM; idx += NT) { const int j = idx >> 10, i = idx & 1023;
          const float v = (j < 32 ? we[i * 32 + j] : (j < 36 ? wg[i * 4 + (j - 32)] : 0.f)) * gf[i];
          const unsigned hb = pk2(v, 0.f) & 0xffffu; const float lo = v - bflo(hb); WRH[idx] = (bf16)hb; WRL[idx] = (bf16)(pk2(lo, 0.f) & 0xffffu); }
      float* RC = (float*)(ws + WS_ROPE); float* RS = RC + SEQ * 40;
      for (int idx = gt; idx < SEQ * 40; idx += NT) { const int pos = idx / 40, f = idx % 40;
          double rv = (double)pos * A.frev[f]; rv -= floor(rv); const float r = (float)rv;
          RC[idx] = __builtin_amdgcn_cosf(r); RS[idx] = __builtin_amdgcn_sinf(r); } }
}

struct SrcPlain {
    const bf16* A; const bf16* Bt; int K;
    __device__ __forceinline__ void setup(const pg8::Unit& u, const int (&RA)[2], const int (&CA)[2], const char*& cA, const char*& cB, unsigned (&v0)[2], unsigned (&v1)[2]) const {
        cA = (const char*)A + (size_t)u.pm * 256 * K * 2; cB = (const char*)Bt + (size_t)u.pn * 256 * K * 2;
#pragma unroll
        for (int i = 0; i < 2; ++i) { v0[i] = (unsigned)(RA[i] * K + CA[i]) * 2u; v1[i] = v0[i] + (unsigned)(128 * K * 2); }
    }
};
struct TileTab { const LAS int* TE; const LAS int* NE; const LAS int* T0; };
struct SrcGather {
    const bf16* HG; const bf16* WGU; const int* LIST; TileTab tt;
    __device__ __forceinline__ void setup(const pg8::Unit& u, const int (&RA)[2], const int (&CA)[2], const char*& cA, const char*& cB, unsigned (&v0)[2], unsigned (&v1)[2]) const {
        const int e = tt.TE[u.pm], ne = tt.NE[e], p0 = (u.pm - tt.T0[e]) * 256;
        cA = (const char*)HG; cB = (const char*)WGU + ((size_t)e * DM + (size_t)u.pn * 256) * DM * 2;
#pragma unroll
        for (int i = 0; i < 2; ++i) {
            const int pa = p0 + RA[i], pb = pa + 128;
            const int ta = pa < ne ? (LIST[e * M + pa] >> 1) : 0, tb = pb < ne ? (LIST[e * M + pb] >> 1) : 0;
            v0[i] = (unsigned)(ta * DM + CA[i]) * 2u; v1[i] = (unsigned)(tb * DM + CA[i]) * 2u; }
    }
};
struct SrcDown {
    const bf16* HID; const bf16* WD; TileTab tt;
    __device__ __forceinline__ void setup(const pg8::Unit& u, const int (&RA)[2], const int (&CA)[2], const char*& cA, const char*& cB, unsigned (&v0)[2], unsigned (&v1)[2]) const {
        const int e = tt.TE[u.pm];
        cA = (const char*)HID + (size_t)u.pm * 256 * FF * 2; cB = (const char*)WD + ((size_t)e * DM + (size_t)u.pn * 256) * FF * 2;
#pragma unroll
        for (int i = 0; i < 2; ++i) { v0[i] = (unsigned)(RA[i] * FF + CA[i]) * 2u; v1[i] = v0[i] + (unsigned)(128 * FF * 2); }
    }
};

struct EpiInProj {
    static constexpr bool PERM = true;
    bf16* SEG; const float* RC; const float* RS;
    __device__ __forceinline__ void operator()(const f32x4 (&acc)[2][2][4][2], const pg8::Unit& u, int wr, int wc, int fr, int fq) const {
        const int seg = u.pn >> 1, colt = (u.pn & 1) * 256;
        bf16* base = SEG + (size_t)seg * M * SEGW;
        const int dq = (wc & 1) * 32 + 8 * fq;
        const bool attn = seg < 2, ret = (seg == 3 || seg == 4);
        const bool rot = ret || (attn && dq < 16);
        const int i0 = ret ? 8 + (dq >> 1) : (dq >> 1);
        const float sc = seg == 0 ? 0.125f * LOG2E : (seg == 4 ? 0.125f : 1.f);
#pragma unroll
        for (int ai = 0; ai < 2; ++ai)
#pragma unroll
            for (int m = 0; m < 4; ++m) {
                const int row = u.pm * 256 + ai * 128 + wr * 64 + m * 16 + fr, pos = row & (SEQ - 1);
                f32x4 c4 = {1.f, 1.f, 1.f, 1.f}, s4 = {0.f, 0.f, 0.f, 0.f};
                if (rot) { c4 = *(const f32x4*)(RC + pos * 40 + i0); s4 = *(const f32x4*)(RS + pos * 40 + i0); }
                bf16* rowp = base + (size_t)row * SEGW + colt + wc * 32 + 8 * fq;
#pragma unroll
                for (int bj = 0; bj < 2; ++bj) {
                    f32x4 v0 = acc[ai][bj][m][0], v1 = acc[ai][bj][m][1];
                    if (attn || ret) {
                        f32x4 r0, r1;
                        r0[0] = v0[0] * c4[0] - v0[1] * s4[0]; r0[1] = v0[1] * c4[0] + v0[0] * s4[0];
                        r0[2] = v0[2] * c4[1] - v0[3] * s4[1]; r0[3] = v0[3] * c4[1] + v0[2] * s4[1];
                        r1[0] = v1[0] * c4[2] - v1[1] * s4[2]; r1[1] = v1[1] * c4[2] + v1[0] * s4[2];
                        r1[2] = v1[2] * c4[3] - v1[3] * s4[3]; r1[3] = v1[3] * c4[3] + v1[2] * s4[3];
                        v0 = r0 * sc; v1 = r1 * sc;
                    } else if (seg == 6) {
#pragma unroll
                        for (int e = 0; e < 4; ++e) { v0[e] = silu_f(v0[e]); v1[e] = silu_f(v1[e]); }
                    }
                    u32x4 w; w.x = pk2(v0[0], v0[1]); w.y = pk2(v0[2], v0[3]); w.z = pk2(v1[0], v1[1]); w.w = pk2(v1[2], v1[3]);
                    *(u32x4*)(rowp + bj * 128) = w;
                }
            }
    }
};
struct EpiOutProj {
    static constexpr bool PERM = true;
    const float* X; bf16* HB;
    __device__ __forceinline__ void operator()(const f32x4 (&acc)[2][2][4][2], const pg8::Unit& u, int wr, int wc, int fr, int fq) const {
        const int col0 = u.pn * 256 + wc * 32 + 8 * fq;
#pragma unroll
        for (int ai = 0; ai < 2; ++ai)
#pragma unroll
            for (int m = 0; m < 4; ++m) { const size_t off = (size_t)(u.pm * 256 + ai * 128 + wr * 64 + m * 16 + fr) * DM + col0;
#pragma unroll
                for (int bj = 0; bj < 2; ++bj) { const f32x4 h0 = __builtin_nontemporal_load((const f32x4*)(X + off + bj * 128)) + acc[ai][bj][m][0], h1 = __builtin_nontemporal_load((const f32x4*)(X + off + bj * 128 + 4)) + acc[ai][bj][m][1];
                    u32x4 w; w.x = pk2(h0[0], h0[1]); w.y = pk2(h0[2], h0[3]); w.z = pk2(h1[0], h1[1]); w.w = pk2(h1[2], h1[3]); *(u32x4*)(HB + off + bj * 128) = w; }
                if (m & 1) asm volatile("" ::: "memory"); }
    }
};
struct EpiGateUp {
    static constexpr bool PERM = true;
    bf16* HID; const float* GATEL; const float* RSL; TileTab tt;
    __device__ __forceinline__ void operator()(const f32x4 (&acc)[2][2][4][2], const pg8::Unit& u, int wr, int wc, int fr, int fq) const {
        const int e = tt.TE[u.pm], ne = tt.NE[e], p0 = (u.pm - tt.T0[e]) * 256;
#pragma unroll
        for (int ai = 0; ai < 2; ++ai)
#pragma unroll
            for (int m = 0; m < 4; ++m) {
                const int rr = ai * 128 + wr * 64 + m * 16 + fr, pos = p0 + rr;
                float rs = 0.f, gt = 0.f; if (pos < ne) { rs = RSL[e * M + pos]; gt = GATEL[e * M + pos]; }
                u32x4 w; unsigned* wp = (unsigned*)&w;
#pragma unroll
                for (int n = 0; n < 2; ++n) { const f32x4 g = acc[ai][0][m][n] * rs, up = acc[ai][1][m][n] * rs; float hv[4];
#pragma unroll
                    for (int q = 0; q < 4; ++q) hv[q] = silu_f(g[q]) * up[q] * gt;
                    wp[2 * n] = pk2(hv[0], hv[1]); wp[2 * n + 1] = pk2(hv[2], hv[3]); }
                *(u32x4*)(HID + (size_t)(u.pm * 256 + rr) * FF + u.pn * 128 + wc * 32 + 8 * fq) = w;
            }
    }
};
struct EpiDown {
    static constexpr bool PERM = true;
    bf16* Y; const int* LIST; TileTab tt;
    __device__ __forceinline__ void operator()(const f32x4 (&acc)[2][2][4][2], const pg8::Unit& u, int wr, int wc, int fr, int fq) const {
        const int e = tt.TE[u.pm], ne = tt.NE[e], p0 = (u.pm - tt.T0[e]) * 256;
#pragma unroll
        for (int ai = 0; ai < 2; ++ai)
#pragma unroll
            for (int m = 0; m < 4; ++m) {
                const int pos = p0 + ai * 128 + wr * 64 + m * 16 + fr;
                if (pos < ne) { const int tk = LIST[e * M + pos]; bf16* rowp = Y + (size_t)tk * DM + u.pn * 256 + wc * 32 + 8 * fq;
#pragma unroll
                    for (int bj = 0; bj < 2; ++bj) { const f32x4 v0 = acc[ai][bj][m][0], v1 = acc[ai][bj][m][1];
                        u32x4 w; w.x = pk2(v0[0], v0[1]); w.y = pk2(v0[2], v0[3]); w.z = pk2(v1[0], v1[1]); w.w = pk2(v1[2], v1[3]);
                        *(u32x4*)(rowp + bj * 128) = w; } }
            }
    }
};

typedef short v4i16_t __attribute__((ext_vector_type(4)));
__device__ __forceinline__ s16x4 vtr(const LAS unsigned char* p) { return __builtin_bit_cast(s16x4, __builtin_amdgcn_ds_read_tr16_b64_v4i16((LAS v4i16_t*)p)); }
#define MFMA32(a, b, c) __builtin_amdgcn_mfma_f32_32x32x16_bf16((a), (b), (c), 0, 0, 0)
__device__ __forceinline__ bf16x8 pack8(const f32x16& x, int s) {
    u32x4 p; p.x = pk2(x[8 * s], x[8 * s + 1]); p.y = pk2(x[8 * s + 2], x[8 * s + 3]); p.z = pk2(x[8 * s + 4], x[8 * s + 5]); p.w = pk2(x[8 * s + 6], x[8 * s + 7]);
    return __builtin_bit_cast(bf16x8, p);
}
__device__ __forceinline__ bf16x8 cat44(s16x4 lo, s16x4 hi) { return __builtin_shufflevector(lo, hi, 0, 1, 2, 3, 4, 5, 6, 7); }
__device__ __forceinline__ bf16x8 scale8(bf16x8 v, float s) {
    u32x4 u = __builtin_bit_cast(u32x4, v), o;
    o.x = pk2(bflo(u.x) * s, bfhi(u.x) * s); o.y = pk2(bflo(u.y) * s, bfhi(u.y) * s); o.z = pk2(bflo(u.z) * s, bfhi(u.z) * s); o.w = pk2(bflo(u.w) * s, bfhi(u.w) * s);
    return __builtin_bit_cast(bf16x8, o);
}
constexpr int TP = 144;
__device__ __forceinline__ void pv_tile_p(f32x16& ot0, f32x16& ot1, const f32x16& st, const LAS unsigned char* vl, int lane) {
    const int hi = lane >> 5;
    const LAS unsigned char* vr = vl + (4 * hi + ((lane & 15) >> 2)) * TP + (16 * ((lane >> 4) & 1) + 4 * (lane & 3)) * 2;
    const bf16x8 pb0 = pack8(st, 0), pb1 = pack8(st, 1);
    { const bf16x8 va = cat44(vtr(vr), vtr(vr + 8 * TP)); ot0 = MFMA32(va, pb0, ot0); }
    { const bf16x8 va = cat44(vtr(vr + 16 * TP), vtr(vr + 24 * TP)); ot0 = MFMA32(va, pb1, ot0); }
    { const bf16x8 va = cat44(vtr(vr + 64), vtr(vr + 8 * TP + 64)); ot1 = MFMA32(va, pb0, ot1); }
    { const bf16x8 va = cat44(vtr(vr + 16 * TP + 64), vtr(vr + 24 * TP + 64)); ot1 = MFMA32(va, pb1, ot1); }
}
__device__ __forceinline__ void kv_task(int cid, const bf16* KR, const bf16* VR, bf16* KV, const float* dec_f, const float* dec_b, LAS unsigned char* wl, int lane) {
    const int bh = cid >> 5, n = cid & 31, b = bh >> 3, h = bh & 7, q = lane & 31, hi = lane >> 5, tr = lane >> 3, tc = (lane & 7) * 8;
    const float lgf = __uint_as_float(__builtin_amdgcn_readfirstlane(__float_as_uint(log1pf(-exp2f(dec_f[h])) * LOG2E))), lgb = __uint_as_float(__builtin_amdgcn_readfirstlane(__float_as_uint(log1pf(-exp2f(dec_b[h])) * LOG2E)));
    const size_t row0 = (size_t)b * SEQ + n * CHUNK; const int loff = tr * SEGW + tc;
    const bf16* Kb = KR + row0 * SEGW + h * HD; const bf16* Vb = VR + row0 * SEGW + h * HD;
    LAS unsigned char* Tf = wl; LAS unsigned char* Tb = wl + 32 * TP; LAS unsigned char* Tv = wl + 64 * TP; LAS unsigned char* tw = wl + tr * TP + tc * 2;
    const int tro = (8 * hi + ((lane & 15) >> 2)) * TP + (16 * ((lane >> 4) & 1) + 4 * (lane & 3)) * 2;
    f32x16 acc[2][2][2];
#pragma unroll
    for (int d = 0; d < 2; ++d)
#pragma unroll
        for (int a = 0; a < 2; ++a)
#pragma unroll
            for (int c = 0; c < 2; ++c)
#pragma unroll
                for (int r = 0; r < 16; ++r) acc[d][a][c][r] = 0.f;
    bf16x8 nk[4], nv[4];
#pragma unroll
    for (int i = 0; i < 4; ++i) { nk[i] = *(const bf16x8*)(Kb + loff + 8 * i * SEGW); nv[i] = *(const bf16x8*)(Vb + loff + 8 * i * SEGW); }
#pragma unroll 1
    for (int it = 0; it < 4; ++it) {
#pragma unroll
        for (int i = 0; i < 4; ++i) { const int key = 32 * it + tr + 8 * i;
            *(LAS bf16x8*)(tw + 8 * i * TP) = scale8(nk[i], __builtin_amdgcn_exp2f((float)(CHUNK - 1 - key) * lgf));
            *(LAS bf16x8*)(tw + 32 * TP + 8 * i * TP) = scale8(nk[i], __builtin_amdgcn_exp2f((float)key * lgb));
            *(LAS bf16x8*)(tw + 64 * TP + 8 * i * TP) = nv[i]; }
        if (it < 3) {
#pragma unroll
            for (int i = 0; i < 4; ++i) { nk[i] = *(const bf16x8*)(Kb + 32 * (it + 1) * SEGW + loff + 8 * i * SEGW); nv[i] = *(const bf16x8*)(Vb + 32 * (it + 1) * SEGW + loff + 8 * i * SEGW); } }
        asm volatile("" ::: "memory");
#pragma unroll
        for (int s2 = 0; s2 < 2; ++s2) {
            bf16x8 bv[2];
#pragma unroll
            for (int c = 0; c < 2; ++c) bv[c] = cat44(vtr(Tv + tro + s2 * 16 * TP + c * 64), vtr(Tv + tro + s2 * 16 * TP + 4 * TP + c * 64));
#pragma unroll
            for (int a = 0; a < 2; ++a) {
                const bf16x8 af = cat44(vtr(Tf + tro + s2 * 16 * TP + a * 64), vtr(Tf + tro + s2 * 16 * TP + 4 * TP + a * 64));
                const bf16x8 ab = cat44(vtr(Tb + tro + s2 * 16 * TP + a * 64), vtr(Tb + tro + s2 * 16 * TP + 4 * TP + a * 64));
#pragma unroll
                for (int c = 0; c < 2; ++c) { acc[0][a][c] = MFMA32(af, bv[c], acc[0][a][c]); acc[1][a][c] = MFMA32(ab, bv[c], acc[1][a][c]); }
            }
        }
        asm volatile("" ::: "memory");
    }
#pragma unroll
    for (int d = 0; d < 2; ++d) { bf16* ob = KV + (((size_t)bh * NCHUNK + n) * 2 + d) * 4096;
#pragma unroll
        for (int a = 0; a < 2; ++a)
#pragma unroll
            for (int c = 0; c < 2; ++c)
#pragma unroll
                for (int g = 0; g < 4; ++g) { u32x2 w; w.x = pk2(acc[d][a][c][4 * g], acc[d][a][c][4 * g + 1]); w.y = pk2(acc[d][a][c][4 * g + 2], acc[d][a][c][4 * g + 3]);
                    *(u32x2*)(ob + ((c * 4 + 2 * a + (g >> 1)) * 64 + q + 32 * (g & 1)) * 8 + 4 * hi) = w; } }
}

struct AttnRound { size_t rowbase; int dil, qb0, nblk, h, br; };
__device__ __forceinline__ AttnRound round_decode(int rg) {
    AttnRound a; const int bh = rg / 48, x = rg - bh * 48, br = x >> 4, w16 = x & 15; int cls, qb0;
    if (br == 0) { cls = 0; qb0 = 8 * w16; } else if (br == 1) { cls = w16 >> 2; qb0 = 8 * (w16 & 3); } else { cls = w16; qb0 = 0; }
    a.rowbase = (size_t)(bh >> 3) * SEQ + cls; a.dil = 1 << (2 * br); a.qb0 = qb0; a.nblk = (SEQ >> (2 * br)) >> 5; a.h = bh & 7; a.br = br; return a;
}
__device__ __forceinline__ int round_id(int r0, int xl, int rr) { if (xl < 0) return r0 + rr; const int t = rr / 3, i = rr - 3 * t; return (r0 + 2 * t + (xl >> 4)) * 48 + 3 * (xl & 15) + i; }
__device__ __forceinline__ void attn_rounds(int r0, int xl, int nr, const bf16* QA, const bf16* KA, const bf16* VA, bf16* OBR, float* LSE, LAS unsigned char* lds, int wave, int lane) {
    const int q = lane & 31, hi = lane >> 5, tr = lane >> 3, tc = (lane & 7) * 8;
    LAS unsigned char* Qt = lds + (24 + wave) * (32 * TP);
    const int twoff = tr * TP + tc * 2;
    bf16x8 pt[3][4], pq[4];
    AttnRound nx = round_decode(round_id(r0, xl, 0));
#define ATT_PREFETCH(R) do { \
        _Pragma("unroll") for (int x_ = 0; x_ < 3; ++x_) { const int tile = 3 * wave + x_, slot = tile >= 12 ? tile - 12 : tile, j_ = (R).qb0 - 2 + slot; \
            if (j_ >= 0 && j_ < (R).nblk) { const bf16* src = (tile >= 12 ? VA : KA) + ((R).rowbase + (size_t)(R).dil * (32 * j_ + tr)) * SEGW + (R).h * HD + tc; \
                _Pragma("unroll") for (int i_ = 0; i_ < 4; ++i_) pt[x_][i_] = *(const bf16x8*)(src + (size_t)(R).dil * 8 * i_ * SEGW); } } \
        { const bf16* src = QA + ((R).rowbase + (size_t)(R).dil * (32 * ((R).qb0 + wave) + tr)) * SEGW + (R).h * HD + tc; \
          _Pragma("unroll") for (int i_ = 0; i_ < 4; ++i_) pq[i_] = *(const bf16x8*)(src + (size_t)(R).dil * 8 * i_ * SEGW); } } while (0)
    ATT_PREFETCH(nx);
#pragma unroll 1
    for (int rr = 0; rr < nr; ++rr) {
        const AttnRound cu = nx;
        __syncthreads();
#pragma unroll
        for (int x = 0; x < 3; ++x) { const int tile = 3 * wave + x, slot = tile >= 12 ? tile - 12 : tile, j = cu.qb0 - 2 + slot;
            if (j >= 0 && j < cu.nblk) { LAS unsigned char* tb = lds + tile * (32 * TP) + twoff;
#pragma unroll
                for (int i = 0; i < 4; ++i) *(LAS bf16x8*)(tb + 8 * i * TP) = pt[x][i]; } }
#pragma unroll
        for (int i = 0; i < 4; ++i) *(LAS bf16x8*)(Qt + twoff + 8 * i * TP) = pq[i];
        if (rr + 1 < nr) { nx = round_decode(round_id(r0, xl, rr + 1)); ATT_PREFETCH(nx); }
        __syncthreads();
        bf16x8 qr[4];
#pragma unroll
        for (int ks = 0; ks < 4; ++ks) qr[ks] = *(const LAS bf16x8*)(Qt + q * TP + hi * 16 + 32 * ks);
        float mrun = -1e30f, lsum = 0.f; f32x16 ot0, ot1;
#pragma unroll
        for (int r = 0; r < 16; ++r) { ot0[r] = 0.f; ot1[r] = 0.f; }
        const int jb = cu.qb0 + wave - 2, klo = jb < 0 ? -jb : 0, khi = jb + 4 >= cu.nblk ? cu.nblk - 1 - jb : 4;
        f32x16 stn;
#define ATT_QK(dst, kb_) do { const LAS unsigned char* Kt_ = lds + (wave + (kb_)) * (32 * TP); _Pragma("unroll") for (int r_ = 0; r_ < 16; ++r_) dst[r_] = 0.f; \
            _Pragma("unroll") for (int ks_ = 0; ks_ < 4; ++ks_) dst = MFMA32(*(const LAS bf16x8*)(Kt_ + q * TP + hi * 16 + 32 * ks_), qr[ks_], dst); } while (0)
        ATT_QK(stn, klo);
#pragma unroll 1
        for (int kb = klo; kb <= khi; ++kb) {
            f32x16 st = stn;
            if (kb < khi) ATT_QK(stn, kb + 1);
            const LAS unsigned char* Vt = lds + (12 + wave + kb) * (32 * TP);
            if (kb == 0) {
#pragma unroll
                for (int r = 0; r < 16; ++r) if (crow(r, hi) < q) st[r] = -1e30f;
            }
            if (kb == 4) {
#pragma unroll
                for (int r = 0; r < 16; ++r) if (crow(r, hi) > q) st[r] = -1e30f;
            }
            float mx = st[0];
#pragma unroll
            for (int r = 1; r < 16; ++r) mx = fmaxf(mx, st[r]);
            mx = fmaxf(mx, __shfl_xor(mx, 32));
            if (!__all(mx <= mrun + 8.f)) {
                const float mnew = fmaxf(mrun, mx), alpha = __builtin_amdgcn_exp2f(mrun - mnew); mrun = mnew; lsum *= alpha;
#pragma unroll
                for (int r = 0; r < 16; ++r) { ot0[r] *= alpha; ot1[r] *= alpha; }
            }
            float ps = 0.f;
#pragma unroll
            for (int r = 0; r < 16; ++r) { st[r] = __builtin_amdgcn_exp2f(st[r] - mrun); ps += st[r]; }
            lsum += ps;
            pv_tile_p(ot0, ot1, st, Vt, lane);
        }
#undef ATT_QK
        const float lt = lsum + __shfl_xor(lsum, 32);
        const float inv = 1.f / lt, lse = (mrun + __log2f(lt)) * LN2;
        asm volatile("" ::: "memory");
        LAS unsigned char* ow = Qt + q * TP + 8 * hi;
#pragma unroll
        for (int g = 0; g < 4; ++g) {
            u32x2 w0, w1; w0.x = pk2(ot0[4 * g] * inv, ot0[4 * g + 1] * inv); w0.y = pk2(ot0[4 * g + 2] * inv, ot0[4 * g + 3] * inv);
            w1.x = pk2(ot1[4 * g] * inv, ot1[4 * g + 1] * inv); w1.y = pk2(ot1[4 * g + 2] * inv, ot1[4 * g + 3] * inv);
            *(LAS u32x2*)(ow + 16 * g) = w0; *(LAS u32x2*)(ow + 64 + 16 * g) = w1; }
        asm volatile("" ::: "memory");
        const size_t qbase = cu.rowbase + (size_t)cu.dil * 32 * (cu.qb0 + wave);
#pragma unroll
        for (int i = 0; i < 4; ++i) { const u32x4 v = *(const LAS u32x4*)(Qt + twoff + 8 * i * TP);
            *(u32x4*)(OBR + ((size_t)cu.br * M + qbase + (size_t)cu.dil * (tr + 8 * i)) * SEGW + cu.h * HD + tc) = v; }
        if (hi == 0) LSE[((size_t)cu.br * M + qbase + (size_t)cu.dil * q) * NHEAD + cu.h] = lse;
        asm volatile("" ::: "memory");
    }
#undef ATT_PREFETCH
    __syncthreads();
}

constexpr int R_K = 0, R_V = 128 * TP, R_Q = 2 * 128 * TP, R_G = 3 * 128 * TP, R_O = 4 * 128 * TP, R_SF = 5 * 128 * TP, R_SB = R_SF + 8192, R_X = R_SB + 8192;
__device__ __forceinline__ void ret_wg(int wgt, const bf16* QR, const bf16* KR, const bf16* VR, const bf16* GR, const bf16* KV, bf16* SBW, bf16* MIXED, const float* dec_f, const float* dec_b,
                                       const bf16* OBR, const float* LSE, long crow0, LAS unsigned char* lds, int tid, int wave, int lane) {
    const int bh = wgt >> 2, n0 = (wgt & 3) * 8, b = bh >> 3, h = bh & 7, q = lane & 31, hi = lane >> 5, tr = lane >> 3, tc = (lane & 7) * 8;
    const float lgf = __uint_as_float(__builtin_amdgcn_readfirstlane(__float_as_uint(log1pf(-exp2f(dec_f[h])) * LOG2E))), lgb = __uint_as_float(__builtin_amdgcn_readfirstlane(__float_as_uint(log1pf(-exp2f(dec_b[h])) * LOG2E)));
    const float gf128 = exp2f(128.f * lgf), gb128 = exp2f(128.f * lgb);
    float pf[16], pb[16];
#pragma unroll
    for (int r = 0; r < 16; ++r) { const int dl = q - crow(r, hi); pf[r] = exp2f((float)dl * lgf); pb[r] = exp2f((float)(-dl) * lgb); }
    const bf16* KVt = KV + (size_t)bh * NCHUNK * 2 * 4096 + 8 * tid;
    bf16* SBt = SBW + (size_t)bh * NCHUNK * 4096 + 8 * tid;
    float Sf[8], Sb[8];
#pragma unroll
    for (int e = 0; e < 8; ++e) { Sf[e] = 0.f; Sb[e] = 0.f; }
#define RET_AXPY(S, g, v) do { S[0] = S[0] * (g) + bflo((v).x); S[1] = S[1] * (g) + bfhi((v).x); S[2] = S[2] * (g) + bflo((v).y); S[3] = S[3] * (g) + bfhi((v).y); \
                               S[4] = S[4] * (g) + bflo((v).z); S[5] = S[5] * (g) + bfhi((v).z); S[6] = S[6] * (g) + bflo((v).w); S[7] = S[7] * (g) + bfhi((v).w); } while (0)
    for (int m0 = 0; m0 < n0; m0 += 8) { u32x4 v[8];
#pragma unroll
        for (int k = 0; k < 8; ++k) v[k] = *(const u32x4*)(KVt + (size_t)((m0 + k) * 2) * 4096);
#pragma unroll
        for (int k = 0; k < 8; ++k) RET_AXPY(Sf, gf128, v[k]); }
    for (int m0 = NCHUNK - 8; m0 >= n0 + 8; m0 -= 8) { u32x4 v[8];
#pragma unroll
        for (int k = 0; k < 8; ++k) v[k] = *(const u32x4*)(KVt + (size_t)((m0 + 7 - k) * 2 + 1) * 4096);
#pragma unroll
        for (int k = 0; k < 8; ++k) RET_AXPY(Sb, gb128, v[k]); }
    { u32x4 v[8];
#pragma unroll
      for (int k = 0; k < 8; ++k) v[k] = *(const u32x4*)(KVt + (size_t)((n0 + 7 - k) * 2 + 1) * 4096);
#pragma unroll
      for (int k = 0; k < 8; ++k) { u32x4 w; w.x = pk2(Sb[0], Sb[1]); w.y = pk2(Sb[2], Sb[3]); w.z = pk2(Sb[4], Sb[5]); w.w = pk2(Sb[6], Sb[7]);
          *(u32x4*)(SBt + (size_t)(n0 + 7 - k) * 4096) = w; RET_AXPY(Sb, gb128, v[k]); } }
    VM_WAIT();
    const int tsel = wave >> 1, rbase = 64 * (wave & 1) + tr;
    const bf16* tsrc = (tsel == 0 ? KR : tsel == 1 ? VR : tsel == 2 ? QR : GR) + ((size_t)b * SEQ + rbase) * SEGW + h * HD + tc;
    LAS unsigned char* tdst = lds + tsel * (128 * TP) + rbase * TP + tc * 2;
    const int qb = wave & 3, dvh = wave >> 2;
    bf16x8 pre[8]; u32x4 pkv, psb;
#define RET_PREFETCH(n_) do { _Pragma("unroll") for (int i_ = 0; i_ < 8; ++i_) pre[i_] = __builtin_nontemporal_load((const bf16x8*)(tsrc + (size_t)((n_) * CHUNK + 8 * i_) * SEGW)); \
        pkv = *(const u32x4*)(KVt + (size_t)((n_) * 2) * 4096); psb = *(const u32x4*)(SBt + (size_t)(n_) * 4096); } while (0)
    RET_PREFETCH(n0);
#pragma unroll 1
    for (int jn = 0; jn < 8; ++jn) {
        const int n = n0 + jn; const size_t row0 = (size_t)b * SEQ + n * CHUNK;
        __syncthreads();
        if (jn > 0) {
#pragma unroll
            for (int i = 0; i < 2; ++i) { const int r = 16 * wave + 8 * i + tr; const u32x4 v = *(const LAS u32x4*)(lds + R_O + r * TP + tc * 2);
                *(u32x4*)(MIXED + (row0 - CHUNK + r) * DM + 512 + h * HD + tc) = v; } }
#pragma unroll
        for (int i = 0; i < 8; ++i) *(LAS bf16x8*)(tdst + 8 * i * TP) = pre[i];
        { u32x4 w; w.x = pk2(Sf[0], Sf[1]); w.y = pk2(Sf[2], Sf[3]); w.z = pk2(Sf[4], Sf[5]); w.w = pk2(Sf[6], Sf[7]);
          *(LAS u32x4*)(lds + R_SF + tid * 16) = w; *(LAS u32x4*)(lds + R_SB + tid * 16) = psb; }
        RET_AXPY(Sf, gf128, pkv);
        if (jn < 7) RET_PREFETCH(n + 1);
        float cl[3]; u32x4 ca[3];
#define RET_CLOAD(rw_) do { _Pragma("unroll") for (int br_ = 0; br_ < 3; ++br_) { cl[br_] = LSE[((size_t)br_ * M + (rw_)) * NHEAD + (lane >> 3)]; ca[br_] = __builtin_nontemporal_load((const u32x4*)(OBR + ((size_t)br_ * M + (rw_)) * SEGW + 8 * lane)); } } while (0)
#define RET_CFIN(rw_) do { const float mx_ = fmaxf(cl[0], fmaxf(cl[1], cl[2])); float w0_ = __expf(cl[0] - mx_), w1_ = __expf(cl[1] - mx_), w2_ = __expf(cl[2] - mx_); \
            const float inv_ = 1.f / (w0_ + w1_ + w2_); w0_ *= inv_; w1_ *= inv_; w2_ *= inv_; float o_[8]; float ssq_ = 0.f; \
            _Pragma("unroll") for (int e_ = 0; e_ < 4; ++e_) { o_[2 * e_] = w0_ * bflo(ca[0][e_]) + w1_ * bflo(ca[1][e_]) + w2_ * bflo(ca[2][e_]); o_[2 * e_ + 1] = w0_ * bfhi(ca[0][e_]) + w1_ * bfhi(ca[1][e_]) + w2_ * bfhi(ca[2][e_]); ssq_ += o_[2 * e_] * o_[2 * e_] + o_[2 * e_ + 1] * o_[2 * e_ + 1]; } \
            const float rs_ = 1.f / sqrtf(wave_sum(ssq_) * (1.f / 512.f) + NORM_EPS); \
            u32x4 w_; w_.x = pk2(o_[0] * rs_, o_[1] * rs_); w_.y = pk2(o_[2] * rs_, o_[3] * rs_); w_.z = pk2(o_[4] * rs_, o_[5] * rs_); w_.w = pk2(o_[6] * rs_, o_[7] * rs_); \
            *(u32x4*)(MIXED + (rw_) * DM + 8 * lane) = w_; } while (0)
        if (crow0 >= 0) RET_CLOAD((size_t)crow0 + 2 * jn);
        __syncthreads();
        const int i_ = 32 * qb + q;
        bf16x8 qr[4];
#pragma unroll
        for (int ks = 0; ks < 4; ++ks) qr[ks] = *(const LAS bf16x8*)(lds + R_Q + i_ * TP + hi * 16 + 32 * ks);
        f32x16 ot;
#pragma unroll
        for (int r = 0; r < 16; ++r) ot[r] = 0.f;
        const LAS unsigned char* vr = lds + R_V + (4 * hi + ((lane & 15) >> 2)) * TP + (32 * dvh + 16 * ((lane >> 4) & 1) + 4 * (lane & 3)) * 2;
#pragma unroll 1
        for (int kb = 0; kb < 4; ++kb) {
            f32x16 st;
#pragma unroll
            for (int r = 0; r < 16; ++r) st[r] = 0.f;
#pragma unroll
            for (int ks = 0; ks < 4; ++ks) st = MFMA32(*(const LAS bf16x8*)(lds + R_K + (32 * kb + q) * TP + hi * 16 + 32 * ks), qr[ks], st);
#pragma unroll
            for (int r = 0; r < 16; ++r) st[r] *= (kb == qb ? (q >= crow(r, hi) ? pf[r] : pb[r]) : kb < qb ? pf[r] : pb[r]);
            if (kb != qb) { const float sc = kb < qb ? exp2f((float)(32 * (qb - kb)) * lgf) : exp2f((float)(32 * (kb - qb)) * lgb);
#pragma unroll
                for (int r = 0; r < 16; ++r) st[r] *= sc; }
            const bf16x8 pb0 = pack8(st, 0), pb1 = pack8(st, 1);
            const LAS unsigned char* v0 = vr + 32 * kb * TP;
            ot = MFMA32(cat44(vtr(v0), vtr(v0 + 8 * TP)), pb0, ot);
            ot = MFMA32(cat44(vtr(v0 + 16 * TP), vtr(v0 + 24 * TP)), pb1, ot);
        }
        {   const float cf = exp2f((float)(i_ + 1) * lgf), cb = exp2f((float)(CHUNK - i_) * lgb);
            f32x16 t;
#pragma unroll
            for (int r = 0; r < 16; ++r) t[r] = 0.f;
#pragma unroll
            for (int ks = 0; ks < 4; ++ks) t = MFMA32(*(const LAS bf16x8*)(lds + R_SF + ((dvh * 4 + ks) * 64 + lane) * 16), qr[ks], t);
#pragma unroll
            for (int r = 0; r < 16; ++r) ot[r] += cf * t[r];
#pragma unroll
            for (int r = 0; r < 16; ++r) t[r] = 0.f;
#pragma unroll
            for (int ks = 0; ks < 4; ++ks) t = MFMA32(*(const LAS bf16x8*)(lds + R_SB + ((dvh * 4 + ks) * 64 + lane) * 16), qr[ks], t);
#pragma unroll
            for (int r = 0; r < 16; ++r) ot[r] += cb * t[r]; }
        if (crow0 >= 0) { RET_CFIN((size_t)crow0 + 2 * jn); RET_CLOAD((size_t)crow0 + 2 * jn + 1); }
        float s1 = 0.f, s2 = 0.f;
#pragma unroll
        for (int r = 0; r < 16; ++r) { s1 += ot[r]; s2 += ot[r] * ot[r]; }
        s1 += __shfl_xor(s1, 32); s2 += __shfl_xor(s2, 32);
        if (hi == 0) *(LAS f32x2*)(lds + R_X + (wave * 32 + q) * 8) = (f32x2){s1, s2};
        __syncthreads();
        { const f32x2 p = *(const LAS f32x2*)(lds + R_X + ((wave ^ 4) * 32 + q) * 8); s1 += p.x; s2 += p.y; }
        const float mean = s1 * (1.f / 64.f), var = fmaxf(s2 * (1.f / 64.f) - mean * mean, 0.f), rstd = 1.f / sqrtf(var + NORM_EPS);
        const LAS unsigned char* gp = lds + R_G + i_ * TP + (32 * dvh + 4 * hi) * 2; LAS unsigned char* op = lds + R_O + i_ * TP + (32 * dvh + 4 * hi) * 2;
#pragma unroll
        for (int g = 0; g < 4; ++g) { const u32x2 gg = *(const LAS u32x2*)(gp + 16 * g); u32x2 w;
            w.x = pk2((ot[4 * g] - mean) * rstd * bflo(gg.x), (ot[4 * g + 1] - mean) * rstd * bfhi(gg.x)); w.y = pk2((ot[4 * g + 2] - mean) * rstd * bflo(gg.y), (ot[4 * g + 3] - mean) * rstd * bfhi(gg.y));
            *(LAS u32x2*)(op + 16 * g) = w; }
        if (crow0 >= 0) RET_CFIN((size_t)crow0 + 2 * jn + 1);
    }
#undef RET_CLOAD
#undef RET_CFIN
    __syncthreads();
    { const size_t row0 = (size_t)b * SEQ + (n0 + 7) * CHUNK;
#pragma unroll
      for (int i = 0; i < 2; ++i) { const int r = 16 * wave + 8 * i + tr; const u32x4 v = *(const LAS u32x4*)(lds + R_O + r * TP + tc * 2);
          *(u32x4*)(MIXED + (row0 + r) * DM + 512 + h * HD + tc) = v; } }
    __syncthreads();
#undef RET_AXPY
#undef RET_PREFETCH
}

template <int NR>
__device__ __forceinline__ void combine_rows(const size_t (&rows)[NR], const bf16* OBR, const float* LSE, bf16* MIXED, int lane) {
    const int hh = lane >> 3;
    float l[NR][3]; u32x4 a[NR][3];
#pragma unroll
    for (int k = 0; k < NR; ++k)
#pragma unroll
        for (int br = 0; br < 3; ++br) { l[k][br] = LSE[((size_t)br * M + rows[k]) * NHEAD + hh]; a[k][br] = *(const u32x4*)(OBR + ((size_t)br * M + rows[k]) * SEGW + 8 * lane); }
#pragma unroll
    for (int k = 0; k < NR; ++k) {
        const float mx = fmaxf(l[k][0], fmaxf(l[k][1], l[k][2])); float w0 = __expf(l[k][0] - mx), w1 = __expf(l[k][1] - mx), w2 = __expf(l[k][2] - mx);
        const float inv = 1.f / (w0 + w1 + w2); w0 *= inv; w1 *= inv; w2 *= inv;
        float o[8]; float ss = 0.f;
#pragma unroll
        for (int e = 0; e < 4; ++e) { o[2 * e] = w0 * bflo(a[k][0][e]) + w1 * bflo(a[k][1][e]) + w2 * bflo(a[k][2][e]); o[2 * e + 1] = w0 * bfhi(a[k][0][e]) + w1 * bfhi(a[k][1][e]) + w2 * bfhi(a[k][2][e]); ss += o[2 * e] * o[2 * e] + o[2 * e + 1] * o[2 * e + 1]; }
        const float rstd = 1.f / sqrtf(wave_sum(ss) * (1.f / 512.f) + NORM_EPS);
        u32x4 w; w.x = pk2(o[0] * rstd, o[1] * rstd); w.y = pk2(o[2] * rstd, o[3] * rstd); w.z = pk2(o[4] * rstd, o[5] * rstd); w.w = pk2(o[6] * rstd, o[7] * rstd);
        *(u32x4*)(MIXED + rows[k] * DM + 8 * lane) = w;
    }
}
constexpr int RP = 528;
constexpr int R5_W = 0, R5_A = 2 * 48 * RP, R5_SC = R5_A + 8 * 16 * RP, R5_CNT = R5_SC + 8 * 3200;
__device__ __forceinline__ void route_wg(int wgt, const bf16* HB, const bf16* WR, const float* bg, const float* be, gu32* ctl, int* LIST, float* GATEL, float* RSL, LAS unsigned char* lds, int tid, int wave, int lane) {
    const size_t row0 = (size_t)wgt * 128;
    LAS unsigned* cntL = (LAS unsigned*)(lds + R5_CNT); LAS unsigned* baseL = cntL + 32;
    if (tid < 32) cntL[tid] = 0u;
    u32x4 pw[6], pa[8];
#define R5_PREF(kc) do { _Pragma("unroll") for (int i_ = 0; i_ < 6; ++i_) { const int idx = tid + 512 * i_; pw[i_] = *(const u32x4*)(WR + (size_t)(idx >> 5) * DM + 256 * (kc) + 8 * (idx & 31)); } \
        _Pragma("unroll") for (int i_ = 0; i_ < 8; ++i_) pa[i_] = *(const u32x4*)(HB + (row0 + 16 * wave + 2 * i_ + (lane >> 5)) * DM + 256 * (kc) + 8 * (lane & 31)); } while (0)
    R5_PREF(0);
    f32x4 acc[3]; float ss = 0.f;
#pragma unroll
    for (int c = 0; c < 3; ++c) acc[c] = (f32x4){0.f, 0.f, 0.f, 0.f};
    const LAS unsigned char* Aw = lds + R5_A + wave * 16 * RP;
#pragma unroll 1
    for (int kc = 0; kc < 4; ++kc) {
        __syncthreads();
#pragma unroll
        for (int i = 0; i < 6; ++i) { const int idx = tid + 512 * i; *(LAS u32x4*)(lds + R5_W + (idx >> 5) * RP + (idx & 31) * 16) = pw[i]; }
#pragma unroll
        for (int i = 0; i < 8; ++i) *(LAS u32x4*)(lds + R5_A + (wave * 16 + 2 * i + (lane >> 5)) * RP + (lane & 31) * 16) = pa[i];
        if (kc < 3) R5_PREF(kc + 1);
        __syncthreads();
#pragma unroll
        for (int ks = 0; ks < 8; ++ks) {
            const int ko = (32 * ks + 8 * (lane >> 4)) * 2;
            const bf16x8 a = *(const LAS bf16x8*)(Aw + (lane & 15) * RP + ko);
            { const u32x4 au = __builtin_bit_cast(u32x4, a);
#pragma unroll
              for (int e = 0; e < 4; ++e) { const float lo = bflo(au[e]), hi_ = bfhi(au[e]); ss += lo * lo + hi_ * hi_; } }
#pragma unroll
            for (int c = 0; c < 3; ++c)
#pragma unroll
                for (int p = 0; p < 2; ++p) { const bf16x8 bb = *(const LAS bf16x8*)(lds + R5_W + (p * 48 + 16 * c + (lane & 15)) * RP + ko);
                    acc[c] = __builtin_amdgcn_mfma_f32_16x16x32_bf16(a, bb, acc[c], 0, 0, 0); }
        }
    }
#undef R5_PREF
    ss += __shfl_xor(ss, 16); ss += __shfl_xor(ss, 32);
    const float rstd = 1.f / sqrtf(ss * (1.f / DM) + NORM_EPS);
    LAS float* sc = (LAS float*)(lds + R5_SC + wave * 3200);
    { const int r = lane & 15, g = lane >> 4;
#pragma unroll
      for (int e = 0; e < 4; ++e) { sc[(4 * g + e) * 48 + r] = acc[0][e]; sc[(4 * g + e) * 48 + 16 + r] = acc[1][e]; sc[(4 * g + e) * 48 + 32 + r] = acc[2][e]; }
      if (g == 0) sc[768 + r] = rstd; }
    LDS_WAIT(); asm volatile("" ::: "memory");
    int e1 = 0, e2 = 0; unsigned r1 = 0, r2 = 0; float g1 = 0.f, g2 = 0.f, rs = 0.f;
    if (lane < 16) {
        rs = sc[768 + lane]; const LAS float* lg = sc + lane * 48;
        float gmax = lg[32] * rs + bg[0]; int gi = 0; float gl[4]; gl[0] = gmax;
#pragma unroll
        for (int k = 1; k < 4; ++k) { gl[k] = lg[32 + k] * rs + bg[k]; if (gl[k] > gmax) { gmax = gl[k]; gi = k; } }
        float den = 0.f;
#pragma unroll
        for (int k = 0; k < 4; ++k) den += __expf(gl[k] - gmax);
        const float ggate = 1.f / den;
        float b1v = -3.0e38f, b2v = -3.0e38f; int i1 = 0, i2 = 0;
        for (int k = 0; k < 8; ++k) { const float v = lg[gi * 8 + k] * rs + be[gi * 8 + k]; if (v > b1v) { b1v = v; i1 = k; } }
        for (int k = 0; k < 8; ++k) { const float v = lg[gi * 8 + k] * rs + be[gi * 8 + k]; if (k != i1 && v > b2v) { b2v = v; i2 = k; } }
        const float p1 = 1.f / (1.f + __expf(b2v - b1v));
        g1 = ggate * p1; g2 = ggate * (1.f - p1); e1 = gi * 8 + i1; e2 = gi * 8 + i2;
        r1 = __hip_atomic_fetch_add(cntL + e1, 1u, __ATOMIC_RELAXED, __HIP_MEMORY_SCOPE_WORKGROUP); r2 = __hip_atomic_fetch_add(cntL + e2, 1u, __ATOMIC_RELAXED, __HIP_MEMORY_SCOPE_WORKGROUP);
    }
    __syncthreads();
    if (tid < 32) { const unsigned c = cntL[tid]; baseL[tid] = c ? __hip_atomic_fetch_add(ctl + CW_CNT + 64 * tid, c, RLX_AGENT) : 0u; }
    __syncthreads();
    if (lane < 16) {
        const size_t trow = row0 + 16 * wave + lane; const size_t s1 = (size_t)e1 * M + baseL[e1] + r1, s2 = (size_t)e2 * M + baseL[e2] + r2;
        LIST[s1] = (int)(trow * 2); GATEL[s1] = g1; RSL[s1] = rs;
        LIST[s2] = (int)(trow * 2 + 1); GATEL[s2] = g2; RSL[s2] = rs;
    }
    __syncthreads();
}
template <int NR>
__device__ __forceinline__ void final_rows(const size_t (&rows)[NR], const bf16* H, const bf16* Y, const f32x4 (&gv)[4], float* out, int lane) {
    u32x2 hv[NR][4], a[NR][4], b[NR][4];
#pragma unroll
    for (int k = 0; k < NR; ++k) { const u32x2* hp = (const u32x2*)(H + rows[k] * DM) + lane; const u32x2* y0 = (const u32x2*)(Y + (rows[k] * 2) * DM) + lane; const u32x2* y1 = (const u32x2*)(Y + (rows[k] * 2 + 1) * DM) + lane;
#pragma unroll
        for (int j = 0; j < 4; ++j) { hv[k][j] = __builtin_nontemporal_load(hp + 64 * j); a[k][j] = __builtin_nontemporal_load(y0 + 64 * j); b[k][j] = __builtin_nontemporal_load(y1 + 64 * j); } }
#pragma unroll
    for (int k = 0; k < NR; ++k) { f32x4 z[4]; float ss = 0.f;
#pragma unroll
        for (int j = 0; j < 4; ++j) {
            z[j][0] = bflo(hv[k][j].x) + bflo(a[k][j].x) + bflo(b[k][j].x); z[j][1] = bfhi(hv[k][j].x) + bfhi(a[k][j].x) + bfhi(b[k][j].x); z[j][2] = bflo(hv[k][j].y) + bflo(a[k][j].y) + bflo(b[k][j].y); z[j][3] = bfhi(hv[k][j].y) + bfhi(a[k][j].y) + bfhi(b[k][j].y);
            ss += (z[j][0] * z[j][0] + z[j][1] * z[j][1]) + (z[j][2] * z[j][2] + z[j][3] * z[j][3]); }
        const float rstd = 1.f / sqrtf(wave_sum(ss) * (1.f / DM) + NORM_EPS);
        f32x4* op = (f32x4*)(out + rows[k] * DM) + lane;
#pragma unroll
        for (int j = 0; j < 4; ++j) __builtin_nontemporal_store(z[j] * rstd * gv[j], op + 64 * j); }
}
__device__ __forceinline__ TileTab build_tiles(Frame& F, int& ntiles) {
    LAS int* T = (LAS int*)(F.lds + TILE_OFF); LAS int* TE = T; LAS int* NE = T + MAXTILES; LAS int* T0 = NE + 32; LAS int* NT = T0 + 32;
    __syncthreads();
    if (F.tid < NEXP) { int n = (int)__hip_atomic_load(F.ctl + CW_CNT + 64 * F.tid, RLX_AGENT); if (n > M) n = M; NE[F.tid] = n; }
    __syncthreads();
    if (F.tid == 0) { int t = 0;
        for (int e = 0; e < NEXP; ++e) { const int n = NE[e]; T0[e] = t; const int k = (n + 255) >> 8;
            for (int j = 0; j < k && t + j < MAXTILES; ++j) TE[t + j] = e; t += k; if (t > MAXTILES) t = MAXTILES; }
        NT[0] = t; }
    __syncthreads();
    ntiles = NT[0];
    TileTab tt; tt.TE = TE; tt.NE = NE; tt.T0 = T0; return tt;
}

__device__ __forceinline__ int fresh_lane() { int t = threadIdx.x; asm volatile("" : "+v"(t)); return t & 63; }
constexpr int N_LAUNCHES = MK_N_LAUNCHES, PER_PHASE = 9;
__global__ void __launch_bounds__(NWAVES * 64, 2) mk_fwd(Args args) {
    extern __shared__ __attribute__((aligned(16))) unsigned char lds_raw[];
    Frame F;
    F.lds = (LAS unsigned char*)lds_raw;
    F.MISC = (volatile LAS unsigned*)(F.lds + MISC_OFF);
    F.tid = threadIdx.x; F.lane = F.tid & 63; F.wave = __builtin_amdgcn_readfirstlane(F.tid >> 6);
    F.G = gridDim.x; { const int bx = blockIdx.x; F.vcu = (F.G % 8 == 0) ? (bx % 8) * (F.G / 8) + bx / 8 : bx; }
    unsigned char* ws = args.ws;
    F.ctl = (gu32*)(ws + WS_CTL);
    for (int u = F.tid; u < (LDS_BYTES - LDSCTL_OFF) / 4; u += NWAVES * 64) ((LAS unsigned*)(F.lds + LDSCTL_OFF))[u] = 0u;
    __syncthreads();
    XcdBarrier bar; bar.bar = (unsigned*)(F.ctl + CW_BAR); bar.x = 0; bar.st = nullptr;
    if (N_LAUNCHES != PER_PHASE) bar = xcd_barrier_post((unsigned*)(F.ctl + CW_BAR) + args.li * XCD_BAR_WORDS, F.MISC + 8);
#define GRID_BAR() do { if (N_LAUNCHES != PER_PHASE) xcd_barrier(bar); } while (0)
    const int lo = args.ph_lo, hi = args.ph_hi;
#define IN(k) (lo <= (k) && (k) < hi)
#define REPS(k) ((MK_REPEAT == (k)) ? MK_NREP : 1)
#define BOTH(k) (IN(k) && IN((k) + 1))
    const int gw = F.vcu * NWAVES + F.wave, NGW = F.G * NWAVES;
#if MK_TIME
    int n_stamp = 0;
#define STAMP() do { if (blockIdx.x == 0 && F.tid == 0) { const unsigned long long t_ = __builtin_amdgcn_s_memrealtime(); __hip_atomic_store(F.ctl + CW_TS + 2 * n_stamp, (unsigned)t_, RLX_AGENT); __hip_atomic_store(F.ctl + CW_TS + 2 * n_stamp + 1, (unsigned)(t_ >> 32), RLX_AGENT); } ++n_stamp; } while (0)
    STAMP();
#else
#define STAMP() do {} while (0)
#endif
    bf16* SEGB = (bf16*)(ws + WS_SEG);
    const bf16 *QA = SEGB, *KA = SEGB + (size_t)1 * M * SEGW, *VA = SEGB + (size_t)2 * M * SEGW, *QR = SEGB + (size_t)3 * M * SEGW, *KR = SEGB + (size_t)4 * M * SEGW, *VR = SEGB + (size_t)5 * M * SEGW, *GR = SEGB + (size_t)6 * M * SEGW;

    for (int rep_ = 0; rep_ < REPS(0); ++rep_) if (IN(0)) { p0_prologue(F, args); if (BOTH(0)) GRID_BAR(); STAMP(); }
    for (int rep_ = 0; rep_ < REPS(1); ++rep_) if (IN(1)) {
        const int bx = (int)blockIdx.x, rowg = bx >> 3; const bool split = (F.G == 256), conv = split && ((rowg & 7) == 7);
        if (conv) {
            expert_items(args, ws, (LAS float*)(F.lds + F.wave * 16384), 0, N_CONV_P1, (((rowg >> 3) << 3) + (bx & 7)) * NWAVES + F.wave, 32 * NWAVES, fresh_lane());
        } else {
            pg8::StaticOrder S; if (split) S.init(M / 256, NIN / 256, 224, (rowg - ((rowg + 1) >> 3)) * 8 + (bx & 7)); else S.init(M / 256, NIN / 256, F.G, bx);
            SrcPlain SRC{(const bf16*)(ws + WS_XN), (const bf16*)(ws + WS_WIN), DM};
            EpiInProj E{SEGB, (const float*)(ws + WS_ROPE), (const float*)(ws + WS_ROPE) + SEQ * 40};
            pg8::gemm_phase<EpiInProj, pg8::StaticOrder, SrcPlain, true, true>(F.lds, DM, S, SRC, E);
        }
        if (BOTH(1)) GRID_BAR(); STAMP();
    }
    for (int rep_ = 0; rep_ < REPS(2); ++rep_) if (IN(2)) {
        bf16* OBR = (bf16*)(ws + WS_OBR); float* LSE = (float*)(ws + WS_LSE); bf16* KVB = (bf16*)(ws + WS_ST);
        for (int cid = gw; cid < NBATCH * NHEAD * NCHUNK; cid += NGW) kv_task(cid, KR, VR, KVB, args.in[4], args.in[5], F.lds + F.wave * 16384, fresh_lane());
        { const int nrt = NBATCH * NHEAD * 48, per = (nrt + F.G - 1) / F.G, r0 = F.vcu * per, nr = r0 + per <= nrt ? per : (nrt > r0 ? nrt - r0 : 0);
          __syncthreads();
          if (F.G == 256) attn_rounds((F.vcu >> 5) * 8, F.vcu & 31, 12, QA, KA, VA, OBR, LSE, F.lds, F.wave, fresh_lane());
          else if (nr > 0) attn_rounds(r0, -1, nr, QA, KA, VA, OBR, LSE, F.lds, F.wave, fresh_lane()); }
        if (BOTH(2)) GRID_BAR(); STAMP();
    }
    for (int rep_ = 0; rep_ < REPS(3); ++rep_) if (IN(3)) {
        bf16* MIXED = (bf16*)(ws + WS_MIXED);
        const bool fold = (F.G == 256);
        for (int wgt = F.vcu; wgt < NBATCH * NHEAD * 4; wgt += F.G) { int t_ = threadIdx.x; asm volatile("" : "+v"(t_));
            ret_wg(wgt, QR, KR, VR, GR, (const bf16*)(ws + WS_ST), (bf16*)(ws + WS_SBW), MIXED, args.in[4], args.in[5], (const bf16*)(ws + WS_OBR), (const float*)(ws + WS_LSE),
                   fold ? (long)wgt * 128 + F.wave * 16 : -1L, F.lds, t_, F.wave, t_ & 63); }
        if (!fold) { const int ln = fresh_lane();
          for (int row = gw; row < M; row += 4 * NGW) { const size_t rows[4] = {(size_t)row, (size_t)(row + NGW), (size_t)(row + 2 * NGW), (size_t)(row + 3 * NGW)};
              combine_rows<4>(rows, (const bf16*)(ws + WS_OBR), (const float*)(ws + WS_LSE), MIXED, ln); } }
        if (BOTH(3)) GRID_BAR(); STAMP();
    }
    for (int rep_ = 0; rep_ < REPS(4); ++rep_) if (IN(4)) {
        pg8::StaticOrder S; S.init(M / 256, DM / 256, F.G, (int)blockIdx.x);
        SrcPlain SRC{(const bf16*)(ws + WS_MIXED), (const bf16*)(ws + WS_WOUT), DM};
        EpiOutProj E{args.in[0], (bf16*)(ws + WS_HG)};
        pg8::gemm_phase<EpiOutProj, pg8::StaticOrder, SrcPlain, true, true>(F.lds, DM, S, SRC, E);
        if (BOTH(4)) GRID_BAR(); STAMP();
    }
    for (int rep_ = 0; rep_ < REPS(5); ++rep_) if (IN(5)) {
        if (rep_ > 0) { if (blockIdx.x == 0 && F.tid < NEXP) __hip_atomic_store(F.ctl + CW_CNT + 64 * F.tid, 0u, RLX_AGENT); GRID_BAR(); }
        for (int wgt = F.vcu; wgt < M / 128; wgt += F.G) { int t_ = threadIdx.x; asm volatile("" : "+v"(t_));
            route_wg(wgt, (const bf16*)(ws + WS_HG), (const bf16*)(ws + WS_WRT), args.in[10], args.in[12], F.ctl, (int*)(ws + WS_LIST), (float*)(ws + WS_GATEL), (float*)(ws + WS_RSL), F.lds, t_, F.wave, t_ & 63); }
        if (BOTH(5)) GRID_BAR(); STAMP();
    }
    for (int rep_ = 0; rep_ < REPS(6); ++rep_) if (IN(6)) {
        int ntiles; const TileTab tt = build_tiles(F, ntiles);
        pg8::StaticOrder S; S.init(ntiles, 4, F.G, (int)blockIdx.x);
        SrcGather SRC{(const bf16*)(ws + WS_HG), (const bf16*)(ws + WS_WGU), (const int*)(ws + WS_LIST), tt};
        EpiGateUp E{(bf16*)(ws + WS_HID), (const float*)(ws + WS_GATEL), (const float*)(ws + WS_RSL), tt};
        pg8::gemm_phase<EpiGateUp, pg8::StaticOrder, SrcGather, true, true>(F.lds, DM, S, SRC, E);
        if (F.G == 256) {
            const int nu = ntiles * 4, rounds = (nu + 255) >> 8, last = nu - (rounds - 1) * 256, nidle = 256 - last, bx = (int)blockIdx.x;
            if (nidle >= 32) { if (bx >= last) expert_items(args, ws, (LAS float*)(F.lds + F.wave * 16384), N_GU_ITEMS, 768 * NEXP, (bx - last) * NWAVES + F.wave, nidle * NWAVES, fresh_lane()); }
            else expert_items(args, ws, (LAS float*)(F.lds + F.wave * 16384), N_GU_ITEMS, 768 * NEXP, gw, NGW, fresh_lane());
        }
        if (BOTH(6)) GRID_BAR(); STAMP();
    }
    for (int rep_ = 0; rep_ < REPS(7); ++rep_) if (IN(7)) {
        int ntiles; const TileTab tt = build_tiles(F, ntiles);
        pg8::StaticOrder S; S.init(ntiles, 4, F.G, (int)blockIdx.x);
        SrcDown SRC{(const bf16*)(ws + WS_HID), (const bf16*)(ws + WS_WD), tt};
        EpiDown E{(bf16*)(ws + WS_Y), (const int*)(ws + WS_LIST), tt};
        pg8::gemm_phase<EpiDown, pg8::StaticOrder, SrcDown, true, true>(F.lds, FF, S, SRC, E);
        if (BOTH(7)) GRID_BAR(); STAMP();
    }
    for (int rep_ = 0; rep_ < REPS(8); ++rep_) if (IN(8)) {
        f32x4 gv[4];
#pragma unroll
        for (int j = 0; j < 4; ++j) gv[j] = ((const f32x4*)args.in[16])[fresh_lane() + 64 * j];
        { const int ln = fresh_lane();
          for (int row = gw; row < M; row += 2 * NGW) { const size_t rows[2] = {(size_t)row, (size_t)(row + NGW)}; final_rows<2>(rows, (const bf16*)(ws + WS_HG), (const bf16*)(ws + WS_Y), gv, args.out, ln); } }
#if MK_TIME
        STAMP();
        if (blockIdx.x == 0 && F.tid == 0) {
            unsigned long long ts[10];
#pragma unroll
            for (int k = 0; k < 10; ++k) ts[k] = (unsigned long long)__hip_atomic_load(F.ctl + CW_TS + 2 * k, RLX_AGENT) | ((unsigned long long)__hip_atomic_load(F.ctl + CW_TS + 2 * k + 1, RLX_AGENT) << 32);
            const float t = MK_TIME == 10 ? (float)(ts[9] - ts[0]) * 0.01f : (float)(ts[MK_TIME] - ts[MK_TIME - 1]) * 0.01f;
            VM_WAIT(); args.out[0] = t * MK_TSCALE; }
#endif
    }
#undef IN
#undef BOTH
#undef GRID_BAR
}

#if MK_CHECK
__device__ __forceinline__ unsigned hsh(unsigned x) { x ^= x >> 16; x *= 0x7feb352dU; x ^= x >> 15; x *= 0x846ca68bU; x ^= x >> 16; return x; }
__device__ __forceinline__ float ldb(const bf16* p, size_t i) { return __uint_as_float(((unsigned)p[i]) << 16); }
__device__ __forceinline__ float rbf(float x) { return bflo(pk2(x, 0.f) & 0xffffu); }
__device__ __forceinline__ void chk_put(gu32* ctl, int stage, float got, float ref, float atol) {
    float e = fabsf(got - ref) / (0.03f * fabsf(ref) + atol); if (!(e == e)) e = 1e30f; if (e > 1e30f) e = 1e30f;
    __hip_atomic_fetch_max(ctl + CW_CHK + stage, __float_as_uint(e), RLX_AGENT);
}
__global__ void __launch_bounds__(256) chk_kernel(Args A, int stage) {
    unsigned char* ws = A.ws; gu32* ctl = (gu32*)(ws + WS_CTL);
    const int gt = blockIdx.x * 256 + threadIdx.x, NT = gridDim.x * 256;
    const bf16* SEGB = (const bf16*)(ws + WS_SEG);
    const bf16 *QA = SEGB, *KA = SEGB + (size_t)1 * M * SEGW, *VA = SEGB + (size_t)2 * M * SEGW, *QR = SEGB + (size_t)3 * M * SEGW, *KR = SEGB + (size_t)4 * M * SEGW, *VR = SEGB + (size_t)5 * M * SEGW, *GR = SEGB + (size_t)6 * M * SEGW;
    if (stage == 0) {
        const bf16* WIN = (const bf16*)(ws + WS_WIN); const bf16* WOUT = (const bf16*)(ws + WS_WOUT); const bf16* WGU = (const bf16*)(ws + WS_WGU); const bf16* WD = (const bf16*)(ws + WS_WD);
        for (int s = gt; s < 65536; s += NT) { const unsigned r = hsh(s * 7 + 1), r2 = hsh(r);
            { const int n = r % NIN, k = r2 % DM; chk_put(ctl, 0, ldb(WIN, (size_t)winperm(n) * DM + k), A.in[2][(size_t)k * NIN + n], 1e-4f); }
            { const int n = r % DM, k = r2 % DM; chk_put(ctl, 0, ldb(WOUT, (size_t)n * DM + k), A.in[7][(size_t)k * DM + n] * (k < 512 ? A.in[3][k] : A.in[6][k - 512]), 1e-4f); }
            { const int j = r % 36, i = r2 % DM; const float ref = (j < 32 ? A.in[11][i * 32 + j] : A.in[9][i * 4 + j - 32]) * A.in[8][i]; chk_put(ctl, 0, 1000.f * (ldb((const bf16*)(ws + WS_WRT), j * DM + i) + ldb((const bf16*)(ws + WS_WRT), (48 + j) * DM + i)), 1000.f * ref, 1e-3f); }
            { const int pos = r % SEQ, f = r2 % 40; const float fr = f < 8 ? powf(500000.f, -(float)f / 8.f) : powf(10000.f, -(float)(f - 8) / 31.f); const float ang = (float)pos * fr;
              chk_put(ctl, 0, ((const float*)(ws + WS_ROPE))[pos * 40 + f], cosf(ang), 2e-3f); chk_put(ctl, 0, ((const float*)(ws + WS_ROPE))[SEQ * 40 + pos * 40 + f], sinf(ang), 2e-3f); }
        }
        for (int s = gt; s < 2048; s += NT) { const unsigned r = hsh(s * 13 + 5); const int row = r % M, c = hsh(r) % DM; const float* x = A.in[0] + (size_t)row * DM; float ss = 0.f;
            for (int k = 0; k < DM; ++k) ss += x[k] * x[k];
            chk_put(ctl, 0, ldb((const bf16*)(ws + WS_XN), (size_t)row * DM + c), x[c] / sqrtf(ss / DM + NORM_EPS) * A.in[1][c], 1e-3f); }
    }
    if (stage == 1) {
        const bf16* XN = (const bf16*)(ws + WS_XN);
        for (int s = gt; s < 8192; s += NT) { const unsigned r = hsh(s * 3 + 11), r2 = hsh(r); const int row = r % M, seg = r2 % 7, hh = (r2 >> 4) % 8, pos = row & (SEQ - 1);
            const int half = (seg == 0 || seg == 1) ? 8 : 32; const int i = (r2 >> 8) % half; const int d1 = i, d2 = i + half;
            float a1 = 0.f, a2 = 0.f; const float* w = A.in[2] + seg * 512 + hh * 64;
            for (int k = 0; k < DM; ++k) { const float xv = ldb(XN, (size_t)row * DM + k); a1 += xv * rbf(w[(size_t)k * NIN + d1]); a2 += xv * rbf(w[(size_t)k * NIN + d2]); }
            const bf16* O = SEGB + (size_t)seg * M * SEGW + (size_t)row * SEGW + hh * 64;
            if (seg == 0 || seg == 1 || seg == 3 || seg == 4) {
                const float fr = seg < 2 ? powf(500000.f, -(float)i / 8.f) : powf(10000.f, -(float)i / 31.f); const float ang = (float)pos * fr, c = cosf(ang), sn = sinf(ang);
                const float sc = seg == 0 ? 0.125f * LOG2E : (seg == 4 ? 0.125f : 1.f);
                chk_put(ctl, 1, ldb(O, 2 * i), (a1 * c - a2 * sn) * sc, 0.02f); chk_put(ctl, 1, ldb(O, 2 * i + 1), (a2 * c + a1 * sn) * sc, 0.02f);
                if (seg < 2) { const int d3 = 16 + (r2 >> 12) % 48; float a3 = 0.f; for (int k = 0; k < DM; ++k) a3 += ldb(XN, (size_t)row * DM + k) * rbf(w[(size_t)k * NIN + d3]); chk_put(ctl, 1, ldb(O, d3), a3 * sc, 0.02f); }
            } else { chk_put(ctl, 1, ldb(O, d1), seg == 6 ? silu_f(a1) : a1, 0.02f); chk_put(ctl, 1, ldb(O, d2), seg == 6 ? silu_f(a2) : a2, 0.02f); }
        }
    }
    if (stage == 2) {
        const bf16* OBR = (const bf16*)(ws + WS_OBR); const float* LSE = (const float*)(ws + WS_LSE); const bf16* ST = (const bf16*)(ws + WS_ST);
        for (int s = gt; s < 4096; s += NT) { const unsigned r = hsh(s * 5 + 3), r2 = hsh(r); const int b = r % NBATCH, pos = (s < 256) ? (s & 1 ? SEQ - 1 - (s >> 1) % 80 : (s >> 1) % 80) : (r >> 3) % SEQ, h = r2 % NHEAD, br = (r2 >> 3) % 3, dd = (r2 >> 8) % HD;
            const int dil = 1 << (2 * br); const size_t row = (size_t)b * SEQ + pos;
            float mx = -1e30f;
            for (int pass = 0; pass < 2; ++pass) { float l = 0.f, o = 0.f;
                for (int j = -64; j <= 64; ++j) { const int kp = pos + j * dil; if (kp < 0 || kp >= SEQ) continue; const size_t kr = (size_t)b * SEQ + kp; float d = 0.f;
                    for (int k = 0; k < HD; ++k) d += ldb(QA, row * SEGW + h * HD + k) * ldb(KA, kr * SEGW + h * HD + k);
                    if (pass == 0) mx = fmaxf(mx, d); else { const float p = exp2f(d - mx); l += p; o += p * ldb(VA, kr * SEGW + h * HD + dd); } }
                if (pass == 1) { chk_put(ctl, 2, ldb(OBR, ((size_t)br * M + row) * SEGW + h * HD + dd), o / l, 0.02f); chk_put(ctl, 2, LSE[((size_t)br * M + row) * NHEAD + h], (mx + log2f(l)) * LN2, 0.02f); } }
        }
        for (int s = gt; s < 8192; s += NT) { const unsigned r = hsh(s * 9 + 7), r2 = hsh(r); const int bh = r % 64, dir = (r >> 6) & 1, n = (r >> 7) % NCHUNK, dv = r2 % 64, dk = (r2 >> 6) % 64, b = bh >> 3, h = bh & 7;
            const float lg2 = log1pf(-exp2f((dir ? A.in[5] : A.in[4])[h])) * LOG2E; float S = 0.f;
            for (int j = 0; j < CHUNK; ++j) { const size_t row = (size_t)b * SEQ + n * CHUNK + j; const float ex = dir == 0 ? (float)(127 - j) : (float)j;
                S += exp2f(ex * lg2) * ldb(KR, row * SEGW + h * HD + dk) * ldb(VR, row * SEGW + h * HD + dv); }
            chk_put(ctl, 2, ldb(ST, (((size_t)bh * NCHUNK + n) * 2 + dir) * 4096 + ((size_t)((dv >> 5) * 4 + (dk >> 4)) * 64 + (dv & 31) + 32 * ((dk >> 3) & 1)) * 8 + (dk & 7)), S, 0.05f);
        }
    }
    if (stage == 3) {
        const bf16* MIXED = (const bf16*)(ws + WS_MIXED);
        for (int s = gt; s < 512; s += NT) { const unsigned r = hsh(s * 17 + 9), r2 = hsh(r); const int b = r % NBATCH, pos = (s < 64) ? (s & 1 ? SEQ - 1 - (s >> 1) * 5 : (s >> 1) * 5) : (r >> 3) % SEQ, h = r2 % NHEAD; const size_t row = (size_t)b * SEQ + pos;
            const float lgf = log1pf(-exp2f(A.in[4][h])) * LOG2E, lgb = log1pf(-exp2f(A.in[5][h])) * LOG2E;
            float o[HD], qv[HD];
#pragma unroll
            for (int k = 0; k < HD; ++k) { o[k] = 0.f; qv[k] = ldb(QR, row * SEGW + h * HD + k); }
            for (int kp = 0; kp < SEQ; ++kp) { const size_t kr = (size_t)b * SEQ + kp; const int dl = pos - kp; const float w = dl >= 0 ? exp2f((float)dl * lgf) : exp2f((float)(-dl) * lgb); if (w < 1e-12f) continue; float d = 0.f;
#pragma unroll
                for (int k = 0; k < HD; ++k) d += qv[k] * ldb(KR, kr * SEGW + h * HD + k);
                d *= w;
#pragma unroll
                for (int k = 0; k < HD; ++k) o[k] += d * ldb(VR, kr * SEGW + h * HD + k); }
            float mean = 0.f, var = 0.f;
#pragma unroll
            for (int k = 0; k < HD; ++k) mean += o[k];
            mean *= (1.f / HD);
#pragma unroll
            for (int k = 0; k < HD; ++k) var += (o[k] - mean) * (o[k] - mean);
            var *= (1.f / HD); const float rstd = 1.f / sqrtf(var + NORM_EPS);
#pragma unroll
            for (int k = 0; k < HD; ++k) if ((k & 7) == (int)(r2 >> 8) % 8) chk_put(ctl, 3, ldb(MIXED, row * DM + 512 + h * HD + k), (o[k] - mean) * rstd * ldb(GR, row * SEGW + h * HD + k), 0.03f);
        }
        {
            const bf16* OBR = (const bf16*)(ws + WS_OBR); const float* LSE = (const float*)(ws + WS_LSE);
            for (int s = gt; s < 4096; s += NT) { const unsigned r = hsh(s * 19 + 1), r2 = hsh(r); const int row = r % M, csel = r2 % 512; float ss = 0.f, osel = 0.f;
                for (int c = 0; c < 512; ++c) { const int h = c >> 6; const float l0 = LSE[((size_t)0 * M + row) * NHEAD + h], l1 = LSE[((size_t)1 * M + row) * NHEAD + h], l2 = LSE[((size_t)2 * M + row) * NHEAD + h];
                    const float mx = fmaxf(l0, fmaxf(l1, l2)), w0 = expf(l0 - mx), w1 = expf(l1 - mx), w2 = expf(l2 - mx);
                    const float o = (w0 * ldb(OBR, ((size_t)0 * M + row) * SEGW + c) + w1 * ldb(OBR, ((size_t)1 * M + row) * SEGW + c) + w2 * ldb(OBR, ((size_t)2 * M + row) * SEGW + c)) / (w0 + w1 + w2);
                    ss += o * o; if (c == csel) osel = o; }
                chk_put(ctl, 3, ldb(MIXED, (size_t)row * DM + csel), osel / sqrtf(ss / 512.f + NORM_EPS), 0.03f); }
        }
    }
    if (stage == 4) {
        const bf16* MIXED = (const bf16*)(ws + WS_MIXED); const bf16* WOUT = (const bf16*)(ws + WS_WOUT); const float* H = (const float*)(ws + WS_H); const bf16* HG = (const bf16*)(ws + WS_HG);
        for (int s = gt; s < 16384; s += NT) { const unsigned r = hsh(s * 23 + 3); const int row = r % M, c = hsh(r) % DM; float a = 0.f;
            for (int k = 0; k < DM; ++k) a += ldb(MIXED, (size_t)row * DM + k) * ldb(WOUT, (size_t)c * DM + k);
            const float h = a + A.in[0][(size_t)row * DM + c]; chk_put(ctl, 4, ldb(HG, (size_t)row * DM + c), h, 0.02f); (void)H; }
    }
    if (stage == 5) { const bf16* WGU = (const bf16*)(ws + WS_WGU);
        for (int s = gt; s < 65536; s += NT) { const unsigned r = hsh(s * 7 + 1), r2 = hsh(r);
            { const int e = (r >> 10) % NEXP, j = r % FF, k = r2 % DM;
              chk_put(ctl, 5, ldb(WGU, ((size_t)e * DM + ((j >> 7) << 8) + (j & 127)) * DM + k), A.in[13][((size_t)e * DM + k) * FF + j] * A.in[8][k], 1e-4f);
              chk_put(ctl, 5, ldb(WGU, ((size_t)e * DM + ((j >> 7) << 8) + 128 + (j & 127)) * DM + k), A.in[14][((size_t)e * DM + k) * FF + j] * A.in[8][k], 1e-4f); }
        } }
    if (stage == 5) {
        const float* H = (const float*)(ws + WS_H); const int* LIST = (const int*)(ws + WS_LIST); const float* GATEL = (const float*)(ws + WS_GATEL); const float* RSL = (const float*)(ws + WS_RSL);
        if (gt == 0) { unsigned tot = 0; for (int e = 0; e < NEXP; ++e) tot += ctl[CW_CNT + 64 * e]; chk_put(ctl, 5, (float)tot, (float)(2 * M), 0.5f); }
        const bf16* HBc = (const bf16*)(ws + WS_HG); (void)H;
        for (int s = gt; s < 2048; s += NT) { const int t = hsh(s * 29 + 5) % M; const bf16* h_ = HBc + (size_t)t * DM; float ss = 0.f;
#define h_AT(k) ldb(h_, (k))
            for (int k = 0; k < DM; ++k) ss += h_AT(k) * h_AT(k);
            const float rs = 1.f / sqrtf(ss / DM + NORM_EPS); float gl[4]; int gi = 0;
            for (int g = 0; g < 4; ++g) { float a = 0.f; for (int k = 0; k < DM; ++k) a += h_AT(k) * rs * A.in[8][k] * A.in[9][k * 4 + g]; gl[g] = a + A.in[10][g]; if (gl[g] > gl[gi]) gi = g; }
            float den = 0.f; for (int g = 0; g < 4; ++g) den += expf(gl[g] - gl[gi]);
            float b1 = -3e38f, b2 = -3e38f, b3 = -3e38f; int i1 = 0, i2 = 0;
            for (int e = 0; e < 8; ++e) { float a = 0.f; for (int k = 0; k < DM; ++k) a += h_AT(k) * rs * A.in[8][k] * A.in[11][k * 32 + gi * 8 + e]; a += A.in[12][gi * 8 + e];
                if (a > b1) { b3 = b2; b2 = b1; i2 = i1; b1 = a; i1 = e; } else if (a > b2) { b3 = b2; b2 = a; i2 = e; } else if (a > b3) b3 = a; }
            float second = -3e38f; for (int g = 0; g < 4; ++g) if (g != gi) second = fmaxf(second, gl[g]);
            if (gl[gi] - second < 1e-3f || b2 - b3 < 1e-3f || b1 - b2 < 1e-3f) continue;
            const float p1 = 1.f / (1.f + expf(b2 - b1)); const float g1 = p1 / den, g2 = (1.f - p1) / den;
            for (int k = 0; k < 2; ++k) { const int e = gi * 8 + (k ? i2 : i1); const int n = (int)ctl[CW_CNT + 64 * e]; int found = -1;
                for (int p = 0; p < n && p < M; ++p) if (LIST[(size_t)e * M + p] == t * 2 + k) { found = p; break; }
                if (found < 0) chk_put(ctl, 5, 0.f, 100.f, 0.1f); else { chk_put(ctl, 5, GATEL[(size_t)e * M + found], k ? g2 : g1, 1e-3f); chk_put(ctl, 5, RSL[(size_t)e * M + found], rs, 1e-4f); } }
        }
    }
    if (stage == 6) { const bf16* WD = (const bf16*)(ws + WS_WD);
        for (int s = gt; s < 65536; s += NT) { const unsigned r = hsh(s * 7 + 1), r2 = hsh(r);
            { const int e = (r >> 10) % NEXP, n = r % DM, k = r2 % FF; chk_put(ctl, 6, ldb(WD, ((size_t)e * DM + n) * FF + k), A.in[15][((size_t)e * FF + k) * DM + n], 1e-4f); }
        } }
    if (stage == 6 || stage == 7) {
        const int* LIST = (const int*)(ws + WS_LIST); const float* GATEL = (const float*)(ws + WS_GATEL); const float* RSL = (const float*)(ws + WS_RSL);
        const bf16* HG = (const bf16*)(ws + WS_HG); const bf16* WGU = (const bf16*)(ws + WS_WGU); const bf16* HID = (const bf16*)(ws + WS_HID); const bf16* WD = (const bf16*)(ws + WS_WD); const bf16* Y = (const bf16*)(ws + WS_Y);
        for (int s = gt; s < 8192; s += NT) { const unsigned r = hsh(s * 31 + 7), r2 = hsh(r); const int e = r % NEXP; const int ne = (int)ctl[CW_CNT + 64 * e]; if (ne <= 0) continue;
            int t0 = 0; for (int q = 0; q < e; ++q) t0 += ((int)ctl[CW_CNT + 64 * q] + 255) >> 8;
            const int pos = (s & 3) == 0 ? ne - 1 - (int)((r >> 5) % (ne < 300 ? ne : 300)) : (int)((r >> 5) % ne); const size_t slot = (size_t)t0 * 256 + pos; const int tk = LIST[(size_t)e * M + pos], t = tk >> 1;
            if (stage == 6) { const int j = r2 % FF; float g = 0.f, u = 0.f; const bf16* wg = WGU + ((size_t)e * DM + ((j >> 7) << 8) + (j & 127)) * DM; const bf16* wu = wg + (size_t)128 * DM;
                for (int k = 0; k < DM; ++k) { const float xv = ldb(HG, (size_t)t * DM + k); g += xv * ldb(wg, k); u += xv * ldb(wu, k); }
                const float rs = RSL[(size_t)e * M + pos]; chk_put(ctl, 6, ldb(HID, slot * FF + j), silu_f(g * rs) * (u * rs) * GATEL[(size_t)e * M + pos], 0.01f); }
            else { const int c = r2 % DM; float a = 0.f; for (int k = 0; k < FF; ++k) a += ldb(HID, slot * FF + k) * ldb(WD, ((size_t)e * DM + c) * FF + k);
                chk_put(ctl, 7, ldb(Y, (size_t)tk * DM + c), a, 0.01f); }
        }
    }
    if (stage == 8) {
        const float* H = (const float*)(ws + WS_H); const bf16* Y = (const bf16*)(ws + WS_Y);
        for (int s = gt; s < 4096; s += NT) { const unsigned r = hsh(s * 37 + 1); const int row = r % M, c = hsh(r) % DM; float ss = 0.f, zc = 0.f;
            for (int k = 0; k < DM; ++k) { const float z = ldb((const bf16*)(ws + WS_HG), (size_t)row * DM + k) + ldb(Y, (size_t)(2 * row) * DM + k) + ldb(Y, (size_t)(2 * row + 1) * DM + k); (void)H; ss += z * z; if (k == c) zc = z; }
            chk_put(ctl, 8, A.out[(size_t)row * DM + c], zc / sqrtf(ss / DM + NORM_EPS) * A.in[16][c], 0.01f); }
    }
}
__global__ void __launch_bounds__(256) chk_final(Args A) {
    gu32* ctl = (gu32*)(A.ws + WS_CTL); int bad = -1; float err = 0.f;
    for (int s = 0; s < 9; ++s) { const float e = __uint_as_float(ctl[CW_CHK + s]); if (e > 1.f) { bad = s; err = e; break; } }
    if (bad < 0 && ctl[CW_BAR + XB_TMO] != 0u) { bad = 10; err = 1.f; }
    if (bad < 0) return;
    float mant = 1.f + log10f(err); if (mant > 9.9f) mant = 9.9f; if (mant < 1.f) mant = 1.f;
    const float C = sqrtf(mant * powf(10.f, (float)(bad + 3)));
    for (size_t i = blockIdx.x * 256 + threadIdx.x; i < (size_t)M * DM; i += (size_t)gridDim.x * 256) A.out[i] = C;
}
#endif

extern "C" void kernel_launch(void* const* d_in, const int* in_sizes, int n_in, void* d_out, int out_size, void* d_ws, size_t ws_size, hipStream_t stream) {
    static int grid = 0;
    if (grid == 0) {
        if (n_in != 17 || in_sizes[0] != M * DM || out_size != M * DM || ws_size < WS_END) { fprintf(stderr, "kernel_launch: unexpected shapes (n_in %d, in0 %d, out %d, ws %zu); nothing launched\n", n_in, n_in > 0 ? in_sizes[0] : -1, out_size, ws_size); grid = -1; return; }
        int dev = 0, cus = 0, per_cu = 0;
        if (hipGetDevice(&dev) != hipSuccess || hipDeviceGetAttribute(&cus, hipDeviceAttributeMultiprocessorCount, dev) != hipSuccess) { grid = -1; return; }
        if (hipFuncSetAttribute((const void*)mk_fwd, hipFuncAttributeMaxDynamicSharedMemorySize, LDS_BYTES) != hipSuccess) { fprintf(stderr, "kernel_launch: hipFuncSetAttribute failed\n"); grid = -1; return; }
        if (hipOccupancyMaxActiveBlocksPerMultiprocessor(&per_cu, (const void*)mk_fwd, NWAVES * 64, LDS_BYTES) != hipSuccess || per_cu < 1) { fprintf(stderr, "kernel_launch: occupancy query says %d blocks per CU; nothing launched\n", per_cu); (void)hipGetLastError(); grid = -1; return; }
        grid = cus;
    }
    if (grid < 0) return;
    if (hipMemsetAsync((char*)d_ws + WS_CTL, 0, CTL_ZERO_BYTES, stream) != hipSuccess) { fprintf(stderr, "kernel_launch: memset failed\n"); return; }
    Args a{};
    for (int i = 0; i < 17; ++i) a.in[i] = (const float*)d_in[i];
    a.out = (float*)d_out; a.ws = (unsigned char*)d_ws;
    const double TWO_PI = 6.283185307179586476925286766559;
    for (int i = 0; i < 8; ++i) a.frev[i] = std::pow(500000.0, -(double)i / 8.0) / TWO_PI;
    for (int i = 0; i < 32; ++i) a.frev[8 + i] = std::pow(10000.0, -(double)i / 31.0) / TWO_PI;
    if (N_LAUNCHES == 1) {
        a.ph_lo = 0; a.ph_hi = PER_PHASE; a.li = 0;
#if MK_COOP
        void* kargs[] = {&a};
        const hipError_t le = hipLaunchCooperativeKernel((const void*)mk_fwd, dim3(grid), dim3(NWAVES * 64), kargs, LDS_BYTES, stream);
        if (le != hipSuccess) fprintf(stderr, "kernel_launch: cooperative launch failed: %s (grid %d)\n", hipGetErrorName(le), grid);
#else
        hipLaunchKernelGGL(mk_fwd, dim3(grid), dim3(NWAVES * 64), LDS_BYTES, stream, a);
#endif
    } else {
        for (int li = 0; li < PER_PHASE; ++li) {
            a.ph_lo = li; a.ph_hi = li + 1; a.li = 0;
            hipLaunchKernelGGL(mk_fwd, dim3(grid), dim3(NWAVES * 64), LDS_BYTES, stream, a);
#if MK_CHECK
            hipLaunchKernelGGL(chk_kernel, dim3(256), dim3(256), 0, stream, a, li);
#endif
        }
#if MK_CHECK
        hipLaunchKernelGGL(chk_final, dim3(1024), dim3(256), 0, stream, a);
#endif
    }
}
```
